# Optimizing an MI355X kernel written in HIP

```python
import jax
import jax.numpy as jnp
from jax import lax
import numpy as np

D_MODEL = 1024
BATCH = 4
SEQ = 4096
DEPTH = 2

GRID_W = 64
CTX_LEN = 256
HEAD_DIM = 64
DN_HEADS = 6
ATTN_HEADS = 6
ATTN_KV_HEADS = 2
ATTN_GROUP = ATTN_HEADS // ATTN_KV_HEADS
MLP_GROUPS = 4
DN_WIDTH = DN_HEADS * HEAD_DIM
ATTN_WIDTH = ATTN_HEADS * HEAD_DIM
ATTN_KV_WIDTH = ATTN_KV_HEADS * HEAD_DIM
MLP_WIDTH = MLP_GROUPS * HEAD_DIM
D_MIX = DN_WIDTH + ATTN_WIDTH + MLP_WIDTH
SPLIT_SIZES = (3 * DN_WIDTH, DN_WIDTH, 2 * DN_HEADS, 2 * DN_HEADS, ATTN_WIDTH, ATTN_KV_WIDTH, ATTN_KV_WIDTH, MLP_WIDTH, MLP_WIDTH)
IN_COLS = 3 * DN_WIDTH + DN_WIDTH + 4 * DN_HEADS + ATTN_WIDTH + 2 * ATTN_KV_WIDTH + 2 * MLP_WIDTH
CONV_K = 3
DN_CHUNK = 64
ATTN_BLOCK = 128
ATTN_SCALE = HEAD_DIM ** -0.5
MLP_CHUNK = 128
ROPE_THETA = 10000.0
ROPE_AXIS_DIM = HEAD_DIM // 2
ROPE_PAIRS = ROPE_AXIS_DIM // 2
D_FF = 2816
MOE_EXPERTS = 8
MOE_TOP_K = 2
MOE_D_FF = 3584
MOE_BLOCK = 256
N_DENSE = (DEPTH + 1) // 2
N_MOE = DEPTH // 2
NORM_EPS = 1e-6

kernel_name = 'hybrid_dit_deltanet_gqa_sgu_moe'


def rms_norm(x, gain):
    xf = x.astype(jnp.float32)
    y = xf * lax.rsqrt(jnp.mean(xf * xf, axis=-1, keepdims=True) + NORM_EPS)
    return (y * gain.astype(jnp.float32)).astype(x.dtype)


def ada_rms_norm(x, gain, shift, scale):
    xf = x.astype(jnp.float32)
    y = xf * lax.rsqrt(jnp.mean(xf * xf, axis=-1, keepdims=True) + NORM_EPS) * gain.astype(jnp.float32)
    return (y * (1.0 + scale.astype(jnp.float32)) + shift.astype(jnp.float32)).astype(x.dtype)


def l2_normalize(x):
    return x * lax.rsqrt(jnp.sum(x * x, axis=-1, keepdims=True) + NORM_EPS)


def split_columns(z):
    idx = np.cumsum(SPLIT_SIZES)[:-1].tolist()
    return jnp.split(z, idx, axis=-1)


def _rev(t, flag):
    return jnp.flip(t, axis=1) if flag else t


def centred_depthwise_conv(x, w):
    return lax.conv_general_dilated(x, w[:, None, :].astype(x.dtype), window_strides=(1,),
                                    padding=[(CONV_K // 2, CONV_K // 2)],
                                    dimension_numbers=('NWC', 'WIO', 'NWC'),
                                    feature_group_count=x.shape[-1])


def axial_rope_tables(n_tokens):
    rows = n_tokens // GRID_W
    row = jnp.repeat(jnp.arange(rows, dtype=jnp.float32), GRID_W)
    col = jnp.tile(jnp.arange(GRID_W, dtype=jnp.float32), rows)
    inv = ROPE_THETA ** (-2.0 * jnp.arange(ROPE_PAIRS, dtype=jnp.float32) / ROPE_AXIS_DIM)
    ang = jnp.stack([row[:, None] * inv, col[:, None] * inv], axis=1)
    return jnp.cos(ang), jnp.sin(ang)


def apply_axial_rope(x, cos, sin):
    xr = x.reshape(x.shape[:-1] + (2, 2, ROPE_PAIRS))
    a, b = xr[..., 0, :], xr[..., 1, :]
    c = cos[None, :, None].astype(x.dtype)
    s = sin[None, :, None].astype(x.dtype)
    out = jnp.stack([a * c - b * s, a * s + b * c], axis=-2)
    return out.reshape(x.shape)


def chunk_gated_delta(q, k, v, g, beta, state):
    B, T, H, Dk = q.shape
    Dv = v.shape[-1]
    n = T // DN_CHUNK

    def chunks(t):
        t = t.reshape((B, n, DN_CHUNK, H) + t.shape[3:])
        return jnp.moveaxis(jnp.moveaxis(t, 3, 2), 1, 0)

    qc, kc, vc = chunks(q), chunks(k), chunks(v)
    gc = jnp.cumsum(chunks(g), axis=-1)
    bc = chunks(beta)[..., None]
    incl = jnp.tril(jnp.ones((DN_CHUNK, DN_CHUNK), bool))
    strict = jnp.tril(jnp.ones((DN_CHUNK, DN_CHUNK), bool), -1)
    decay = jnp.exp(jnp.where(incl, gc[..., :, None] - gc[..., None, :], -jnp.inf))
    kb = kc * bc
    a_mat = jnp.where(strict, jnp.einsum('nbhid,nbhjd->nbhij', kb, kc) * decay, 0.0)
    rhs = jnp.concatenate([vc * bc, kb * jnp.exp(gc)[..., None]], axis=-1)
    sol = lax.linalg.triangular_solve(a_mat, rhs, left_side=True, lower=True, unit_diagonal=True)
    u, w = sol[..., :Dv], sol[..., Dv:]
    attn = jnp.einsum('nbhid,nbhjd->nbhij', qc, kc) * decay

    def step(S, xs):
        q_i, k_i, u_i, w_i, g_i, a_i = xs
        v_new = u_i - jnp.einsum('bhcd,bhde->bhce', w_i, S)
        o_i = (jnp.einsum('bhcd,bhde->bhce', q_i * jnp.exp(g_i)[..., None], S)
               + jnp.einsum('bhij,bhje->bhie', a_i, v_new))
        g_last = g_i[..., -1:]
        S = (S * jnp.exp(g_last)[..., None]
             + jnp.einsum('bhcd,bhce->bhde', k_i * jnp.exp(g_last - g_i)[..., None], v_new))
        return S, o_i

    S, o = lax.scan(step, state, (qc, kc, u, w, gc, attn))
    o = jnp.swapaxes(jnp.moveaxis(o, 0, 1), 2, 3).reshape(B, T, H, Dv)
    return o, S


def dn_inputs(z_qkv, z_beta, z_alpha, conv_w, a_log, dt_bias):
    B, T, _ = z_qkv.shape
    qkv = jax.nn.silu(centred_depthwise_conv(z_qkv, conv_w)).astype(jnp.float32)
    qkv = qkv.reshape(B, T, 3, DN_HEADS, HEAD_DIM)
    q = l2_normalize(qkv[:, :, 0]) * (HEAD_DIM ** -0.5)
    k = l2_normalize(qkv[:, :, 1])
    v = qkv[:, :, 2]
    beta = jax.nn.sigmoid(z_beta.astype(jnp.float32)).reshape(B, T, 2, DN_HEADS)
    g = -jnp.exp(a_log.astype(jnp.float32)) * jax.nn.softplus(
        z_alpha.astype(jnp.float32).reshape(B, T, 2, DN_HEADS) + dt_bias.astype(jnp.float32))
    return q, k, v, g, beta


def dn_bidirectional(ctx_in, lat_in):
    qc, kc, vc, gc, bc = ctx_in
    ql, kl, vl, gl, bl = lat_in
    B, _, H, Dk = qc.shape
    o_ctx, o_lat = [], []
    for d in range(2):
        rev = d == 1
        s0 = jnp.zeros((B, H, Dk, vc.shape[-1]), jnp.float32)
        oc, s_ctx = chunk_gated_delta(_rev(qc, rev), _rev(kc, rev), _rev(vc, rev),
                                      _rev(gc[:, :, d], rev), _rev(bc[:, :, d], rev), s0)
        ol, _ = chunk_gated_delta(_rev(ql, rev), _rev(kl, rev), _rev(vl, rev),
                                  _rev(gl[:, :, d], rev), _rev(bl[:, :, d], rev), s_ctx)
        o_ctx.append(_rev(oc, rev))
        o_lat.append(_rev(ol, rev))
    return o_ctx[0] + o_ctx[1], o_lat[0] + o_lat[1]


def dn_output(o, z_gate, norm_g):
    B, T, H, D = o.shape
    gate = jax.nn.silu(z_gate.astype(jnp.float32)).reshape(B, T, H, D)
    return (rms_norm(o, norm_g) * gate).reshape(B, T, H * D).astype(z_gate.dtype)


def attn_heads(zq, zk, zv, q_gain, k_gain):
    B, T, _ = zq.shape
    q = rms_norm(zq.reshape(B, T, ATTN_HEADS, HEAD_DIM), q_gain)
    k = rms_norm(zk.reshape(B, T, ATTN_KV_HEADS, HEAD_DIM), k_gain)
    v = zv.reshape(B, T, ATTN_KV_HEADS, HEAD_DIM)
    return q, k, v


def context_attention(q, k, v):
    B, L, H, D = q.shape
    qg = q.reshape(B, L, ATTN_KV_HEADS, ATTN_GROUP, D)
    s = jnp.einsum('bqhgd,bkhd->bhgqk', qg, k, preferred_element_type=jnp.float32) * ATTN_SCALE
    p = jax.nn.softmax(s, axis=-1).astype(v.dtype)
    return jnp.einsum('bhgqk,bkhd->bqhgd', p, v).reshape(B, L, H * D)


def latent_attention(q, k, v, k_ctx, v_ctx):
    B, S, H, D = q.shape
    k_all = jnp.concatenate([k_ctx, k], axis=1)
    v_all = jnp.concatenate([v_ctx, v], axis=1)
    qb = jnp.moveaxis(q.reshape(B, S // ATTN_BLOCK, ATTN_BLOCK, ATTN_KV_HEADS, ATTN_GROUP, D), 1, 0)

    def attend(q_blk):
        s = jnp.einsum('bqhgd,bkhd->bhgqk', q_blk, k_all, preferred_element_type=jnp.float32) * ATTN_SCALE
        p = jax.nn.softmax(s, axis=-1).astype(v_all.dtype)
        return jnp.einsum('bhgqk,bkhd->bqhgd', p, v_all)

    o = lax.map(attend, qb)
    return jnp.moveaxis(o, 0, 1).reshape(B, S, H * D)


def spatial_gating(z_u, z_v, norm_g, w_s, b_s):
    B, T, _ = z_u.shape
    gd = MLP_WIDTH // MLP_GROUPS
    u = jax.nn.gelu(z_u)
    v = rms_norm(jax.nn.gelu(z_v).reshape(B, T, MLP_GROUPS, gd), norm_g.reshape(MLP_GROUPS, gd))
    v = v.reshape(B, T // MLP_CHUNK, MLP_CHUNK, MLP_GROUPS, gd)
    mixed = jnp.einsum('gij,bnjgd->bnigd', w_s.astype(v.dtype), v) + b_s.T[None, None, :, :, None].astype(v.dtype)
    return u * mixed.reshape(B, T, MLP_WIDTH)


def token_mixer(h, hc, with_ctx_out, w_in, conv_w, dn_a_log, dn_dt_bias, dn_norm_g, q_norm_g, k_norm_g,
                sgu_norm_g, sgu_w, sgu_b, w_out, rope_cos, rope_sin):
    z = split_columns(h @ w_in)
    zc = split_columns(hc @ w_in)
    dn_lat = dn_inputs(z[0], z[2], z[3], conv_w, dn_a_log, dn_dt_bias)
    dn_ctx = dn_inputs(zc[0], zc[2], zc[3], conv_w, dn_a_log, dn_dt_bias)
    o_ctx, o_lat = dn_bidirectional(dn_ctx, dn_lat)
    q, k, v = attn_heads(z[4], z[5], z[6], q_norm_g, k_norm_g)
    q = apply_axial_rope(q, rope_cos, rope_sin)
    k = apply_axial_rope(k, rope_cos, rope_sin)
    q_c, k_c, v_c = attn_heads(zc[4], zc[5], zc[6], q_norm_g, k_norm_g)
    mixed = jnp.concatenate([dn_output(o_lat, z[1], dn_norm_g),
                             latent_attention(q, k, v, k_c, v_c),
                             spatial_gating(z[7], z[8], sgu_norm_g, sgu_w, sgu_b)], axis=-1)
    y = mixed @ w_out
    if not with_ctx_out:
        return y, None
    mixed_c = jnp.concatenate([dn_output(o_ctx, zc[1], dn_norm_g),
                               context_attention(q_c, k_c, v_c),
                               spatial_gating(zc[7], zc[8], sgu_norm_g, sgu_w, sgu_b)], axis=-1)
    return y, mixed_c @ w_out


def swiglu(h, w1, w3, w2):
    return (jax.nn.silu(h @ w1) * (h @ w3)) @ w2


def moe_swiglu(h, router_w, router_b, w1, w3, w2):
    shape = h.shape
    t = h.reshape(-1, shape[-1])
    n = t.shape[0]
    logits = jnp.einsum('nd,de->ne', t, router_w, preferred_element_type=jnp.float32) + router_b.astype(jnp.float32)
    top_logit, top_idx = lax.top_k(logits, MOE_TOP_K)
    gates = jax.nn.softmax(top_logit, axis=-1)
    n_assign = n * MOE_TOP_K
    expert = top_idx.reshape(-1)
    token = jnp.repeat(jnp.arange(n, dtype=jnp.int32), MOE_TOP_K)
    order = jnp.argsort(expert)
    e_sorted, tok_sorted, gate_sorted = expert[order], token[order], gates.reshape(-1)[order]
    counts = jnp.bincount(expert, length=MOE_EXPERTS)
    padded = (counts + MOE_BLOCK - 1) // MOE_BLOCK * MOE_BLOCK
    starts = jnp.cumsum(counts) - counts
    pad_ends = jnp.cumsum(padded)
    pad_starts = pad_ends - padded
    dest = pad_starts[e_sorted] + jnp.arange(n_assign, dtype=jnp.int32) - starts[e_sorted]
    n_blocks = -(-(n_assign + MOE_EXPERTS * (MOE_BLOCK - 1)) // MOE_BLOCK)
    slot_token = jnp.full((n_blocks * MOE_BLOCK,), n, jnp.int32).at[dest].set(tok_sorted)
    block_expert = jnp.minimum(jnp.searchsorted(pad_ends, jnp.arange(n_blocks) * MOE_BLOCK, side='right'),
                               MOE_EXPERTS - 1)
    t_pad = jnp.concatenate([t, jnp.zeros((1, t.shape[1]), t.dtype)], axis=0)
    xb = t_pad[slot_token].reshape(n_blocks, MOE_BLOCK, t.shape[1])

    def expert_block(args):
        xi, e = args
        return swiglu(xi, w1[e], w3[e], w2[e])

    yb = lax.map(expert_block, (xb, block_expert)).reshape(n_blocks * MOE_BLOCK, t.shape[1])
    y = jnp.zeros_like(t).at[tok_sorted].add(yb[dest] * gate_sorted[:, None].astype(t.dtype))
    return y.reshape(shape)


def channel_mixer(h, layer, ffn_w1, ffn_w3, ffn_w2, router_w, router_b, moe_w1, moe_w3, moe_w2):
    i = layer // 2
    if layer % 2 == 0:
        return swiglu(h, ffn_w1[i], ffn_w3[i], ffn_w2[i])
    return moe_swiglu(h, router_w[i], router_b[i], moe_w1[i], moe_w3[i], moe_w2[i])


def setup_inputs(seed: int = 0) -> dict:
    key = jax.random.key(seed)
    ks = iter(jax.random.split(key, 32))

    def nrm(shape, scale):
        return jax.random.normal(next(ks), shape, jnp.float32) * scale

    def gain(shape):
        return 1.0 + nrm(shape, 0.02)

    dt = jnp.exp(jax.random.uniform(next(ks), (DEPTH, 2, DN_HEADS), jnp.float32, np.log(1e-3), np.log(1e-1)))
    return {
        'x': nrm((BATCH, SEQ, D_MODEL), 1.0),
        'c': nrm((BATCH, D_MODEL), 1.0),
        'ctx': nrm((BATCH, CTX_LEN, D_MODEL), 1.0),
        'c_ctx': nrm((D_MODEL,), 1.0),
        'mod_w': nrm((DEPTH, D_MODEL, 6 * D_MODEL), 0.5 * D_MODEL ** -0.5),
        'mod_b': nrm((DEPTH, 6 * D_MODEL), 0.02),
        'norm1_g': gain((DEPTH, D_MODEL)),
        'norm2_g': gain((DEPTH, D_MODEL)),
        'w_in': nrm((DEPTH, D_MODEL, IN_COLS), D_MODEL ** -0.5),
        'conv_w': nrm((DEPTH, CONV_K, 3 * DN_WIDTH), CONV_K ** -0.5),
        'dn_a_log': jnp.log(jax.random.uniform(next(ks), (DEPTH, 2, DN_HEADS), jnp.float32, 1.0, 16.0)),
        'dn_dt_bias': dt + jnp.log(-jnp.expm1(-dt)),
        'dn_norm_g': gain((DEPTH, HEAD_DIM)),
        'q_norm_g': gain((DEPTH, HEAD_DIM)),
        'k_norm_g': gain((DEPTH, HEAD_DIM)),
        'sgu_norm_g': gain((DEPTH, MLP_WIDTH)),
        'sgu_w': nrm((DEPTH, MLP_GROUPS, MLP_CHUNK, MLP_CHUNK), MLP_CHUNK ** -0.5),
        'sgu_b': gain((DEPTH, MLP_GROUPS, MLP_CHUNK)),
        'w_out': nrm((DEPTH, D_MIX, D_MODEL), D_MIX ** -0.5),
        'ffn_w1': nrm((N_DENSE, D_MODEL, D_FF), D_MODEL ** -0.5),
        'ffn_w3': nrm((N_DENSE, D_MODEL, D_FF), D_MODEL ** -0.5),
        'ffn_w2': nrm((N_DENSE, D_FF, D_MODEL), D_FF ** -0.5),
        'router_w': nrm((N_MOE, D_MODEL, MOE_EXPERTS), D_MODEL ** -0.5),
        'router_b': nrm((N_MOE, MOE_EXPERTS), 0.01),
        'moe_w1': nrm((N_MOE, MOE_EXPERTS, D_MODEL, MOE_D_FF), D_MODEL ** -0.5),
        'moe_w3': nrm((N_MOE, MOE_EXPERTS, D_MODEL, MOE_D_FF), D_MODEL ** -0.5),
        'moe_w2': nrm((N_MOE, MOE_EXPERTS, MOE_D_FF, D_MODEL), MOE_D_FF ** -0.5),
        'final_norm_g': gain((D_MODEL,)),
    }


def reference(x, c, ctx, c_ctx, mod_w, mod_b, norm1_g, norm2_g, w_in, conv_w, dn_a_log, dn_dt_bias, dn_norm_g,
              q_norm_g, k_norm_g, sgu_norm_g, sgu_w, sgu_b, w_out, ffn_w1, ffn_w3, ffn_w2, router_w, router_b,
              moe_w1, moe_w3, moe_w2, final_norm_g):
    rope_cos, rope_sin = axial_rope_tables(x.shape[1])
    cond = jax.nn.silu(c)[:, None, :]
    cond_ctx = jax.nn.silu(c_ctx)[None, None, :]
    xc = ctx
    for layer in range(DEPTH):
        last = layer == DEPTH - 1
        mod = jnp.split(cond @ mod_w[layer] + mod_b[layer], 6, axis=-1)
        mod_c = jnp.split(cond_ctx @ mod_w[layer] + mod_b[layer], 6, axis=-1)
        h = ada_rms_norm(x, norm1_g[layer], mod[0], mod[1])
        hc = ada_rms_norm(xc, norm1_g[layer], mod_c[0], mod_c[1])
        y, yc = token_mixer(h, hc, not last, w_in[layer], conv_w[layer], dn_a_log[layer], dn_dt_bias[layer],
                            dn_norm_g[layer], q_norm_g[layer], k_norm_g[layer], sgu_norm_g[layer], sgu_w[layer],
                            sgu_b[layer], w_out[layer], rope_cos, rope_sin)
        x = x + mod[2] * y
        h = ada_rms_norm(x, norm2_g[layer], mod[3], mod[4])
        x = x + mod[5] * channel_mixer(h, layer, ffn_w1, ffn_w3, ffn_w2, router_w, router_b, moe_w1, moe_w3, moe_w2)
        if not last:
            xc = xc + mod_c[2] * yc
            hc = ada_rms_norm(xc, norm2_g[layer], mod_c[3], mod_c[4])
            xc = xc + mod_c[5] * channel_mixer(hc, layer, ffn_w1, ffn_w3, ffn_w2, router_w, router_b,
                                               moe_w1, moe_w3, moe_w2)
    return rms_norm(x, final_norm_g)
```

```cpp
#include <hip/hip_runtime.h>
#include <hip/hip_cooperative_groups.h>
#include <hip/hip_bf16.h>
#include <cstdio>
#include <cstdint>
namespace cg = cooperative_groups;

#define DEVI __device__ __forceinline__
typedef unsigned short bf16_t;
typedef float f32x4 __attribute__((ext_vector_type(4)));
typedef float f32x2 __attribute__((ext_vector_type(2)));
typedef unsigned u32x4 __attribute__((ext_vector_type(4)));
typedef unsigned u32x2 __attribute__((ext_vector_type(2)));

constexpr int D = 1024, NB = 4, SEQ = 4096, CTXL = 256;
constexpr int NLAT = NB * SEQ, NCTX = NB * CTXL, NT = NLAT + NCTX;
constexpr int SKV = CTXL + SEQ;
constexpr int INC = 2712, ZP = 2816;
constexpr int ZC_QKV = 0, ZC_GATE = 1152, ZC_AQ = 1536, ZC_AK = 1920, ZC_AV = 2048, ZC_MU = 2176, ZC_MV = 2432, ZC_BETA = 2688, ZC_ALPHA = 2700;
constexpr int FF = 2816, MFF = 3584, NE = 8;
constexpr int MAXSLOT = 34816;
constexpr float EPS = 1e-6f;
constexpr float QSCALE = 0.125f * 1.4426950408889634f;

constexpr size_t MiB = 1u << 20, KiB = 1024;
constexpr size_t WS_CTL = 0;
constexpr size_t CTL_ROPE = 32 * KiB;
constexpr size_t CTL_MODV = 64 * KiB;
constexpr size_t CTL_TOPE = 320 * KiB;
constexpr size_t CTL_TOPG = 448 * KiB;
constexpr size_t CTL_CNT = 576 * KiB;
constexpr size_t CTL_SEG = 584 * KiB;
constexpr size_t CTL_TOKSLOT = 592 * KiB;
constexpr size_t CTL_UTAB = 720 * KiB;
constexpr size_t WS_XB = 4 * MiB;
constexpr size_t WS_WL = 72 * MiB;
constexpr size_t WL_WIN = 0;
constexpr size_t WL_WOUT = 11 * MiB;
constexpr size_t WL_F13 = 15 * MiB;
constexpr size_t WL_F2 = 26 * MiB;
static_assert(WL_WIN + (size_t)2 * 2816 * 1024 * 2 <= WL_WOUT && WL_WOUT + (size_t)2 * 1024 * 1024 * 2 <= WL_F13 && WL_F13 + (size_t)5632 * 1024 * 2 <= WL_F2 && WS_WL + WL_F2 + (size_t)1024 * 2816 * 2 <= 104 * MiB, "WL map");
constexpr size_t WS_H = 104 * MiB;
constexpr size_t WS_Z = 138 * MiB;
constexpr size_t WS_MIX = 232 * MiB;
constexpr size_t WS_QA = 266 * MiB;
constexpr size_t WS_QC = 278 * MiB;
constexpr size_t WS_KA = 279 * MiB;
constexpr size_t WS_VA = 284 * MiB;
constexpr size_t WS_DN = 289 * MiB;
constexpr size_t WS_QN = WS_H, WS_KN = WS_H + 13 * MiB;
constexpr size_t DN_VB = 0;
constexpr size_t DN_BG = 13 * MiB;
constexpr size_t DN_O = 15 * MiB;
constexpr size_t WS_SV = 499 * MiB;
constexpr size_t DN_OPS = 66 * MiB;
static_assert(WS_DN + DN_OPS + (size_t)3264 * 46080 <= WS_SV && WS_SV + (size_t)NT * 256 * 2 <= 512 * MiB, "ws");
constexpr size_t WS_MHID = 72 * MiB;
constexpr size_t WS_MXB = 310 * MiB;
constexpr size_t WS_M13 = 378 * MiB;
constexpr size_t WS_M2 = 378 * MiB;
constexpr size_t WS_PB = 508 * MiB;
constexpr size_t WS_YB2 = 440 * MiB;
constexpr size_t WS_END = 512 * MiB;
static_assert(WS_M13 + (size_t)8 * 7168 * 1024 * 2 <= WS_END, "ws");
static_assert(WS_MHID + (size_t)MAXSLOT * 3584 * 2 <= WS_MXB && WS_MXB + (size_t)MAXSLOT * 1024 * 2 <= WS_M13, "ws");
static_assert(WS_H + (size_t)NT * 1024 * 2 <= WS_Z && WS_Z + (size_t)NT * ZP * 2 <= WS_MIX && WS_MIX + (size_t)NT * 1024 * 2 <= WS_QA, "ws");

constexpr int LDS_BYTES = 147456;
constexpr int NTHREADS = 512, NWAVES = 8;

DEVI unsigned f2bf(float f) { unsigned u = __float_as_uint(f); return (u + 0x7fffu + ((u >> 16) & 1u)) >> 16; }
DEVI float bf2f(unsigned h) { return __uint_as_float(h << 16); }
DEVI unsigned pk2(float lo, float hi) { return f2bf(lo) | (f2bf(hi) << 16); }
DEVI float bflo(unsigned w) { return __uint_as_float(w << 16); }
DEVI float bfhi(unsigned w) { return __uint_as_float(w & 0xffff0000u); }
DEVI void unpack8(const u32x4 w, float* v) { v[0] = bflo(w.x); v[1] = bfhi(w.x); v[2] = bflo(w.y); v[3] = bfhi(w.y); v[4] = bflo(w.z); v[5] = bfhi(w.z); v[6] = bflo(w.w); v[7] = bfhi(w.w); }
DEVI u32x4 pack8(const float* v) { u32x4 w; w.x = pk2(v[0], v[1]); w.y = pk2(v[2], v[3]); w.z = pk2(v[4], v[5]); w.w = pk2(v[6], v[7]); return w; }
DEVI float wave_sum(float v) {
#pragma unroll
    for (int o = 1; o < 64; o <<= 1) v += __shfl_xor(v, o);
    return v;
}
DEVI float wave_max(float v) {
#pragma unroll
    for (int o = 1; o < 64; o <<= 1) v = fmaxf(v, __shfl_xor(v, o));
    return v;
}
DEVI float silu_f(float x) { return x * __builtin_amdgcn_rcpf(1.f + __expf(-x)); }
DEVI float gelu_f(float x) { const float u = 0.7978845608028654f * (x + 0.044715f * x * x * x); const float e = __expf(2.f * u); return x * (1.f - __builtin_amdgcn_rcpf(1.f + e)); }
DEVI float softplus_f(float x) { const float e = __expf(-fabsf(x)); const float l = e < 0.01f ? e * (1.f - e * (0.5f - e * 0.33333334f)) : __logf(1.f + e); return fmaxf(x, 0.f) + l; }
DEVI int row_mod(int r) { return r < NLAT ? (r >> 12) : 4; }

struct Args { const float* in[28]; float* out; unsigned char* ws; int ph_lo, ph_hi, probe_sub, pad; };

struct Ctx {
    const float* in[28]; float* out; unsigned char* ws;
    int tid, lane, wave, gw, ngw;
    float* lds;
    __attribute__((address_space(3))) unsigned char* lds3;
};
enum { I_X = 0, I_C, I_CTX, I_CCTX, I_MODW, I_MODB, I_N1G, I_N2G, I_WIN, I_CONVW, I_ALOG, I_DTB, I_DNG, I_QG, I_KG, I_SGUG, I_SGUW, I_SGUB, I_WOUT,
       I_F1, I_F3, I_F2, I_RW, I_RB, I_M1, I_M3, I_M2, I_FNG };

DEVI const float* modv(const Ctx& c, int layer, int r, int which) { return (const float*)(c.ws + CTL_MODV) + ((size_t)(layer * 5 + row_mod(r)) * 6 + which) * 1024; }

template <int MAP>
DEVI int map_row(int n, int add) {
    if (MAP == 1) return n < 1536 ? n : (n < 1560 ? n + 1152 : n - 24);
    if (MAP == 2) return (n >> 7) * 256 + (n & 127) + add;
    return n;
}
template <int MAP>
DEVI void transpose_tiles(const Ctx& c, const float* W, int K, int N, bf16_t* WT, int add, int& base, int wv = -1, int nwv = 0) {
    float* Ls = c.lds + c.wave * (64 * 65);
    const int ntn = (N + 63) / 64, ntiles = (K / 64) * ntn, G = wv < 0 ? c.ngw : nwv, wid = wv < 0 ? c.gw : wv;
    const int nq = c.lane & 15, kr = c.lane >> 4, cch = c.lane & 7, rn = c.lane >> 3;
    int t = (wid - base % G + G) % G;
    base += ntiles;
    f32x4 v[16];
#define TT_LOAD(tile) do { const int kb_ = (tile) / ntn, nb_ = (tile) % ntn, n_ = nb_ * 64 + 4 * nq; \
        _Pragma("unroll") for (int p_ = 0; p_ < 16; ++p_) v[p_] = n_ < N ? __builtin_nontemporal_load((const f32x4*)(W + (size_t)(kb_ * 64 + kr + 4 * p_) * N + n_)) : (f32x4){0.f, 0.f, 0.f, 0.f}; } while (0)
    if (t < ntiles) TT_LOAD(t);
    for (; t < ntiles; t += G) {
#pragma unroll
        for (int p = 0; p < 16; ++p) { float* q = Ls + (kr + 4 * p) * 65 + 4 * nq; q[0] = v[p].x; q[1] = v[p].y; q[2] = v[p].z; q[3] = v[p].w; }
        if (t + G < ntiles) TT_LOAD(t + G);
        __builtin_amdgcn_wave_barrier(); asm volatile("" ::: "memory");
        const int kb = t / ntn, nb = t % ntn;
#pragma unroll
        for (int j = 0; j < 8; ++j) { const int nl = 8 * j + rn, n = nb * 64 + nl; float x[8];
#pragma unroll
            for (int i = 0; i < 8; ++i) x[i] = Ls[(8 * cch + i) * 65 + nl];
            if (n < N) *(u32x4*)(WT + (size_t)map_row<MAP>(n, add) * K + kb * 64 + 8 * cch) = pack8(x); }
        __builtin_amdgcn_wave_barrier(); asm volatile("" ::: "memory");
    }
#undef TT_LOAD
}

DEVI void phase_prologue(const Ctx& c) {
    bf16_t* wl = (bf16_t*)(c.ws + WS_WL);
    int tb = 0;
    for (int l = 0; l < 2; ++l) {
        transpose_tiles<1>(c, c.in[I_WIN] + (size_t)l * 1024 * INC, 1024, INC, (bf16_t*)((char*)wl + WL_WIN) + (size_t)l * ZP * 1024, 0, tb);
        transpose_tiles<0>(c, c.in[I_WOUT] + (size_t)l * 1024 * 1024, 1024, 1024, (bf16_t*)((char*)wl + WL_WOUT) + (size_t)l * 1024 * 1024, 0, tb);
        u32x4* pad = (u32x4*)((bf16_t*)((char*)wl + WL_WIN) + (size_t)l * ZP * 1024 + (size_t)INC * 1024);
        for (int i = c.gw * 64 + c.lane; i < (ZP - INC) * 1024 / 8; i += c.ngw * 64) pad[i] = (u32x4){0u, 0u, 0u, 0u};
    }
    transpose_tiles<2>(c, c.in[I_F1], 1024, FF, (bf16_t*)((char*)wl + WL_F13), 0, tb);
    transpose_tiles<2>(c, c.in[I_F3], 1024, FF, (bf16_t*)((char*)wl + WL_F13), 128, tb);
    transpose_tiles<0>(c, c.in[I_F2], FF, 1024, (bf16_t*)((char*)wl + WL_F2), 0, tb);
    if (blockIdx.x == 0) for (int i = c.tid; i < 2 * 64 * 16; i += NTHREADS) { const int p = i & 15, pos = (i >> 4) & 63, ax = i >> 10;
        const float ang = (float)pos * powf(10000.f, -2.f * (float)p / 32.f); float* tp = (float*)(c.ws + CTL_ROPE) + (ax * 64 + pos) * 32; tp[p] = cosf(ang); tp[16 + p] = sinf(ang); }
    if (blockIdx.x == 0 && c.tid < 32) ((float*)(c.ws + CTL_ROPE))[128 * 32 + c.tid] = c.tid < 16 ? 1.f : 0.f;
    __syncthreads();
    {
        float* sc = c.lds;
        float* part = c.lds + 5 * 1024;
        for (int i = c.tid; i < 5 * 1024; i += NTHREADS) { const int r = i >> 10, k = i & 1023; const float v = r < 4 ? c.in[I_C][r * 1024 + k] : c.in[I_CCTX][k]; sc[i] = silu_f(v); }
        __syncthreads();
        for (int item = blockIdx.x; item < 2 * 96; item += gridDim.x) {
            const int l = item / 96, j = (item % 96) * 64 + c.lane;
            const float* w = c.in[I_MODW] + (size_t)l * 1024 * 6144 + j;
            float a0 = 0.f, a1 = 0.f, a2 = 0.f, a3 = 0.f, a4 = 0.f;
            const int kb = c.wave * 128;
#pragma unroll 4
            for (int k = 0; k < 128; ++k) { const float wv = w[(size_t)(kb + k) * 6144]; a0 += sc[kb + k] * wv; a1 += sc[1024 + kb + k] * wv; a2 += sc[2048 + kb + k] * wv; a3 += sc[3072 + kb + k] * wv; a4 += sc[4096 + kb + k] * wv; }
            float* p = part + c.wave * 320 + c.lane; p[0] = a0; p[64] = a1; p[128] = a2; p[192] = a3; p[256] = a4;
            __syncthreads();
            if (c.tid < 320) { float s = 0.f;
#pragma unroll
                for (int w8 = 0; w8 < 8; ++w8) s += part[w8 * 320 + c.tid];
                const int r = c.tid >> 6, jj = (item % 96) * 64 + (c.tid & 63);
                ((float*)(c.ws + CTL_MODV))[(size_t)(l * 5 + r) * 6144 + jj] = s + c.in[I_MODB][l * 6144 + jj]; }
            __syncthreads();
        }
    }
}

DEVI void phase_conv_m13(const Ctx& c, int wv = -1, int nwv = 0) {
    int tb = 0;
    for (int e = 0; e < NE; ++e) {
        bf16_t* dst = (bf16_t*)(c.ws + WS_M13) + (size_t)e * 7168 * 1024;
        transpose_tiles<2>(c, c.in[I_M1] + (size_t)e * 1024 * MFF, 1024, MFF, dst, 0, tb, wv, nwv);
        transpose_tiles<2>(c, c.in[I_M3] + (size_t)e * 1024 * MFF, 1024, MFF, dst, 128, tb, wv, nwv);
    }
}
DEVI void phase_conv_m2(const Ctx& c) {
    int tb = 0;
    for (int e = 0; e < NE; ++e)
        transpose_tiles<0>(c, c.in[I_M2] + (size_t)e * MFF * 1024, MFF, 1024, (bf16_t*)(c.ws + WS_M2) + (size_t)e * 1024 * MFF, 0, tb);
}

template <bool ROUTER>
DEVI void phase_norm(const Ctx& c, int layer, int which0, const float* gain, int nrows, const float* src_lat, const float* src_ctx, const float* addp = nullptr, int rpw = 8) {
    bf16_t* H = (bf16_t*)(c.ws + WS_H);
#define NORM_ROW(rr) ((rr) < NLAT ? src_lat + (size_t)(rr) * 1024 : src_ctx + (size_t)((rr) - NLAT) * 1024)
    int* sel = (int*)c.lds;
    const int nvb = nrows / 64;
    int vb = blockIdx.x, i = 0;
    int r = ROUTER ? vb * 64 + c.wave * rpw : c.gw;
    bool valid = ROUTER ? (vb < nvb && c.wave * rpw < 64) : (r < nrows);
    f32x4 v[4];
    if (valid) { const f32x4* xr = (const f32x4*)NORM_ROW(r) + c.lane;
#pragma unroll
        for (int j = 0; j < 4; ++j) v[j] = xr[64 * j]; }
    while (valid) {
        int rn, vbn = vb, in_ = i + 1; bool validn;
        if (ROUTER) { if (in_ == rpw) { in_ = 0; vbn = vb + gridDim.x; } rn = vbn * 64 + c.wave * rpw + in_; validn = vbn < nvb; }
        else { rn = r + c.ngw; validn = rn < nrows; }
        f32x4 vn[4];
        if (validn) { const f32x4* xr = (const f32x4*)NORM_ROW(rn) + c.lane;
#pragma unroll
            for (int j = 0; j < 4; ++j) vn[j] = xr[64 * j]; }
        if (addp && r >= NLAT) { const f32x4* pr = (const f32x4*)(addp + (size_t)(r - NLAT) * 1024) + c.lane;
#pragma unroll
            for (int j = 0; j < 4; ++j) v[j] = v[j] + pr[64 * j]; }
        float ss = 0.f;
#pragma unroll
        for (int j = 0; j < 4; ++j) ss += (v[j].x * v[j].x + v[j].y * v[j].y) + (v[j].z * v[j].z + v[j].w * v[j].w);
        const float rstd = rsqrtf(wave_sum(ss) * (1.f / 1024.f) + EPS);
        const f32x4* g4 = (const f32x4*)gain + c.lane; const f32x4* sh4 = (const f32x4*)modv(c, layer, r, which0) + c.lane; const f32x4* sc4 = (const f32x4*)modv(c, layer, r, which0 + 1) + c.lane;
        u32x2* o8 = (u32x2*)(H + (size_t)r * 1024) + c.lane;
#pragma unroll
        for (int j = 0; j < 4; ++j) { const f32x4 g = g4[64 * j], sh = sh4[64 * j], sc = sc4[64 * j];
            v[j] = v[j] * rstd * g * (1.f + sc) + sh;
            u32x2 o; o.x = pk2(v[j].x, v[j].y); o.y = pk2(v[j].z, v[j].w); o8[64 * j] = o; }
        if (ROUTER) {
            float lg[8];
#pragma unroll
            for (int e = 0; e < 8; ++e) lg[e] = 0.f;
            const float* rw = c.in[I_RW];
#pragma unroll
            for (int j = 0; j < 4; ++j)
#pragma unroll
                for (int q = 0; q < 4; ++q) { const int col = 4 * c.lane + 256 * j + q; const f32x4 w0 = *(const f32x4*)(rw + col * 8), w1 = *(const f32x4*)(rw + col * 8 + 4); const float hv = v[j][q];
                    lg[0] += hv * w0.x; lg[1] += hv * w0.y; lg[2] += hv * w0.z; lg[3] += hv * w0.w; lg[4] += hv * w1.x; lg[5] += hv * w1.y; lg[6] += hv * w1.z; lg[7] += hv * w1.w; }
#pragma unroll
            for (int e = 0; e < 8; ++e) lg[e] = wave_sum(lg[e]) + c.in[I_RB][e];
            int e1 = 0; float l1 = lg[0];
#pragma unroll
            for (int e = 1; e < 8; ++e) if (lg[e] > l1) { l1 = lg[e]; e1 = e; }
            int e2 = -1; float l2 = -3.0e38f;
#pragma unroll
            for (int e = 0; e < 8; ++e) if (e != e1 && lg[e] > l2) { l2 = lg[e]; e2 = e; }
            const float g2 = 1.f / (1.f + expf(l1 - l2)), g1 = 1.f - g2;
            if (c.lane == 0) { int* te = (int*)(c.ws + CTL_TOPE) + r * 2; te[0] = e1; te[1] = e2; float* tg = (float*)(c.ws + CTL_TOPG) + r * 2; tg[0] = g1; tg[1] = g2;
                sel[(c.wave * rpw + i) * 2] = e1; sel[(c.wave * rpw + i) * 2 + 1] = e2; }
            if (rpw == 8 && i == 7) {
                __syncthreads();
                if (c.tid < 8) { int n = 0; for (int q = 0; q < 128; ++q) n += (sel[q] == c.tid) ? 1 : 0; ((int*)(c.ws + CTL_CNT))[vb * 8 + c.tid] = n; }
                __syncthreads();
            }
        }
#pragma unroll
        for (int j = 0; j < 4; ++j) v[j] = vn[j];
        r = rn; vb = vbn; i = in_; valid = validn;
    }
}

#undef NORM_ROW
template <bool DUAL, class BSel, class Epi>
DEVI void gemm_naive(const Ctx& c, const bf16_t* A, int lda, int K, int ntm, int ntn, const BSel& bsel, const Epi& epi) {
    float* As = c.lds; float* Bs = c.lds + 32 * 132; float* Bs2 = c.lds + 2 * 32 * 132;
    const int ty = c.tid >> 4, tx = c.tid & 15, lr = c.tid >> 2, lk = (c.tid & 3) * 8;
    for (int tile = blockIdx.x; tile < ntm * ntn; tile += gridDim.x) {
        const int tm = tile / ntn, tn = tile % ntn;
        const bf16_t* B0 = bsel(tm, tn, 0); if (!B0) continue;
        const bf16_t* B1 = DUAL ? bsel(tm, tn, 1) : B0;
        float acc[4][8], acc2[4][8];
#pragma unroll
        for (int i = 0; i < 4; ++i)
#pragma unroll
            for (int j = 0; j < 8; ++j) { acc[i][j] = 0.f; acc2[i][j] = 0.f; }
        const bf16_t* ap = A + (size_t)(tm * 128 + lr) * lda + lk; const bf16_t* bp = B0 + (size_t)lr * K + lk; const bf16_t* bp2 = B1 + (size_t)lr * K + lk;
        for (int k0 = 0; k0 < K; k0 += 32) {
            const u32x4 av = *(const u32x4*)(ap + k0), bv = *(const u32x4*)(bp + k0); u32x4 bv2 = bv; if (DUAL) bv2 = *(const u32x4*)(bp2 + k0);
            __syncthreads();
#pragma unroll
            for (int q = 0; q < 4; ++q) { As[(lk + 2 * q) * 132 + lr] = bflo(av[q]); As[(lk + 2 * q + 1) * 132 + lr] = bfhi(av[q]);
                Bs[(lk + 2 * q) * 132 + lr] = bflo(bv[q]); Bs[(lk + 2 * q + 1) * 132 + lr] = bfhi(bv[q]);
                if (DUAL) { Bs2[(lk + 2 * q) * 132 + lr] = bflo(bv2[q]); Bs2[(lk + 2 * q + 1) * 132 + lr] = bfhi(bv2[q]); } }
            __syncthreads();
#pragma unroll 4
            for (int kk = 0; kk < 32; ++kk) {
                const f32x4 a = *(const f32x4*)(As + kk * 132 + ty * 4); const f32x4 b0 = *(const f32x4*)(Bs + kk * 132 + tx * 8), b1 = *(const f32x4*)(Bs + kk * 132 + tx * 8 + 4);
#pragma unroll
                for (int i = 0; i < 4; ++i) { acc[i][0] += a[i] * b0.x; acc[i][1] += a[i] * b0.y; acc[i][2] += a[i] * b0.z; acc[i][3] += a[i] * b0.w; acc[i][4] += a[i] * b1.x; acc[i][5] += a[i] * b1.y; acc[i][6] += a[i] * b1.z; acc[i][7] += a[i] * b1.w; }
                if (DUAL) { const f32x4 c0 = *(const f32x4*)(Bs2 + kk * 132 + tx * 8), c1 = *(const f32x4*)(Bs2 + kk * 132 + tx * 8 + 4);
#pragma unroll
                    for (int i = 0; i < 4; ++i) { acc2[i][0] += a[i] * c0.x; acc2[i][1] += a[i] * c0.y; acc2[i][2] += a[i] * c0.z; acc2[i][3] += a[i] * c0.w; acc2[i][4] += a[i] * c1.x; acc2[i][5] += a[i] * c1.y; acc2[i][6] += a[i] * c1.z; acc2[i][7] += a[i] * c1.w; } }
            }
        }
#pragma unroll
        for (int i = 0; i < 4; ++i) epi(tm * 128 + ty * 4 + i, tn * 128 + tx * 8, acc[i], acc2[i]);
    }
}
struct BSelPlain { const bf16_t* Bt; int K; DEVI const bf16_t* operator()(int, int tn, int) const { return Bt + (size_t)tn * 128 * K; } };
struct BSelDual { const bf16_t* Bt; int K; DEVI const bf16_t* operator()(int, int tn, int which) const { return Bt + (size_t)(tn * 256 + which * 128) * K; } };
struct BSelMoe { const bf16_t* Bt; int K; int rows_per_expert; bool dual; const int* seg;
    DEVI const bf16_t* operator()(int tm, int tn, int which) const {
        const int s = tm * 128; if (s >= seg[8]) return nullptr; int e = 0;
#pragma unroll
        for (int q = 1; q < 8; ++q) e += (s >= seg[q]) ? 1 : 0;
        return Bt + (size_t)e * rows_per_expert * K + (size_t)(dual ? tn * 256 + which * 128 : tn * 128) * K; } };
struct EpiStoreBf16 { bf16_t* O; int ldc; DEVI void operator()(int r, int c0, const float* a, const float*) const {
    u32x4 o; o.x = pk2(a[0], a[1]); o.y = pk2(a[2], a[3]); o.z = pk2(a[4], a[5]); o.w = pk2(a[6], a[7]); *(u32x4*)(O + (size_t)r * ldc + c0) = o; } };
struct EpiSwiglu { bf16_t* O; int ldc; DEVI void operator()(int r, int c0, const float* a, const float* b) const {
    float h[8];
#pragma unroll
    for (int j = 0; j < 8; ++j) h[j] = silu_f(a[j]) * b[j];
    u32x4 o; o.x = pk2(h[0], h[1]); o.y = pk2(h[2], h[3]); o.z = pk2(h[4], h[5]); o.w = pk2(h[6], h[7]); *(u32x4*)(O + (size_t)r * ldc + c0) = o; } };
struct EpiResid { float* XB; const float* mv; int which;
    DEVI void operator()(int r, int c0, const float* a, const float*) const {
        const float* g = mv + (size_t)(row_mod(r) * 6 + which) * 1024 + c0; float* x = XB + (size_t)r * 1024 + c0;
        f32x4 x0 = *(f32x4*)x, x1 = *(f32x4*)(x + 4); const f32x4 g0 = *(const f32x4*)g, g1 = *(const f32x4*)(g + 4);
        x0.x += g0.x * a[0]; x0.y += g0.y * a[1]; x0.z += g0.z * a[2]; x0.w += g0.w * a[3]; x1.x += g1.x * a[4]; x1.y += g1.y * a[5]; x1.z += g1.z * a[6]; x1.w += g1.w * a[7];
        *(f32x4*)x = x0; *(f32x4*)(x + 4) = x1; } };

namespace pg8 {
#define PG8_LAS __attribute__((address_space(3)))

typedef short bf16x8 __attribute__((ext_vector_type(8)));


constexpr int MOE_FF = 3584;
constexpr int BM = 256, BK = 64, HALF = 128, HTB = HALF * BK * 2  , STAGE_BYTES = 8 * HTB, NXCD = 8, WGM = 8;

__host__ __device__ __forceinline__ int lds_byte(int r, int c) { const int st = (r >> 4) * 2 + (c >> 5), rr = r & 15, cc = c & 31, ob = rr * 64 + cc * 2; return st * 1024 + (ob ^ (((ob >> 9) & 1) << 5)); }
__host__ __device__ __forceinline__ void stage_rc(int b, int& R, int& C) { const int st = b / 1024, sb = b % 1024, swz = sb ^ (((sb >> 9) & 1) << 5); R = (st >> 1) * 16 + swz / 64; C = (st & 1) * 32 + (swz % 64) / 2; }
__host__ __device__ __forceinline__ int perm32(int rho) { const int n = rho >> 4, i = rho & 15; return 8 * (i >> 2) + 4 * n + (i & 3); }

struct Unit { int pm, pn, ko, nt; };
struct Gemm { const bf16_t* A; const bf16_t* Bt; int M, N, K; };

struct StaticOrder {
    int nM, nN, nwg, G, c;
    __host__ __device__ void init(int M, int N, int G_, int c_) { nM = M / BM; nN = N / BM; nwg = nM * nN; G = G_; c = c_; }
    __host__ __device__ bool next(int i, Unit& u) const {
        const long L = (long)i * G + c; if (L >= nwg) return false;
        int wgid = (int)L; { const int q = nwg / NXCD, r = nwg % NXCD, xcd = wgid % NXCD, off = wgid / NXCD; wgid = (xcd < r ? xcd * (q + 1) : r * (q + 1) + (xcd - r) * q) + off; }
        const int nig = WGM * nN, gid = wgid / nig, fm = gid * WGM, gsz = (nM - fm) < WGM ? (nM - fm) : WGM;
        u.pm = fm + ((wgid % nig) % gsz); u.pn = (wgid % nig) / gsz; u.ko = 0; u.nt = 0; return true;
    }
    __device__ __forceinline__ void a_ready(const Unit&) const {}
    __device__ __forceinline__ void done(const Unit&) const {}
};


__device__ __forceinline__ unsigned cvt_pk_bf16(float lo, float hi) { unsigned r; asm volatile("v_cvt_pk_bf16_f32 %0, %1, %2" : "=v"(r) : "v"(lo), "v"(hi)); return r; }
__device__ __forceinline__ float silu1(float x) { return x * __builtin_amdgcn_rcpf(1.f + __expf(-x)); }
struct EpiStore {
    static constexpr bool PERM = true, AFTER_DRAIN = false;
    bf16_t* O; int ldc; int nN; long d2;
    __device__ __forceinline__ void operator()(const f32x4 (&acc)[2][2][4][2], const Unit& u, int wr, int wc, int fr, int fq) const {
        const int row0 = u.pm * BM + wr * 64 + fr, pnl = nN ? u.pn % nN : u.pn, col0 = pnl * BM + wc * 32 + 8 * fq;
        bf16_t* Ob = O + (u.ko ? d2 : 0l);
#pragma unroll
        for (int ai = 0; ai < 2; ++ai)
#pragma unroll
            for (int m = 0; m < 4; ++m) { bf16_t* rowp = Ob + (size_t)(row0 + ai * HALF + m * 16) * ldc + col0;
#pragma unroll
                for (int bj = 0; bj < 2; ++bj) { const f32x4 v0 = acc[ai][bj][m][0], v1 = acc[ai][bj][m][1];
                    u32x4 w; w.x = cvt_pk_bf16(v0[0], v0[1]); w.y = cvt_pk_bf16(v0[2], v0[3]); w.z = cvt_pk_bf16(v1[0], v1[1]); w.w = cvt_pk_bf16(v1[2], v1[3]);
                    *(u32x4*)(rowp + bj * HALF) = w; } }
    }
};
struct EpiSwi {
    static constexpr bool PERM = true, AFTER_DRAIN = false;
    bf16_t* O; int ldc; int nN;
    __device__ __forceinline__ void operator()(const f32x4 (&acc)[2][2][4][2], const Unit& u, int wr, int wc, int fr, int fq) const {
        const int row0 = u.pm * BM + wr * 64 + fr, pnl = nN ? u.pn % nN : u.pn, col0 = pnl * HALF + wc * 32 + 8 * fq;
#pragma unroll
        for (int ai = 0; ai < 2; ++ai)
#pragma unroll
            for (int m = 0; m < 4; ++m) { bf16_t* rowp = O + (size_t)(row0 + ai * HALF + m * 16) * ldc + col0;
                const f32x4 a0 = acc[ai][0][m][0], a1 = acc[ai][0][m][1], b0 = acc[ai][1][m][0], b1 = acc[ai][1][m][1];
                u32x4 w; w.x = cvt_pk_bf16(silu1(a0[0]) * b0[0], silu1(a0[1]) * b0[1]); w.y = cvt_pk_bf16(silu1(a0[2]) * b0[2], silu1(a0[3]) * b0[3]);
                w.z = cvt_pk_bf16(silu1(a1[0]) * b1[0], silu1(a1[1]) * b1[1]); w.w = cvt_pk_bf16(silu1(a1[2]) * b1[2], silu1(a1[3]) * b1[3]);
                *(u32x4*)rowp = w; }
    }
};
struct EpiRes {
    static constexpr bool PERM = false, AFTER_DRAIN = false;
    float* XB; const float* mv; int which; const float* base_lat; const float* base_ctx;
    float* PB;
    __device__ __forceinline__ void operator()(const f32x4 (&acc)[2][2][4][2], const Unit& u, int wr, int wc, int fr, int fq) const {
        const int row0 = u.pm * BM + wr * 64 + fr, col0 = u.pn * BM + wc * 32 + 4 * fq;
#pragma unroll
        for (int ai = 0; ai < 2; ++ai)
#pragma unroll
            for (int m = 0; m < 4; ++m) { const int r = row0 + ai * HALF + m * 16; const float* g = mv + (size_t)((r < 16384 ? (r >> 12) : 4) * 6 + which) * 1024 + col0; float* x = XB + (size_t)r * 1024 + col0;
                const float* bs = (r < 16384 ? base_lat + (size_t)r * 1024 : base_ctx + (size_t)(r - 16384) * 1024) + col0;
#pragma unroll
                for (int bj = 0; bj < 2; ++bj)
#pragma unroll
                    for (int n = 0; n < 2; ++n) { const int o = bj * HALF + n * 16; const f32x4 gv = *(const f32x4*)(g + o);
                        if (u.ko) *(f32x4*)(PB + (size_t)(r - 16384) * 1024 + col0 + o) = gv * acc[ai][bj][m][n];
                        else { f32x4 xv = *(const f32x4*)(bs + o); xv = xv + gv * acc[ai][bj][m][n]; *(f32x4*)(x + o) = xv; } } }
    }
};
struct FfnDownOrder {
    StaticOrder so; int ntk;
    __device__ __forceinline__ void init(int G_, int c_, int ntk_half) { so.init(16384, 1024, G_, c_); ntk = ntk_half; }
    __device__ __forceinline__ bool next(int i, Unit& u) const {
        if (so.next(i, u)) return true;
        const long L = (long)i * so.G + so.c - so.nwg; if (L < 0 || L >= 32) return false;
        const int unit = (int)L >> 1; u.pm = 64 + (unit >> 2); u.pn = unit & 3; u.ko = ((int)L & 1) * ntk * 64; u.nt = ntk; return true; }
    __device__ __forceinline__ void a_ready(const Unit&) const {}
    __device__ __forceinline__ void done(const Unit&) const {}
};
struct MoeOrder {
    StaticOrder so; int nN; int sg[9];
    __device__ __forceinline__ void init(const int* seg, int nN_, int G_, int c_) {
#pragma unroll
        for (int i = 0; i < 9; ++i) sg[i] = seg[i];
        nN = nN_; so.nM = sg[8] >> 8; so.nN = nN_; so.nwg = so.nM * nN_; so.G = G_; so.c = c_; }
    __device__ __forceinline__ bool next(int i, Unit& u) const {
        if (!so.next(i, u)) return false;
        const int s = u.pm * 256; int e = 0;
#pragma unroll
        for (int q = 1; q < 8; ++q) e += (s >= sg[q]) ? 1 : 0;
        u.pn += e * nN; return true; }
    __device__ __forceinline__ void a_ready(const Unit&) const {}
    __device__ __forceinline__ void done(const Unit&) const {}
};
struct TableOrder {
    const int* tab; int n, G, vc;
    __device__ __forceinline__ void init(const int* tab_, int G_, int c_) { tab = tab_ + 4; n = tab_[0]; G = G_; vc = (G_ % 8 == 0) ? (c_ % 8) * (G_ / 8) + c_ / 8 : c_; }
    __device__ __forceinline__ bool next(int i, Unit& u) const { const int L = i * G + vc; if (L >= n) return false; const int* t = tab + 4 * L; u.pm = t[0]; u.pn = t[1]; u.ko = t[2]; u.nt = t[3]; return true; }
    __device__ __forceinline__ void a_ready(const Unit&) const {}
    __device__ __forceinline__ void done(const Unit&) const {}
};
template <class Epi, class Sched, bool ALIGN_EPI = false, bool SP2 = false>
__device__ __forceinline__ void gemm_phase(PG8_LAS unsigned char* lds, const Gemm g, const Sched& S, const Epi& E) {
    const int tid = threadIdx.x, wid = __builtin_amdgcn_readfirstlane(tid >> 6), lane = tid & 63, wr = wid >> 2, wc = wid & 3, fr = lane & 15, fq = lane >> 4;
    const int K = g.K; int nt = K / BK;
    unsigned voffA[2], voffB[2];
#pragma unroll
    for (int i = 0; i < 2; ++i) { int R, C; stage_rc(tid * 16 + i * 8192, R, C); const int Rb = Epi::PERM ? ((R & ~31) + perm32(R & 31)) : R;
        voffA[i] = (unsigned)(R * K + C) * 2u; voffB[i] = (unsigned)(Rb * K + C) * 2u; }
    const size_t kstep = (size_t)(BK * 2);
    const size_t hstep = (size_t)HALF * K * 2;
    const size_t tstep = 2 * hstep;
    const unsigned ldsw = (unsigned)wid * 1024u;
    const int aoff = lds_byte(wr * 64 + fr, fq * 8), boff = lds_byte(wc * 32 + fr, fq * 8);
#define PG8_SA(b, h) (((b) * 2 + (h)) * HTB)
#define PG8_SB(b, h) ((4 + (b) * 2 + (h)) * HTB)
#define PG8_STAGE(bufoff, gbase, voff) do { _Pragma("unroll") for (int _i = 0; _i < 2; ++_i) \
        __builtin_amdgcn_global_load_lds((const unsigned*)((const char*)(gbase) + (voff)[_i]), (PG8_LAS unsigned*)(lds + (bufoff) + ldsw + _i * 8192), 16, 0, 0); } while (0)
#define PG8_LDA(dst, b, h) do { _Pragma("unroll") for (int m = 0; m < 4; ++m) _Pragma("unroll") for (int k = 0; k < 2; ++k) dst[m][k] = *(const PG8_LAS bf16x8*)(lds + PG8_SA(b, h) + aoff + m * 2048 + k * 1024); } while (0)
#define PG8_LDB(dst, b, h) do { _Pragma("unroll") for (int n = 0; n < 2; ++n) _Pragma("unroll") for (int k = 0; k < 2; ++k) dst[n][k] = *(const PG8_LAS bf16x8*)(lds + PG8_SB(b, h) + boff + n * 2048 + k * 1024); } while (0)
#define PG8_MMA(ai, bj, At, Bt) do { __builtin_amdgcn_s_setprio(1); _Pragma("unroll") for (int m = 0; m < 4; ++m) _Pragma("unroll") for (int n = 0; n < 2; ++n) _Pragma("unroll") for (int k = 0; k < 2; ++k) \
        acc[ai][bj][m][n] = __builtin_amdgcn_mfma_f32_16x16x32_bf16(Bt[n][k], At[m][k], acc[ai][bj][m][n], 0, 0, 0); __builtin_amdgcn_s_setprio(0); } while (0)
#define PG8_WAIT_V(n) asm volatile("s_waitcnt vmcnt(" #n ")" ::: "memory")
#define PG8_WAIT_L(n) asm volatile("s_waitcnt lgkmcnt(" #n ")" ::: "memory")
#define PG8_BAR __builtin_amdgcn_s_barrier()
#define PG8_SCHED __builtin_amdgcn_sched_barrier(0)
    Unit cur, nxt; int ui = 0;
    if (!S.next(0, cur)) return;
    if (cur.nt) nt = cur.nt;
    f32x4 acc[2][2][4][2];
#pragma unroll
    for (int a = 0; a < 2; ++a)
#pragma unroll
        for (int b = 0; b < 2; ++b)
#pragma unroll
            for (int m = 0; m < 4; ++m)
#pragma unroll
                for (int n = 0; n < 2; ++n) acc[a][b][m][n] = (f32x4){0.f, 0.f, 0.f, 0.f};
    bf16x8 At[4][2], B0[2][2], B1[2][2];
    const char* cA = (const char*)g.A + (size_t)cur.pm * tstep + (size_t)cur.ko * 2; const char* cB = (const char*)g.Bt + (size_t)cur.pn * tstep + (size_t)cur.ko * 2;
    S.a_ready(cur);
    if constexpr (SP2) {
        PG8_STAGE(PG8_SB(0, 0), cB, voffB); PG8_STAGE(PG8_SB(0, 1), cB + hstep, voffB); PG8_STAGE(PG8_SA(0, 0), cA, voffA); PG8_STAGE(PG8_SA(0, 1), cA + hstep, voffA);
        if (wr == 1) PG8_BAR;
        PG8_WAIT_V(2); PG8_BAR;
        PG8_STAGE(PG8_SB(1, 0), cB + kstep, voffB); PG8_STAGE(PG8_SA(1, 0), cA + kstep, voffA); PG8_STAGE(PG8_SB(1, 1), cB + hstep + kstep, voffB);
        PG8_WAIT_V(6); PG8_BAR;
    } else {
        PG8_STAGE(PG8_SB(0, 0), cB, voffB); PG8_STAGE(PG8_SA(0, 0), cA, voffA); PG8_STAGE(PG8_SB(0, 1), cB + hstep, voffB); PG8_STAGE(PG8_SA(0, 1), cA + hstep, voffA);
        if (wr == 1) PG8_BAR;
        PG8_WAIT_V(4); PG8_BAR;
        PG8_STAGE(PG8_SB(1, 0), cB + kstep, voffB); PG8_STAGE(PG8_SA(1, 0), cA + kstep, voffA); PG8_STAGE(PG8_SB(1, 1), cB + hstep + kstep, voffB);
        PG8_WAIT_V(6); PG8_BAR;
    }
    for (;;) {
        const bool has_next = S.next(ui + 1, nxt);
        const char* nA = has_next ? (const char*)g.A + (size_t)nxt.pm * tstep + (size_t)nxt.ko * 2 : cA; const char* nB = has_next ? (const char*)g.Bt + (size_t)nxt.pn * tstep + (size_t)nxt.ko * 2 : cB;
        for (int t = 0; t < nt; t += 2) {
            const bool last = (t == nt - 2);
            const char* a1 = cA + (size_t)(t + 1) * kstep;
            const char* a2 = last ? nA : cA + (size_t)(t + 2) * kstep; const char* b2 = last ? nB : cB + (size_t)(t + 2) * kstep;
            const char* a3 = a2 + kstep; const char* b3 = b2 + kstep;
            if (last && has_next) S.a_ready(nxt);
            if constexpr (SP2) {
            PG8_LDB(B0, 0, 0); PG8_LDB(B1, 0, 1); PG8_SCHED; PG8_LDA(At, 0, 0); PG8_STAGE(PG8_SA(1, 1), a1 + hstep, voffA);
            PG8_WAIT_V(8); PG8_WAIT_L(0); PG8_BAR; PG8_MMA(0, 0, At, B0); PG8_MMA(0, 1, At, B1); PG8_BAR; PG8_SCHED;
            PG8_LDA(At, 0, 1); PG8_STAGE(PG8_SB(0, 0), b2, voffB); PG8_STAGE(PG8_SB(0, 1), b2 + hstep, voffB); PG8_STAGE(PG8_SA(0, 0), a2, voffA);
            PG8_WAIT_V(8); PG8_WAIT_L(0); PG8_BAR; PG8_MMA(1, 0, At, B0); PG8_MMA(1, 1, At, B1); PG8_BAR; PG8_SCHED;
            PG8_LDB(B0, 1, 0); PG8_LDB(B1, 1, 1); PG8_SCHED; PG8_LDA(At, 1, 0); PG8_STAGE(PG8_SA(0, 1), a2 + hstep, voffA);
            PG8_WAIT_V(8); PG8_WAIT_L(0); PG8_BAR; PG8_MMA(0, 0, At, B0); PG8_MMA(0, 1, At, B1); PG8_BAR; PG8_SCHED;
            PG8_LDA(At, 1, 1); PG8_STAGE(PG8_SB(1, 0), b3, voffB); PG8_STAGE(PG8_SB(1, 1), b3 + hstep, voffB); PG8_STAGE(PG8_SA(1, 0), a3, voffA);
            PG8_WAIT_V(8); PG8_WAIT_L(0); PG8_BAR; PG8_MMA(1, 0, At, B0); PG8_MMA(1, 1, At, B1); PG8_BAR; PG8_SCHED;
            } else {
            PG8_LDB(B0, 0, 0); PG8_SCHED; PG8_LDA(At, 0, 0); PG8_STAGE(PG8_SA(1, 1), a1 + hstep, voffA);
            PG8_WAIT_L(8); PG8_BAR; PG8_WAIT_L(0); PG8_MMA(0, 0, At, B0); PG8_BAR; PG8_SCHED;
            PG8_LDB(B1, 0, 1); PG8_STAGE(PG8_SB(0, 0), b2, voffB);
            PG8_BAR; PG8_WAIT_L(0); PG8_MMA(0, 1, At, B1); PG8_BAR;
            PG8_LDA(At, 0, 1); PG8_STAGE(PG8_SA(0, 0), a2, voffA);
            PG8_BAR; PG8_WAIT_L(0); PG8_MMA(1, 0, At, B0); PG8_BAR; PG8_SCHED;
            PG8_STAGE(PG8_SB(0, 1), b2 + hstep, voffB);
            PG8_WAIT_V(6); PG8_BAR; PG8_MMA(1, 1, At, B1); PG8_BAR;
            PG8_LDB(B0, 1, 0); PG8_SCHED; PG8_LDA(At, 1, 0); PG8_STAGE(PG8_SA(0, 1), a2 + hstep, voffA);
            PG8_WAIT_L(8); PG8_BAR; PG8_WAIT_L(0); PG8_MMA(0, 0, At, B0); PG8_BAR; PG8_SCHED;
            PG8_LDB(B1, 1, 1); PG8_STAGE(PG8_SB(1, 0), b3, voffB);
            PG8_BAR; PG8_WAIT_L(0); PG8_MMA(0, 1, At, B1); PG8_BAR;
            PG8_LDA(At, 1, 1); PG8_STAGE(PG8_SA(1, 0), a3, voffA);
            PG8_BAR; PG8_WAIT_L(0); PG8_MMA(1, 0, At, B0); PG8_BAR; PG8_SCHED;
            PG8_STAGE(PG8_SB(1, 1), b3 + hstep, voffB);
            PG8_WAIT_V(6); PG8_BAR; PG8_MMA(1, 1, At, B1); PG8_BAR;
            }
        }
        if constexpr (ALIGN_EPI) { if (wr == 0) PG8_BAR; }
        if constexpr (!Epi::AFTER_DRAIN) { E(acc, cur, wr, wc, fr, fq); S.done(cur); }
        if (!has_next) break;
#pragma unroll
        for (int a = 0; a < 2; ++a)
#pragma unroll
            for (int b = 0; b < 2; ++b)
#pragma unroll
                for (int m = 0; m < 4; ++m)
#pragma unroll
                    for (int n = 0; n < 2; ++n) acc[a][b][m][n] = (f32x4){0.f, 0.f, 0.f, 0.f};
        cur = nxt; cA = nA; cB = nB; ++ui; nt = cur.nt ? cur.nt : K / BK;
        if constexpr (ALIGN_EPI) { if (wr == 1) PG8_BAR; }
    }
    PG8_WAIT_V(0);
    if constexpr (!ALIGN_EPI) { if (wr == 0) PG8_BAR; }
    PG8_BAR;
    if constexpr (Epi::AFTER_DRAIN) { E.fused(acc, cur, wr, wc, fr, fq, lds, wid, lane); S.done(cur); }
#undef PG8_SA
#undef PG8_SB
#undef PG8_STAGE
#undef PG8_LDA
#undef PG8_LDB
#undef PG8_MMA
#undef PG8_WAIT_V
#undef PG8_WAIT_L
#undef PG8_BAR
#undef PG8_SCHED
}
}

DEVI void row_seq(int r, int& t, int& len) { if (r < NLAT) { t = r & 4095; len = SEQ; } else { t = (r - NLAT) & 255; len = CTXL; } }

#define DPP_F(v, ctrl) __int_as_float(__builtin_amdgcn_update_dpp(0, __float_as_int(v), (ctrl), 0xF, 0xF, true))
DEVI float sum8lanes(float x) { x += DPP_F(x, 0xB1); x += DPP_F(x, 0x4E); x += DPP_F(x, 0x141); return x; }

DEVI void phase_prep(const Ctx& c, int layer, bool need_ctx_q) {
    const bf16_t* Z = (const bf16_t*)(c.ws + WS_Z);
    {
        bf16_t* QN = (bf16_t*)(c.ws + WS_QN); bf16_t* KN = (bf16_t*)(c.ws + WS_KN); bf16_t* VB = (bf16_t*)(c.ws + WS_DN + DN_VB); float* bg = (float*)(c.ws + WS_DN + DN_BG);
        const float* cw = c.in[I_CONVW] + (size_t)layer * 3 * 1152;
        const int lc = c.lane < 48 ? c.lane : 47;
        float w[3][3][8];
#pragma unroll
        for (int th = 0; th < 3; ++th)
#pragma unroll
            for (int tap = 0; tap < 3; ++tap) { const float* wp = cw + tap * 1152 + th * 384 + lc * 8; *(f32x4*)w[th][tap] = *(const f32x4*)wp; *(f32x4*)(w[th][tap] + 4) = *(const f32x4*)(wp + 4); }
        const int dh = c.lane - 48; float alog = 0.f, dtb = 0.f;
        if (c.lane >= 48 && c.lane < 60) { alog = -expf(c.in[I_ALOG][layer * 12 + dh]); dtb = c.in[I_DTB][layer * 12 + dh]; }
        for (int r = c.gw; r < NT; r += c.ngw) {
            int t, len; row_seq(r, t, len);
            const bf16_t* zr = Z + (size_t)r * ZP + lc * 8; const bool hm = t > 0, hp = t < len - 1;
            u32x4 zc[3], zm[3], zp[3];
#pragma unroll
            for (int th = 0; th < 3; ++th) { zc[th] = *(const u32x4*)(zr + th * 384); zm[th] = hm ? *(const u32x4*)(zr + th * 384 - ZP) : (u32x4){0u, 0u, 0u, 0u}; zp[th] = hp ? *(const u32x4*)(zr + th * 384 + ZP) : (u32x4){0u, 0u, 0u, 0u}; }
            float zb = 0.f, za = 0.f;
            if (c.lane >= 48 && c.lane < 60) { zb = bf2f(Z[(size_t)r * ZP + ZC_BETA + dh]); za = bf2f(Z[(size_t)r * ZP + ZC_ALPHA + dh]); }
            u32x4 outw[3];
#pragma unroll
            for (int th = 0; th < 3; ++th) {
                float a[8], b[8], d[8], v[8]; unpack8(zm[th], a); unpack8(zc[th], b); unpack8(zp[th], d);
                float ss = 0.f;
#pragma unroll
                for (int e = 0; e < 8; ++e) { v[e] = silu_f(a[e] * w[th][0][e] + b[e] * w[th][1][e] + d[e] * w[th][2][e]); ss += v[e] * v[e]; }
                if (th < 2) { ss = sum8lanes(ss); const float sc = rsqrtf(ss + EPS) * (th == 0 ? 0.125f : 1.f);
#pragma unroll
                    for (int e = 0; e < 8; ++e) v[e] *= sc; }
                outw[th] = pack8(v);
            }
            if (c.lane < 48) { *(u32x4*)(QN + (size_t)r * 384 + c.lane * 8) = outw[0]; *(u32x4*)(KN + (size_t)r * 384 + c.lane * 8) = outw[1]; *(u32x4*)(VB + (size_t)r * 384 + c.lane * 8) = outw[2]; }
            else if (c.lane < 60) { bg[((size_t)r * 12 + dh) * 2] = __builtin_amdgcn_rcpf(1.f + __expf(-zb)); bg[((size_t)r * 12 + dh) * 2 + 1] = alog * softplus_f(za + dtb); }
        }
    }
    {
        bf16_t* Qa = (bf16_t*)(c.ws + WS_QA); bf16_t* Qc = (bf16_t*)(c.ws + WS_QC); bf16_t* Ka = (bf16_t*)(c.ws + WS_KA); bf16_t* Va = (bf16_t*)(c.ws + WS_VA);
        const float* rope = (const float*)(c.ws + CTL_ROPE);
        const bool isq = c.lane < 48; const int j = c.lane & 7, axis = j >> 2, half = (j >> 1) & 1, p0 = 8 * (j & 1);
        const int col = isq ? ZC_AQ + c.lane * 8 : ZC_AK + (c.lane - 48) * 8;
        float gn[8];
        { const float* gp = (isq ? c.in[I_QG] : c.in[I_KG]) + layer * 64 + 8 * j; *(f32x4*)gn = *(const f32x4*)gp; *(f32x4*)(gn + 4) = *(const f32x4*)(gp + 4); }
        const float qs = isq ? QSCALE : 1.f;
        for (int r0 = c.gw; r0 < NT; r0 += 2 * c.ngw) {
            int rr[2]; bool ok[2]; rr[0] = r0; ok[0] = true; rr[1] = r0 + c.ngw; ok[1] = rr[1] < NT; if (!ok[1]) rr[1] = r0;
            u32x4 zq[2], zv[2]; const float* tp[2];
#pragma unroll
            for (int q = 0; q < 2; ++q) { const int r = rr[q]; zq[q] = *(const u32x4*)(Z + (size_t)r * ZP + col); zv[q] = *(const u32x4*)(Z + (size_t)r * ZP + ZC_AV + (c.lane & 15) * 8);
                const int t = r & 4095; tp[q] = rope + (r < NLAT ? (axis * 64 + (axis == 0 ? (t >> 6) : (t & 63))) * 32 : 128 * 32) + p0; }
#pragma unroll
            for (int q = 0; q < 2; ++q) { const int r = rr[q]; const bool lat = r < NLAT; const int b = lat ? (r >> 12) : ((r - NLAT) >> 8), pos = lat ? CTXL + (r & 4095) : ((r - NLAT) & 255);
                float v[8]; unpack8(zq[q], v);
                float ss = 0.f;
#pragma unroll
                for (int e = 0; e < 8; ++e) ss += v[e] * v[e];
                ss = sum8lanes(ss); const float sc = rsqrtf(ss * (1.f / 64.f) + EPS);
                float cs[8], sn[8]; *(f32x4*)cs = *(const f32x4*)tp[q]; *(f32x4*)(cs + 4) = *(const f32x4*)(tp[q] + 4); *(f32x4*)sn = *(const f32x4*)(tp[q] + 16); *(f32x4*)(sn + 4) = *(const f32x4*)(tp[q] + 20);
#pragma unroll
                for (int e = 0; e < 8; ++e) { v[e] *= sc * gn[e]; const float o = DPP_F(v[e], 0x4E); v[e] = (half == 0 ? v[e] * cs[e] - o * sn[e] : o * sn[e] + v[e] * cs[e]) * qs; }
                const u32x4 w = pack8(v);
                if (ok[q]) {
                    if (isq) { if (lat) *(u32x4*)(Qa + (size_t)r * 384 + c.lane * 8) = w; else if (need_ctx_q) *(u32x4*)(Qc + (size_t)(r - NLAT) * 384 + c.lane * 8) = w; }
                    else *(u32x4*)(Ka + ((size_t)b * SKV + pos) * 128 + (c.lane - 48) * 8) = w;
                    if (c.lane < 16) *(u32x4*)(Va + ((size_t)b * SKV + pos) * 128 + c.lane * 8) = zv[q];
                } }
        }
    }
    {
        bf16_t* SV = (bf16_t*)(c.ws + WS_SV); const int l32 = c.lane & 31;
        float gn[8]; { const float* gp = c.in[I_SGUG] + layer * 256 + l32 * 8; *(f32x4*)gn = *(const f32x4*)gp; *(f32x4*)(gn + 4) = *(const f32x4*)(gp + 4); }
        const int nr = need_ctx_q ? NT : NLAT;
        for (int it = c.gw; it < nr / 2; it += c.ngw) {
            const int r = it * 2 + (c.lane >> 5);
            float v[8]; unpack8(*(const u32x4*)(Z + (size_t)r * ZP + ZC_MV + l32 * 8), v);
            float ss = 0.f;
#pragma unroll
            for (int e = 0; e < 8; ++e) { v[e] = gelu_f(v[e]); ss += v[e] * v[e]; }
            ss = sum8lanes(ss); const float sc = rsqrtf(ss * (1.f / 64.f) + EPS);
#pragma unroll
            for (int e = 0; e < 8; ++e) v[e] *= sc * gn[e];
            *(u32x4*)(SV + (size_t)r * 256 + l32 * 8) = pack8(v);
        }
    }
}
DEVI void phase_dnscan_naive(const Ctx& c) {
    const bf16_t* QN = (const bf16_t*)(c.ws + WS_QN); const bf16_t* KN = (const bf16_t*)(c.ws + WS_KN); const bf16_t* VB = (const bf16_t*)(c.ws + WS_DN + DN_VB);
    const float* BG = (const float*)(c.ws + WS_DN + DN_BG); float* OD = (float*)(c.ws + WS_DN + DN_O);
    float* kqv = c.lds; float* part = c.lds + 256; float* part2 = c.lds + 256 + 512;
    const int e = c.tid & 63, dg = c.tid >> 6;
    for (int seq = blockIdx.x; seq < 48; seq += gridDim.x) {
        const int b = seq / 12, h = (seq >> 1) % 6, dir = seq & 1;
        float S[8];
#pragma unroll
        for (int i = 0; i < 8; ++i) S[i] = 0.f;
        for (int step = 0; step < SKV; ++step) {
            int row;
            if (step < CTXL) { const int t = dir ? CTXL - 1 - step : step; row = NLAT + b * CTXL + t; }
            else { const int u = step - CTXL; const int t = dir ? SEQ - 1 - u : u; row = b * SEQ + t; }
            if (c.wave == 0) kqv[e] = bf2f(KN[(size_t)row * 384 + h * 64 + e]);
            else if (c.wave == 1) kqv[64 + e] = bf2f(QN[(size_t)row * 384 + h * 64 + e]);
            else if (c.wave == 2) kqv[128 + e] = bf2f(VB[(size_t)row * 384 + h * 64 + e]);
            else if (c.wave == 3 && e < 2) { const float v = BG[((size_t)row * 12 + dir * 6 + h) * 2 + e]; kqv[192 + e] = e == 0 ? v : __expf(v); }
            __syncthreads();
            const float a = kqv[193], beta = kqv[192];
            float kd[8], p = 0.f;
#pragma unroll
            for (int i = 0; i < 8; ++i) { kd[i] = kqv[dg * 8 + i]; S[i] *= a; p += S[i] * kd[i]; }
            part[dg * 64 + e] = p;
            __syncthreads();
            float rr = kqv[128 + e];
#pragma unroll
            for (int w = 0; w < 8; ++w) rr -= part[w * 64 + e];
            rr *= beta; float po = 0.f;
#pragma unroll
            for (int i = 0; i < 8; ++i) { S[i] += kd[i] * rr; po += S[i] * kqv[64 + dg * 8 + i]; }
            part2[dg * 64 + e] = po;
            __syncthreads();
            if (dg == 0) { float o = 0.f;
#pragma unroll
                for (int w = 0; w < 8; ++w) o += part2[w * 64 + e];
                OD[((size_t)dir * NT + row) * 384 + h * 64 + e] = o; }
        }
        __syncthreads();
    }
}

DEVI void phase_dnfinish(const Ctx& c, int layer, int nrows) {
    const float* OD = (const float*)(c.ws + WS_DN + DN_O); const bf16_t* Z = (const bf16_t*)(c.ws + WS_Z); bf16_t* MIX = (bf16_t*)(c.ws + WS_MIX);
    float gn[8]; { const float* gp = c.in[I_DNG] + layer * 64 + 8 * (c.lane & 7); *(f32x4*)gn = *(const f32x4*)gp; *(f32x4*)(gn + 4) = *(const f32x4*)(gp + 4); }
    if (c.lane < 48) for (int r = c.gw; r < nrows; r += c.ngw) {
        const float* o0 = OD + (size_t)r * 384 + c.lane * 8; const float* o1 = o0 + (size_t)NT * 384;
        float v[8], g[8]; *(f32x4*)v = *(const f32x4*)o0 + *(const f32x4*)o1; *(f32x4*)(v + 4) = *(const f32x4*)(o0 + 4) + *(const f32x4*)(o1 + 4);
        unpack8(*(const u32x4*)(Z + (size_t)r * ZP + ZC_GATE + c.lane * 8), g);
        float ss = 0.f;
#pragma unroll
        for (int e = 0; e < 8; ++e) ss += v[e] * v[e];
        ss = sum8lanes(ss); const float sc = rsqrtf(ss * (1.f / 64.f) + EPS);
#pragma unroll
        for (int e = 0; e < 8; ++e) v[e] = v[e] * sc * gn[e] * silu_f(g[e]);
        *(u32x4*)(MIX + (size_t)r * 1024 + c.lane * 8) = pack8(v);
    }
}

DEVI void phase_attn_naive(const Ctx& c, bool with_ctx) {
    const bf16_t* Qa = (const bf16_t*)(c.ws + WS_QA); const bf16_t* Qc = (const bf16_t*)(c.ws + WS_QC); const bf16_t* Ka = (const bf16_t*)(c.ws + WS_KA); const bf16_t* Va = (const bf16_t*)(c.ws + WS_VA);
    bf16_t* MIX = (bf16_t*)(c.ws + WS_MIX);
    const int nitems = NLAT * 6 + (with_ctx ? NCTX * 6 : 0);
    for (int it = c.gw; it < nitems; it += c.ngw) {
        int b, hq, nkeys, orow; const bf16_t* qp;
        if (it < NLAT * 6) { const int r = it / 6; hq = it % 6; b = r >> 12; qp = Qa + (size_t)r * 384 + hq * 64; nkeys = SKV; orow = r; }
        else { const int q = it - NLAT * 6, rc = q / 6; hq = q % 6; b = rc >> 8; qp = Qc + (size_t)rc * 384 + hq * 64; nkeys = CTXL; orow = NLAT + rc; }
        const int kvh = hq / 3; const bf16_t* Kp = Ka + (size_t)b * SKV * 128 + kvh * 64; const bf16_t* Vp = Va + (size_t)b * SKV * 128 + kvh * 64;
        u32x4 qv[8];
#pragma unroll
        for (int i = 0; i < 8; ++i) qv[i] = *(const u32x4*)(qp + i * 8);
        float m = -1e30f, l = 0.f, acc = 0.f;
        for (int t0 = 0; t0 < nkeys; t0 += 64) {
            const bf16_t* kp = Kp + (size_t)(t0 + c.lane) * 128; float s = 0.f;
#pragma unroll
            for (int i = 0; i < 8; ++i) { const u32x4 kv = *(const u32x4*)(kp + i * 8);
#pragma unroll
                for (int q = 0; q < 4; ++q) s += bflo(kv[q]) * bflo(qv[i][q]) + bfhi(kv[q]) * bfhi(qv[i][q]); }
            const float mn = fmaxf(m, wave_max(s)); const float alpha = exp2f(m - mn); const float p = exp2f(s - mn);
            l = l * alpha + wave_sum(p); acc *= alpha; m = mn;
#pragma unroll 8
            for (int jj = 0; jj < 64; ++jj) { const float pj = __shfl(p, jj); acc += pj * bf2f(Vp[(size_t)(t0 + jj) * 128 + c.lane]); }
        }
        MIX[(size_t)orow * 1024 + 384 + hq * 64 + c.lane] = (bf16_t)f2bf(acc / l);
    }
}


namespace dn {
using bf16x8 = __attribute__((ext_vector_type(8))) short;
using f32x16 = __attribute__((ext_vector_type(16))) float;
typedef __attribute__((address_space(3))) unsigned char* ldsp;
constexpr int IMG = 46080, NCHK = 68, NSEQ = 48;
constexpr int O_NEGK = 0, O_T = 8192, O_QG = 14336, O_AT = 22528, O_KDT = 28672, O_BV = 36864, O_MISC = 45056;
DEVI int rowmap(int t, int hq) { return (t & 3) + 8 * (t >> 2) + 4 * hq; }
typedef float f32x2_t __attribute__((ext_vector_type(2))); typedef __bf16 bf16x2_t __attribute__((ext_vector_type(2)));
DEVI unsigned cvtpk(float lo, float hi) { f32x2_t v = {lo, hi}; bf16x2_t b = __builtin_convertvector(v, bf16x2_t); return __builtin_bit_cast(unsigned, b); }
#define DN_PACK8(x, s) __builtin_bit_cast(dn::bf16x8, (u32x4){dn::cvtpk((x)[8 * (s)], (x)[8 * (s) + 1]), dn::cvtpk((x)[8 * (s) + 2], (x)[8 * (s) + 3]), dn::cvtpk((x)[8 * (s) + 4], (x)[8 * (s) + 5]), dn::cvtpk((x)[8 * (s) + 6], (x)[8 * (s) + 7])})
#define DN_MFMA(a, b, c) __builtin_amdgcn_mfma_f32_32x32x16_bf16((a), (b), (c), 0, 0, 0)
DEVI u32x4 perm_frag(u32x4 f, int hq) {
    const unsigned s0 = hq ? f.x : f.z, s1 = hq ? f.y : f.w;
    const unsigned r0 = (unsigned)__shfl_xor((int)s0, 32), r1 = (unsigned)__shfl_xor((int)s1, 32);
    u32x4 o; o.x = hq ? r0 : f.x; o.y = hq ? r1 : f.y; o.z = hq ? f.z : r0; o.w = hq ? f.w : r1; return o;
}
DEVI u32x4 scale_frag(u32x4 f, float sc) {
    u32x4 o; o.x = cvtpk(bflo(f.x) * sc, bfhi(f.x) * sc); o.y = cvtpk(bflo(f.y) * sc, bfhi(f.y) * sc); o.z = cvtpk(bflo(f.z) * sc, bfhi(f.z) * sc); o.w = cvtpk(bflo(f.w) * sc, bfhi(f.w) * sc); return o;
}
DEVI bf16x8 ident_frag(int e, int r, int hq) {
    const int js = r - 16 * e - 8 * hq; u32x4 w;
    w.x = (js == 0 ? 0x3F80u : 0u) | (js == 1 ? 0x3F800000u : 0u); w.y = (js == 2 ? 0x3F80u : 0u) | (js == 3 ? 0x3F800000u : 0u);
    w.z = (js == 4 ? 0x3F80u : 0u) | (js == 5 ? 0x3F800000u : 0u); w.w = (js == 6 ? 0x3F80u : 0u) | (js == 7 ? 0x3F800000u : 0u);
    return __builtin_bit_cast(bf16x8, w);
}
DEVI int chunk_base(int b, int dir, int n) {
    if (n < 4) return NLAT + b * CTXL + (dir ? 3 - n : n) * 64;
    return b * SEQ + (dir ? 63 - (n - 4) : n - 4) * 64;
}

DEVI void phase_chunkprep(const Ctx& c) {
    const bf16_t* QN = (const bf16_t*)(c.ws + WS_QN); const bf16_t* KN = (const bf16_t*)(c.ws + WS_KN); const bf16_t* VB = (const bf16_t*)(c.ws + WS_DN + DN_VB);
    const float* BG = (const float*)(c.ws + WS_DN + DN_BG); unsigned char* OPS = c.ws + WS_DN + DN_OPS;
    float* Al = c.lds + c.wave * (17408 / 4);
    float* sgc = Al + 4096; float* sbe = sgc + 64; float* skd = sbe + 64;
    const int l = c.lane, r = l & 31, hq = l >> 5;
    for (int task = c.gw; task < NSEQ * NCHK; task += c.ngw) {
        const int seq = task / NCHK, n = task % NCHK, b = seq / 12, h = (seq >> 1) % 6, dir = seq & 1;
        const int base = chunk_base(b, dir, n);
        unsigned char* img = OPS + (size_t)task * IMG;
        const int myrow = base + (dir ? 63 - l : l);
        const float beta = BG[((size_t)myrow * 12 + dir * 6 + h) * 2]; const float g = BG[((size_t)myrow * 12 + dir * 6 + h) * 2 + 1];
        float gc = g;
#pragma unroll
        for (int o = 1; o < 64; o <<= 1) { const float t = __shfl_up(gc, o); if (l >= o) gc += t; }
        const float glast = __shfl(gc, 63);
        sgc[l] = gc; sbe[l] = beta; skd[l] = __expf(glast - gc);
        if (l == 0) *(float*)(img + O_MISC) = __expf(glast);
        __builtin_amdgcn_wave_barrier(); asm volatile("" ::: "memory");
        u32x4 kf[2][4], qf[2][4];
#pragma unroll
        for (int t = 0; t < 2; ++t) { const int pos = 32 * t + r; const size_t ro = (size_t)(base + (dir ? 63 - pos : pos)) * 384 + h * 64 + 8 * hq;
#pragma unroll
            for (int kk = 0; kk < 4; ++kk) { kf[t][kk] = *(const u32x4*)(KN + ro + 16 * kk); qf[t][kk] = *(const u32x4*)(QN + ro + 16 * kk); } }
#define KF(t, kk) __builtin_bit_cast(bf16x8, kf[t][kk])
#define QF(t, kk) __builtin_bit_cast(bf16x8, qf[t][kk])
#pragma unroll
        for (int tile = 0; tile < 3; ++tile) { const int rb = tile == 2 ? 1 : 0, cb = tile == 0 ? 0 : 1;
            f32x16 G = {}, P = {};
#pragma unroll
            for (int kk = 0; kk < 4; ++kk) { G = DN_MFMA(KF(rb, kk), KF(cb, kk), G); P = DN_MFMA(KF(rb, kk), QF(cb, kk), P); }
            const int lp = 32 * cb + r; const float bl = __shfl(beta, lp), gl = __shfl(gc, lp);
#pragma unroll
            for (int t = 0; t < 16; ++t) { const int rp = 32 * rb + rowmap(t, hq); const float e = __expf(gl - sgc[rp]);
                if (tile == 1) G[t] = -bl * e * G[t]; else Al[rp * 64 + lp] = lp > rp ? bl * e * G[t] : 0.f;
                P[t] = rp <= lp ? P[t] * e : 0.f; }
            if (tile == 1) { *(bf16x8*)(img + O_T + 2 * 1024 + l * 16) = DN_PACK8(G, 0); *(bf16x8*)(img + O_T + 3 * 1024 + l * 16) = DN_PACK8(G, 1); }
            *(bf16x8*)(img + O_AT + (2 * tile + 0) * 1024 + l * 16) = DN_PACK8(P, 0);
            *(bf16x8*)(img + O_AT + (2 * tile + 1) * 1024 + l * 16) = DN_PACK8(P, 1); }
#pragma unroll
        for (int rt = 0; rt < 2; ++rt) { const float gr = __shfl(gc, 32 * rt + r), br = __shfl(beta, 32 * rt + r); const float eg = __expf(gr);
#pragma unroll
            for (int kk = 0; kk < 4; ++kk) {
                *(u32x4*)(img + O_NEGK + (rt * 4 + kk) * 1024 + l * 16) = scale_frag(perm_frag(kf[rt][kk], hq), -br * eg);
                *(u32x4*)(img + O_QG + (rt * 4 + kk) * 1024 + l * 16) = scale_frag(perm_frag(qf[rt][kk], hq), eg); } }
#pragma unroll
        for (int dt = 0; dt < 2; ++dt)
#pragma unroll
            for (int cb = 0; cb < 2; ++cb) { f32x16 X = {};
                X = DN_MFMA(KF(cb, 2 * dt), ident_frag(0, r, hq), X); X = DN_MFMA(KF(cb, 2 * dt + 1), ident_frag(1, r, hq), X);
#pragma unroll
                for (int t = 0; t < 16; ++t) X[t] *= skd[32 * cb + rowmap(t, hq)];
                *(bf16x8*)(img + O_KDT + ((dt * 2 + cb) * 2 + 0) * 1024 + l * 16) = DN_PACK8(X, 0);
                *(bf16x8*)(img + O_KDT + ((dt * 2 + cb) * 2 + 1) * 1024 + l * 16) = DN_PACK8(X, 1); }
        {
            u32x4 vf[2][4];
#pragma unroll
            for (int t = 0; t < 2; ++t) { const int pos = 32 * t + r; const size_t ro = (size_t)(base + (dir ? 63 - pos : pos)) * 384 + h * 64 + 8 * hq;
#pragma unroll
                for (int kk = 0; kk < 4; ++kk) vf[t][kk] = *(const u32x4*)(VB + ro + 16 * kk); }
#pragma unroll
            for (int sl = 0; sl < 2; ++sl)
#pragma unroll
                for (int ct = 0; ct < 2; ++ct) { f32x16 Y = {};
                    Y = DN_MFMA(__builtin_bit_cast(bf16x8, vf[ct][2 * sl]), ident_frag(0, r, hq), Y); Y = DN_MFMA(__builtin_bit_cast(bf16x8, vf[ct][2 * sl + 1]), ident_frag(1, r, hq), Y);
#pragma unroll
                    for (int t = 0; t < 16; ++t) Y[t] *= sbe[32 * ct + rowmap(t, hq)];
                    *(bf16x8*)(img + O_BV + ((sl * 2 + ct) * 64 + l) * 32) = DN_PACK8(Y, 0);
                    *(bf16x8*)(img + O_BV + ((sl * 2 + ct) * 64 + l) * 32 + 16) = DN_PACK8(Y, 1); }
        }
#undef KF
#undef QF
        __builtin_amdgcn_wave_barrier(); asm volatile("" ::: "memory");
        {
            const float* Ab = Al + hq * (32 * 64 + 32);
            float* Tb = Al + hq * (32 * 64) + (hq ? 0 : 32);
#pragma unroll 1
            for (int JB = 3; JB >= 0; --JB) {
                float acc[8];
#pragma unroll
                for (int jj = 0; jj < 8; ++jj) acc[jj] = (r == 8 * JB + jj) ? 1.f : 0.f;
                float tk[24];
#pragma unroll
                for (int k = 8; k < 32; ++k) { const float tv = Tb[k * 64 + r]; tk[k - 8] = (k >= 8 * (JB + 1)) ? tv : 0.f; }
                const float* Aj = Ab + (8 * JB) * 64;
#pragma unroll
                for (int jj = 0; jj < 8; ++jj) { float a0 = 0.f, a1 = 0.f;
#pragma unroll
                    for (int k4 = 2; k4 < 8; ++k4) { const f32x4 av = *(const f32x4*)(Aj + jj * 64 + 4 * k4);
                        a0 += tk[4 * k4 - 8] * av.x + tk[4 * k4 - 6] * av.z; a1 += tk[4 * k4 - 7] * av.y + tk[4 * k4 - 5] * av.w; }
                    acc[jj] -= a0 + a1; }
#pragma unroll
                for (int jj = 6; jj >= 0; --jj) {
                    const f32x4 a0v = *(const f32x4*)(Aj + jj * 64 + 8 * JB), a1v = *(const f32x4*)(Aj + jj * 64 + 8 * JB + 4);
                    const float av[8] = {a0v.x, a0v.y, a0v.z, a0v.w, a1v.x, a1v.y, a1v.z, a1v.w};
                    float a = acc[jj];
#pragma unroll
                    for (int kk = jj + 1; kk < 8; ++kk) a -= acc[kk] * av[kk];
                    acc[jj] = a; }
#pragma unroll
                for (int jj = 0; jj < 8; ++jj) Tb[(8 * JB + jj) * 64 + r] = acc[jj];
            }
            float T[32];
#pragma unroll
            for (int k = 0; k < 32; ++k) T[k] = Tb[k * 64 + r];
#pragma unroll
            for (int s = 0; s < 2; ++s)
#pragma unroll
                for (int h2 = 0; h2 < 2; ++h2) { const int k0 = 16 * s + 4 * h2;
                    u32x4 w; w.x = cvtpk(T[k0], T[k0 + 1]); w.y = cvtpk(T[k0 + 2], T[k0 + 3]); w.z = cvtpk(T[k0 + 8], T[k0 + 9]); w.w = cvtpk(T[k0 + 10], T[k0 + 11]);
                    *(u32x4*)(img + O_T + ((hq ? 4 : 0) + s) * 1024 + (32 * h2 + r) * 16) = w; }
        }
        __builtin_amdgcn_wave_barrier(); asm volatile("" ::: "memory");
    }
}

DEVI void glds16(const void* gsrc, unsigned lds_dst) { unsigned keep;
    asm volatile("s_mov_b32 %0, m0\n\ts_mov_b32 m0, %2\n\ts_nop 0\n\tglobal_load_lds_dwordx4 %1, off\n\ts_mov_b32 m0, %0" : "=&s"(keep) : "v"(gsrc), "s"(lds_dst) : "memory"); }
DEVI void scan_sequence(const Ctx& c, int seq) {
    const unsigned char* OPS = c.ws + WS_DN + DN_OPS + (size_t)seq * NCHK * IMG; float* OD = (float*)(c.ws + WS_DN + DN_O);
    const int b = seq / 12, h = (seq >> 1) % 6, dir = seq & 1;
    const int l = c.lane, r = l & 31, hq = l >> 5, w = c.wave;
    const unsigned lds0 = (unsigned)(uintptr_t)c.lds;
    const bool loader = (w >= 2), consumer = (w < 2);
    constexpr int RSLOT = 36864;
#define DN_ISSUE(step, slot) do { if (loader) { _Pragma("unroll") for (int q_ = 0; q_ < 6; ++q_) { const int p_ = (w - 2) * 6 + q_; \
        glds16(OPS + (size_t)(step) * IMG + p_ * 1024 + l * 16, (unsigned)__builtin_amdgcn_readfirstlane(lds0 + (slot) * RSLOT + p_ * 1024)); } } } while (0)
    f32x16 S0 = {}, S1 = {};
    float gam_n = 0.f; u32x4 bv_n[4] = {};
    if (consumer) { gam_n = *(const float*)(OPS + O_MISC);
        bv_n[0] = *(const u32x4*)(OPS + O_BV + ((w * 2 + 0) * 64 + l) * 32); bv_n[1] = *(const u32x4*)(OPS + O_BV + ((w * 2 + 0) * 64 + l) * 32 + 16);
        bv_n[2] = *(const u32x4*)(OPS + O_BV + ((w * 2 + 1) * 64 + l) * 32); bv_n[3] = *(const u32x4*)(OPS + O_BV + ((w * 2 + 1) * 64 + l) * 32 + 16); }
    DN_ISSUE(0, 0); DN_ISSUE(1, 1);
    int slot = 0;
    for (int n = 0; n < NCHK; ++n) {
        if (loader) { if (n + 1 < NCHK) asm volatile("s_waitcnt vmcnt(6)" ::: "memory"); else asm volatile("s_waitcnt vmcnt(0)" ::: "memory"); }
        asm volatile("s_barrier" ::: "memory");
        if (n + 2 < NCHK) { const int s2 = slot == 0 ? 2 : slot - 1; DN_ISSUE(n + 2, s2); }
        if (consumer) {
            const ldsp img = c.lds3 + slot * RSLOT; const int sl = w;
#define DN_A(off, f) (*(const __attribute__((address_space(3))) bf16x8*)(img + (off) + (f) * 1024 + l * 16))
            const float gamma = gam_n; const u32x4 a = bv_n[0], bq = bv_n[1], a1 = bv_n[2], b1 = bv_n[3];
            if (n + 1 < NCHK) { const unsigned char* g2 = OPS + (size_t)(n + 1) * IMG;
                gam_n = *(const float*)(g2 + O_MISC);
                bv_n[0] = *(const u32x4*)(g2 + O_BV + ((sl * 2 + 0) * 64 + l) * 32); bv_n[1] = *(const u32x4*)(g2 + O_BV + ((sl * 2 + 0) * 64 + l) * 32 + 16);
                bv_n[2] = *(const u32x4*)(g2 + O_BV + ((sl * 2 + 1) * 64 + l) * 32); bv_n[3] = *(const u32x4*)(g2 + O_BV + ((sl * 2 + 1) * 64 + l) * 32 + 16); }
            const bf16x8 sb00 = DN_PACK8(S0, 0), sb01 = DN_PACK8(S0, 1), sb10 = DN_PACK8(S1, 0), sb11 = DN_PACK8(S1, 1);
            f32x16 v0, v1;
            {
#pragma unroll
              for (int q = 0; q < 4; ++q) { v0[2 * q] = bflo(a[q]); v0[2 * q + 1] = bfhi(a[q]); v0[8 + 2 * q] = bflo(bq[q]); v0[8 + 2 * q + 1] = bfhi(bq[q]);
                  v1[2 * q] = bflo(a1[q]); v1[2 * q + 1] = bfhi(a1[q]); v1[8 + 2 * q] = bflo(b1[q]); v1[8 + 2 * q + 1] = bfhi(b1[q]); } }
            v0 = DN_MFMA(DN_A(O_NEGK, 0), sb00, v0); v1 = DN_MFMA(DN_A(O_NEGK, 4), sb00, v1);
            v0 = DN_MFMA(DN_A(O_NEGK, 1), sb01, v0); v1 = DN_MFMA(DN_A(O_NEGK, 5), sb01, v1);
            v0 = DN_MFMA(DN_A(O_NEGK, 2), sb10, v0); v1 = DN_MFMA(DN_A(O_NEGK, 6), sb10, v1);
            v0 = DN_MFMA(DN_A(O_NEGK, 3), sb11, v0); v1 = DN_MFMA(DN_A(O_NEGK, 7), sb11, v1);
            __builtin_amdgcn_sched_barrier(0);
            const bf16x8 vb00 = DN_PACK8(v0, 0), vb01 = DN_PACK8(v0, 1);
            f32x16 n0 = {}, n1 = {};
            n0 = DN_MFMA(DN_A(O_T, 0), vb00, n0); n0 = DN_MFMA(DN_A(O_T, 1), vb01, n0);
            const bf16x8 nb00 = DN_PACK8(n0, 0), nb01 = DN_PACK8(n0, 1);
            v1 = DN_MFMA(DN_A(O_T, 2), nb00, v1); v1 = DN_MFMA(DN_A(O_T, 3), nb01, v1);
            const bf16x8 xb10 = DN_PACK8(v1, 0), xb11 = DN_PACK8(v1, 1);
            n1 = DN_MFMA(DN_A(O_T, 4), xb10, n1); n1 = DN_MFMA(DN_A(O_T, 5), xb11, n1);
            const bf16x8 nb10 = DN_PACK8(n1, 0), nb11 = DN_PACK8(n1, 1);
            __builtin_amdgcn_sched_barrier(0);
            f32x16 o0 = {}, o1 = {};
            o0 = DN_MFMA(DN_A(O_QG, 0), sb00, o0); o1 = DN_MFMA(DN_A(O_QG, 4), sb00, o1);
            o0 = DN_MFMA(DN_A(O_QG, 1), sb01, o0); o1 = DN_MFMA(DN_A(O_QG, 5), sb01, o1);
            o0 = DN_MFMA(DN_A(O_QG, 2), sb10, o0); o1 = DN_MFMA(DN_A(O_QG, 6), sb10, o1);
            o0 = DN_MFMA(DN_A(O_QG, 3), sb11, o0); o1 = DN_MFMA(DN_A(O_QG, 7), sb11, o1);
            o0 = DN_MFMA(DN_A(O_AT, 0), nb00, o0); o1 = DN_MFMA(DN_A(O_AT, 2), nb00, o1);
            o0 = DN_MFMA(DN_A(O_AT, 1), nb01, o0); o1 = DN_MFMA(DN_A(O_AT, 3), nb01, o1);
            o1 = DN_MFMA(DN_A(O_AT, 4), nb10, o1); o1 = DN_MFMA(DN_A(O_AT, 5), nb11, o1);
            __builtin_amdgcn_sched_barrier(0);
            {
                const int base = chunk_base(b, dir, n); float* od = OD + (size_t)dir * NT * 384 + h * 64 + 32 * sl + r;
#pragma unroll
                for (int t = 0; t < 16; ++t) { const int i0 = rowmap(t, hq), i1 = 32 + i0;
                    od[(size_t)(base + (dir ? 63 - i0 : i0)) * 384] = o0[t]; od[(size_t)(base + (dir ? 63 - i1 : i1)) * 384] = o1[t]; }
            }
            __builtin_amdgcn_sched_barrier(0);
#pragma unroll
            for (int t = 0; t < 16; ++t) { S0[t] *= gamma; S1[t] *= gamma; }
            S0 = DN_MFMA(DN_A(O_KDT, 0), nb00, S0); S1 = DN_MFMA(DN_A(O_KDT, 4), nb00, S1);
            S0 = DN_MFMA(DN_A(O_KDT, 1), nb01, S0); S1 = DN_MFMA(DN_A(O_KDT, 5), nb01, S1);
            S0 = DN_MFMA(DN_A(O_KDT, 2), nb10, S0); S1 = DN_MFMA(DN_A(O_KDT, 6), nb10, S1);
            S0 = DN_MFMA(DN_A(O_KDT, 3), nb11, S0); S1 = DN_MFMA(DN_A(O_KDT, 7), nb11, S1);
#undef DN_A
        }
        slot = slot == 2 ? 0 : slot + 1;
    }
    asm volatile("s_waitcnt vmcnt(0) lgkmcnt(0)\n\ts_barrier" ::: "memory");
#undef DN_ISSUE
}
}

DEVI void phase_sgu(const Ctx& c, int layer, bool need_ctx) {
    using dn::bf16x8; using dn::f32x16;
    const bf16_t* Z = (const bf16_t*)(c.ws + WS_Z); const bf16_t* SV = (const bf16_t*)(c.ws + WS_SV); bf16_t* MIX = (bf16_t*)(c.ws + WS_MIX);
    const float* sw = c.in[I_SGUW] + (size_t)layer * 4 * 128 * 128; const float* sb = c.in[I_SGUB] + layer * 512;
    const int nchunks = (need_ctx ? NT : NLAT) / 128; const int l = c.lane, r = l & 31, hq = l >> 5;
    const bf16x8 id0 = dn::ident_frag(0, r, hq), id1 = dn::ident_frag(1, r, hq);
    for (int sit = c.gw; sit < nchunks * 32; sit += c.ngw) {
        const int it = sit >> 2, itile = sit & 3, ch = it >> 3, g = (it >> 1) & 3, dvb = it & 1, r0 = ch * 128;
        bf16x8 yb[4][2];
#pragma unroll
        for (int jt = 0; jt < 4; ++jt) { const bf16_t* sp = SV + (size_t)(r0 + 32 * jt + r) * 256 + g * 64 + 32 * dvb + 8 * hq;
            f32x16 Y = {};
            Y = DN_MFMA(__builtin_bit_cast(bf16x8, *(const u32x4*)sp), id0, Y); Y = DN_MFMA(__builtin_bit_cast(bf16x8, *(const u32x4*)(sp + 16)), id1, Y);
            yb[jt][0] = DN_PACK8(Y, 0); yb[jt][1] = DN_PACK8(Y, 1); }
        const float* wg = sw + (size_t)g * 128 * 128;
        {
            f32x16 C = {}; const float* wr = wg + (size_t)(32 * itile + r) * 128 + 4 * hq;
#pragma unroll
            for (int jt = 0; jt < 4; ++jt)
#pragma unroll
                for (int sI = 0; sI < 2; ++sI) { const f32x4 w0 = *(const f32x4*)(wr + 32 * jt + 16 * sI), w1 = *(const f32x4*)(wr + 32 * jt + 16 * sI + 8);
                    u32x4 a; a.x = dn::cvtpk(w0.x, w0.y); a.y = dn::cvtpk(w0.z, w0.w); a.z = dn::cvtpk(w1.x, w1.y); a.w = dn::cvtpk(w1.z, w1.w);
                    C = DN_MFMA(__builtin_bit_cast(bf16x8, a), yb[jt][sI], C); }
#pragma unroll
            for (int t = 0; t < 16; ++t) { const int i = 32 * itile + dn::rowmap(t, hq); const size_t row = (size_t)(r0 + i);
                const float u = gelu_f(bf2f(Z[row * ZP + ZC_MU + g * 64 + 32 * dvb + r]));
                MIX[row * 1024 + 768 + g * 64 + 32 * dvb + r] = (bf16_t)f2bf(u * (C[t] + sb[g * 128 + i])); }
        }
    }
}

namespace attn_body {
using bf16=__hip_bfloat16;
using bf16x8=__attribute__((ext_vector_type(8)))short;
using s16x4=__attribute__((ext_vector_type(4)))short;
using f32x16=__attribute__((ext_vector_type(16)))float;
using u32x4=__attribute__((ext_vector_type(4)))unsigned;
constexpr int D=64,QP=384,KVP=128,OP=1024;
constexpr int NW=8,QBLK=32,QB=QBLK*NW,KVBLK=64;
constexpr int ATTN_UNIT_ROWS=QB;
__device__ __forceinline__ int crow(int r,int hi){return (r&3)+8*(r>>2)+4*hi;}
#define SBAR() __builtin_amdgcn_sched_barrier(0)
__device__ __forceinline__ void cmask(f32x16&p0,f32x16&p1,int jb,int qrel,int hi){
  const float NEG=-INFINITY; int kb=64*jb+4*hi;
  #pragma unroll
  for(int r=0;r<16;++r){int kv=kb+(r&3)+8*(r>>2); if(kv>qrel)p0[r]=NEG; if(kv+32>qrel)p1[r]=NEG;}
}

constexpr int NSLOT=3, SLOTB=8192;
constexpr int LDS_K=0, LDS_V=NSLOT*SLOTB, LDS_WS=2*NSLOT*SLOTB, LDS_OST=LDS_WS+NW*64*4, LDS_BYTES=LDS_OST+NW*4096;
constexpr float C2=0.125f*1.4426950408889634f;
__device__ __forceinline__ void glds16(const void*gsrc,unsigned lds_dst){unsigned keep;
  asm volatile("s_mov_b32 %0, m0\n\ts_mov_b32 m0, %2\n\ts_nop 0\n\tglobal_load_lds_dwordx4 %1, off\n\ts_mov_b32 m0, %0":"=&s"(keep):"v"(gsrc),"s"(lds_dst):"memory");}
__device__ __forceinline__ float max3f(float a,float b,float c){float r;asm("v_max3_f32 %0, %1, %2, %3":"=v"(r):"v"(a),"v"(b),"v"(c));return r;}
__device__ __forceinline__ float max2f(float a,float b){float r;asm("v_max_f32_e32 %0, %1, %2":"=v"(r):"v"(a),"v"(b));return r;}
__device__ __forceinline__ float fadd_s(float a,float b){float r;asm("v_add_f32_e32 %0, %1, %2":"=v"(r):"v"(a),"v"(b));return r;}
__device__ __forceinline__ float fsub_s(float a,float b){float r;asm("v_sub_f32_e32 %0, %1, %2":"=v"(r):"v"(a),"v"(b));return r;}
typedef float f32x2_t __attribute__((ext_vector_type(2))); typedef __bf16 bf16x2_t __attribute__((ext_vector_type(2)));
__device__ __forceinline__ unsigned cvtpk_s(float lo,float hi){f32x2_t v={lo,hi};bf16x2_t b=__builtin_convertvector(v,bf16x2_t);return __builtin_bit_cast(unsigned,b);}
#define WAIT_BAR(N) asm volatile("s_waitcnt vmcnt(" #N ") lgkmcnt(0)\n\ts_barrier":::"memory")

__device__ __forceinline__ void qkt(f32x16&p0,f32x16&p1,const char*Kslot,const bf16x8*qr,const f32x16&negm,int r32,int hi){
  const char*kb=Kslot+hi*1024+r32*16;
  #pragma unroll
  for(int d0=0;d0<4;++d0){
    const bf16x8 b0=*reinterpret_cast<const bf16x8*>(kb+d0*2048);
    const bf16x8 b1=*reinterpret_cast<const bf16x8*>(kb+d0*2048+512);
    if(d0==0){p0=__builtin_amdgcn_mfma_f32_32x32x16_bf16(b0,qr[0],negm,0,0,0);p1=__builtin_amdgcn_mfma_f32_32x32x16_bf16(b1,qr[0],negm,0,0,0);}
    else{p0=__builtin_amdgcn_mfma_f32_32x32x16_bf16(b0,qr[d0],p0,0,0,0);p1=__builtin_amdgcn_mfma_f32_32x32x16_bf16(b1,qr[d0],p1,0,0,0);}}
}
typedef __attribute__((address_space(3))) const char* lds_cptr;
typedef short v4i16_t __attribute__((ext_vector_type(4)));
__device__ __forceinline__ void kload8(bf16x8*kf,lds_cptr kp){
  kf[0]=*(const __attribute__((address_space(3))) bf16x8*)(kp);      kf[1]=*(const __attribute__((address_space(3))) bf16x8*)(kp+512);
  kf[2]=*(const __attribute__((address_space(3))) bf16x8*)(kp+2048); kf[3]=*(const __attribute__((address_space(3))) bf16x8*)(kp+2560);
  kf[4]=*(const __attribute__((address_space(3))) bf16x8*)(kp+4096); kf[5]=*(const __attribute__((address_space(3))) bf16x8*)(kp+4608);
  kf[6]=*(const __attribute__((address_space(3))) bf16x8*)(kp+6144); kf[7]=*(const __attribute__((address_space(3))) bf16x8*)(kp+6656);
}
__device__ __forceinline__ void kload2(bf16x8*kf,lds_cptr kp,int j){ kf[2*j]=*(const __attribute__((address_space(3))) bf16x8*)(kp+j*2048); kf[2*j+1]=*(const __attribute__((address_space(3))) bf16x8*)(kp+j*2048+512); }
__device__ __forceinline__ s16x4 vtr(lds_cptr p){ return __builtin_bit_cast(s16x4,__builtin_amdgcn_ds_read_tr16_b64_v4i16((__attribute__((address_space(3))) v4i16_t*)p)); }
__device__ __forceinline__ float rowmax(const f32x16&p0,const f32x16&p1){
  float a=max3f(p0[0],p0[1],p1[0]),b=max3f(p0[2],p0[3],p1[1]);a=max3f(a,p1[2],p1[3]);
  #pragma unroll
  for(int r=4;r<16;r+=4){a=max3f(a,p0[r],p0[r+1]);b=max3f(b,p0[r+2],p0[r+3]);a=max3f(a,p1[r],p1[r+1]);b=max3f(b,p1[r+2],p1[r+3]);}
  const float m=max2f(a,b);
  auto rr=__builtin_amdgcn_permlane32_swap(__float_as_uint(m),__float_as_uint(m),false,false);
  return max2f(__uint_as_float(rr[0]),__uint_as_float(rr[1]));
}
__device__ __forceinline__ void pv(f32x16*o,int vb,bf16x8 pa0,bf16x8 pa1,bf16x8 pa2,bf16x8 pa3){
  #pragma unroll
  for(int d0=0;d0<2;++d0){s16x4 lo[4],hi[4];
    #pragma unroll
    for(int ks=0;ks<4;++ks){
      asm volatile("ds_read_b64_tr_b16 %0,%1 offset:%c2":"=&v"(lo[ks]):"v"(vb),"i"(d0*4096+ks*1024):"memory");
      asm volatile("ds_read_b64_tr_b16 %0,%1 offset:%c2":"=&v"(hi[ks]):"v"(vb),"i"(d0*4096+ks*1024+512):"memory");}
    asm volatile("s_waitcnt lgkmcnt(0)":::"memory");SBAR();
    #define PK(k) (bf16x8){lo[k][0],lo[k][1],lo[k][2],lo[k][3],hi[k][0],hi[k][1],hi[k][2],hi[k][3]}
    o[d0]=__builtin_amdgcn_mfma_f32_32x32x16_bf16(pa0,PK(0),o[d0],0,0,0);
    o[d0]=__builtin_amdgcn_mfma_f32_32x32x16_bf16(pa1,PK(1),o[d0],0,0,0);
    o[d0]=__builtin_amdgcn_mfma_f32_32x32x16_bf16(pa2,PK(2),o[d0],0,0,0);
    o[d0]=__builtin_amdgcn_mfma_f32_32x32x16_bf16(pa3,PK(3),o[d0],0,0,0);
    #undef PK
  }
}

#ifndef ATTN_STORE16
#define ATTN_STORE16(p,v) (*(u32x4*)(p)=(v))
#endif
template<int THRL> __device__ __forceinline__ void attn_unit(const bf16*Qu,const bf16*__restrict__ Kh,const bf16*__restrict__ Vh,const int NT,bf16*Ou,char*shm){
  const int tid=threadIdx.x,lane=tid&63,r32=lane&31,hi=lane>>5; const int wid=__builtin_amdgcn_readfirstlane(tid>>6);
  const bf16*Qw=Qu+(long)(wid*QBLK)*QP;
  const unsigned lds0=(unsigned)(uintptr_t)shm;
  float*wsf=(float*)(shm+LDS_WS)+wid*64;
  const bf16*ksrc=Kh+(long)lane*KVP+wid*8;
  const bf16*vsrc=Vh+(long)(16*(wid&3)+(lane>>2))*KVP+(wid>>2)*32+(lane&3)*8;
  const unsigned kdst=lds0+LDS_K+wid*1024, vdst=lds0+LDS_V+wid*1024;
  #define DMA_K(t,slot) glds16(ksrc+(long)(t)*KVBLK*KVP,(unsigned)__builtin_amdgcn_readfirstlane(kdst+(slot)))
  #define DMA_V(t,slot) glds16(vsrc+(long)(t)*KVBLK*KVP,(unsigned)__builtin_amdgcn_readfirstlane(vdst+(slot)))
  const int vb0=(int)(lds0+LDS_V)+((lane>>4)&1)*32+(lane&3)*8+(4*hi+((lane&15)>>2))*64;
  const char*Kbase=shm+LDS_K; bf16x8 kf[8];
  const lds_cptr shm3=(lds_cptr)shm; const lds_cptr kp0=shm3+LDS_K+hi*1024+r32*16; const lds_cptr vp0=shm3+LDS_V+((lane>>4)&1)*32+(lane&3)*8+(4*hi+((lane&15)>>2))*64;
  DMA_K(0,0);DMA_V(0,0);DMA_K(1,SLOTB);
  bf16x8 qr[4];
  #pragma unroll
  for(int d0=0;d0<4;++d0)qr[d0]=*reinterpret_cast<const bf16x8*>(&Qw[(long)r32*QP+d0*16+hi*8]);
  float mhat=0.f,l_reg=0.f;f32x16 o[2];o[0]=f32x16{};o[1]=f32x16{};f32x16 negm=f32x16{};asm volatile("":"+v"(negm));
  #define CMASK(P0,P1,t) do{}while(0)
  bool resc=false;
  #define START(P0,P1) do{ const float rm=rowmax(P0,P1); resc=false; \
    { const float dl=rm; mhat=fadd_s(mhat,dl); \
      _Pragma("unroll") for(int r=0;r<16;++r){P0[r]=fsub_s(P0[r],dl);P1[r]=fsub_s(P1[r],dl);} \
      _Pragma("unroll") for(int r=0;r<16;++r)negm[r]=-mhat; asm volatile("":"+v"(negm)); } \
    _Pragma("unroll") for(int r=0;r<16;++r)P0[r]=__builtin_amdgcn_exp2f(P0[r]); }while(0)
  #define RESC() do{ if(resc){ asm volatile("s_waitcnt lgkmcnt(0)":::"memory"); \
      _Pragma("unroll") for(int d_=0;d_<2;++d_) _Pragma("unroll") for(int r=0;r<16;++r)o[d_][r]*=wsf[crow(r,hi)]; } }while(0)
  f32x16 pA0,pA1,pB0,pB1;
  int sl_prev=0,sl_cur=0,sl_next=SLOTB;
  #define ROT() do{sl_prev=sl_cur;sl_cur=sl_next;sl_next=(sl_next==(NSLOT-1)*SLOTB)?0:sl_next+SLOTB;}while(0)
  DMA_K(2,2*SLOTB);
  WAIT_BAR(3);
  qkt(pA0,pA1,Kbase,qr,negm,r32,hi);asm volatile("s_nop 15\n\ts_nop 7":"+v"(pA0),"+v"(pA1));CMASK(pA0,pA1,0);
  START(pA0,pA1);
  _Pragma("unroll") for(int r=0;r<16;++r)pA1[r]=__builtin_amdgcn_exp2f(pA1[r]);
  WAIT_BAR(0);
  DMA_K(3,0);DMA_V(1,SLOTB);
  ROT();
  kload8(kf,kp0+sl_cur);
  WAIT_BAR(2);
  s16x4 vlo[8],vhi[8]; u32x4 pw0,pw1,pw2,pw3;
  #define PKW(P,B) cvtpk_s(P[B],P[B+1])
  #define PAF(k) __builtin_bit_cast(bf16x8,pw##k)
  #define VFR(i) (bf16x8){vlo[i][0],vlo[i][1],vlo[i][2],vlo[i][3],vhi[i][0],vhi[i][1],vhi[i][2],vhi[i][3]}
  #define PIN(x) asm volatile("":"+v"(x))
  #define MX3(a,b,c) __builtin_fmaxf(__builtin_fmaxf((a),(b)),(c))
  #define GAPA(MF,A0,A1,A2,A3,W0,W1,PW) do{ MF; sacc+=A0; sacc+=A1; sacc+=A2; sacc+=A3; PIN(sacc); W0; W1; PIN(PW); SBAR(); }while(0)
  #define EX(v) __builtin_amdgcn_exp2f(v)
  #define GAPB(MF,X,B) do{ MF; X[B]=EX(X[B]); X[B+1]=EX(X[B+1]); X[B+2]=EX(X[B+2]); X[B+3]=EX(X[B+3]); PIN(X); SBAR(); }while(0)
  #define VRD(i) do{ vlo[i]=vtr(vp_+(((i)>>2)*4096+((i)&3)*1024)); vhi[i]=vtr(vp_+(((i)>>2)*4096+((i)&3)*1024+512)); }while(0)
  #define KRD(G,j) do{ if(G){ kload2(kf,kp0+sl_next,j); SBAR(); } }while(0)
  #define STEP(C0,C1,P0,P1,t,GK,GV,GL) do{ SBAR(); \
    const lds_cptr vp_=vp0+sl_prev; \
    VRD(0); SBAR(); float sacc=(P0[0]+P0[1]); \
    GAPA(C0=__builtin_amdgcn_mfma_f32_32x32x16_bf16(kf[0],qr[0],negm,0,0,0), P0[2],P0[3],P0[4],P0[5],     pw0[0]=PKW(P0,0), pw0[1]=PKW(P0,2), pw0); \
    VRD(4); SBAR(); GAPA(C1=__builtin_amdgcn_mfma_f32_32x32x16_bf16(kf[1],qr[0],negm,0,0,0), P0[6],P0[7],P0[8],P0[9],     pw0[2]=PKW(P0,4), pw0[3]=PKW(P0,6), pw0); \
    VRD(1); SBAR(); GAPA(C0=__builtin_amdgcn_mfma_f32_32x32x16_bf16(kf[2],qr[1],C0,0,0,0),   P0[10],P0[11],P0[12],P0[13], pw1[0]=PKW(P0,8), pw1[1]=PKW(P0,10), pw1); \
    VRD(5); SBAR(); GAPA(C1=__builtin_amdgcn_mfma_f32_32x32x16_bf16(kf[3],qr[1],C1,0,0,0),   P0[14],P0[15],P1[0],P1[1],   pw1[2]=PKW(P0,12),pw1[3]=PKW(P0,14), pw1); \
    VRD(2); SBAR(); GAPA(C0=__builtin_amdgcn_mfma_f32_32x32x16_bf16(kf[4],qr[2],C0,0,0,0),   P1[2],P1[3],P1[4],P1[5],     pw2[0]=PKW(P1,0), pw2[1]=PKW(P1,2), pw2); \
    VRD(6); SBAR(); GAPA(C1=__builtin_amdgcn_mfma_f32_32x32x16_bf16(kf[5],qr[2],C1,0,0,0),   P1[6],P1[7],P1[8],P1[9],     pw2[2]=PKW(P1,4), pw2[3]=PKW(P1,6), pw2); \
    VRD(3); SBAR(); GAPA(C0=__builtin_amdgcn_mfma_f32_32x32x16_bf16(kf[6],qr[3],C0,0,0,0),   P1[10],P1[11],P1[12],P1[13], pw3[0]=PKW(P1,8), pw3[1]=PKW(P1,10), pw3); \
    VRD(7); SBAR(); GAPA(C1=__builtin_amdgcn_mfma_f32_32x32x16_bf16(kf[7],qr[3],C1,0,0,0),   P1[14],P1[15],0.f,0.f,       pw3[2]=PKW(P1,12),pw3[3]=PKW(P1,14), pw3); \
    l_reg+=sacc; \
    if(GK){DMA_K((t)+3,sl_cur);} if(GV){DMA_V((t)+1,sl_next);} \
    CMASK(C0,C1,t); \
    { float a=MX3(C0[0],C0[1],C1[0]),b=MX3(C0[2],C0[3],C1[1]); a=MX3(a,C1[2],C1[3]); \
      _Pragma("unroll") for(int r=4;r<16;r+=4){a=MX3(a,C0[r],C0[r+1]);b=MX3(b,C0[r+2],C0[r+3]);a=MX3(a,C1[r],C1[r+1]);b=MX3(b,C1[r+2],C1[r+3]);} \
      float rm=__builtin_fmaxf(a,b); { auto rr=__builtin_amdgcn_permlane32_swap(__float_as_uint(rm),__float_as_uint(rm),false,false); rm=__builtin_fmaxf(__uint_as_float(rr[0]),__uint_as_float(rr[1])); } \
      resc=false; \
      if(__builtin_expect(__any(rm>(float)THRL),0)){ const float dl=__builtin_fmaxf(rm,0.f); mhat+=dl; \
        _Pragma("unroll") for(int r=0;r<16;++r){C0[r]-=dl;C1[r]-=dl;} \
        _Pragma("unroll") for(int r=0;r<16;++r)negm[r]=-mhat; asm volatile("":"+v"(negm)); \
        const float f=__builtin_amdgcn_exp2f(-dl); l_reg*=f; if(hi==0)wsf[r32]=f; resc=true; } } \
    SBAR(); \
    GAPB(o[0]=__builtin_amdgcn_mfma_f32_32x32x16_bf16(PAF(0),VFR(0),o[0],0,0,0), C0,0); \
    GAPB(o[1]=__builtin_amdgcn_mfma_f32_32x32x16_bf16(PAF(0),VFR(4),o[1],0,0,0), C0,4); \
    KRD(GL,0); GAPB(o[0]=__builtin_amdgcn_mfma_f32_32x32x16_bf16(PAF(1),VFR(1),o[0],0,0,0), C0,8); \
    KRD(GL,1); GAPB(o[1]=__builtin_amdgcn_mfma_f32_32x32x16_bf16(PAF(1),VFR(5),o[1],0,0,0), C0,12); \
    KRD(GL,2); GAPB(o[0]=__builtin_amdgcn_mfma_f32_32x32x16_bf16(PAF(2),VFR(2),o[0],0,0,0), C1,0); \
    KRD(GL,3); GAPB(o[1]=__builtin_amdgcn_mfma_f32_32x32x16_bf16(PAF(2),VFR(6),o[1],0,0,0), C1,4); \
    GAPB(o[0]=__builtin_amdgcn_mfma_f32_32x32x16_bf16(PAF(3),VFR(3),o[0],0,0,0), C1,8); \
    GAPB(o[1]=__builtin_amdgcn_mfma_f32_32x32x16_bf16(PAF(3),VFR(7),o[1],0,0,0), C1,12); \
    }while(0)
  int t=1;
  #undef CMASK
  #define CMASK(P0,P1,t) do{}while(0)
  for(;t+5<NT;t+=2){
    STEP(pB0,pB1,pA0,pA1,t,true,true,true);     WAIT_BAR(2); RESC(); ROT();
    STEP(pA0,pA1,pB0,pB1,t+1,true,true,true);   WAIT_BAR(2); RESC(); ROT();
  }
  #undef CMASK
  #define CMASK(P0,P1,t) do{}while(0)
  #define ENDW(tt) do{ if((tt)+3<NT){WAIT_BAR(2);} else if((tt)+2<NT){WAIT_BAR(1);} else {WAIT_BAR(0);} }while(0)
  for(;t+1<NT;t+=2){
    STEP(pB0,pB1,pA0,pA1,t,(t+3<NT),(t+1<NT),(t+1<NT));       ENDW(t);   RESC(); ROT();
    STEP(pA0,pA1,pB0,pB1,t+1,(t+4<NT),(t+2<NT),(t+2<NT));     ENDW(t+1); RESC(); ROT();
  }
  STEP(pB0,pB1,pA0,pA1,NT-1,false,false,false); RESC();
  { float sacc=pB0[0]+pB0[1]; _Pragma("unroll") for(int r=2;r<16;++r)sacc+=pB0[r]; _Pragma("unroll") for(int r=0;r<16;++r)sacc+=pB1[r]; l_reg+=sacc;
    pw0=(u32x4){PKW(pB0,0),PKW(pB0,2),PKW(pB0,4),PKW(pB0,6)};pw1=(u32x4){PKW(pB0,8),PKW(pB0,10),PKW(pB0,12),PKW(pB0,14)};pw2=(u32x4){PKW(pB1,0),PKW(pB1,2),PKW(pB1,4),PKW(pB1,6)};pw3=(u32x4){PKW(pB1,8),PKW(pB1,10),PKW(pB1,12),PKW(pB1,14)};
    SBAR(); pv(o,vb0+sl_cur,PAF(0),PAF(1),PAF(2),PAF(3)); }
  #undef PKW
  #undef PAF
  #undef VFR
  #undef PIN
  #undef MX3
  #undef GAPA
  #undef GAPB
  #undef EX
  #undef VRD
  #undef KRD
  #undef STEP
  #undef ENDW
  {auto rr=__builtin_amdgcn_permlane32_swap(__float_as_uint(l_reg),__float_as_uint(l_reg),false,false);l_reg=__uint_as_float(rr[0])+__uint_as_float(rr[1]);}
  if(hi==0)wsf[32+r32]=l_reg;asm volatile("s_waitcnt lgkmcnt(0)":::"memory");
  float rli[16];
  #pragma unroll
  for(int r=0;r<16;++r)rli[r]=__builtin_amdgcn_rcpf(wsf[32+crow(r,hi)]);
  bf16*Ow=Ou+(long)(wid*QBLK)*OP;
  { bf16*stg=(bf16*)(shm+LDS_OST)+wid*2048;
    #pragma unroll
    for(int r=0;r<16;++r){const int orow=crow(r,hi);
      #pragma unroll
      for(int d0=0;d0<2;++d0)stg[orow*64+d0*32+r32]=__float2bfloat16(o[d0][r]*rli[r]);}
    asm volatile("s_waitcnt lgkmcnt(0)":::"memory");
    #pragma unroll
    for(int i=0;i<4;++i){const int row=i*8+(lane>>3),ch=lane&7; const u32x4 v=*(const u32x4*)(stg+row*64+ch*8); ATTN_STORE16(Ow+(long)row*OP+ch*8,v);} }
  asm volatile("s_waitcnt lgkmcnt(0)\n\ts_barrier":::"memory");
  #undef DMA_K
  #undef DMA_V
  #undef CMASK
  #undef START
  #undef RESC
  #undef ROT
}
constexpr int ATTN_LDS_BYTES=LDS_BYTES;
#undef SBAR
#undef WAIT_BAR
}

DEVI void attn_unit_run(const Ctx& c, int u) {
    using attn_body::bf16;
    const bf16* Qa = (const bf16*)(c.ws + WS_QA); const bf16* Qc = (const bf16*)(c.ws + WS_QC); const bf16* Ka = (const bf16*)(c.ws + WS_KA); const bf16* Va = (const bf16*)(c.ws + WS_VA);
    bf16* MIX = (bf16*)(c.ws + WS_MIX);
    if (u < 384) { const int grp = u / 48, rem = u % 48, g = rem >> 4, qb = rem & 15, b = grp >> 1, kvh = grp & 1, hq = kvh * 3 + g;
        attn_body::attn_unit<8>(Qa + (size_t)(b * SEQ + qb * 256) * 384 + hq * 64, Ka + (size_t)b * SKV * 128 + kvh * 64, Va + (size_t)b * SKV * 128 + kvh * 64, SKV / 64,
                                MIX + (size_t)(b * SEQ + qb * 256) * 1024 + 384 + hq * 64, (char*)c.lds); }
    else { const int uc = u - 384, b = uc / 6, hq = uc % 6, kvh = hq / 3;
        attn_body::attn_unit<8>(Qc + (size_t)(b * CTXL) * 384 + hq * 64, Ka + (size_t)b * SKV * 128 + kvh * 64, Va + (size_t)b * SKV * 128 + kvh * 64, CTXL / 64,
                                MIX + (size_t)(NLAT + b * CTXL) * 1024 + 384 + hq * 64, (char*)c.lds); }
}
template <bool FAST_SCAN>
DEVI void phase_mixer_fast(const Ctx& c, bool with_ctx, int psub = 0) {
    const int G = gridDim.x, bx = blockIdx.x; const int nunits = 384 + (with_ctx ? 24 : 0);
    if (G == 256) {
        const int vcu = (bx & 7) * 32 + (bx >> 3), x = vcu >> 5, j = vcu & 31;
        if (FAST_SCAN && j < 6) { if (!(psub & 4)) dn::scan_sequence(c, x * 6 + j); return; }
        if (psub & 8) return;
        if (!FAST_SCAN) { for (int u = vcu; u < nunits; u += 256) attn_unit_run(c, u); return; }
        const int a = x * 26 + (j - 6);
        attn_unit_run(c, a);
        if (208 + a < nunits) attn_unit_run(c, 208 + a);
    } else {
        if (FAST_SCAN) for (int sq = bx; sq < 48; sq += G) dn::scan_sequence(c, sq);
        for (int u = bx; u < nunits; u += G) attn_unit_run(c, u);
    }
}

DEVI void phase_moe_assign(const Ctx& c) {
    int* cnt = (int*)c.lds;
    int* misc = (int*)c.lds + 2048;
    int* slots = (int*)c.lds + 2048 + 64;
    const int* gcnt = (const int*)(c.ws + CTL_CNT); const int* tope = (const int*)(c.ws + CTL_TOPE);
    const bf16_t* H = (const bf16_t*)(c.ws + WS_H); bf16_t* XBm = (bf16_t*)(c.ws + WS_MXB);
    for (int i = c.tid; i < 2048; i += NTHREADS) cnt[i] = gcnt[i];
    __syncthreads();
    if (c.tid < 8) { int tot = 0; for (int v = 0; v < 256; ++v) tot += cnt[v * 8 + c.tid]; misc[8 + c.tid] = tot; }
    __syncthreads();
    if (c.tid == 0) { int s = 0; for (int e = 0; e < 8; ++e) { misc[16 + e] = s; s += (misc[8 + e] + 255) & ~255; } misc[24] = s;
        if (blockIdx.x == 0) { int* seg = (int*)(c.ws + CTL_SEG); for (int e = 0; e <= 8; ++e) seg[e] = misc[16 + e]; for (int e = 0; e < 8; ++e) seg[16 + e] = misc[8 + e];
            for (int e = 0; e < 8; ++e) for (int pm = misc[16 + e] >> 8; pm < (misc[16 + e + 1] >> 8); ++pm) seg[32 + pm] = e; } }
    __syncthreads();
    if (blockIdx.x == 0) {
        int* ut = (int*)(c.ws + CTL_UTAB); const int nu = (misc[24] >> 8) * 4, ntab = nu <= 512 ? nu : 512 + 2 * (nu - 512);
        if (c.tid == 0) ut[0] = ntab;
        for (int L = c.tid; L < ntab; L += NTHREADS) { const int unit = L < 512 ? L : 512 + ((L - 512) >> 1), pm = unit >> 2; int e = 0;
            for (int q = 1; q < 8; ++q) e += (pm * 256 >= misc[16 + q]) ? 1 : 0;
            ut[4 + 4 * L] = pm; ut[4 + 4 * L + 1] = (unit & 3) + 4 * e; ut[4 + 4 * L + 2] = L < 512 ? 0 : ((L - 512) & 1) * (MFF / 2); ut[4 + 4 * L + 3] = L < 512 ? 0 : MFF / 128; } }
    for (int vb = blockIdx.x; vb < 256; vb += gridDim.x) {
        int* sel = slots + 128;
        if (c.tid < 128) sel[c.tid] = tope[vb * 128 + c.tid];
        __syncthreads();
        if (c.tid < 8) { int bs = 0; for (int v = 0; v < vb; ++v) bs += cnt[v * 8 + c.tid];
            int rank = misc[16 + c.tid] + bs;
            for (int i = 0; i < 128; ++i) if (sel[i] == c.tid) { slots[i] = rank; ++rank; } }
        __syncthreads();
        if (c.tid < 128) ((int*)(c.ws + CTL_TOKSLOT))[vb * 128 + c.tid] = slots[c.tid];
        for (int a = c.wave; a < 128; a += NWAVES) { const int row = vb * 64 + (a >> 1); const int slot = slots[a];
            const u32x4* src = (const u32x4*)(H + (size_t)row * 1024) + c.lane; u32x4* dst = (u32x4*)(XBm + (size_t)slot * 1024) + c.lane; dst[0] = src[0]; dst[64] = src[64]; }
        __syncthreads();
    }
    for (int e = 0; e < 8; ++e) { const int p0 = misc[16 + e] + misc[8 + e], p1 = misc[16 + e + 1];
        for (int s = p0 + c.gw; s < p1; s += c.ngw) { u32x4* dst = (u32x4*)(XBm + (size_t)s * 1024) + c.lane; dst[0] = (u32x4){0u, 0u, 0u, 0u}; dst[64] = (u32x4){0u, 0u, 0u, 0u}; } }
}

DEVI void phase_final(const Ctx& c) {
    const float* xb = (const float*)(c.ws + WS_XB); const bf16_t* YB = (const bf16_t*)(c.ws + WS_MXB); const bf16_t* YB2 = (const bf16_t*)(c.ws + WS_YB2);
    const int* ts = (const int*)(c.ws + CTL_TOKSLOT); const float* tg = (const float*)(c.ws + CTL_TOPG);
    struct Sc { int s1, s2; float g1, g2; };
    struct Dt { u32x2 a[4], b[4], za[4], zb[4]; f32x4 x[4]; };
#define FIN_SC(sc, r) do { sc.s1 = ts[(r) * 2]; sc.s2 = ts[(r) * 2 + 1]; sc.g1 = tg[(r) * 2]; sc.g2 = tg[(r) * 2 + 1]; } while (0)
#define FIN_DT(dt, sc, r) do { const u32x2* y1_ = (const u32x2*)(YB + (size_t)sc.s1 * 1024) + c.lane; const u32x2* y2_ = (const u32x2*)(YB + (size_t)sc.s2 * 1024) + c.lane; \
        const u32x2* z1_ = (const u32x2*)(YB2 + (size_t)(sc.s1 >= 32768 ? sc.s1 - 32768 : 0) * 1024) + c.lane; const u32x2* z2_ = (const u32x2*)(YB2 + (size_t)(sc.s2 >= 32768 ? sc.s2 - 32768 : 0) * 1024) + c.lane; \
        const f32x4* xr_ = (const f32x4*)(xb + (size_t)(r) * 1024) + c.lane; \
        _Pragma("unroll") for (int j_ = 0; j_ < 4; ++j_) { dt.a[j_] = y1_[64 * j_]; dt.b[j_] = y2_[64 * j_]; dt.x[j_] = xr_[64 * j_]; \
            dt.za[j_] = sc.s1 >= 32768 ? z1_[64 * j_] : (u32x2){0u, 0u}; dt.zb[j_] = sc.s2 >= 32768 ? z2_[64 * j_] : (u32x2){0u, 0u}; } } while (0)
    int r = c.gw; if (r >= NLAT) return;
    Sc sc0, sc1, sc2; Dt d0, d1;
    FIN_SC(sc0, r); sc1 = sc0; sc2 = sc0;
    if (r + c.ngw < NLAT) FIN_SC(sc1, r + c.ngw);
    FIN_DT(d0, sc0, r); d1 = d0;
    for (; r < NLAT; r += c.ngw) {
        if (r + 2 * c.ngw < NLAT) FIN_SC(sc2, r + 2 * c.ngw);
        if (r + c.ngw < NLAT) FIN_DT(d1, sc1, r + c.ngw);
        const float g1 = sc0.g1, g2 = sc0.g2; const f32x4* gt = (const f32x4*)modv(c, 1, r, 5) + c.lane;
        f32x4 v[4]; float ss = 0.f;
#pragma unroll
        for (int j = 0; j < 4; ++j) { const u32x2 a = d0.a[j], b = d0.b[j], p = d0.za[j], q = d0.zb[j]; const f32x4 g = gt[64 * j]; f32x4 y;
            y.x = g1 * (bflo(a.x) + bflo(p.x)) + g2 * (bflo(b.x) + bflo(q.x)); y.y = g1 * (bfhi(a.x) + bfhi(p.x)) + g2 * (bfhi(b.x) + bfhi(q.x));
            y.z = g1 * (bflo(a.y) + bflo(p.y)) + g2 * (bflo(b.y) + bflo(q.y)); y.w = g1 * (bfhi(a.y) + bfhi(p.y)) + g2 * (bfhi(b.y) + bfhi(q.y));
            v[j] = d0.x[j] + g * y; ss += (v[j].x * v[j].x + v[j].y * v[j].y) + (v[j].z * v[j].z + v[j].w * v[j].w); }
        const float rstd = rsqrtf(wave_sum(ss) * (1.f / 1024.f) + EPS);
        const f32x4* fg = (const f32x4*)c.in[I_FNG] + c.lane; f32x4* o = (f32x4*)(c.out + (size_t)r * 1024) + c.lane;
#pragma unroll
        for (int j = 0; j < 4; ++j) o[64 * j] = v[j] * rstd * fg[64 * j];
        sc0 = sc1; sc1 = sc2; d0 = d1;
    }
#undef FIN_SC
#undef FIN_DT
}

#define LAS __attribute__((address_space(3)))
#define XB_TMO      128
#define XB_XCNT(j)  (256  + 64 * (j))
#define XB_XSUB(j)  (1280 + 64 * (j))
#define XB_XGEN(j)  (2304 + 64 * (j))
#define XB_TOP      3328
#define XB_TOPGEN   3392
#define XCD_BAR_WORDS 3456
#define XB_SPIN_CAP (1u << 18)

__device__ __forceinline__ unsigned xb_ld(unsigned* p)              { return __hip_atomic_load(p, __ATOMIC_RELAXED, __HIP_MEMORY_SCOPE_AGENT); }
__device__ __forceinline__ unsigned xb_add(unsigned* p, unsigned v) { return __hip_atomic_fetch_add(p, v, __ATOMIC_RELAXED, __HIP_MEMORY_SCOPE_AGENT); }
__device__ __forceinline__ unsigned xb_xcc_id() { return (unsigned)__builtin_amdgcn_s_getreg((3 << 11) | 20) & 0xFu; }
#define XB_SPIN(cond, bar) do { unsigned _sp = 0; while (cond) { __builtin_amdgcn_s_sleep(1); \
    if ((++_sp & 255u) == 0u) { if (xb_ld(&(bar)[XB_TMO])) break; if (_sp > XB_SPIN_CAP) { atomicAdd(&(bar)[XB_TMO], 1u); break; } } } } while (0)

struct XcdBarrier {
    unsigned* bar; unsigned x;
    volatile LAS unsigned* st;
};

__device__ __forceinline__ XcdBarrier xcd_barrier_post(unsigned* bar, volatile LAS unsigned* st) {
    XcdBarrier b; b.bar = bar; b.x = xb_xcc_id(); b.st = st;
    if (threadIdx.x == 0) (void)xb_add(&bar[XB_XCNT(b.x)], 1u);
    return b;
}
__device__ __forceinline__ void xcd_barrier_complete(unsigned* bar, unsigned x, unsigned& nloc, unsigned& nx) {
    const unsigned G = gridDim.x * gridDim.y * gridDim.z;
    unsigned sum, cnt, mine, sp = 0u;
    for (;;) {
        sum = 0u; cnt = 0u; mine = 0u;
#pragma unroll
        for (unsigned j = 0; j < 16; ++j) { const unsigned c = xb_ld(&bar[XB_XCNT(j)]); sum += c; cnt += (c > 0u) ? 1u : 0u; mine = (j == x) ? c : mine; }
        if (sum == G) break;
        __builtin_amdgcn_s_sleep(1);
        if ((++sp & 255u) == 0u) { if (xb_ld(&bar[XB_TMO])) break; if (sp > XB_SPIN_CAP) { atomicAdd(&bar[XB_TMO], 1u); break; } }
    }
    nloc = mine > 0u ? mine : 1u; nx = cnt > 0u ? cnt : 1u;
}

__device__ __forceinline__ void xcd_barrier(const XcdBarrier& b) {
    asm volatile("s_waitcnt vmcnt(0)" ::: "memory");
    __syncthreads();
    if (threadIdx.x == 0) {
        unsigned* bar = b.bar;
        __builtin_amdgcn_s_waitcnt(0);
        unsigned nloc = b.st[0], nx = b.st[1];
        if (nloc == 0u) { xcd_barrier_complete(bar, b.x, nloc, nx); b.st[0] = nloc; b.st[1] = nx; }
        const unsigned old = xb_add(&bar[XB_XSUB(b.x)], 1u);
        const unsigned gen = old / nloc;
        if (old + 1u == (gen + 1u) * nloc) {
            __builtin_amdgcn_fence(__ATOMIC_RELEASE, "agent");
            asm volatile("s_waitcnt vmcnt(0)" ::: "memory");
            const unsigned og = xb_add(&bar[XB_TOP], 1u);
            const unsigned tg = og / nx;
            if (og + 1u == (tg + 1u) * nx) xb_add(&bar[XB_TOPGEN], 1u);
            else XB_SPIN(xb_ld(&bar[XB_TOPGEN]) == tg, bar);
            __builtin_amdgcn_fence(__ATOMIC_ACQUIRE, "agent");
            xb_add(&bar[XB_XGEN(b.x)], 1u);
            asm volatile("s_waitcnt vmcnt(0)" ::: "memory");
        } else {
            XB_SPIN(xb_ld(&bar[XB_XGEN(b.x)]) == gen, bar);
            __builtin_amdgcn_fence(__ATOMIC_ACQUIRE, "agent");
            asm volatile("s_waitcnt vmcnt(0)" ::: "memory");
        }
    }
    __syncthreads();
}

#ifndef FAST_DN
#define FAST_DN 1
#endif
constexpr int NPHASES = 24;
#define IN(k) (lo <= (k) && (k) < hi)
#define SYNC(k) do { if (IN(k) && IN((k) + 1)) xcd_barrier(grid); } while (0)
template <int LAYER>
DEVI void mixer_phases(const Ctx& c, int lo, int hi, int psub, const XcdBarrier& grid) {
    constexpr int P = 1 + LAYER * 10;
    bf16_t* wl = (bf16_t*)(c.ws + WS_WL);
    const float* mvl = (const float*)(c.ws + CTL_MODV) + (size_t)LAYER * 5 * 6144;
    const float* xl = LAYER == 0 ? c.in[I_X] : (const float*)(c.ws + WS_XB); const float* xc = LAYER == 0 ? c.in[I_CTX] : (const float*)(c.ws + WS_XB) + (size_t)NLAT * 1024;
    if (IN(P)) { phase_norm<false>(c, LAYER, 0, c.in[I_N1G] + LAYER * 1024, NT, xl, xc, LAYER == 1 ? (const float*)(c.ws + WS_PB) : nullptr); } SYNC(P);
    if (IN(P + 1)) { const bf16_t* bt = (const bf16_t*)((char*)wl + WL_WIN) + (size_t)LAYER * ZP * 1024;
        pg8::Gemm g{(const bf16_t*)(c.ws + WS_H), bt, NT, ZP, 1024}; pg8::StaticOrder S; S.init(NT, ZP, (int)gridDim.x, (int)blockIdx.x);
        pg8::gemm_phase<pg8::EpiStore, pg8::StaticOrder, true, true>(c.lds3, g, S, pg8::EpiStore{(bf16_t*)(c.ws + WS_Z), ZP, 0, 0l}); } SYNC(P + 1);
    if (IN(P + 2)) { phase_prep(c, LAYER, LAYER == 0); } SYNC(P + 2);
#if FAST_DN
    if (IN(P + 3)) { if (!(psub & 1)) dn::phase_chunkprep(c); if (!(psub & 2)) phase_sgu(c, LAYER, LAYER == 0); } SYNC(P + 3);
    if (IN(P + 4)) { phase_mixer_fast<true>(c, LAYER == 0, psub); } SYNC(P + 4);
#else
    if (IN(P + 3)) { phase_sgu(c, LAYER, LAYER == 0); } SYNC(P + 3);
    if (IN(P + 4)) { phase_dnscan_naive(c); phase_mixer_fast<false>(c, LAYER == 0); } SYNC(P + 4);
#endif
    if (IN(P + 5)) { phase_dnfinish(c, LAYER, LAYER == 0 ? NT : NLAT); } SYNC(P + 5);
    if (IN(P + 6)) { const bf16_t* bt = (const bf16_t*)((char*)wl + WL_WOUT) + (size_t)LAYER * 1024 * 1024;
        constexpr int MR = LAYER == 0 ? NT : NLAT;
        pg8::Gemm g{(const bf16_t*)(c.ws + WS_MIX), bt, MR, 1024, 1024}; pg8::StaticOrder S; S.init(MR, 1024, (int)gridDim.x, (int)blockIdx.x);
        pg8::gemm_phase<pg8::EpiRes, pg8::StaticOrder, true, true>(c.lds3, g, S, pg8::EpiRes{(float*)(c.ws + WS_XB), mvl, 2, xl, xc, nullptr}); } SYNC(P + 6);
}

__global__ void __launch_bounds__(NTHREADS, 2) mega_fwd(Args args) {
    extern __shared__ __attribute__((aligned(16))) unsigned char lds_raw[];
    Ctx c;
#pragma unroll
    for (int i = 0; i < 28; ++i) c.in[i] = args.in[i];
    c.out = args.out; c.ws = args.ws; c.tid = threadIdx.x; c.lane = c.tid & 63; c.wave = __builtin_amdgcn_readfirstlane(c.tid >> 6);
    c.gw = blockIdx.x * NWAVES + c.wave; c.ngw = gridDim.x * NWAVES; c.lds = (float*)lds_raw; c.lds3 = (__attribute__((address_space(3))) unsigned char*)lds_raw;
    bf16_t* wl = (bf16_t*)(c.ws + WS_WL);
    const int lo = args.ph_lo, hi = args.ph_hi;
    volatile LAS unsigned* bst = (volatile LAS unsigned*)(c.lds3 + LDS_BYTES - 64);
    if (c.tid < 16) bst[c.tid] = 0u;
    __syncthreads();
    const XcdBarrier grid = xcd_barrier_post((unsigned*)(c.ws + WS_CTL), bst);
    if (IN(0)) { phase_prologue(c); } SYNC(0);
    mixer_phases<0>(c, lo, hi, args.probe_sub, grid);
    {
        const float* mvl = (const float*)(c.ws + CTL_MODV);
        const float* xbl = (const float*)(c.ws + WS_XB); const float* xbc = xbl + (size_t)NLAT * 1024;
        if (IN(8)) { phase_norm<false>(c, 0, 3, c.in[I_N2G], NT, xbl, xbc); } SYNC(8);
        if (IN(9)) { pg8::Gemm g{(const bf16_t*)(c.ws + WS_H), (const bf16_t*)((char*)wl + WL_F13), NT, 2 * FF, 1024}; pg8::StaticOrder S; S.init(NT, 2 * FF, (int)gridDim.x, (int)blockIdx.x);
            pg8::gemm_phase<pg8::EpiSwi, pg8::StaticOrder, true, true>(c.lds3, g, S, pg8::EpiSwi{(bf16_t*)(c.ws + WS_Z), FF, 0}); } SYNC(9);
        if (IN(10)) { pg8::Gemm g{(const bf16_t*)(c.ws + WS_Z), (const bf16_t*)((char*)wl + WL_F2), NT, 1024, FF}; pg8::FfnDownOrder S; S.init((int)gridDim.x, (int)blockIdx.x, FF / 128);
            pg8::gemm_phase<pg8::EpiRes, pg8::FfnDownOrder, true, true>(c.lds3, g, S, pg8::EpiRes{(float*)(c.ws + WS_XB), mvl, 5, xbl, xbc, (float*)(c.ws + WS_PB)}); } SYNC(10);
    }
    mixer_phases<1>(c, lo, hi, args.probe_sub, grid);
    {
        if (IN(18)) { const float* xbl = (const float*)(c.ws + WS_XB);
            if (gridDim.x == 256) {
                if (c.wave < 4) phase_norm<true>(c, 1, 3, c.in[I_N2G] + 1024, NLAT, xbl, xbl + (size_t)NLAT * 1024, nullptr, 16);
                else phase_conv_m13(c, (int)blockIdx.x * 4 + (c.wave - 4), 1024);
                __syncthreads();
                if (c.tid < 8) { const int* sel = (const int*)c.lds; int n = 0; for (int q = 0; q < 128; ++q) n += (sel[q] == c.tid) ? 1 : 0; ((int*)(c.ws + CTL_CNT))[blockIdx.x * 8 + c.tid] = n; }
            } else { phase_norm<true>(c, 1, 3, c.in[I_N2G] + 1024, NLAT, xbl, xbl + (size_t)NLAT * 1024); phase_conv_m13(c); } } SYNC(18);
        if (IN(19)) { phase_moe_assign(c); } SYNC(19);
        if (IN(20)) { pg8::Gemm g{(const bf16_t*)(c.ws + WS_MXB), (const bf16_t*)(c.ws + WS_M13), 0, 0, 1024}; pg8::MoeOrder S; S.init((const int*)(c.ws + CTL_SEG), 28, (int)gridDim.x, (int)blockIdx.x);
            pg8::gemm_phase<pg8::EpiSwi, pg8::MoeOrder, true, true>(c.lds3, g, S, pg8::EpiSwi{(bf16_t*)(c.ws + WS_MHID), MFF, 28}); } SYNC(20);
        if (IN(21)) { phase_conv_m2(c); } SYNC(21);
        if (IN(22)) { pg8::Gemm g{(const bf16_t*)(c.ws + WS_MHID), (const bf16_t*)(c.ws + WS_M2), 0, 0, MFF}; pg8::TableOrder S; S.init((const int*)(c.ws + CTL_UTAB), (int)gridDim.x, (int)blockIdx.x);
            pg8::gemm_phase<pg8::EpiStore, pg8::TableOrder, true, true>(c.lds3, g, S, pg8::EpiStore{(bf16_t*)(c.ws + WS_MXB), 1024, 4, (long)((WS_YB2 - WS_MXB) / 2) - 32768l * 1024}); } SYNC(22);
        if (IN(23)) { phase_final(c); }
    }
}
#undef IN
#undef SYNC

extern "C" void kernel_launch(void* const* d_in, const int* in_sizes, int n_in, void* d_out, int out_size, void* d_ws, size_t ws_size, hipStream_t stream) {
    static int grid = 0;
    if (grid == 0) {
        if (n_in != 28 || out_size != NLAT * D || ws_size < WS_END) { fprintf(stderr, "kernel_launch: unexpected shapes (n_in %d out %d ws %zu)\n", n_in, out_size, ws_size); grid = -1; return; }
        int dev = 0, cus = 0, per_cu = 0;
        hipGetDevice(&dev); hipDeviceGetAttribute(&cus, hipDeviceAttributeMultiprocessorCount, dev);
        hipFuncSetAttribute((const void*)mega_fwd, hipFuncAttributeMaxDynamicSharedMemorySize, LDS_BYTES);
        hipOccupancyMaxActiveBlocksPerMultiprocessor(&per_cu, (const void*)mega_fwd, NTHREADS, LDS_BYTES);
        if (per_cu < 1) { fprintf(stderr, "kernel_launch: occupancy query says %d blocks per CU\n", per_cu); per_cu = 1; }
        (void)hipGetLastError();
        grid = cus;
    }
    if (grid < 0) return;
    if (hipMemsetAsync(d_ws, 0, 16384, stream) != hipSuccess) { fprintf(stderr, "kernel_launch: memset of the barrier words failed\n"); return; }
    Args a{};
    for (int i = 0; i < 28; ++i) a.in[i] = (const float*)d_in[i];
    a.out = (float*)d_out; a.ws = (unsigned char*)d_ws;
#ifndef MK_PER_PHASE
#define MK_PER_PHASE 0
#endif
#if MK_PER_PHASE
    for (int ph = 0; ph < NPHASES; ++ph) {
        a.ph_lo = ph; a.ph_hi = ph + 1; void* kargs[] = {&a};
        hipError_t e = hipLaunchCooperativeKernel((const void*)mega_fwd, dim3(grid), dim3(NTHREADS), kargs, LDS_BYTES, stream);
        if (e != hipSuccess) { fprintf(stderr, "launch failed: %s\n", hipGetErrorString(e)); break; }
    }
#else
    a.ph_lo = 0; a.ph_hi = NPHASES; void* kargs[] = {&a};
    hipError_t e = hipLaunchCooperativeKernel((const void*)mega_fwd, dim3(grid), dim3(NTHREADS), kargs, LDS_BYTES, stream);
    if (e != hipSuccess) fprintf(stderr, "launch failed: %s\n", hipGetErrorString(e));
#ifndef PROBE_LO
#define PROBE_LO -1
#define PROBE_HI -1
#endif
#if PROBE_LO >= 0
    (void)hipMemsetAsync(d_ws, 0, 16384, stream);
    a.ph_lo = PROBE_LO; a.ph_hi = PROBE_HI;
#ifdef PROBE_SUB
    a.probe_sub = PROBE_SUB;
#endif
    e = hipLaunchCooperativeKernel((const void*)mega_fwd, dim3(grid), dim3(NTHREADS), kargs, LDS_BYTES, stream);
    if (e != hipSuccess) fprintf(stderr, "probe launch failed: %s\n", hipGetErrorString(e));
#endif
#endif
}
```

```cpp
#include <hip/hip_runtime.h>
#include <hip/hip_cooperative_groups.h>
#include <hip/hip_bf16.h>
#include <cstdio>
#include <cstdint>
namespace cg = cooperative_groups;

#define DEVI __device__ __forceinline__
typedef unsigned short bf16_t;
typedef float f32x4 __attribute__((ext_vector_type(4)));
typedef float f32x2 __attribute__((ext_vector_type(2)));
typedef unsigned u32x4 __attribute__((ext_vector_type(4)));
typedef unsigned u32x2 __attribute__((ext_vector_type(2)));

constexpr int D = 1024, NB = 4, SEQ = 4096, CTXL = 256;
constexpr int NLAT = NB * SEQ, NCTX = NB * CTXL, NT = NLAT + NCTX;
constexpr int SKV = CTXL + SEQ;
constexpr int INC = 2712, ZP = 2816;
constexpr int ZC_QKV = 0, ZC_GATE = 1152, ZC_AQ = 1536, ZC_AK = 1920, ZC_AV = 2048, ZC_MU = 2176, ZC_MV = 2432, ZC_BETA = 2688, ZC_ALPHA = 2700;
constexpr int FF = 2816, MFF = 3584, NE = 8;
constexpr int MAXSLOT = 34816;
constexpr float EPS = 1e-6f;
constexpr float QSCALE = 0.125f * 1.4426950408889634f;

constexpr size_t MiB = 1u << 20, KiB = 1024;
constexpr size_t WS_CTL = 0;
constexpr size_t CTL_ROPE = 32 * KiB;
constexpr size_t CTL_MODV = 64 * KiB;
constexpr size_t CTL_TOPE = 320 * KiB;
constexpr size_t CTL_TOPG = 448 * KiB;
constexpr size_t CTL_CNT = 576 * KiB;
constexpr size_t CTL_SEG = 584 * KiB;
constexpr size_t CTL_TOKSLOT = 592 * KiB;
constexpr size_t CTL_UTAB = 720 * KiB;
constexpr size_t WS_XB = 4 * MiB;
constexpr size_t WS_WL = 72 * MiB;
constexpr size_t WL_WIN = 0;
constexpr size_t WL_WOUT = 11 * MiB;
constexpr size_t WL_F13 = 15 * MiB;
constexpr size_t WL_F2 = 26 * MiB;
static_assert(WL_WIN + (size_t)2 * 2816 * 1024 * 2 <= WL_WOUT && WL_WOUT + (size_t)2 * 1024 * 1024 * 2 <= WL_F13 && WL_F13 + (size_t)5632 * 1024 * 2 <= WL_F2 && WS_WL + WL_F2 + (size_t)1024 * 2816 * 2 <= 104 * MiB, "WL map");
constexpr size_t WS_H = 104 * MiB;
constexpr size_t WS_Z = 138 * MiB;
constexpr size_t WS_MIX = 232 * MiB;
constexpr size_t WS_QA = 266 * MiB;
constexpr size_t WS_QC = 278 * MiB;
constexpr size_t WS_KA = 279 * MiB;
constexpr size_t WS_VA = 284 * MiB;
constexpr size_t WS_DN = 289 * MiB;
constexpr size_t WS_QN = WS_H, WS_KN = WS_H + 13 * MiB;
constexpr size_t DN_VB = 0;
constexpr size_t DN_BG = 13 * MiB;
constexpr size_t DN_O = 15 * MiB;
constexpr size_t WS_SV = 499 * MiB;
constexpr size_t DN_OPS = 66 * MiB;
static_assert(WS_DN + DN_OPS + (size_t)3264 * 46080 <= WS_SV && WS_SV + (size_t)NT * 256 * 2 <= 512 * MiB, "ws");
constexpr size_t WS_MHID = 72 * MiB;
constexpr size_t WS_MXB = 310 * MiB;
constexpr size_t WS_M13 = 378 * MiB;
constexpr size_t WS_M2 = 378 * MiB;
constexpr size_t WS_PB = 508 * MiB;
constexpr size_t WS_YB2 = 440 * MiB;
constexpr size_t WS_END = 512 * MiB;
static_assert(WS_M13 + (size_t)8 * 7168 * 1024 * 2 <= WS_END, "ws");
static_assert(WS_MHID + (size_t)MAXSLOT * 3584 * 2 <= WS_MXB && WS_MXB + (size_t)MAXSLOT * 1024 * 2 <= WS_M13, "ws");
static_assert(WS_H + (size_t)NT * 1024 * 2 <= WS_Z && WS_Z + (size_t)NT * ZP * 2 <= WS_MIX && WS_MIX + (size_t)NT * 1024 * 2 <= WS_QA, "ws");

constexpr int LDS_BYTES = 147456;
constexpr int NTHREADS = 512, NWAVES = 8;

DEVI unsigned f2bf(float f) { unsigned u = __float_as_uint(f); return (u + 0x7fffu + ((u >> 16) & 1u)) >> 16; }
DEVI float bf2f(unsigned h) { return __uint_as_float(h << 16); }
DEVI unsigned pk2(float lo, float hi) { return f2bf(lo) | (f2bf(hi) << 16); }
DEVI float bflo(unsigned w) { return __uint_as_float(w << 16); }
DEVI float bfhi(unsigned w) { return __uint_as_float(w & 0xffff0000u); }
DEVI void unpack8(const u32x4 w, float* v) { v[0] = bflo(w.x); v[1] = bfhi(w.x); v[2] = bflo(w.y); v[3] = bfhi(w.y); v[4] = bflo(w.z); v[5] = bfhi(w.z); v[6] = bflo(w.w); v[7] = bfhi(w.w); }
DEVI u32x4 pack8(const float* v) { u32x4 w; w.x = pk2(v[0], v[1]); w.y = pk2(v[2], v[3]); w.z = pk2(v[4], v[5]); w.w = pk2(v[6], v[7]); return w; }
DEVI float wave_sum(float v) {
#pragma unroll
    for (int o = 1; o < 64; o <<= 1) v += __shfl_xor(v, o);
    return v;
}
DEVI float wave_max(float v) {
#pragma unroll
    for (int o = 1; o < 64; o <<= 1) v = fmaxf(v, __shfl_xor(v, o));
    return v;
}
DEVI float silu_f(float x) { return x * __builtin_amdgcn_rcpf(1.f + __expf(-x)); }
DEVI float gelu_f(float x) { const float u = 0.7978845608028654f * (x + 0.044715f * x * x * x); const float e = __expf(2.f * u); return x * (1.f - __builtin_amdgcn_rcpf(1.f + e)); }
DEVI float softplus_f(float x) { const float e = __expf(-fabsf(x)); const float l = e < 0.01f ? e * (1.f - e * (0.5f - e * 0.33333334f)) : __logf(1.f + e); return fmaxf(x, 0.f) + l; }
DEVI int row_mod(int r) { return r < NLAT ? (r >> 12) : 4; }

struct Args { const float* in[28]; float* out; unsigned char* ws; int ph_lo, ph_hi, probe_sub, pad; };

struct Ctx {
    const float* in[28]; float* out; unsigned char* ws;
    int tid, lane, wave, gw, ngw;
    float* lds;
    __attribute__((address_space(3))) unsigned char* lds3;
};
enum { I_X = 0, I_C, I_CTX, I_CCTX, I_MODW, I_MODB, I_N1G, I_N2G, I_WIN, I_CONVW, I_ALOG, I_DTB, I_DNG, I_QG, I_KG, I_SGUG, I_SGUW, I_SGUB, I_WOUT,
       I_F1, I_F3, I_F2, I_RW, I_RB, I_M1, I_M3, I_M2, I_FNG };

DEVI const float* modv(const Ctx& c, int layer, int r, int which) { return (const float*)(c.ws + CTL_MODV) + ((size_t)(layer * 5 + row_mod(r)) * 6 + which) * 1024; }

template <int MAP>
DEVI int map_row(int n, int add) {
    if (MAP == 1) return n < 1536 ? n : (n < 1560 ? n + 1152 : n - 24);
    if (MAP == 2) return (n >> 7) * 256 + (n & 127) + add;
    return n;
}
template <int MAP>
DEVI void transpose_tiles(const Ctx& c, const float* W, int K, int N, bf16_t* WT, int add, int& base, int wv = -1, int nwv = 0) {
    float* Ls = c.lds + c.wave * (64 * 65);
    const int ntn = (N + 63) / 64, ntiles = (K / 64) * ntn, G = wv < 0 ? c.ngw : nwv, wid = wv < 0 ? c.gw : wv;
    const int nq = c.lane & 15, kr = c.lane >> 4, cch = c.lane & 7, rn = c.lane >> 3;
    int t = (wid - base % G + G) % G;
    base += ntiles;
    f32x4 v[16];
#define TT_LOAD(tile) do { const int kb_ = (tile) / ntn, nb_ = (tile) % ntn, n_ = nb_ * 64 + 4 * nq; \
        _Pragma("unroll") for (int p_ = 0; p_ < 16; ++p_) v[p_] = n_ < N ? __builtin_nontemporal_load((const f32x4*)(W + (size_t)(kb_ * 64 + kr + 4 * p_) * N + n_)) : (f32x4){0.f, 0.f, 0.f, 0.f}; } while (0)
    if (t < ntiles) TT_LOAD(t);
    for (; t < ntiles; t += G) {
#pragma unroll
        for (int p = 0; p < 16; ++p) { float* q = Ls + (kr + 4 * p) * 65 + 4 * nq; q[0] = v[p].x; q[1] = v[p].y; q[2] = v[p].z; q[3] = v[p].w; }
        if (t + G < ntiles) TT_LOAD(t + G);
        __builtin_amdgcn_wave_barrier(); asm volatile("" ::: "memory");
        const int kb = t / ntn, nb = t % ntn;
#pragma unroll
        for (int j = 0; j < 8; ++j) { const int nl = 8 * j + rn, n = nb * 64 + nl; float x[8];
#pragma unroll
            for (int i = 0; i < 8; ++i) x[i] = Ls[(8 * cch + i) * 65 + nl];
            if (n < N) *(u32x4*)(WT + (size_t)map_row<MAP>(n, add) * K + kb * 64 + 8 * cch) = pack8(x); }
        __builtin_amdgcn_wave_barrier(); asm volatile("" ::: "memory");
    }
#undef TT_LOAD
}

DEVI void phase_prologue(const Ctx& c) {
    bf16_t* wl = (bf16_t*)(c.ws + WS_WL);
    int tb = 0;
    for (int l = 0; l < 2; ++l) {
        transpose_tiles<1>(c, c.in[I_WIN] + (size_t)l * 1024 * INC, 1024, INC, (bf16_t*)((char*)wl + WL_WIN) + (size_t)l * ZP * 1024, 0, tb);
        transpose_tiles<0>(c, c.in[I_WOUT] + (size_t)l * 1024 * 1024, 1024, 1024, (bf16_t*)((char*)wl + WL_WOUT) + (size_t)l * 1024 * 1024, 0, tb);
        u32x4* pad = (u32x4*)((bf16_t*)((char*)wl + WL_WIN) + (size_t)l * ZP * 1024 + (size_t)INC * 1024);
        for (int i = c.gw * 64 + c.lane; i < (ZP - INC) * 1024 / 8; i += c.ngw * 64) pad[i] = (u32x4){0u, 0u, 0u, 0u};
    }
    transpose_tiles<2>(c, c.in[I_F1], 1024, FF, (bf16_t*)((char*)wl + WL_F13), 0, tb);
    transpose_tiles<2>(c, c.in[I_F3], 1024, FF, (bf16_t*)((char*)wl + WL_F13), 128, tb);
    transpose_tiles<0>(c, c.in[I_F2], FF, 1024, (bf16_t*)((char*)wl + WL_F2), 0, tb);
    if (blockIdx.x == 0) for (int i = c.tid; i < 2 * 64 * 16; i += NTHREADS) { const int p = i & 15, pos = (i >> 4) & 63, ax = i >> 10;
        const float ang = (float)pos * powf(10000.f, -2.f * (float)p / 32.f); float* tp = (float*)(c.ws + CTL_ROPE) + (ax * 64 + pos) * 32; tp[p] = cosf(ang); tp[16 + p] = sinf(ang); }
    if (blockIdx.x == 0 && c.tid < 32) ((float*)(c.ws + CTL_ROPE))[128 * 32 + c.tid] = c.tid < 16 ? 1.f : 0.f;
    __syncthreads();
    {
        float* sc = c.lds;
        float* part = c.lds + 5 * 1024;
        for (int i = c.tid; i < 5 * 1024; i += NTHREADS) { const int r = i >> 10, k = i & 1023; const float v = r < 4 ? c.in[I_C][r * 1024 + k] : c.in[I_CCTX][k]; sc[i] = silu_f(v); }
        __syncthreads();
        for (int item = blockIdx.x; item < 2 * 96; item += gridDim.x) {
            const int l = item / 96, j = (item % 96) * 64 + c.lane;
            const float* w = c.in[I_MODW] + (size_t)l * 1024 * 6144 + j;
            float a0 = 0.f, a1 = 0.f, a2 = 0.f, a3 = 0.f, a4 = 0.f;
            const int kb = c.wave * 128;
#pragma unroll 4
            for (int k = 0; k < 128; ++k) { const float wv = w[(size_t)(kb + k) * 6144]; a0 += sc[kb + k] * wv; a1 += sc[1024 + kb + k] * wv; a2 += sc[2048 + kb + k] * wv; a3 += sc[3072 + kb + k] * wv; a4 += sc[4096 + kb + k] * wv; }
            float* p = part + c.wave * 320 + c.lane; p[0] = a0; p[64] = a1; p[128] = a2; p[192] = a3; p[256] = a4;
            __syncthreads();
            if (c.tid < 320) { float s = 0.f;
#pragma unroll
                for (int w8 = 0; w8 < 8; ++w8) s += part[w8 * 320 + c.tid];
                const int r = c.tid >> 6, jj = (item % 96) * 64 + (c.tid & 63);
                ((float*)(c.ws + CTL_MODV))[(size_t)(l * 5 + r) * 6144 + jj] = s + c.in[I_MODB][l * 6144 + jj]; }
            __syncthreads();
        }
    }
}

DEVI void phase_conv_m13(const Ctx& c, int wv = -1, int nwv = 0) {
    int tb = 0;
    for (int e = 0; e < NE; ++e) {
        bf16_t* dst = (bf16_t*)(c.ws + WS_M13) + (size_t)e * 7168 * 1024;
        transpose_tiles<2>(c, c.in[I_M1] + (size_t)e * 1024 * MFF, 1024, MFF, dst, 0, tb, wv, nwv);
        transpose_tiles<2>(c, c.in[I_M3] + (size_t)e * 1024 * MFF, 1024, MFF, dst, 128, tb, wv, nwv);
    }
}
DEVI void phase_conv_m2(const Ctx& c, int wv = -1, int nwv = 0) {
    int tb = 0;
    for (int e = 0; e < NE; ++e)
        transpose_tiles<0>(c, c.in[I_M2] + (size_t)e * MFF * 1024, MFF, 1024, (bf16_t*)c.out + (size_t)e * 1024 * MFF, 0, tb, wv, nwv);
}

template <bool ROUTER>
DEVI void phase_norm(const Ctx& c, int layer, int which0, const float* gain, int nrows, const float* src_lat, const float* src_ctx, const float* addp = nullptr, int rpw = 8) {
    bf16_t* H = (bf16_t*)(c.ws + WS_H);
#define NORM_ROW(rr) ((rr) < NLAT ? src_lat + (size_t)(rr) * 1024 : src_ctx + (size_t)((rr) - NLAT) * 1024)
    int* sel = (int*)c.lds;
    const int nvb = nrows / 64;
    int vb = blockIdx.x, i = 0;
    int r = ROUTER ? vb * 64 + c.wave * rpw : c.gw;
    bool valid = ROUTER ? (vb < nvb && c.wave * rpw < 64) : (r < nrows);
    f32x4 v[4];
    if (valid) { const f32x4* xr = (const f32x4*)NORM_ROW(r) + c.lane;
#pragma unroll
        for (int j = 0; j < 4; ++j) v[j] = xr[64 * j]; }
    while (valid) {
        int rn, vbn = vb, in_ = i + 1; bool validn;
        if (ROUTER) { if (in_ == rpw) { in_ = 0; vbn = vb + gridDim.x; } rn = vbn * 64 + c.wave * rpw + in_; validn = vbn < nvb; }
        else { rn = r + c.ngw; validn = rn < nrows; }
        f32x4 vn[4];
        if (validn) { const f32x4* xr = (const f32x4*)NORM_ROW(rn) + c.lane;
#pragma unroll
            for (int j = 0; j < 4; ++j) vn[j] = xr[64 * j]; }
        if (addp && r >= NLAT) { const f32x4* pr = (const f32x4*)(addp + (size_t)(r - NLAT) * 1024) + c.lane;
#pragma unroll
            for (int j = 0; j < 4; ++j) v[j] = v[j] + pr[64 * j]; }
        float ss = 0.f;
#pragma unroll
        for (int j = 0; j < 4; ++j) ss += (v[j].x * v[j].x + v[j].y * v[j].y) + (v[j].z * v[j].z + v[j].w * v[j].w);
        const float rstd = rsqrtf(wave_sum(ss) * (1.f / 1024.f) + EPS);
        const f32x4* g4 = (const f32x4*)gain + c.lane; const f32x4* sh4 = (const f32x4*)modv(c, layer, r, which0) + c.lane; const f32x4* sc4 = (const f32x4*)modv(c, layer, r, which0 + 1) + c.lane;
        u32x2* o8 = (u32x2*)(H + (size_t)r * 1024) + c.lane;
#pragma unroll
        for (int j = 0; j < 4; ++j) { const f32x4 g = g4[64 * j], sh = sh4[64 * j], sc = sc4[64 * j];
            v[j] = v[j] * rstd * g * (1.f + sc) + sh;
            u32x2 o; o.x = pk2(v[j].x, v[j].y); o.y = pk2(v[j].z, v[j].w); o8[64 * j] = o; }
        if (ROUTER) {
            float lg[8];
#pragma unroll
            for (int e = 0; e < 8; ++e) lg[e] = 0.f;
            const float* rw = c.in[I_RW];
#pragma unroll
            for (int j = 0; j < 4; ++j)
#pragma unroll
                for (int q = 0; q < 4; ++q) { const int col = 4 * c.lane + 256 * j + q; const f32x4 w0 = *(const f32x4*)(rw + col * 8), w1 = *(const f32x4*)(rw + col * 8 + 4); const float hv = v[j][q];
                    lg[0] += hv * w0.x; lg[1] += hv * w0.y; lg[2] += hv * w0.z; lg[3] += hv * w0.w; lg[4] += hv * w1.x; lg[5] += hv * w1.y; lg[6] += hv * w1.z; lg[7] += hv * w1.w; }
#pragma unroll
            for (int e = 0; e < 8; ++e) lg[e] = wave_sum(lg[e]) + c.in[I_RB][e];
            int e1 = 0; float l1 = lg[0];
#pragma unroll
            for (int e = 1; e < 8; ++e) if (lg[e] > l1) { l1 = lg[e]; e1 = e; }
            int e2 = -1; float l2 = -3.0e38f;
#pragma unroll
            for (int e = 0; e < 8; ++e) if (e != e1 && lg[e] > l2) { l2 = lg[e]; e2 = e; }
            const float g2 = 1.f / (1.f + expf(l1 - l2)), g1 = 1.f - g2;
            if (c.lane == 0) { int* te = (int*)(c.ws + CTL_TOPE) + r * 2; te[0] = e1; te[1] = e2; float* tg = (float*)(c.ws + CTL_TOPG) + r * 2; tg[0] = g1; tg[1] = g2;
                sel[(c.wave * rpw + i) * 2] = e1; sel[(c.wave * rpw + i) * 2 + 1] = e2; }
            if (rpw == 8 && i == 7) {
                __syncthreads();
                if (c.tid < 8) { int n = 0; for (int q = 0; q < 128; ++q) n += (sel[q] == c.tid) ? 1 : 0; ((int*)(c.ws + CTL_CNT))[vb * 8 + c.tid] = n; }
                __syncthreads();
            }
        }
#pragma unroll
        for (int j = 0; j < 4; ++j) v[j] = vn[j];
        r = rn; vb = vbn; i = in_; valid = validn;
    }
}

#undef NORM_ROW
template <bool DUAL, class BSel, class Epi>
DEVI void gemm_naive(const Ctx& c, const bf16_t* A, int lda, int K, int ntm, int ntn, const BSel& bsel, const Epi& epi) {
    float* As = c.lds; float* Bs = c.lds + 32 * 132; float* Bs2 = c.lds + 2 * 32 * 132;
    const int ty = c.tid >> 4, tx = c.tid & 15, lr = c.tid >> 2, lk = (c.tid & 3) * 8;
    for (int tile = blockIdx.x; tile < ntm * ntn; tile += gridDim.x) {
        const int tm = tile / ntn, tn = tile % ntn;
        const bf16_t* B0 = bsel(tm, tn, 0); if (!B0) continue;
        const bf16_t* B1 = DUAL ? bsel(tm, tn, 1) : B0;
        float acc[4][8], acc2[4][8];
#pragma unroll
        for (int i = 0; i < 4; ++i)
#pragma unroll
            for (int j = 0; j < 8; ++j) { acc[i][j] = 0.f; acc2[i][j] = 0.f; }
        const bf16_t* ap = A + (size_t)(tm * 128 + lr) * lda + lk; const bf16_t* bp = B0 + (size_t)lr * K + lk; const bf16_t* bp2 = B1 + (size_t)lr * K + lk;
        for (int k0 = 0; k0 < K; k0 += 32) {
            const u32x4 av = *(const u32x4*)(ap + k0), bv = *(const u32x4*)(bp + k0); u32x4 bv2 = bv; if (DUAL) bv2 = *(const u32x4*)(bp2 + k0);
            __syncthreads();
#pragma unroll
            for (int q = 0; q < 4; ++q) { As[(lk + 2 * q) * 132 + lr] = bflo(av[q]); As[(lk + 2 * q + 1) * 132 + lr] = bfhi(av[q]);
                Bs[(lk + 2 * q) * 132 + lr] = bflo(bv[q]); Bs[(lk + 2 * q + 1) * 132 + lr] = bfhi(bv[q]);
                if (DUAL) { Bs2[(lk + 2 * q) * 132 + lr] = bflo(bv2[q]); Bs2[(lk + 2 * q + 1) * 132 + lr] = bfhi(bv2[q]); } }
            __syncthreads();
#pragma unroll 4
            for (int kk = 0; kk < 32; ++kk) {
                const f32x4 a = *(const f32x4*)(As + kk * 132 + ty * 4); const f32x4 b0 = *(const f32x4*)(Bs + kk * 132 + tx * 8), b1 = *(const f32x4*)(Bs + kk * 132 + tx * 8 + 4);
#pragma unroll
                for (int i = 0; i < 4; ++i) { acc[i][0] += a[i] * b0.x; acc[i][1] += a[i] * b0.y; acc[i][2] += a[i] * b0.z; acc[i][3] += a[i] * b0.w; acc[i][4] += a[i] * b1.x; acc[i][5] += a[i] * b1.y; acc[i][6] += a[i] * b1.z; acc[i][7] += a[i] * b1.w; }
                if (DUAL) { const f32x4 c0 = *(const f32x4*)(Bs2 + kk * 132 + tx * 8), c1 = *(const f32x4*)(Bs2 + kk * 132 + tx * 8 + 4);
#pragma unroll
                    for (int i = 0; i < 4; ++i) { acc2[i][0] += a[i] * c0.x; acc2[i][1] += a[i] * c0.y; acc2[i][2] += a[i] * c0.z; acc2[i][3] += a[i] * c0.w; acc2[i][4] += a[i] * c1.x; acc2[i][5] += a[i] * c1.y; acc2[i][6] += a[i] * c1.z; acc2[i][7] += a[i] * c1.w; } }
            }
        }
#pragma unroll
        for (int i = 0; i < 4; ++i) epi(tm * 128 + ty * 4 + i, tn * 128 + tx * 8, acc[i], acc2[i]);
    }
}
struct BSelPlain { const bf16_t* Bt; int K; DEVI const bf16_t* operator()(int, int tn, int) const { return Bt + (size_t)tn * 128 * K; } };
struct BSelDual { const bf16_t* Bt; int K; DEVI const bf16_t* operator()(int, int tn, int which) const { return Bt + (size_t)(tn * 256 + which * 128) * K; } };
struct BSelMoe { const bf16_t* Bt; int K; int rows_per_expert; bool dual; const int* seg;
    DEVI const bf16_t* operator()(int tm, int tn, int which) const {
        const int s = tm * 128; if (s >= seg[8]) return nullptr; int e = 0;
#pragma unroll
        for (int q = 1; q < 8; ++q) e += (s >= seg[q]) ? 1 : 0;
        return Bt + (size_t)e * rows_per_expert * K + (size_t)(dual ? tn * 256 + which * 128 : tn * 128) * K; } };
struct EpiStoreBf16 { bf16_t* O; int ldc; DEVI void operator()(int r, int c0, const float* a, const float*) const {
    u32x4 o; o.x = pk2(a[0], a[1]); o.y = pk2(a[2], a[3]); o.z = pk2(a[4], a[5]); o.w = pk2(a[6], a[7]); *(u32x4*)(O + (size_t)r * ldc + c0) = o; } };
struct EpiSwiglu { bf16_t* O; int ldc; DEVI void operator()(int r, int c0, const float* a, const float* b) const {
    float h[8];
#pragma unroll
    for (int j = 0; j < 8; ++j) h[j] = silu_f(a[j]) * b[j];
    u32x4 o; o.x = pk2(h[0], h[1]); o.y = pk2(h[2], h[3]); o.z = pk2(h[4], h[5]); o.w = pk2(h[6], h[7]); *(u32x4*)(O + (size_t)r * ldc + c0) = o; } };
struct EpiResid { float* XB; const float* mv; int which;
    DEVI void operator()(int r, int c0, const float* a, const float*) const {
        const float* g = mv + (size_t)(row_mod(r) * 6 + which) * 1024 + c0; float* x = XB + (size_t)r * 1024 + c0;
        f32x4 x0 = *(f32x4*)x, x1 = *(f32x4*)(x + 4); const f32x4 g0 = *(const f32x4*)g, g1 = *(const f32x4*)(g + 4);
        x0.x += g0.x * a[0]; x0.y += g0.y * a[1]; x0.z += g0.z * a[2]; x0.w += g0.w * a[3]; x1.x += g1.x * a[4]; x1.y += g1.y * a[5]; x1.z += g1.z * a[6]; x1.w += g1.w * a[7];
        *(f32x4*)x = x0; *(f32x4*)(x + 4) = x1; } };

namespace pg8 {
#define PG8_LAS __attribute__((address_space(3)))

typedef short bf16x8 __attribute__((ext_vector_type(8)));


constexpr int MOE_FF = 3584;
constexpr int BM = 256, BK = 64, HALF = 128, HTB = HALF * BK * 2  , STAGE_BYTES = 8 * HTB, NXCD = 8, WGM = 8;

__host__ __device__ __forceinline__ int lds_byte(int r, int c) { const int st = (r >> 4) * 2 + (c >> 5), rr = r & 15, cc = c & 31, ob = rr * 64 + cc * 2; return st * 1024 + (ob ^ (((ob >> 9) & 1) << 5)); }
__host__ __device__ __forceinline__ void stage_rc(int b, int& R, int& C) { const int st = b / 1024, sb = b % 1024, swz = sb ^ (((sb >> 9) & 1) << 5); R = (st >> 1) * 16 + swz / 64; C = (st & 1) * 32 + (swz % 64) / 2; }
__host__ __device__ __forceinline__ int perm32(int rho) { const int n = rho >> 4, i = rho & 15; return 8 * (i >> 2) + 4 * n + (i & 3); }

struct Unit { int pm, pn, ko, nt; };
struct Gemm { const bf16_t* A; const bf16_t* Bt; int M, N, K; };

struct StaticOrder {
    int nM, nN, nwg, G, c;
    __host__ __device__ void init(int M, int N, int G_, int c_) { nM = M / BM; nN = N / BM; nwg = nM * nN; G = G_; c = c_; }
    __host__ __device__ bool next(int i, Unit& u) const {
        const long L = (long)i * G + c; if (L >= nwg) return false;
        int wgid = (int)L; { const int q = nwg / NXCD, r = nwg % NXCD, xcd = wgid % NXCD, off = wgid / NXCD; wgid = (xcd < r ? xcd * (q + 1) : r * (q + 1) + (xcd - r) * q) + off; }
        const int nig = WGM * nN, gid = wgid / nig, fm = gid * WGM, gsz = (nM - fm) < WGM ? (nM - fm) : WGM;
        u.pm = fm + ((wgid % nig) % gsz); u.pn = (wgid % nig) / gsz; u.ko = 0; u.nt = 0; return true;
    }
    __device__ __forceinline__ void a_ready(const Unit&) const {}
    __device__ __forceinline__ void done(const Unit&) const {}
};


__device__ __forceinline__ unsigned cvt_pk_bf16(float lo, float hi) { unsigned r; asm volatile("v_cvt_pk_bf16_f32 %0, %1, %2" : "=v"(r) : "v"(lo), "v"(hi)); return r; }
__device__ __forceinline__ float silu1(float x) { return x * __builtin_amdgcn_rcpf(1.f + __expf(-x)); }
struct EpiStore {
    static constexpr bool PERM = true, AFTER_DRAIN = false;
    bf16_t* O; int ldc; int nN; long d2;
    __device__ __forceinline__ void operator()(const f32x4 (&acc)[2][2][4][2], const Unit& u, int wr, int wc, int fr, int fq) const {
        const int row0 = u.pm * BM + wr * 64 + fr, pnl = nN ? u.pn % nN : u.pn, col0 = pnl * BM + wc * 32 + 8 * fq;
        bf16_t* Ob = O + (u.ko ? d2 : 0l);
#pragma unroll
        for (int ai = 0; ai < 2; ++ai)
#pragma unroll
            for (int m = 0; m < 4; ++m) { bf16_t* rowp = Ob + (size_t)(row0 + ai * HALF + m * 16) * ldc + col0;
#pragma unroll
                for (int bj = 0; bj < 2; ++bj) { const f32x4 v0 = acc[ai][bj][m][0], v1 = acc[ai][bj][m][1];
                    u32x4 w; w.x = cvt_pk_bf16(v0[0], v0[1]); w.y = cvt_pk_bf16(v0[2], v0[3]); w.z = cvt_pk_bf16(v1[0], v1[1]); w.w = cvt_pk_bf16(v1[2], v1[3]);
                    *(u32x4*)(rowp + bj * HALF) = w; } }
    }
};
struct EpiSwi {
    static constexpr bool PERM = true, AFTER_DRAIN = false;
    bf16_t* O; int ldc; int nN;
    __device__ __forceinline__ void operator()(const f32x4 (&acc)[2][2][4][2], const Unit& u, int wr, int wc, int fr, int fq) const {
        const int row0 = u.pm * BM + wr * 64 + fr, pnl = nN ? u.pn % nN : u.pn, col0 = pnl * HALF + wc * 32 + 8 * fq;
#pragma unroll
        for (int ai = 0; ai < 2; ++ai)
#pragma unroll
            for (int m = 0; m < 4; ++m) { bf16_t* rowp = O + (size_t)(row0 + ai * HALF + m * 16) * ldc + col0;
                const f32x4 a0 = acc[ai][0][m][0], a1 = acc[ai][0][m][1], b0 = acc[ai][1][m][0], b1 = acc[ai][1][m][1];
                u32x4 w; w.x = cvt_pk_bf16(silu1(a0[0]) * b0[0], silu1(a0[1]) * b0[1]); w.y = cvt_pk_bf16(silu1(a0[2]) * b0[2], silu1(a0[3]) * b0[3]);
                w.z = cvt_pk_bf16(silu1(a1[0]) * b1[0], silu1(a1[1]) * b1[1]); w.w = cvt_pk_bf16(silu1(a1[2]) * b1[2], silu1(a1[3]) * b1[3]);
                *(u32x4*)rowp = w; }
    }
};
struct EpiRes {
    static constexpr bool PERM = false, AFTER_DRAIN = false;
    float* XB; const float* mv; int which; const float* base_lat; const float* base_ctx;
    float* PB;
    __device__ __forceinline__ void operator()(const f32x4 (&acc)[2][2][4][2], const Unit& u, int wr, int wc, int fr, int fq) const {
        const int row0 = u.pm * BM + wr * 64 + fr, col0 = u.pn * BM + wc * 32 + 4 * fq;
#pragma unroll
        for (int ai = 0; ai < 2; ++ai)
#pragma unroll
            for (int m = 0; m < 4; ++m) { const int r = row0 + ai * HALF + m * 16; const float* g = mv + (size_t)((r < 16384 ? (r >> 12) : 4) * 6 + which) * 1024 + col0; float* x = XB + (size_t)r * 1024 + col0;
                const float* bs = (r < 16384 ? base_lat + (size_t)r * 1024 : base_ctx + (size_t)(r - 16384) * 1024) + col0;
#pragma unroll
                for (int bj = 0; bj < 2; ++bj)
#pragma unroll
                    for (int n = 0; n < 2; ++n) { const int o = bj * HALF + n * 16; const f32x4 gv = *(const f32x4*)(g + o);
                        if (u.ko) *(f32x4*)(PB + (size_t)(r - 16384) * 1024 + col0 + o) = gv * acc[ai][bj][m][n];
                        else { f32x4 xv = *(const f32x4*)(bs + o); xv = xv + gv * acc[ai][bj][m][n]; *(f32x4*)(x + o) = xv; } } }
    }
};
struct FfnDownOrder {
    StaticOrder so; int ntk;
    __device__ __forceinline__ void init(int G_, int c_, int ntk_half) { so.init(16384, 1024, G_, c_); ntk = ntk_half; }
    __device__ __forceinline__ bool next(int i, Unit& u) const {
        if (so.next(i, u)) return true;
        const long L = (long)i * so.G + so.c - so.nwg; if (L < 0 || L >= 32) return false;
        const int unit = (int)L >> 1; u.pm = 64 + (unit >> 2); u.pn = unit & 3; u.ko = ((int)L & 1) * ntk * 64; u.nt = ntk; return true; }
    __device__ __forceinline__ void a_ready(const Unit&) const {}
    __device__ __forceinline__ void done(const Unit&) const {}
};
struct MoeOrder {
    StaticOrder so; int nN; int sg[9];
    __device__ __forceinline__ void init(const int* seg, int nN_, int G_, int c_) {
#pragma unroll
        for (int i = 0; i < 9; ++i) sg[i] = seg[i];
        nN = nN_; so.nM = sg[8] >> 8; so.nN = nN_; so.nwg = so.nM * nN_; so.G = G_; so.c = c_; }
    __device__ __forceinline__ bool next(int i, Unit& u) const {
        if (!so.next(i, u)) return false;
        const int s = u.pm * 256; int e = 0;
#pragma unroll
        for (int q = 1; q < 8; ++q) e += (s >= sg[q]) ? 1 : 0;
        u.pn += e * nN; return true; }
    __device__ __forceinline__ void a_ready(const Unit&) const {}
    __device__ __forceinline__ void done(const Unit&) const {}
};
struct TableOrder {
    const int* tab; int n, G, vc;
    __device__ __forceinline__ void init(const int* tab_, int G_, int c_) { tab = tab_ + 4; n = tab_[0]; G = G_; vc = (G_ % 8 == 0) ? (c_ % 8) * (G_ / 8) + c_ / 8 : c_; }
    __device__ __forceinline__ bool next(int i, Unit& u) const { const int L = i * G + vc; if (L >= n) return false; const int* t = tab + 4 * L; u.pm = t[0]; u.pn = t[1]; u.ko = t[2]; u.nt = t[3]; return true; }
    __device__ __forceinline__ void a_ready(const Unit&) const {}
    __device__ __forceinline__ void done(const Unit&) const {}
};
template <class Epi, class Sched, bool ALIGN_EPI = false, bool SP2 = false>
__device__ __forceinline__ void gemm_phase(PG8_LAS unsigned char* lds, const Gemm g, const Sched& S, const Epi& E) {
    const int tid = threadIdx.x, wid = __builtin_amdgcn_readfirstlane(tid >> 6), lane = tid & 63, wr = wid >> 2, wc = wid & 3, fr = lane & 15, fq = lane >> 4;
    const int K = g.K; int nt = K / BK;
    unsigned voffA[2], voffB[2];
#pragma unroll
    for (int i = 0; i < 2; ++i) { int R, C; stage_rc(tid * 16 + i * 8192, R, C); const int Rb = Epi::PERM ? ((R & ~31) + perm32(R & 31)) : R;
        voffA[i] = (unsigned)(R * K + C) * 2u; voffB[i] = (unsigned)(Rb * K + C) * 2u; }
    const size_t kstep = (size_t)(BK * 2);
    const size_t hstep = (size_t)HALF * K * 2;
    const size_t tstep = 2 * hstep;
    const unsigned ldsw = (unsigned)wid * 1024u;
    const int aoff = lds_byte(wr * 64 + fr, fq * 8), boff = lds_byte(wc * 32 + fr, fq * 8);
#define PG8_SA(b, h) (((b) * 2 + (h)) * HTB)
#define PG8_SB(b, h) ((4 + (b) * 2 + (h)) * HTB)
#define PG8_STAGE(bufoff, gbase, voff) do { _Pragma("unroll") for (int _i = 0; _i < 2; ++_i) \
        __builtin_amdgcn_global_load_lds((const unsigned*)((const char*)(gbase) + (voff)[_i]), (PG8_LAS unsigned*)(lds + (bufoff) + ldsw + _i * 8192), 16, 0, 0); } while (0)
#define PG8_LDA(dst, b, h) do { _Pragma("unroll") for (int m = 0; m < 4; ++m) _Pragma("unroll") for (int k = 0; k < 2; ++k) dst[m][k] = *(const PG8_LAS bf16x8*)(lds + PG8_SA(b, h) + aoff + m * 2048 + k * 1024); } while (0)
#define PG8_LDB(dst, b, h) do { _Pragma("unroll") for (int n = 0; n < 2; ++n) _Pragma("unroll") for (int k = 0; k < 2; ++k) dst[n][k] = *(const PG8_LAS bf16x8*)(lds + PG8_SB(b, h) + boff + n * 2048 + k * 1024); } while (0)
#define PG8_MMA(ai, bj, At, Bt) do { __builtin_amdgcn_s_setprio(1); _Pragma("unroll") for (int m = 0; m < 4; ++m) _Pragma("unroll") for (int n = 0; n < 2; ++n) _Pragma("unroll") for (int k = 0; k < 2; ++k) \
        acc[ai][bj][m][n] = __builtin_amdgcn_mfma_f32_16x16x32_bf16(Bt[n][k], At[m][k], acc[ai][bj][m][n], 0, 0, 0); __builtin_amdgcn_s_setprio(0); } while (0)
#define PG8_WAIT_V(n) asm volatile("s_waitcnt vmcnt(" #n ")" ::: "memory")
#define PG8_WAIT_L(n) asm volatile("s_waitcnt lgkmcnt(" #n ")" ::: "memory")
#define PG8_BAR __builtin_amdgcn_s_barrier()
#define PG8_SCHED __builtin_amdgcn_sched_barrier(0)
    Unit cur, nxt; int ui = 0;
    if (!S.next(0, cur)) return;
    if (cur.nt) nt = cur.nt;
    f32x4 acc[2][2][4][2];
#pragma unroll
    for (int a = 0; a < 2; ++a)
#pragma unroll
        for (int b = 0; b < 2; ++b)
#pragma unroll
            for (int m = 0; m < 4; ++m)
#pragma unroll
                for (int n = 0; n < 2; ++n) acc[a][b][m][n] = (f32x4){0.f, 0.f, 0.f, 0.f};
    bf16x8 At[4][2], B0[2][2], B1[2][2];
    const char* cA = (const char*)g.A + (size_t)cur.pm * tstep + (size_t)cur.ko * 2; const char* cB = (const char*)g.Bt + (size_t)cur.pn * tstep + (size_t)cur.ko * 2;
    S.a_ready(cur);
    if constexpr (SP2) {
        PG8_STAGE(PG8_SB(0, 0), cB, voffB); PG8_STAGE(PG8_SB(0, 1), cB + hstep, voffB); PG8_STAGE(PG8_SA(0, 0), cA, voffA); PG8_STAGE(PG8_SA(0, 1), cA + hstep, voffA);
        if (wr == 1) PG8_BAR;
        PG8_WAIT_V(2); PG8_BAR;
        PG8_STAGE(PG8_SB(1, 0), cB + kstep, voffB); PG8_STAGE(PG8_SA(1, 0), cA + kstep, voffA); PG8_STAGE(PG8_SB(1, 1), cB + hstep + kstep, voffB);
        PG8_WAIT_V(6); PG8_BAR;
    } else {
        PG8_STAGE(PG8_SB(0, 0), cB, voffB); PG8_STAGE(PG8_SA(0, 0), cA, voffA); PG8_STAGE(PG8_SB(0, 1), cB + hstep, voffB); PG8_STAGE(PG8_SA(0, 1), cA + hstep, voffA);
        if (wr == 1) PG8_BAR;
        PG8_WAIT_V(4); PG8_BAR;
        PG8_STAGE(PG8_SB(1, 0), cB + kstep, voffB); PG8_STAGE(PG8_SA(1, 0), cA + kstep, voffA); PG8_STAGE(PG8_SB(1, 1), cB + hstep + kstep, voffB);
        PG8_WAIT_V(6); PG8_BAR;
    }
    for (;;) {
        const bool has_next = S.next(ui + 1, nxt);
        const char* nA = has_next ? (const char*)g.A + (size_t)nxt.pm * tstep + (size_t)nxt.ko * 2 : cA; const char* nB = has_next ? (const char*)g.Bt + (size_t)nxt.pn * tstep + (size_t)nxt.ko * 2 : cB;
        for (int t = 0; t < nt; t += 2) {
            const bool last = (t == nt - 2);
            const char* a1 = cA + (size_t)(t + 1) * kstep;
            const char* a2 = last ? nA : cA + (size_t)(t + 2) * kstep; const char* b2 = last ? nB : cB + (size_t)(t + 2) * kstep;
            const char* a3 = a2 + kstep; const char* b3 = b2 + kstep;
            if (last && has_next) S.a_ready(nxt);
            if constexpr (SP2) {
            PG8_LDB(B0, 0, 0); PG8_LDB(B1, 0, 1); PG8_SCHED; PG8_LDA(At, 0, 0); PG8_STAGE(PG8_SA(1, 1), a1 + hstep, voffA);
            PG8_WAIT_V(8); PG8_WAIT_L(0); PG8_BAR; PG8_MMA(0, 0, At, B0); PG8_MMA(0, 1, At, B1); PG8_BAR; PG8_SCHED;
            PG8_LDA(At, 0, 1); PG8_STAGE(PG8_SB(0, 0), b2, voffB); PG8_STAGE(PG8_SB(0, 1), b2 + hstep, voffB); PG8_STAGE(PG8_SA(0, 0), a2, voffA);
            PG8_WAIT_V(8); PG8_WAIT_L(0); PG8_BAR; PG8_MMA(1, 0, At, B0); PG8_MMA(1, 1, At, B1); PG8_BAR; PG8_SCHED;
            PG8_LDB(B0, 1, 0); PG8_LDB(B1, 1, 1); PG8_SCHED; PG8_LDA(At, 1, 0); PG8_STAGE(PG8_SA(0, 1), a2 + hstep, voffA);
            PG8_WAIT_V(8); PG8_WAIT_L(0); PG8_BAR; PG8_MMA(0, 0, At, B0); PG8_MMA(0, 1, At, B1); PG8_BAR; PG8_SCHED;
            PG8_LDA(At, 1, 1); PG8_STAGE(PG8_SB(1, 0), b3, voffB); PG8_STAGE(PG8_SB(1, 1), b3 + hstep, voffB); PG8_STAGE(PG8_SA(1, 0), a3, voffA);
            PG8_WAIT_V(8); PG8_WAIT_L(0); PG8_BAR; PG8_MMA(1, 0, At, B0); PG8_MMA(1, 1, At, B1); PG8_BAR; PG8_SCHED;
            } else {
            PG8_LDB(B0, 0, 0); PG8_SCHED; PG8_LDA(At, 0, 0); PG8_STAGE(PG8_SA(1, 1), a1 + hstep, voffA);
            PG8_WAIT_L(8); PG8_BAR; PG8_WAIT_L(0); PG8_MMA(0, 0, At, B0); PG8_BAR; PG8_SCHED;
            PG8_LDB(B1, 0, 1); PG8_STAGE(PG8_SB(0, 0), b2, voffB);
            PG8_BAR; PG8_WAIT_L(0); PG8_MMA(0, 1, At, B1); PG8_BAR;
            PG8_LDA(At, 0, 1); PG8_STAGE(PG8_SA(0, 0), a2, voffA);
            PG8_BAR; PG8_WAIT_L(0); PG8_MMA(1, 0, At, B0); PG8_BAR; PG8_SCHED;
            PG8_STAGE(PG8_SB(0, 1), b2 + hstep, voffB);
            PG8_WAIT_V(6); PG8_BAR; PG8_MMA(1, 1, At, B1); PG8_BAR;
            PG8_LDB(B0, 1, 0); PG8_SCHED; PG8_LDA(At, 1, 0); PG8_STAGE(PG8_SA(0, 1), a2 + hstep, voffA);
            PG8_WAIT_L(8); PG8_BAR; PG8_WAIT_L(0); PG8_MMA(0, 0, At, B0); PG8_BAR; PG8_SCHED;
            PG8_LDB(B1, 1, 1); PG8_STAGE(PG8_SB(1, 0), b3, voffB);
            PG8_BAR; PG8_WAIT_L(0); PG8_MMA(0, 1, At, B1); PG8_BAR;
            PG8_LDA(At, 1, 1); PG8_STAGE(PG8_SA(1, 0), a3, voffA);
            PG8_BAR; PG8_WAIT_L(0); PG8_MMA(1, 0, At, B0); PG8_BAR; PG8_SCHED;
            PG8_STAGE(PG8_SB(1, 1), b3 + hstep, voffB);
            PG8_WAIT_V(6); PG8_BAR; PG8_MMA(1, 1, At, B1); PG8_BAR;
            }
        }
        if constexpr (ALIGN_EPI) { if (wr == 0) PG8_BAR; }
        if constexpr (!Epi::AFTER_DRAIN) { E(acc, cur, wr, wc, fr, fq); S.done(cur); }
        if (!has_next) break;
#pragma unroll
        for (int a = 0; a < 2; ++a)
#pragma unroll
            for (int b = 0; b < 2; ++b)
#pragma unroll
                for (int m = 0; m < 4; ++m)
#pragma unroll
                    for (int n = 0; n < 2; ++n) acc[a][b][m][n] = (f32x4){0.f, 0.f, 0.f, 0.f};
        cur = nxt; cA = nA; cB = nB; ++ui; nt = cur.nt ? cur.nt : K / BK;
        if constexpr (ALIGN_EPI) { if (wr == 1) PG8_BAR; }
    }
    PG8_WAIT_V(0);
    if constexpr (!ALIGN_EPI) { if (wr == 0) PG8_BAR; }
    PG8_BAR;
    if constexpr (Epi::AFTER_DRAIN) { E.fused(acc, cur, wr, wc, fr, fq, lds, wid, lane); S.done(cur); }
#undef PG8_SA
#undef PG8_SB
#undef PG8_STAGE
#undef PG8_LDA
#undef PG8_LDB
#undef PG8_MMA
#undef PG8_WAIT_V
#undef PG8_WAIT_L
#undef PG8_BAR
#undef PG8_SCHED
}
}

DEVI void row_seq(int r, int& t, int& len) { if (r < NLAT) { t = r & 4095; len = SEQ; } else { t = (r - NLAT) & 255; len = CTXL; } }

#define DPP_F(v, ctrl) __int_as_float(__builtin_amdgcn_update_dpp(0, __float_as_int(v), (ctrl), 0xF, 0xF, true))
DEVI float sum8lanes(float x) { x += DPP_F(x, 0xB1); x += DPP_F(x, 0x4E); x += DPP_F(x, 0x141); return x; }

DEVI void phase_prep(const Ctx& c, int layer, bool need_ctx_q) {
    const bf16_t* Z = (const bf16_t*)(c.ws + WS_Z);
    {
        bf16_t* QN = (bf16_t*)(c.ws + WS_QN); bf16_t* KN = (bf16_t*)(c.ws + WS_KN); bf16_t* VB = (bf16_t*)(c.ws + WS_DN + DN_VB); float* bg = (float*)(c.ws + WS_DN + DN_BG);
        const float* cw = c.in[I_CONVW] + (size_t)layer * 3 * 1152;
        const int lc = c.lane < 48 ? c.lane : 47;
        float w[3][3][8];
#pragma unroll
        for (int th = 0; th < 3; ++th)
#pragma unroll
            for (int tap = 0; tap < 3; ++tap) { const float* wp = cw + tap * 1152 + th * 384 + lc * 8; *(f32x4*)w[th][tap] = *(const f32x4*)wp; *(f32x4*)(w[th][tap] + 4) = *(const f32x4*)(wp + 4); }
        const int dh = c.lane - 48; float alog = 0.f, dtb = 0.f;
        if (c.lane >= 48 && c.lane < 60) { alog = -expf(c.in[I_ALOG][layer * 12 + dh]); dtb = c.in[I_DTB][layer * 12 + dh]; }
        for (int r = c.gw; r < NT; r += c.ngw) {
            int t, len; row_seq(r, t, len);
            const bf16_t* zr = Z + (size_t)r * ZP + lc * 8; const bool hm = t > 0, hp = t < len - 1;
            u32x4 zc[3], zm[3], zp[3];
#pragma unroll
            for (int th = 0; th < 3; ++th) { zc[th] = *(const u32x4*)(zr + th * 384); zm[th] = hm ? *(const u32x4*)(zr + th * 384 - ZP) : (u32x4){0u, 0u, 0u, 0u}; zp[th] = hp ? *(const u32x4*)(zr + th * 384 + ZP) : (u32x4){0u, 0u, 0u, 0u}; }
            float zb = 0.f, za = 0.f;
            if (c.lane >= 48 && c.lane < 60) { zb = bf2f(Z[(size_t)r * ZP + ZC_BETA + dh]); za = bf2f(Z[(size_t)r * ZP + ZC_ALPHA + dh]); }
            u32x4 outw[3];
#pragma unroll
            for (int th = 0; th < 3; ++th) {
                float a[8], b[8], d[8], v[8]; unpack8(zm[th], a); unpack8(zc[th], b); unpack8(zp[th], d);
                float ss = 0.f;
#pragma unroll
                for (int e = 0; e < 8; ++e) { v[e] = silu_f(a[e] * w[th][0][e] + b[e] * w[th][1][e] + d[e] * w[th][2][e]); ss += v[e] * v[e]; }
                if (th < 2) { ss = sum8lanes(ss); const float sc = rsqrtf(ss + EPS) * (th == 0 ? 0.125f : 1.f);
#pragma unroll
                    for (int e = 0; e < 8; ++e) v[e] *= sc; }
                outw[th] = pack8(v);
            }
            if (c.lane < 48) { *(u32x4*)(QN + (size_t)r * 384 + c.lane * 8) = outw[0]; *(u32x4*)(KN + (size_t)r * 384 + c.lane * 8) = outw[1]; *(u32x4*)(VB + (size_t)r * 384 + c.lane * 8) = outw[2]; }
            else if (c.lane < 60) { bg[((size_t)r * 12 + dh) * 2] = __builtin_amdgcn_rcpf(1.f + __expf(-zb)); bg[((size_t)r * 12 + dh) * 2 + 1] = alog * softplus_f(za + dtb); }
        }
    }
    {
        bf16_t* Qa = (bf16_t*)(c.ws + WS_QA); bf16_t* Qc = (bf16_t*)(c.ws + WS_QC); bf16_t* Ka = (bf16_t*)(c.ws + WS_KA); bf16_t* Va = (bf16_t*)(c.ws + WS_VA);
        const float* rope = (const float*)(c.ws + CTL_ROPE);
        const bool isq = c.lane < 48; const int j = c.lane & 7, axis = j >> 2, half = (j >> 1) & 1, p0 = 8 * (j & 1);
        const int col = isq ? ZC_AQ + c.lane * 8 : ZC_AK + (c.lane - 48) * 8;
        float gn[8];
        { const float* gp = (isq ? c.in[I_QG] : c.in[I_KG]) + layer * 64 + 8 * j; *(f32x4*)gn = *(const f32x4*)gp; *(f32x4*)(gn + 4) = *(const f32x4*)(gp + 4); }
        const float qs = isq ? QSCALE : 1.f;
        for (int r0 = c.gw; r0 < NT; r0 += 2 * c.ngw) {
            int rr[2]; bool ok[2]; rr[0] = r0; ok[0] = true; rr[1] = r0 + c.ngw; ok[1] = rr[1] < NT; if (!ok[1]) rr[1] = r0;
            u32x4 zq[2], zv[2]; const float* tp[2];
#pragma unroll
            for (int q = 0; q < 2; ++q) { const int r = rr[q]; zq[q] = *(const u32x4*)(Z + (size_t)r * ZP + col); zv[q] = *(const u32x4*)(Z + (size_t)r * ZP + ZC_AV + (c.lane & 15) * 8);
                const int t = r & 4095; tp[q] = rope + (r < NLAT ? (axis * 64 + (axis == 0 ? (t >> 6) : (t & 63))) * 32 : 128 * 32) + p0; }
#pragma unroll
            for (int q = 0; q < 2; ++q) { const int r = rr[q]; const bool lat = r < NLAT; const int b = lat ? (r >> 12) : ((r - NLAT) >> 8), pos = lat ? CTXL + (r & 4095) : ((r - NLAT) & 255);
                float v[8]; unpack8(zq[q], v);
                float ss = 0.f;
#pragma unroll
                for (int e = 0; e < 8; ++e) ss += v[e] * v[e];
                ss = sum8lanes(ss); const float sc = rsqrtf(ss * (1.f / 64.f) + EPS);
                float cs[8], sn[8]; *(f32x4*)cs = *(const f32x4*)tp[q]; *(f32x4*)(cs + 4) = *(const f32x4*)(tp[q] + 4); *(f32x4*)sn = *(const f32x4*)(tp[q] + 16); *(f32x4*)(sn + 4) = *(const f32x4*)(tp[q] + 20);
#pragma unroll
                for (int e = 0; e < 8; ++e) { v[e] *= sc * gn[e]; const float o = DPP_F(v[e], 0x4E); v[e] = (half == 0 ? v[e] * cs[e] - o * sn[e] : o * sn[e] + v[e] * cs[e]) * qs; }
                const u32x4 w = pack8(v);
                if (ok[q]) {
                    if (isq) { if (lat) *(u32x4*)(Qa + (size_t)r * 384 + c.lane * 8) = w; else if (need_ctx_q) *(u32x4*)(Qc + (size_t)(r - NLAT) * 384 + c.lane * 8) = w; }
                    else *(u32x4*)(Ka + ((size_t)b * SKV + pos) * 128 + (c.lane - 48) * 8) = w;
                    if (c.lane < 16) *(u32x4*)(Va + ((size_t)b * SKV + pos) * 128 + c.lane * 8) = zv[q];
                } }
        }
    }
    {
        bf16_t* SV = (bf16_t*)(c.ws + WS_SV); const int l32 = c.lane & 31;
        float gn[8]; { const float* gp = c.in[I_SGUG] + layer * 256 + l32 * 8; *(f32x4*)gn = *(const f32x4*)gp; *(f32x4*)(gn + 4) = *(const f32x4*)(gp + 4); }
        const int nr = need_ctx_q ? NT : NLAT;
        for (int it = c.gw; it < nr / 2; it += c.ngw) {
            const int r = it * 2 + (c.lane >> 5);
            float v[8]; unpack8(*(const u32x4*)(Z + (size_t)r * ZP + ZC_MV + l32 * 8), v);
            float ss = 0.f;
#pragma unroll
            for (int e = 0; e < 8; ++e) { v[e] = gelu_f(v[e]); ss += v[e] * v[e]; }
            ss = sum8lanes(ss); const float sc = rsqrtf(ss * (1.f / 64.f) + EPS);
#pragma unroll
            for (int e = 0; e < 8; ++e) v[e] *= sc * gn[e];
            *(u32x4*)(SV + (size_t)r * 256 + l32 * 8) = pack8(v);
        }
    }
}
DEVI void phase_dnscan_naive(const Ctx& c) {
    const bf16_t* QN = (const bf16_t*)(c.ws + WS_QN); const bf16_t* KN = (const bf16_t*)(c.ws + WS_KN); const bf16_t* VB = (const bf16_t*)(c.ws + WS_DN + DN_VB);
    const float* BG = (const float*)(c.ws + WS_DN + DN_BG); float* OD = (float*)(c.ws + WS_DN + DN_O);
    float* kqv = c.lds; float* part = c.lds + 256; float* part2 = c.lds + 256 + 512;
    const int e = c.tid & 63, dg = c.tid >> 6;
    for (int seq = blockIdx.x; seq < 48; seq += gridDim.x) {
        const int b = seq / 12, h = (seq >> 1) % 6, dir = seq & 1;
        float S[8];
#pragma unroll
        for (int i = 0; i < 8; ++i) S[i] = 0.f;
        for (int step = 0; step < SKV; ++step) {
            int row;
            if (step < CTXL) { const int t = dir ? CTXL - 1 - step : step; row = NLAT + b * CTXL + t; }
            else { const int u = step - CTXL; const int t = dir ? SEQ - 1 - u : u; row = b * SEQ + t; }
            if (c.wave == 0) kqv[e] = bf2f(KN[(size_t)row * 384 + h * 64 + e]);
            else if (c.wave == 1) kqv[64 + e] = bf2f(QN[(size_t)row * 384 + h * 64 + e]);
            else if (c.wave == 2) kqv[128 + e] = bf2f(VB[(size_t)row * 384 + h * 64 + e]);
            else if (c.wave == 3 && e < 2) { const float v = BG[((size_t)row * 12 + dir * 6 + h) * 2 + e]; kqv[192 + e] = e == 0 ? v : __expf(v); }
            __syncthreads();
            const float a = kqv[193], beta = kqv[192];
            float kd[8], p = 0.f;
#pragma unroll
            for (int i = 0; i < 8; ++i) { kd[i] = kqv[dg * 8 + i]; S[i] *= a; p += S[i] * kd[i]; }
            part[dg * 64 + e] = p;
            __syncthreads();
            float rr = kqv[128 + e];
#pragma unroll
            for (int w = 0; w < 8; ++w) rr -= part[w * 64 + e];
            rr *= beta; float po = 0.f;
#pragma unroll
            for (int i = 0; i < 8; ++i) { S[i] += kd[i] * rr; po += S[i] * kqv[64 + dg * 8 + i]; }
            part2[dg * 64 + e] = po;
            __syncthreads();
            if (dg == 0) { float o = 0.f;
#pragma unroll
                for (int w = 0; w < 8; ++w) o += part2[w * 64 + e];
                OD[((size_t)dir * NT + row) * 384 + h * 64 + e] = o; }
        }
        __syncthreads();
    }
}

DEVI void phase_dnfinish(const Ctx& c, int layer, int nrows) {
    const float* OD = (const float*)(c.ws + WS_DN + DN_O); const bf16_t* Z = (const bf16_t*)(c.ws + WS_Z); bf16_t* MIX = (bf16_t*)(c.ws + WS_MIX);
    float gn[8]; { const float* gp = c.in[I_DNG] + layer * 64 + 8 * (c.lane & 7); *(f32x4*)gn = *(const f32x4*)gp; *(f32x4*)(gn + 4) = *(const f32x4*)(gp + 4); }
    if (c.lane < 48) for (int r = c.gw; r < nrows; r += c.ngw) {
        const float* o0 = OD + (size_t)r * 384 + c.lane * 8; const float* o1 = o0 + (size_t)NT * 384;
        float v[8], g[8]; *(f32x4*)v = *(const f32x4*)o0 + *(const f32x4*)o1; *(f32x4*)(v + 4) = *(const f32x4*)(o0 + 4) + *(const f32x4*)(o1 + 4);
        unpack8(*(const u32x4*)(Z + (size_t)r * ZP + ZC_GATE + c.lane * 8), g);
        float ss = 0.f;
#pragma unroll
        for (int e = 0; e < 8; ++e) ss += v[e] * v[e];
        ss = sum8lanes(ss); const float sc = rsqrtf(ss * (1.f / 64.f) + EPS);
#pragma unroll
        for (int e = 0; e < 8; ++e) v[e] = v[e] * sc * gn[e] * silu_f(g[e]);
        *(u32x4*)(MIX + (size_t)r * 1024 + c.lane * 8) = pack8(v);
    }
}

DEVI void phase_attn_naive(const Ctx& c, bool with_ctx) {
    const bf16_t* Qa = (const bf16_t*)(c.ws + WS_QA); const bf16_t* Qc = (const bf16_t*)(c.ws + WS_QC); const bf16_t* Ka = (const bf16_t*)(c.ws + WS_KA); const bf16_t* Va = (const bf16_t*)(c.ws + WS_VA);
    bf16_t* MIX = (bf16_t*)(c.ws + WS_MIX);
    const int nitems = NLAT * 6 + (with_ctx ? NCTX * 6 : 0);
    for (int it = c.gw; it < nitems; it += c.ngw) {
        int b, hq, nkeys, orow; const bf16_t* qp;
        if (it < NLAT * 6) { const int r = it / 6; hq = it % 6; b = r >> 12; qp = Qa + (size_t)r * 384 + hq * 64; nkeys = SKV; orow = r; }
        else { const int q = it - NLAT * 6, rc = q / 6; hq = q % 6; b = rc >> 8; qp = Qc + (size_t)rc * 384 + hq * 64; nkeys = CTXL; orow = NLAT + rc; }
        const int kvh = hq / 3; const bf16_t* Kp = Ka + (size_t)b * SKV * 128 + kvh * 64; const bf16_t* Vp = Va + (size_t)b * SKV * 128 + kvh * 64;
        u32x4 qv[8];
#pragma unroll
        for (int i = 0; i < 8; ++i) qv[i] = *(const u32x4*)(qp + i * 8);
        float m = -1e30f, l = 0.f, acc = 0.f;
        for (int t0 = 0; t0 < nkeys; t0 += 64) {
            const bf16_t* kp = Kp + (size_t)(t0 + c.lane) * 128; float s = 0.f;
#pragma unroll
            for (int i = 0; i < 8; ++i) { const u32x4 kv = *(const u32x4*)(kp + i * 8);
#pragma unroll
                for (int q = 0; q < 4; ++q) s += bflo(kv[q]) * bflo(qv[i][q]) + bfhi(kv[q]) * bfhi(qv[i][q]); }
            const float mn = fmaxf(m, wave_max(s)); const float alpha = exp2f(m - mn); const float p = exp2f(s - mn);
            l = l * alpha + wave_sum(p); acc *= alpha; m = mn;
#pragma unroll 8
            for (int jj = 0; jj < 64; ++jj) { const float pj = __shfl(p, jj); acc += pj * bf2f(Vp[(size_t)(t0 + jj) * 128 + c.lane]); }
        }
        MIX[(size_t)orow * 1024 + 384 + hq * 64 + c.lane] = (bf16_t)f2bf(acc / l);
    }
}


namespace dn {
using bf16x8 = __attribute__((ext_vector_type(8))) short;
using f32x16 = __attribute__((ext_vector_type(16))) float;
typedef __attribute__((address_space(3))) unsigned char* ldsp;
constexpr int IMG = 46080, NCHK = 68, NSEQ = 48;
constexpr int O_NEGK = 0, O_T = 8192, O_QG = 14336, O_AT = 22528, O_KDT = 28672, O_BV = 36864, O_MISC = 45056;
DEVI int rowmap(int t, int hq) { return (t & 3) + 8 * (t >> 2) + 4 * hq; }
typedef float f32x2_t __attribute__((ext_vector_type(2))); typedef __bf16 bf16x2_t __attribute__((ext_vector_type(2)));
DEVI unsigned cvtpk(float lo, float hi) { f32x2_t v = {lo, hi}; bf16x2_t b = __builtin_convertvector(v, bf16x2_t); return __builtin_bit_cast(unsigned, b); }
#define DN_PACK8(x, s) __builtin_bit_cast(dn::bf16x8, (u32x4){dn::cvtpk((x)[8 * (s)], (x)[8 * (s) + 1]), dn::cvtpk((x)[8 * (s) + 2], (x)[8 * (s) + 3]), dn::cvtpk((x)[8 * (s) + 4], (x)[8 * (s) + 5]), dn::cvtpk((x)[8 * (s) + 6], (x)[8 * (s) + 7])})
#define DN_MFMA(a, b, c) __builtin_amdgcn_mfma_f32_32x32x16_bf16((a), (b), (c), 0, 0, 0)
DEVI u32x4 perm_frag(u32x4 f, int hq) {
    const unsigned s0 = hq ? f.x : f.z, s1 = hq ? f.y : f.w;
    const unsigned r0 = (unsigned)__shfl_xor((int)s0, 32), r1 = (unsigned)__shfl_xor((int)s1, 32);
    u32x4 o; o.x = hq ? r0 : f.x; o.y = hq ? r1 : f.y; o.z = hq ? f.z : r0; o.w = hq ? f.w : r1; return o;
}
DEVI u32x4 scale_frag(u32x4 f, float sc) {
    u32x4 o; o.x = cvtpk(bflo(f.x) * sc, bfhi(f.x) * sc); o.y = cvtpk(bflo(f.y) * sc, bfhi(f.y) * sc); o.z = cvtpk(bflo(f.z) * sc, bfhi(f.z) * sc); o.w = cvtpk(bflo(f.w) * sc, bfhi(f.w) * sc); return o;
}
DEVI bf16x8 ident_frag(int e, int r, int hq) {
    const int js = r - 16 * e - 8 * hq; u32x4 w;
    w.x = (js == 0 ? 0x3F80u : 0u) | (js == 1 ? 0x3F800000u : 0u); w.y = (js == 2 ? 0x3F80u : 0u) | (js == 3 ? 0x3F800000u : 0u);
    w.z = (js == 4 ? 0x3F80u : 0u) | (js == 5 ? 0x3F800000u : 0u); w.w = (js == 6 ? 0x3F80u : 0u) | (js == 7 ? 0x3F800000u : 0u);
    return __builtin_bit_cast(bf16x8, w);
}
DEVI int chunk_base(int b, int dir, int n) {
    if (n < 4) return NLAT + b * CTXL + (dir ? 3 - n : n) * 64;
    return b * SEQ + (dir ? 63 - (n - 4) : n - 4) * 64;
}

DEVI void phase_chunkprep(const Ctx& c) {
    const bf16_t* QN = (const bf16_t*)(c.ws + WS_QN); const bf16_t* KN = (const bf16_t*)(c.ws + WS_KN); const bf16_t* VB = (const bf16_t*)(c.ws + WS_DN + DN_VB);
    const float* BG = (const float*)(c.ws + WS_DN + DN_BG); unsigned char* OPS = c.ws + WS_DN + DN_OPS;
    float* Al = c.lds + c.wave * (17408 / 4);
    float* sgc = Al + 4096; float* sbe = sgc + 64; float* skd = sbe + 64;
    const int l = c.lane, r = l & 31, hq = l >> 5;
    for (int task = c.gw; task < NSEQ * NCHK; task += c.ngw) {
        const int seq = task / NCHK, n = task % NCHK, b = seq / 12, h = (seq >> 1) % 6, dir = seq & 1;
        const int base = chunk_base(b, dir, n);
        unsigned char* img = OPS + (size_t)task * IMG;
        const int myrow = base + (dir ? 63 - l : l);
        const float beta = BG[((size_t)myrow * 12 + dir * 6 + h) * 2]; const float g = BG[((size_t)myrow * 12 + dir * 6 + h) * 2 + 1];
        float gc = g;
#pragma unroll
        for (int o = 1; o < 64; o <<= 1) { const float t = __shfl_up(gc, o); if (l >= o) gc += t; }
        const float glast = __shfl(gc, 63);
        sgc[l] = gc; sbe[l] = beta; skd[l] = __expf(glast - gc);
        if (l == 0) *(float*)(img + O_MISC) = __expf(glast);
        __builtin_amdgcn_wave_barrier(); asm volatile("" ::: "memory");
        u32x4 kf[2][4], qf[2][4];
#pragma unroll
        for (int t = 0; t < 2; ++t) { const int pos = 32 * t + r; const size_t ro = (size_t)(base + (dir ? 63 - pos : pos)) * 384 + h * 64 + 8 * hq;
#pragma unroll
            for (int kk = 0; kk < 4; ++kk) { kf[t][kk] = *(const u32x4*)(KN + ro + 16 * kk); qf[t][kk] = *(const u32x4*)(QN + ro + 16 * kk); } }
#define KF(t, kk) __builtin_bit_cast(bf16x8, kf[t][kk])
#define QF(t, kk) __builtin_bit_cast(bf16x8, qf[t][kk])
#pragma unroll
        for (int tile = 0; tile < 3; ++tile) { const int rb = tile == 2 ? 1 : 0, cb = tile == 0 ? 0 : 1;
            f32x16 G = {}, P = {};
#pragma unroll
            for (int kk = 0; kk < 4; ++kk) { G = DN_MFMA(KF(rb, kk), KF(cb, kk), G); P = DN_MFMA(KF(rb, kk), QF(cb, kk), P); }
            const int lp = 32 * cb + r; const float bl = __shfl(beta, lp), gl = __shfl(gc, lp);
#pragma unroll
            for (int t = 0; t < 16; ++t) { const int rp = 32 * rb + rowmap(t, hq); const float e = __expf(gl - sgc[rp]);
                if (tile == 1) G[t] = -bl * e * G[t]; else Al[rp * 64 + lp] = lp > rp ? bl * e * G[t] : 0.f;
                P[t] = rp <= lp ? P[t] * e : 0.f; }
            if (tile == 1) { *(bf16x8*)(img + O_T + 2 * 1024 + l * 16) = DN_PACK8(G, 0); *(bf16x8*)(img + O_T + 3 * 1024 + l * 16) = DN_PACK8(G, 1); }
            *(bf16x8*)(img + O_AT + (2 * tile + 0) * 1024 + l * 16) = DN_PACK8(P, 0);
            *(bf16x8*)(img + O_AT + (2 * tile + 1) * 1024 + l * 16) = DN_PACK8(P, 1); }
#pragma unroll
        for (int rt = 0; rt < 2; ++rt) { const float gr = __shfl(gc, 32 * rt + r), br = __shfl(beta, 32 * rt + r); const float eg = __expf(gr);
#pragma unroll
            for (int kk = 0; kk < 4; ++kk) {
                *(u32x4*)(img + O_NEGK + (rt * 4 + kk) * 1024 + l * 16) = scale_frag(perm_frag(kf[rt][kk], hq), -br * eg);
                *(u32x4*)(img + O_QG + (rt * 4 + kk) * 1024 + l * 16) = scale_frag(perm_frag(qf[rt][kk], hq), eg); } }
#pragma unroll
        for (int dt = 0; dt < 2; ++dt)
#pragma unroll
            for (int cb = 0; cb < 2; ++cb) { f32x16 X = {};
                X = DN_MFMA(KF(cb, 2 * dt), ident_frag(0, r, hq), X); X = DN_MFMA(KF(cb, 2 * dt + 1), ident_frag(1, r, hq), X);
#pragma unroll
                for (int t = 0; t < 16; ++t) X[t] *= skd[32 * cb + rowmap(t, hq)];
                *(bf16x8*)(img + O_KDT + ((dt * 2 + cb) * 2 + 0) * 1024 + l * 16) = DN_PACK8(X, 0);
                *(bf16x8*)(img + O_KDT + ((dt * 2 + cb) * 2 + 1) * 1024 + l * 16) = DN_PACK8(X, 1); }
        {
            u32x4 vf[2][4];
#pragma unroll
            for (int t = 0; t < 2; ++t) { const int pos = 32 * t + r; const size_t ro = (size_t)(base + (dir ? 63 - pos : pos)) * 384 + h * 64 + 8 * hq;
#pragma unroll
                for (int kk = 0; kk < 4; ++kk) vf[t][kk] = *(const u32x4*)(VB + ro + 16 * kk); }
#pragma unroll
            for (int sl = 0; sl < 2; ++sl)
#pragma unroll
                for (int ct = 0; ct < 2; ++ct) { f32x16 Y = {};
                    Y = DN_MFMA(__builtin_bit_cast(bf16x8, vf[ct][2 * sl]), ident_frag(0, r, hq), Y); Y = DN_MFMA(__builtin_bit_cast(bf16x8, vf[ct][2 * sl + 1]), ident_frag(1, r, hq), Y);
#pragma unroll
                    for (int t = 0; t < 16; ++t) Y[t] *= sbe[32 * ct + rowmap(t, hq)];
                    *(bf16x8*)(img + O_BV + ((sl * 2 + ct) * 64 + l) * 32) = DN_PACK8(Y, 0);
                    *(bf16x8*)(img + O_BV + ((sl * 2 + ct) * 64 + l) * 32 + 16) = DN_PACK8(Y, 1); }
        }
#undef KF
#undef QF
        __builtin_amdgcn_wave_barrier(); asm volatile("" ::: "memory");
        {
            const float* Ab = Al + hq * (32 * 64 + 32);
            float* Tb = Al + hq * (32 * 64) + (hq ? 0 : 32);
#pragma unroll 1
            for (int JB = 3; JB >= 0; --JB) {
                float acc[8];
#pragma unroll
                for (int jj = 0; jj < 8; ++jj) acc[jj] = (r == 8 * JB + jj) ? 1.f : 0.f;
                float tk[24];
#pragma unroll
                for (int k = 8; k < 32; ++k) { const float tv = Tb[k * 64 + r]; tk[k - 8] = (k >= 8 * (JB + 1)) ? tv : 0.f; }
                const float* Aj = Ab + (8 * JB) * 64;
#pragma unroll
                for (int jj = 0; jj < 8; ++jj) { float a0 = 0.f, a1 = 0.f;
#pragma unroll
                    for (int k4 = 2; k4 < 8; ++k4) { const f32x4 av = *(const f32x4*)(Aj + jj * 64 + 4 * k4);
                        a0 += tk[4 * k4 - 8] * av.x + tk[4 * k4 - 6] * av.z; a1 += tk[4 * k4 - 7] * av.y + tk[4 * k4 - 5] * av.w; }
                    acc[jj] -= a0 + a1; }
#pragma unroll
                for (int jj = 6; jj >= 0; --jj) {
                    const f32x4 a0v = *(const f32x4*)(Aj + jj * 64 + 8 * JB), a1v = *(const f32x4*)(Aj + jj * 64 + 8 * JB + 4);
                    const float av[8] = {a0v.x, a0v.y, a0v.z, a0v.w, a1v.x, a1v.y, a1v.z, a1v.w};
                    float a = acc[jj];
#pragma unroll
                    for (int kk = jj + 1; kk < 8; ++kk) a -= acc[kk] * av[kk];
                    acc[jj] = a; }
#pragma unroll
                for (int jj = 0; jj < 8; ++jj) Tb[(8 * JB + jj) * 64 + r] = acc[jj];
            }
            float T[32];
#pragma unroll
            for (int k = 0; k < 32; ++k) T[k] = Tb[k * 64 + r];
#pragma unroll
            for (int s = 0; s < 2; ++s)
#pragma unroll
                for (int h2 = 0; h2 < 2; ++h2) { const int k0 = 16 * s + 4 * h2;
                    u32x4 w; w.x = cvtpk(T[k0], T[k0 + 1]); w.y = cvtpk(T[k0 + 2], T[k0 + 3]); w.z = cvtpk(T[k0 + 8], T[k0 + 9]); w.w = cvtpk(T[k0 + 10], T[k0 + 11]);
                    *(u32x4*)(img + O_T + ((hq ? 4 : 0) + s) * 1024 + (32 * h2 + r) * 16) = w; }
        }
        __builtin_amdgcn_wave_barrier(); asm volatile("" ::: "memory");
    }
}

DEVI void glds16(const void* gsrc, unsigned lds_dst) { unsigned keep;
    asm volatile("s_mov_b32 %0, m0\n\ts_mov_b32 m0, %2\n\ts_nop 0\n\tglobal_load_lds_dwordx4 %1, off\n\ts_mov_b32 m0, %0" : "=&s"(keep) : "v"(gsrc), "s"(lds_dst) : "memory"); }
DEVI void scan_sequence(const Ctx& c, int seq) {
    const unsigned char* OPS = c.ws + WS_DN + DN_OPS + (size_t)seq * NCHK * IMG; float* OD = (float*)(c.ws + WS_DN + DN_O);
    const int b = seq / 12, h = (seq >> 1) % 6, dir = seq & 1;
    const int l = c.lane, r = l & 31, hq = l >> 5, w = c.wave;
    const unsigned lds0 = (unsigned)(uintptr_t)c.lds;
    const bool loader = (w >= 2), consumer = (w < 2);
    constexpr int RSLOT = 36864;
#define DN_ISSUE(step, slot) do { if (loader) { _Pragma("unroll") for (int q_ = 0; q_ < 6; ++q_) { const int p_ = (w - 2) * 6 + q_; \
        glds16(OPS + (size_t)(step) * IMG + p_ * 1024 + l * 16, (unsigned)__builtin_amdgcn_readfirstlane(lds0 + (slot) * RSLOT + p_ * 1024)); } } } while (0)
    f32x16 S0 = {}, S1 = {};
    float gam_n = 0.f; u32x4 bv_n[4] = {};
    if (consumer) { gam_n = *(const float*)(OPS + O_MISC);
        bv_n[0] = *(const u32x4*)(OPS + O_BV + ((w * 2 + 0) * 64 + l) * 32); bv_n[1] = *(const u32x4*)(OPS + O_BV + ((w * 2 + 0) * 64 + l) * 32 + 16);
        bv_n[2] = *(const u32x4*)(OPS + O_BV + ((w * 2 + 1) * 64 + l) * 32); bv_n[3] = *(const u32x4*)(OPS + O_BV + ((w * 2 + 1) * 64 + l) * 32 + 16); }
    DN_ISSUE(0, 0); DN_ISSUE(1, 1);
    int slot = 0;
    for (int n = 0; n < NCHK; ++n) {
        if (loader) { if (n + 1 < NCHK) asm volatile("s_waitcnt vmcnt(6)" ::: "memory"); else asm volatile("s_waitcnt vmcnt(0)" ::: "memory"); }
        asm volatile("s_barrier" ::: "memory");
        if (n + 2 < NCHK) { const int s2 = slot == 0 ? 2 : slot - 1; DN_ISSUE(n + 2, s2); }
        if (consumer) {
            const ldsp img = c.lds3 + slot * RSLOT; const int sl = w;
#define DN_A(off, f) (*(const __attribute__((address_space(3))) bf16x8*)(img + (off) + (f) * 1024 + l * 16))
            const float gamma = gam_n; const u32x4 a = bv_n[0], bq = bv_n[1], a1 = bv_n[2], b1 = bv_n[3];
            if (n + 1 < NCHK) { const unsigned char* g2 = OPS + (size_t)(n + 1) * IMG;
                gam_n = *(const float*)(g2 + O_MISC);
                bv_n[0] = *(const u32x4*)(g2 + O_BV + ((sl * 2 + 0) * 64 + l) * 32); bv_n[1] = *(const u32x4*)(g2 + O_BV + ((sl * 2 + 0) * 64 + l) * 32 + 16);
                bv_n[2] = *(const u32x4*)(g2 + O_BV + ((sl * 2 + 1) * 64 + l) * 32); bv_n[3] = *(const u32x4*)(g2 + O_BV + ((sl * 2 + 1) * 64 + l) * 32 + 16); }
            const bf16x8 sb00 = DN_PACK8(S0, 0), sb01 = DN_PACK8(S0, 1), sb10 = DN_PACK8(S1, 0), sb11 = DN_PACK8(S1, 1);
            f32x16 v0, v1;
            {
#pragma unroll
              for (int q = 0; q < 4; ++q) { v0[2 * q] = bflo(a[q]); v0[2 * q + 1] = bfhi(a[q]); v0[8 + 2 * q] = bflo(bq[q]); v0[8 + 2 * q + 1] = bfhi(bq[q]);
                  v1[2 * q] = bflo(a1[q]); v1[2 * q + 1] = bfhi(a1[q]); v1[8 + 2 * q] = bflo(b1[q]); v1[8 + 2 * q + 1] = bfhi(b1[q]); } }
            v0 = DN_MFMA(DN_A(O_NEGK, 0), sb00, v0); v1 = DN_MFMA(DN_A(O_NEGK, 4), sb00, v1);
            v0 = DN_MFMA(DN_A(O_NEGK, 1), sb01, v0); v1 = DN_MFMA(DN_A(O_NEGK, 5), sb01, v1);
            v0 = DN_MFMA(DN_A(O_NEGK, 2), sb10, v0); v1 = DN_MFMA(DN_A(O_NEGK, 6), sb10, v1);
            v0 = DN_MFMA(DN_A(O_NEGK, 3), sb11, v0); v1 = DN_MFMA(DN_A(O_NEGK, 7), sb11, v1);
            __builtin_amdgcn_sched_barrier(0);
            const bf16x8 vb00 = DN_PACK8(v0, 0), vb01 = DN_PACK8(v0, 1);
            f32x16 n0 = {}, n1 = {};
            n0 = DN_MFMA(DN_A(O_T, 0), vb00, n0); n0 = DN_MFMA(DN_A(O_T, 1), vb01, n0);
            const bf16x8 nb00 = DN_PACK8(n0, 0), nb01 = DN_PACK8(n0, 1);
            v1 = DN_MFMA(DN_A(O_T, 2), nb00, v1); v1 = DN_MFMA(DN_A(O_T, 3), nb01, v1);
            const bf16x8 xb10 = DN_PACK8(v1, 0), xb11 = DN_PACK8(v1, 1);
            n1 = DN_MFMA(DN_A(O_T, 4), xb10, n1); n1 = DN_MFMA(DN_A(O_T, 5), xb11, n1);
            const bf16x8 nb10 = DN_PACK8(n1, 0), nb11 = DN_PACK8(n1, 1);
            __builtin_amdgcn_sched_barrier(0);
            f32x16 o0 = {}, o1 = {};
            o0 = DN_MFMA(DN_A(O_QG, 0), sb00, o0); o1 = DN_MFMA(DN_A(O_QG, 4), sb00, o1);
            o0 = DN_MFMA(DN_A(O_QG, 1), sb01, o0); o1 = DN_MFMA(DN_A(O_QG, 5), sb01, o1);
            o0 = DN_MFMA(DN_A(O_QG, 2), sb10, o0); o1 = DN_MFMA(DN_A(O_QG, 6), sb10, o1);
            o0 = DN_MFMA(DN_A(O_QG, 3), sb11, o0); o1 = DN_MFMA(DN_A(O_QG, 7), sb11, o1);
            o0 = DN_MFMA(DN_A(O_AT, 0), nb00, o0); o1 = DN_MFMA(DN_A(O_AT, 2), nb00, o1);
            o0 = DN_MFMA(DN_A(O_AT, 1), nb01, o0); o1 = DN_MFMA(DN_A(O_AT, 3), nb01, o1);
            o1 = DN_MFMA(DN_A(O_AT, 4), nb10, o1); o1 = DN_MFMA(DN_A(O_AT, 5), nb11, o1);
            __builtin_amdgcn_sched_barrier(0);
            {
                const int base = chunk_base(b, dir, n); float* od = OD + (size_t)dir * NT * 384 + h * 64 + 32 * sl + r;
#pragma unroll
                for (int t = 0; t < 16; ++t) { const int i0 = rowmap(t, hq), i1 = 32 + i0;
                    od[(size_t)(base + (dir ? 63 - i0 : i0)) * 384] = o0[t]; od[(size_t)(base + (dir ? 63 - i1 : i1)) * 384] = o1[t]; }
            }
            __builtin_amdgcn_sched_barrier(0);
#pragma unroll
            for (int t = 0; t < 16; ++t) { S0[t] *= gamma; S1[t] *= gamma; }
            S0 = DN_MFMA(DN_A(O_KDT, 0), nb00, S0); S1 = DN_MFMA(DN_A(O_KDT, 4), nb00, S1);
            S0 = DN_MFMA(DN_A(O_KDT, 1), nb01, S0); S1 = DN_MFMA(DN_A(O_KDT, 5), nb01, S1);
            S0 = DN_MFMA(DN_A(O_KDT, 2), nb10, S0); S1 = DN_MFMA(DN_A(O_KDT, 6), nb10, S1);
            S0 = DN_MFMA(DN_A(O_KDT, 3), nb11, S0); S1 = DN_MFMA(DN_A(O_KDT, 7), nb11, S1);
#undef DN_A
        }
        slot = slot == 2 ? 0 : slot + 1;
    }
    asm volatile("s_waitcnt vmcnt(0) lgkmcnt(0)\n\ts_barrier" ::: "memory");
#undef DN_ISSUE
}
}

DEVI void phase_sgu(const Ctx& c, int layer, bool need_ctx) {
    using dn::bf16x8; using dn::f32x16;
    const bf16_t* Z = (const bf16_t*)(c.ws + WS_Z); const bf16_t* SV = (const bf16_t*)(c.ws + WS_SV); bf16_t* MIX = (bf16_t*)(c.ws + WS_MIX);
    const float* sw = c.in[I_SGUW] + (size_t)layer * 4 * 128 * 128; const float* sb = c.in[I_SGUB] + layer * 512;
    const int nchunks = (need_ctx ? NT : NLAT) / 128; const int l = c.lane, r = l & 31, hq = l >> 5;
    const bf16x8 id0 = dn::ident_frag(0, r, hq), id1 = dn::ident_frag(1, r, hq);
    for (int sit = c.gw; sit < nchunks * 32; sit += c.ngw) {
        const int it = sit >> 2, itile = sit & 3, ch = it >> 3, g = (it >> 1) & 3, dvb = it & 1, r0 = ch * 128;
        bf16x8 yb[4][2];
#pragma unroll
        for (int jt = 0; jt < 4; ++jt) { const bf16_t* sp = SV + (size_t)(r0 + 32 * jt + r) * 256 + g * 64 + 32 * dvb + 8 * hq;
            f32x16 Y = {};
            Y = DN_MFMA(__builtin_bit_cast(bf16x8, *(const u32x4*)sp), id0, Y); Y = DN_MFMA(__builtin_bit_cast(bf16x8, *(const u32x4*)(sp + 16)), id1, Y);
            yb[jt][0] = DN_PACK8(Y, 0); yb[jt][1] = DN_PACK8(Y, 1); }
        const float* wg = sw + (size_t)g * 128 * 128;
        {
            f32x16 C = {}; const float* wr = wg + (size_t)(32 * itile + r) * 128 + 4 * hq;
#pragma unroll
            for (int jt = 0; jt < 4; ++jt)
#pragma unroll
                for (int sI = 0; sI < 2; ++sI) { const f32x4 w0 = *(const f32x4*)(wr + 32 * jt + 16 * sI), w1 = *(const f32x4*)(wr + 32 * jt + 16 * sI + 8);
                    u32x4 a; a.x = dn::cvtpk(w0.x, w0.y); a.y = dn::cvtpk(w0.z, w0.w); a.z = dn::cvtpk(w1.x, w1.y); a.w = dn::cvtpk(w1.z, w1.w);
                    C = DN_MFMA(__builtin_bit_cast(bf16x8, a), yb[jt][sI], C); }
#pragma unroll
            for (int t = 0; t < 16; ++t) { const int i = 32 * itile + dn::rowmap(t, hq); const size_t row = (size_t)(r0 + i);
                const float u = gelu_f(bf2f(Z[row * ZP + ZC_MU + g * 64 + 32 * dvb + r]));
                MIX[row * 1024 + 768 + g * 64 + 32 * dvb + r] = (bf16_t)f2bf(u * (C[t] + sb[g * 128 + i])); }
        }
    }
}

namespace attn_body {
using bf16=__hip_bfloat16;
using bf16x8=__attribute__((ext_vector_type(8)))short;
using s16x4=__attribute__((ext_vector_type(4)))short;
using f32x16=__attribute__((ext_vector_type(16)))float;
using u32x4=__attribute__((ext_vector_type(4)))unsigned;
constexpr int D=64,QP=384,KVP=128,OP=1024;
constexpr int NW=8,QBLK=32,QB=QBLK*NW,KVBLK=64;
constexpr int ATTN_UNIT_ROWS=QB;
__device__ __forceinline__ int crow(int r,int hi){return (r&3)+8*(r>>2)+4*hi;}
#define SBAR() __builtin_amdgcn_sched_barrier(0)
__device__ __forceinline__ void cmask(f32x16&p0,f32x16&p1,int jb,int qrel,int hi){
  const float NEG=-INFINITY; int kb=64*jb+4*hi;
  #pragma unroll
  for(int r=0;r<16;++r){int kv=kb+(r&3)+8*(r>>2); if(kv>qrel)p0[r]=NEG; if(kv+32>qrel)p1[r]=NEG;}
}

constexpr int NSLOT=3, SLOTB=8192;
constexpr int LDS_K=0, LDS_V=NSLOT*SLOTB, LDS_WS=2*NSLOT*SLOTB, LDS_OST=LDS_WS+NW*64*4, LDS_BYTES=LDS_OST+NW*4096;
constexpr float C2=0.125f*1.4426950408889634f;
__device__ __forceinline__ void glds16(const void*gsrc,unsigned lds_dst){unsigned keep;
  asm volatile("s_mov_b32 %0, m0\n\ts_mov_b32 m0, %2\n\ts_nop 0\n\tglobal_load_lds_dwordx4 %1, off\n\ts_mov_b32 m0, %0":"=&s"(keep):"v"(gsrc),"s"(lds_dst):"memory");}
__device__ __forceinline__ float max3f(float a,float b,float c){float r;asm("v_max3_f32 %0, %1, %2, %3":"=v"(r):"v"(a),"v"(b),"v"(c));return r;}
__device__ __forceinline__ float max2f(float a,float b){float r;asm("v_max_f32_e32 %0, %1, %2":"=v"(r):"v"(a),"v"(b));return r;}
__device__ __forceinline__ float fadd_s(float a,float b){float r;asm("v_add_f32_e32 %0, %1, %2":"=v"(r):"v"(a),"v"(b));return r;}
__device__ __forceinline__ float fsub_s(float a,float b){float r;asm("v_sub_f32_e32 %0, %1, %2":"=v"(r):"v"(a),"v"(b));return r;}
typedef float f32x2_t __attribute__((ext_vector_type(2))); typedef __bf16 bf16x2_t __attribute__((ext_vector_type(2)));
__device__ __forceinline__ unsigned cvtpk_s(float lo,float hi){f32x2_t v={lo,hi};bf16x2_t b=__builtin_convertvector(v,bf16x2_t);return __builtin_bit_cast(unsigned,b);}
#define WAIT_BAR(N) asm volatile("s_waitcnt vmcnt(" #N ") lgkmcnt(0)\n\ts_barrier":::"memory")

__device__ __forceinline__ void qkt(f32x16&p0,f32x16&p1,const char*Kslot,const bf16x8*qr,const f32x16&negm,int r32,int hi){
  const char*kb=Kslot+hi*1024+r32*16;
  #pragma unroll
  for(int d0=0;d0<4;++d0){
    const bf16x8 b0=*reinterpret_cast<const bf16x8*>(kb+d0*2048);
    const bf16x8 b1=*reinterpret_cast<const bf16x8*>(kb+d0*2048+512);
    if(d0==0){p0=__builtin_amdgcn_mfma_f32_32x32x16_bf16(b0,qr[0],negm,0,0,0);p1=__builtin_amdgcn_mfma_f32_32x32x16_bf16(b1,qr[0],negm,0,0,0);}
    else{p0=__builtin_amdgcn_mfma_f32_32x32x16_bf16(b0,qr[d0],p0,0,0,0);p1=__builtin_amdgcn_mfma_f32_32x32x16_bf16(b1,qr[d0],p1,0,0,0);}}
}
typedef __attribute__((address_space(3))) const char* lds_cptr;
typedef short v4i16_t __attribute__((ext_vector_type(4)));
__device__ __forceinline__ void kload8(bf16x8*kf,lds_cptr kp){
  kf[0]=*(const __attribute__((address_space(3))) bf16x8*)(kp);      kf[1]=*(const __attribute__((address_space(3))) bf16x8*)(kp+512);
  kf[2]=*(const __attribute__((address_space(3))) bf16x8*)(kp+2048); kf[3]=*(const __attribute__((address_space(3))) bf16x8*)(kp+2560);
  kf[4]=*(const __attribute__((address_space(3))) bf16x8*)(kp+4096); kf[5]=*(const __attribute__((address_space(3))) bf16x8*)(kp+4608);
  kf[6]=*(const __attribute__((address_space(3))) bf16x8*)(kp+6144); kf[7]=*(const __attribute__((address_space(3))) bf16x8*)(kp+6656);
}
__device__ __forceinline__ void kload2(bf16x8*kf,lds_cptr kp,int j){ kf[2*j]=*(const __attribute__((address_space(3))) bf16x8*)(kp+j*2048); kf[2*j+1]=*(const __attribute__((address_space(3))) bf16x8*)(kp+j*2048+512); }
__device__ __forceinline__ s16x4 vtr(lds_cptr p){ return __builtin_bit_cast(s16x4,__builtin_amdgcn_ds_read_tr16_b64_v4i16((__attribute__((address_space(3))) v4i16_t*)p)); }
__device__ __forceinline__ float rowmax(const f32x16&p0,const f32x16&p1){
  float a=max3f(p0[0],p0[1],p1[0]),b=max3f(p0[2],p0[3],p1[1]);a=max3f(a,p1[2],p1[3]);
  #pragma unroll
  for(int r=4;r<16;r+=4){a=max3f(a,p0[r],p0[r+1]);b=max3f(b,p0[r+2],p0[r+3]);a=max3f(a,p1[r],p1[r+1]);b=max3f(b,p1[r+2],p1[r+3]);}
  const float m=max2f(a,b);
  auto rr=__builtin_amdgcn_permlane32_swap(__float_as_uint(m),__float_as_uint(m),false,false);
  return max2f(__uint_as_float(rr[0]),__uint_as_float(rr[1]));
}
__device__ __forceinline__ void pv(f32x16*o,int vb,bf16x8 pa0,bf16x8 pa1,bf16x8 pa2,bf16x8 pa3){
  #pragma unroll
  for(int d0=0;d0<2;++d0){s16x4 lo[4],hi[4];
    #pragma unroll
    for(int ks=0;ks<4;++ks){
      asm volatile("ds_read_b64_tr_b16 %0,%1 offset:%c2":"=&v"(lo[ks]):"v"(vb),"i"(d0*4096+ks*1024):"memory");
      asm volatile("ds_read_b64_tr_b16 %0,%1 offset:%c2":"=&v"(hi[ks]):"v"(vb),"i"(d0*4096+ks*1024+512):"memory");}
    asm volatile("s_waitcnt lgkmcnt(0)":::"memory");SBAR();
    #define PK(k) (bf16x8){lo[k][0],lo[k][1],lo[k][2],lo[k][3],hi[k][0],hi[k][1],hi[k][2],hi[k][3]}
    o[d0]=__builtin_amdgcn_mfma_f32_32x32x16_bf16(pa0,PK(0),o[d0],0,0,0);
    o[d0]=__builtin_amdgcn_mfma_f32_32x32x16_bf16(pa1,PK(1),o[d0],0,0,0);
    o[d0]=__builtin_amdgcn_mfma_f32_32x32x16_bf16(pa2,PK(2),o[d0],0,0,0);
    o[d0]=__builtin_amdgcn_mfma_f32_32x32x16_bf16(pa3,PK(3),o[d0],0,0,0);
    #undef PK
  }
}

#ifndef ATTN_STORE16
#define ATTN_STORE16(p,v) (*(u32x4*)(p)=(v))
#endif
template<int THRL> __device__ __forceinline__ void attn_unit(const bf16*Qu,const bf16*__restrict__ Kh,const bf16*__restrict__ Vh,const int NT,bf16*Ou,char*shm){
  const int tid=threadIdx.x,lane=tid&63,r32=lane&31,hi=lane>>5; const int wid=__builtin_amdgcn_readfirstlane(tid>>6);
  const bf16*Qw=Qu+(long)(wid*QBLK)*QP;
  const unsigned lds0=(unsigned)(uintptr_t)shm;
  float*wsf=(float*)(shm+LDS_WS)+wid*64;
  const bf16*ksrc=Kh+(long)lane*KVP+wid*8;
  const bf16*vsrc=Vh+(long)(16*(wid&3)+(lane>>2))*KVP+(wid>>2)*32+(lane&3)*8;
  const unsigned kdst=lds0+LDS_K+wid*1024, vdst=lds0+LDS_V+wid*1024;
  #define DMA_K(t,slot) glds16(ksrc+(long)(t)*KVBLK*KVP,(unsigned)__builtin_amdgcn_readfirstlane(kdst+(slot)))
  #define DMA_V(t,slot) glds16(vsrc+(long)(t)*KVBLK*KVP,(unsigned)__builtin_amdgcn_readfirstlane(vdst+(slot)))
  const int vb0=(int)(lds0+LDS_V)+((lane>>4)&1)*32+(lane&3)*8+(4*hi+((lane&15)>>2))*64;
  const char*Kbase=shm+LDS_K; bf16x8 kf[8];
  const lds_cptr shm3=(lds_cptr)shm; const lds_cptr kp0=shm3+LDS_K+hi*1024+r32*16; const lds_cptr vp0=shm3+LDS_V+((lane>>4)&1)*32+(lane&3)*8+(4*hi+((lane&15)>>2))*64;
  DMA_K(0,0);DMA_V(0,0);DMA_K(1,SLOTB);
  bf16x8 qr[4];
  #pragma unroll
  for(int d0=0;d0<4;++d0)qr[d0]=*reinterpret_cast<const bf16x8*>(&Qw[(long)r32*QP+d0*16+hi*8]);
  float mhat=0.f,l_reg=0.f;f32x16 o[2];o[0]=f32x16{};o[1]=f32x16{};f32x16 negm=f32x16{};asm volatile("":"+v"(negm));
  #define CMASK(P0,P1,t) do{}while(0)
  bool resc=false;
  #define START(P0,P1) do{ const float rm=rowmax(P0,P1); resc=false; \
    { const float dl=rm; mhat=fadd_s(mhat,dl); \
      _Pragma("unroll") for(int r=0;r<16;++r){P0[r]=fsub_s(P0[r],dl);P1[r]=fsub_s(P1[r],dl);} \
      _Pragma("unroll") for(int r=0;r<16;++r)negm[r]=-mhat; asm volatile("":"+v"(negm)); } \
    _Pragma("unroll") for(int r=0;r<16;++r)P0[r]=__builtin_amdgcn_exp2f(P0[r]); }while(0)
  #define RESC() do{ if(resc){ asm volatile("s_waitcnt lgkmcnt(0)":::"memory"); \
      _Pragma("unroll") for(int d_=0;d_<2;++d_) _Pragma("unroll") for(int r=0;r<16;++r)o[d_][r]*=wsf[crow(r,hi)]; } }while(0)
  f32x16 pA0,pA1,pB0,pB1;
  int sl_prev=0,sl_cur=0,sl_next=SLOTB;
  #define ROT() do{sl_prev=sl_cur;sl_cur=sl_next;sl_next=(sl_next==(NSLOT-1)*SLOTB)?0:sl_next+SLOTB;}while(0)
  DMA_K(2,2*SLOTB);
  WAIT_BAR(3);
  qkt(pA0,pA1,Kbase,qr,negm,r32,hi);asm volatile("s_nop 15\n\ts_nop 7":"+v"(pA0),"+v"(pA1));CMASK(pA0,pA1,0);
  START(pA0,pA1);
  _Pragma("unroll") for(int r=0;r<16;++r)pA1[r]=__builtin_amdgcn_exp2f(pA1[r]);
  WAIT_BAR(0);
  DMA_K(3,0);DMA_V(1,SLOTB);
  ROT();
  kload8(kf,kp0+sl_cur);
  WAIT_BAR(2);
  s16x4 vlo[8],vhi[8]; u32x4 pw0,pw1,pw2,pw3;
  #define PKW(P,B) cvtpk_s(P[B],P[B+1])
  #define PAF(k) __builtin_bit_cast(bf16x8,pw##k)
  #define VFR(i) (bf16x8){vlo[i][0],vlo[i][1],vlo[i][2],vlo[i][3],vhi[i][0],vhi[i][1],vhi[i][2],vhi[i][3]}
  #define PIN(x) asm volatile("":"+v"(x))
  #define MX3(a,b,c) __builtin_fmaxf(__builtin_fmaxf((a),(b)),(c))
  #define GAPA(MF,A0,A1,A2,A3,W0,W1,PW) do{ MF; sacc+=A0; sacc+=A1; sacc+=A2; sacc+=A3; PIN(sacc); W0; W1; PIN(PW); SBAR(); }while(0)
  #define EX(v) __builtin_amdgcn_exp2f(v)
  #define GAPB(MF,X,B) do{ MF; X[B]=EX(X[B]); X[B+1]=EX(X[B+1]); X[B+2]=EX(X[B+2]); X[B+3]=EX(X[B+3]); PIN(X); SBAR(); }while(0)
  #define VRD(i) do{ vlo[i]=vtr(vp_+(((i)>>2)*4096+((i)&3)*1024)); vhi[i]=vtr(vp_+(((i)>>2)*4096+((i)&3)*1024+512)); }while(0)
  #define KRD(G,j) do{ if(G){ kload2(kf,kp0+sl_next,j); SBAR(); } }while(0)
  #define STEP(C0,C1,P0,P1,t,GK,GV,GL) do{ SBAR(); \
    const lds_cptr vp_=vp0+sl_prev; \
    VRD(0); SBAR(); float sacc=(P0[0]+P0[1]); \
    GAPA(C0=__builtin_amdgcn_mfma_f32_32x32x16_bf16(kf[0],qr[0],negm,0,0,0), P0[2],P0[3],P0[4],P0[5],     pw0[0]=PKW(P0,0), pw0[1]=PKW(P0,2), pw0); \
    VRD(4); SBAR(); GAPA(C1=__builtin_amdgcn_mfma_f32_32x32x16_bf16(kf[1],qr[0],negm,0,0,0), P0[6],P0[7],P0[8],P0[9],     pw0[2]=PKW(P0,4), pw0[3]=PKW(P0,6), pw0); \
    VRD(1); SBAR(); GAPA(C0=__builtin_amdgcn_mfma_f32_32x32x16_bf16(kf[2],qr[1],C0,0,0,0),   P0[10],P0[11],P0[12],P0[13], pw1[0]=PKW(P0,8), pw1[1]=PKW(P0,10), pw1); \
    VRD(5); SBAR(); GAPA(C1=__builtin_amdgcn_mfma_f32_32x32x16_bf16(kf[3],qr[1],C1,0,0,0),   P0[14],P0[15],P1[0],P1[1],   pw1[2]=PKW(P0,12),pw1[3]=PKW(P0,14), pw1); \
    VRD(2); SBAR(); GAPA(C0=__builtin_amdgcn_mfma_f32_32x32x16_bf16(kf[4],qr[2],C0,0,0,0),   P1[2],P1[3],P1[4],P1[5],     pw2[0]=PKW(P1,0), pw2[1]=PKW(P1,2), pw2); \
    VRD(6); SBAR(); GAPA(C1=__builtin_amdgcn_mfma_f32_32x32x16_bf16(kf[5],qr[2],C1,0,0,0),   P1[6],P1[7],P1[8],P1[9],     pw2[2]=PKW(P1,4), pw2[3]=PKW(P1,6), pw2); \
    VRD(3); SBAR(); GAPA(C0=__builtin_amdgcn_mfma_f32_32x32x16_bf16(kf[6],qr[3],C0,0,0,0),   P1[10],P1[11],P1[12],P1[13], pw3[0]=PKW(P1,8), pw3[1]=PKW(P1,10), pw3); \
    VRD(7); SBAR(); GAPA(C1=__builtin_amdgcn_mfma_f32_32x32x16_bf16(kf[7],qr[3],C1,0,0,0),   P1[14],P1[15],0.f,0.f,       pw3[2]=PKW(P1,12),pw3[3]=PKW(P1,14), pw3); \
    l_reg+=sacc; \
    if(GK){DMA_K((t)+3,sl_cur);} if(GV){DMA_V((t)+1,sl_next);} \
    CMASK(C0,C1,t); \
    { float a=MX3(C0[0],C0[1],C1[0]),b=MX3(C0[2],C0[3],C1[1]); a=MX3(a,C1[2],C1[3]); \
      _Pragma("unroll") for(int r=4;r<16;r+=4){a=MX3(a,C0[r],C0[r+1]);b=MX3(b,C0[r+2],C0[r+3]);a=MX3(a,C1[r],C1[r+1]);b=MX3(b,C1[r+2],C1[r+3]);} \
      float rm=__builtin_fmaxf(a,b); { auto rr=__builtin_amdgcn_permlane32_swap(__float_as_uint(rm),__float_as_uint(rm),false,false); rm=__builtin_fmaxf(__uint_as_float(rr[0]),__uint_as_float(rr[1])); } \
      resc=false; \
      if(__builtin_expect(__any(rm>(float)THRL),0)){ const float dl=__builtin_fmaxf(rm,0.f); mhat+=dl; \
        _Pragma("unroll") for(int r=0;r<16;++r){C0[r]-=dl;C1[r]-=dl;} \
        _Pragma("unroll") for(int r=0;r<16;++r)negm[r]=-mhat; asm volatile("":"+v"(negm)); \
        const float f=__builtin_amdgcn_exp2f(-dl); l_reg*=f; if(hi==0)wsf[r32]=f; resc=true; } } \
    SBAR(); \
    GAPB(o[0]=__builtin_amdgcn_mfma_f32_32x32x16_bf16(PAF(0),VFR(0),o[0],0,0,0), C0,0); \
    GAPB(o[1]=__builtin_amdgcn_mfma_f32_32x32x16_bf16(PAF(0),VFR(4),o[1],0,0,0), C0,4); \
    KRD(GL,0); GAPB(o[0]=__builtin_amdgcn_mfma_f32_32x32x16_bf16(PAF(1),VFR(1),o[0],0,0,0), C0,8); \
    KRD(GL,1); GAPB(o[1]=__builtin_amdgcn_mfma_f32_32x32x16_bf16(PAF(1),VFR(5),o[1],0,0,0), C0,12); \
    KRD(GL,2); GAPB(o[0]=__builtin_amdgcn_mfma_f32_32x32x16_bf16(PAF(2),VFR(2),o[0],0,0,0), C1,0); \
    KRD(GL,3); GAPB(o[1]=__builtin_amdgcn_mfma_f32_32x32x16_bf16(PAF(2),VFR(6),o[1],0,0,0), C1,4); \
    GAPB(o[0]=__builtin_amdgcn_mfma_f32_32x32x16_bf16(PAF(3),VFR(3),o[0],0,0,0), C1,8); \
    GAPB(o[1]=__builtin_amdgcn_mfma_f32_32x32x16_bf16(PAF(3),VFR(7),o[1],0,0,0), C1,12); \
    }while(0)
  int t=1;
  #undef CMASK
  #define CMASK(P0,P1,t) do{}while(0)
  for(;t+5<NT;t+=2){
    STEP(pB0,pB1,pA0,pA1,t,true,true,true);     WAIT_BAR(2); RESC(); ROT();
    STEP(pA0,pA1,pB0,pB1,t+1,true,true,true);   WAIT_BAR(2); RESC(); ROT();
  }
  #undef CMASK
  #define CMASK(P0,P1,t) do{}while(0)
  #define ENDW(tt) do{ if((tt)+3<NT){WAIT_BAR(2);} else if((tt)+2<NT){WAIT_BAR(1);} else {WAIT_BAR(0);} }while(0)
  for(;t+1<NT;t+=2){
    STEP(pB0,pB1,pA0,pA1,t,(t+3<NT),(t+1<NT),(t+1<NT));       ENDW(t);   RESC(); ROT();
    STEP(pA0,pA1,pB0,pB1,t+1,(t+4<NT),(t+2<NT),(t+2<NT));     ENDW(t+1); RESC(); ROT();
  }
  STEP(pB0,pB1,pA0,pA1,NT-1,false,false,false); RESC();
  { float sacc=pB0[0]+pB0[1]; _Pragma("unroll") for(int r=2;r<16;++r)sacc+=pB0[r]; _Pragma("unroll") for(int r=0;r<16;++r)sacc+=pB1[r]; l_reg+=sacc;
    pw0=(u32x4){PKW(pB0,0),PKW(pB0,2),PKW(pB0,4),PKW(pB0,6)};pw1=(u32x4){PKW(pB0,8),PKW(pB0,10),PKW(pB0,12),PKW(pB0,14)};pw2=(u32x4){PKW(pB1,0),PKW(pB1,2),PKW(pB1,4),PKW(pB1,6)};pw3=(u32x4){PKW(pB1,8),PKW(pB1,10),PKW(pB1,12),PKW(pB1,14)};
    SBAR(); pv(o,vb0+sl_cur,PAF(0),PAF(1),PAF(2),PAF(3)); }
  #undef PKW
  #undef PAF
  #undef VFR
  #undef PIN
  #undef MX3
  #undef GAPA
  #undef GAPB
  #undef EX
  #undef VRD
  #undef KRD
  #undef STEP
  #undef ENDW
  {auto rr=__builtin_amdgcn_permlane32_swap(__float_as_uint(l_reg),__float_as_uint(l_reg),false,false);l_reg=__uint_as_float(rr[0])+__uint_as_float(rr[1]);}
  if(hi==0)wsf[32+r32]=l_reg;asm volatile("s_waitcnt lgkmcnt(0)":::"memory");
  float rli[16];
  #pragma unroll
  for(int r=0;r<16;++r)rli[r]=__builtin_amdgcn_rcpf(wsf[32+crow(r,hi)]);
  bf16*Ow=Ou+(long)(wid*QBLK)*OP;
  { bf16*stg=(bf16*)(shm+LDS_OST)+wid*2048;
    #pragma unroll
    for(int r=0;r<16;++r){const int orow=crow(r,hi);
      #pragma unroll
      for(int d0=0;d0<2;++d0)stg[orow*64+d0*32+r32]=__float2bfloat16(o[d0][r]*rli[r]);}
    asm volatile("s_waitcnt lgkmcnt(0)":::"memory");
    #pragma unroll
    for(int i=0;i<4;++i){const int row=i*8+(lane>>3),ch=lane&7; const u32x4 v=*(const u32x4*)(stg+row*64+ch*8); ATTN_STORE16(Ow+(long)row*OP+ch*8,v);} }
  asm volatile("s_waitcnt lgkmcnt(0)\n\ts_barrier":::"memory");
  #undef DMA_K
  #undef DMA_V
  #undef CMASK
  #undef START
  #undef RESC
  #undef ROT
}
constexpr int ATTN_LDS_BYTES=LDS_BYTES;
#undef SBAR
#undef WAIT_BAR
}

DEVI void attn_unit_run(const Ctx& c, int u) {
    using attn_body::bf16;
    const bf16* Qa = (const bf16*)(c.ws + WS_QA); const bf16* Qc = (const bf16*)(c.ws + WS_QC); const bf16* Ka = (const bf16*)(c.ws + WS_KA); const bf16* Va = (const bf16*)(c.ws + WS_VA);
    bf16* MIX = (bf16*)(c.ws + WS_MIX);
    if (u < 384) { const int grp = u / 48, rem = u % 48, g = rem >> 4, qb = rem & 15, b = grp >> 1, kvh = grp & 1, hq = kvh * 3 + g;
        attn_body::attn_unit<8>(Qa + (size_t)(b * SEQ + qb * 256) * 384 + hq * 64, Ka + (size_t)b * SKV * 128 + kvh * 64, Va + (size_t)b * SKV * 128 + kvh * 64, SKV / 64,
                                MIX + (size_t)(b * SEQ + qb * 256) * 1024 + 384 + hq * 64, (char*)c.lds); }
    else { const int uc = u - 384, b = uc / 6, hq = uc % 6, kvh = hq / 3;
        attn_body::attn_unit<8>(Qc + (size_t)(b * CTXL) * 384 + hq * 64, Ka + (size_t)b * SKV * 128 + kvh * 64, Va + (size_t)b * SKV * 128 + kvh * 64, CTXL / 64,
                                MIX + (size_t)(NLAT + b * CTXL) * 1024 + 384 + hq * 64, (char*)c.lds); }
}
template <bool FAST_SCAN>
DEVI void phase_mixer_fast(const Ctx& c, bool with_ctx, int psub = 0) {
    const int G = gridDim.x, bx = blockIdx.x; const int nunits = 384 + (with_ctx ? 24 : 0);
    if (G == 256) {
        const int vcu = (bx & 7) * 32 + (bx >> 3), x = vcu >> 5, j = vcu & 31;
        if (FAST_SCAN && j < 6) { if (!(psub & 4)) dn::scan_sequence(c, x * 6 + j); return; }
        if (psub & 8) return;
        if (!FAST_SCAN) { for (int u = vcu; u < nunits; u += 256) attn_unit_run(c, u); return; }
        const int jp = j - 6;
        attn_unit_run(c, 48 * x + jp);
        if (jp < 22) attn_unit_run(c, 48 * x + 26 + jp);
        else if (with_ctx && jp < 25) attn_unit_run(c, 384 + (x >> 1) * 6 + (x & 1) * 3 + (jp - 22));
    } else {
        if (FAST_SCAN) for (int sq = bx; sq < 48; sq += G) dn::scan_sequence(c, sq);
        for (int u = bx; u < nunits; u += G) attn_unit_run(c, u);
    }
}

DEVI void phase_moe_assign(const Ctx& c) {
    int* cnt = (int*)c.lds;
    int* misc = (int*)c.lds + 2048;
    int* slots = (int*)c.lds + 2048 + 64;
    const int* gcnt = (const int*)(c.ws + CTL_CNT); const int* tope = (const int*)(c.ws + CTL_TOPE);
    const bf16_t* H = (const bf16_t*)(c.ws + WS_H); bf16_t* XBm = (bf16_t*)(c.ws + WS_MXB);
    for (int i = c.tid; i < 2048; i += NTHREADS) cnt[i] = gcnt[i];
    __syncthreads();
    if (c.tid < 8) { int tot = 0; for (int v = 0; v < 256; ++v) tot += cnt[v * 8 + c.tid]; misc[8 + c.tid] = tot; }
    __syncthreads();
    if (c.tid == 0) { int s = 0; for (int e = 0; e < 8; ++e) { misc[16 + e] = s; s += (misc[8 + e] + 255) & ~255; } misc[24] = s;
        if (blockIdx.x == 0) { int* seg = (int*)(c.ws + CTL_SEG); for (int e = 0; e <= 8; ++e) seg[e] = misc[16 + e]; for (int e = 0; e < 8; ++e) seg[16 + e] = misc[8 + e];
            for (int e = 0; e < 8; ++e) for (int pm = misc[16 + e] >> 8; pm < (misc[16 + e + 1] >> 8); ++pm) seg[32 + pm] = e; } }
    __syncthreads();
    if (blockIdx.x == 0) {
        int* ut = (int*)(c.ws + CTL_UTAB); const int nu = (misc[24] >> 8) * 4, ntab = nu <= 512 ? nu : 512 + 2 * (nu - 512);
        if (c.tid == 0) ut[0] = ntab;
        for (int L = c.tid; L < ntab; L += NTHREADS) { const int unit = L < 512 ? L : 512 + ((L - 512) >> 1), pm = unit >> 2; int e = 0;
            for (int q = 1; q < 8; ++q) e += (pm * 256 >= misc[16 + q]) ? 1 : 0;
            ut[4 + 4 * L] = pm; ut[4 + 4 * L + 1] = (unit & 3) + 4 * e; ut[4 + 4 * L + 2] = L < 512 ? 0 : ((L - 512) & 1) * (MFF / 2); ut[4 + 4 * L + 3] = L < 512 ? 0 : MFF / 128; } }
    for (int vb = blockIdx.x; vb < 256; vb += gridDim.x) {
        int* sel = slots + 128;
        if (c.tid < 128) sel[c.tid] = tope[vb * 128 + c.tid];
        __syncthreads();
        if (c.tid < 8) { int bs = 0; for (int v = 0; v < vb; ++v) bs += cnt[v * 8 + c.tid];
            int rank = misc[16 + c.tid] + bs;
            for (int i = 0; i < 128; ++i) if (sel[i] == c.tid) { slots[i] = rank; ++rank; } }
        __syncthreads();
        if (c.tid < 128) ((int*)(c.ws + CTL_TOKSLOT))[vb * 128 + c.tid] = slots[c.tid];
        for (int a = c.wave; a < 128; a += NWAVES) { const int row = vb * 64 + (a >> 1); const int slot = slots[a];
            const u32x4* src = (const u32x4*)(H + (size_t)row * 1024) + c.lane; u32x4* dst = (u32x4*)(XBm + (size_t)slot * 1024) + c.lane; dst[0] = src[0]; dst[64] = src[64]; }
        __syncthreads();
    }
    for (int e = 0; e < 8; ++e) { const int p0 = misc[16 + e] + misc[8 + e], p1 = misc[16 + e + 1];
        for (int s = p0 + c.gw; s < p1; s += c.ngw) { u32x4* dst = (u32x4*)(XBm + (size_t)s * 1024) + c.lane; dst[0] = (u32x4){0u, 0u, 0u, 0u}; dst[64] = (u32x4){0u, 0u, 0u, 0u}; } }
}

DEVI void phase_final(const Ctx& c) {
    const float* xb = (const float*)(c.ws + WS_XB); const bf16_t* YB = (const bf16_t*)(c.ws + WS_MXB); const bf16_t* YB2 = (const bf16_t*)(c.ws + WS_YB2);
    const int* ts = (const int*)(c.ws + CTL_TOKSLOT); const float* tg = (const float*)(c.ws + CTL_TOPG);
    struct Sc { int s1, s2; float g1, g2; };
    struct Dt { u32x2 a[4], b[4], za[4], zb[4]; f32x4 x[4]; };
#define FIN_SC(sc, r) do { sc.s1 = ts[(r) * 2]; sc.s2 = ts[(r) * 2 + 1]; sc.g1 = tg[(r) * 2]; sc.g2 = tg[(r) * 2 + 1]; } while (0)
#define FIN_DT(dt, sc, r) do { const u32x2* y1_ = (const u32x2*)(YB + (size_t)sc.s1 * 1024) + c.lane; const u32x2* y2_ = (const u32x2*)(YB + (size_t)sc.s2 * 1024) + c.lane; \
        const u32x2* z1_ = (const u32x2*)(YB2 + (size_t)(sc.s1 >= 32768 ? sc.s1 - 32768 : 0) * 1024) + c.lane; const u32x2* z2_ = (const u32x2*)(YB2 + (size_t)(sc.s2 >= 32768 ? sc.s2 - 32768 : 0) * 1024) + c.lane; \
        const f32x4* xr_ = (const f32x4*)(xb + (size_t)(r) * 1024) + c.lane; \
        _Pragma("unroll") for (int j_ = 0; j_ < 4; ++j_) { dt.a[j_] = y1_[64 * j_]; dt.b[j_] = y2_[64 * j_]; dt.x[j_] = xr_[64 * j_]; \
            dt.za[j_] = sc.s1 >= 32768 ? z1_[64 * j_] : (u32x2){0u, 0u}; dt.zb[j_] = sc.s2 >= 32768 ? z2_[64 * j_] : (u32x2){0u, 0u}; } } while (0)
    int r = c.gw; if (r >= NLAT) return;
    Sc sc0, sc1, sc2; Dt d0, d1;
    FIN_SC(sc0, r); sc1 = sc0; sc2 = sc0;
    if (r + c.ngw < NLAT) FIN_SC(sc1, r + c.ngw);
    FIN_DT(d0, sc0, r); d1 = d0;
    for (; r < NLAT; r += c.ngw) {
        if (r + 2 * c.ngw < NLAT) FIN_SC(sc2, r + 2 * c.ngw);
        if (r + c.ngw < NLAT) FIN_DT(d1, sc1, r + c.ngw);
        const float g1 = sc0.g1, g2 = sc0.g2; const f32x4* gt = (const f32x4*)modv(c, 1, r, 5) + c.lane;
        f32x4 v[4]; float ss = 0.f;
#pragma unroll
        for (int j = 0; j < 4; ++j) { const u32x2 a = d0.a[j], b = d0.b[j], p = d0.za[j], q = d0.zb[j]; const f32x4 g = gt[64 * j]; f32x4 y;
            y.x = g1 * (bflo(a.x) + bflo(p.x)) + g2 * (bflo(b.x) + bflo(q.x)); y.y = g1 * (bfhi(a.x) + bfhi(p.x)) + g2 * (bfhi(b.x) + bfhi(q.x));
            y.z = g1 * (bflo(a.y) + bflo(p.y)) + g2 * (bflo(b.y) + bflo(q.y)); y.w = g1 * (bfhi(a.y) + bfhi(p.y)) + g2 * (bfhi(b.y) + bfhi(q.y));
            v[j] = d0.x[j] + g * y; ss += (v[j].x * v[j].x + v[j].y * v[j].y) + (v[j].z * v[j].z + v[j].w * v[j].w); }
        const float rstd = rsqrtf(wave_sum(ss) * (1.f / 1024.f) + EPS);
        const f32x4* fg = (const f32x4*)c.in[I_FNG] + c.lane; f32x4* o = (f32x4*)(c.out + (size_t)r * 1024) + c.lane;
#pragma unroll
        for (int j = 0; j < 4; ++j) o[64 * j] = v[j] * rstd * fg[64 * j];
        sc0 = sc1; sc1 = sc2; d0 = d1;
    }
#undef FIN_SC
#undef FIN_DT
}

#define LAS __attribute__((address_space(3)))
#define XB_TMO      128
#define XB_XCNT(j)  (256  + 64 * (j))
#define XB_XSUB(j)  (1280 + 64 * (j))
#define XB_XGEN(j)  (2304 + 64 * (j))
#define XB_TOP      3328
#define XB_TOPGEN   3392
#define XCD_BAR_WORDS 3456
#define XB_SPIN_CAP (1u << 18)

__device__ __forceinline__ unsigned xb_ld(unsigned* p)              { return __hip_atomic_load(p, __ATOMIC_RELAXED, __HIP_MEMORY_SCOPE_AGENT); }
__device__ __forceinline__ unsigned xb_add(unsigned* p, unsigned v) { return __hip_atomic_fetch_add(p, v, __ATOMIC_RELAXED, __HIP_MEMORY_SCOPE_AGENT); }
__device__ __forceinline__ unsigned xb_xcc_id() { return (unsigned)__builtin_amdgcn_s_getreg((3 << 11) | 20) & 0xFu; }
#define XB_SPIN(cond, bar) do { unsigned _sp = 0; while (cond) { __builtin_amdgcn_s_sleep(1); \
    if ((++_sp & 255u) == 0u) { if (xb_ld(&(bar)[XB_TMO])) break; if (_sp > XB_SPIN_CAP) { atomicAdd(&(bar)[XB_TMO], 1u); break; } } } } while (0)

struct XcdBarrier {
    unsigned* bar; unsigned x;
    volatile LAS unsigned* st;
};

__device__ __forceinline__ XcdBarrier xcd_barrier_post(unsigned* bar, volatile LAS unsigned* st) {
    XcdBarrier b; b.bar = bar; b.x = xb_xcc_id(); b.st = st;
    if (threadIdx.x == 0) (void)xb_add(&bar[XB_XCNT(b.x)], 1u);
    return b;
}
__device__ __forceinline__ void xcd_barrier_complete(unsigned* bar, unsigned x, unsigned& nloc, unsigned& nx) {
    const unsigned G = gridDim.x * gridDim.y * gridDim.z;
    unsigned sum, cnt, mine, sp = 0u;
    for (;;) {
        sum = 0u; cnt = 0u; mine = 0u;
#pragma unroll
        for (unsigned j = 0; j < 16; ++j) { const unsigned c = xb_ld(&bar[XB_XCNT(j)]); sum += c; cnt += (c > 0u) ? 1u : 0u; mine = (j == x) ? c : mine; }
        if (sum == G) break;
        __builtin_amdgcn_s_sleep(1);
        if ((++sp & 255u) == 0u) { if (xb_ld(&bar[XB_TMO])) break; if (sp > XB_SPIN_CAP) { atomicAdd(&bar[XB_TMO], 1u); break; } }
    }
    nloc = mine > 0u ? mine : 1u; nx = cnt > 0u ? cnt : 1u;
}

__device__ __forceinline__ void xcd_barrier(const XcdBarrier& b) {
    asm volatile("s_waitcnt vmcnt(0)" ::: "memory");
    __syncthreads();
    if (threadIdx.x == 0) {
        unsigned* bar = b.bar;
        __builtin_amdgcn_s_waitcnt(0);
        unsigned nloc = b.st[0], nx = b.st[1];
        if (nloc == 0u) { xcd_barrier_complete(bar, b.x, nloc, nx); b.st[0] = nloc; b.st[1] = nx; }
        const unsigned old = xb_add(&bar[XB_XSUB(b.x)], 1u);
        const unsigned gen = old / nloc;
        if (old + 1u == (gen + 1u) * nloc) {
            __builtin_amdgcn_fence(__ATOMIC_RELEASE, "agent");
            asm volatile("s_waitcnt vmcnt(0)" ::: "memory");
            const unsigned og = xb_add(&bar[XB_TOP], 1u);
            const unsigned tg = og / nx;
            if (og + 1u == (tg + 1u) * nx) xb_add(&bar[XB_TOPGEN], 1u);
            else XB_SPIN(xb_ld(&bar[XB_TOPGEN]) == tg, bar);
            __builtin_amdgcn_fence(__ATOMIC_ACQUIRE, "agent");
            xb_add(&bar[XB_XGEN(b.x)], 1u);
            asm volatile("s_waitcnt vmcnt(0)" ::: "memory");
        } else {
            XB_SPIN(xb_ld(&bar[XB_XGEN(b.x)]) == gen, bar);
            __builtin_amdgcn_fence(__ATOMIC_ACQUIRE, "agent");
            asm volatile("s_waitcnt vmcnt(0)" ::: "memory");
        }
    }
    __syncthreads();
}

#ifndef FAST_DN
#define FAST_DN 1
#endif
constexpr int NPHASES = 24;
#define IN(k) (lo <= (k) && (k) < hi)
#define SYNC(k) do { if (IN(k) && IN((k) + 1)) xcd_barrier(grid); } while (0)
template <int LAYER>
DEVI void mixer_phases(const Ctx& c, int lo, int hi, int psub, const XcdBarrier& grid) {
    constexpr int P = 1 + LAYER * 10;
    bf16_t* wl = (bf16_t*)(c.ws + WS_WL);
    const float* mvl = (const float*)(c.ws + CTL_MODV) + (size_t)LAYER * 5 * 6144;
    const float* xl = LAYER == 0 ? c.in[I_X] : (const float*)(c.ws + WS_XB); const float* xc = LAYER == 0 ? c.in[I_CTX] : (const float*)(c.ws + WS_XB) + (size_t)NLAT * 1024;
    if (IN(P)) { phase_norm<false>(c, LAYER, 0, c.in[I_N1G] + LAYER * 1024, NT, xl, xc, LAYER == 1 ? (const float*)(c.ws + WS_PB) : nullptr); } SYNC(P);
    if (IN(P + 1)) { const bf16_t* bt = (const bf16_t*)((char*)wl + WL_WIN) + (size_t)LAYER * ZP * 1024;
        pg8::Gemm g{(const bf16_t*)(c.ws + WS_H), bt, NT, ZP, 1024}; pg8::StaticOrder S; S.init(NT, ZP, (int)gridDim.x, (int)blockIdx.x);
        pg8::gemm_phase<pg8::EpiStore, pg8::StaticOrder, true, true>(c.lds3, g, S, pg8::EpiStore{(bf16_t*)(c.ws + WS_Z), ZP, 0, 0l}); } SYNC(P + 1);
    if (IN(P + 2)) { phase_prep(c, LAYER, LAYER == 0); } SYNC(P + 2);
#if FAST_DN
    if (IN(P + 3)) { if (!(psub & 1)) dn::phase_chunkprep(c); if (!(psub & 2)) phase_sgu(c, LAYER, LAYER == 0); } SYNC(P + 3);
    if (IN(P + 4)) { phase_mixer_fast<true>(c, LAYER == 0, psub); } SYNC(P + 4);
#else
    if (IN(P + 3)) { phase_sgu(c, LAYER, LAYER == 0); } SYNC(P + 3);
    if (IN(P + 4)) { phase_dnscan_naive(c); phase_mixer_fast<false>(c, LAYER == 0); } SYNC(P + 4);
#endif
    if (IN(P + 5)) { phase_dnfinish(c, LAYER, LAYER == 0 ? NT : NLAT); } SYNC(P + 5);
    if (IN(P + 6)) { const bf16_t* bt = (const bf16_t*)((char*)wl + WL_WOUT) + (size_t)LAYER * 1024 * 1024;
        constexpr int MR = LAYER == 0 ? NT : NLAT;
        pg8::Gemm g{(const bf16_t*)(c.ws + WS_MIX), bt, MR, 1024, 1024}; pg8::StaticOrder S; S.init(MR, 1024, (int)gridDim.x, (int)blockIdx.x);
        pg8::gemm_phase<pg8::EpiRes, pg8::StaticOrder, true, true>(c.lds3, g, S, pg8::EpiRes{(float*)(c.ws + WS_XB), mvl, 2, xl, xc, nullptr}); } SYNC(P + 6);
}

__global__ void __launch_bounds__(NTHREADS, 2) mega_fwd(Args args) {
    extern __shared__ __attribute__((aligned(16))) unsigned char lds_raw[];
    Ctx c;
#pragma unroll
    for (int i = 0; i < 28; ++i) c.in[i] = args.in[i];
    c.out = args.out; c.ws = args.ws; c.tid = threadIdx.x; c.lane = c.tid & 63; c.wave = __builtin_amdgcn_readfirstlane(c.tid >> 6);
    c.gw = blockIdx.x * NWAVES + c.wave; c.ngw = gridDim.x * NWAVES; c.lds = (float*)lds_raw; c.lds3 = (__attribute__((address_space(3))) unsigned char*)lds_raw;
    bf16_t* wl = (bf16_t*)(c.ws + WS_WL);
    const int lo = args.ph_lo, hi = args.ph_hi;
    volatile LAS unsigned* bst = (volatile LAS unsigned*)(c.lds3 + LDS_BYTES - 64);
    if (c.tid < 16) bst[c.tid] = 0u;
    __syncthreads();
    const XcdBarrier grid = xcd_barrier_post((unsigned*)(c.ws + WS_CTL), bst);
    if (IN(0)) { phase_prologue(c); } SYNC(0);
    mixer_phases<0>(c, lo, hi, args.probe_sub, grid);
    {
        const float* mvl = (const float*)(c.ws + CTL_MODV);
        const float* xbl = (const float*)(c.ws + WS_XB); const float* xbc = xbl + (size_t)NLAT * 1024;
        if (IN(8)) { phase_norm<false>(c, 0, 3, c.in[I_N2G], NT, xbl, xbc); } SYNC(8);
        if (IN(9)) { pg8::Gemm g{(const bf16_t*)(c.ws + WS_H), (const bf16_t*)((char*)wl + WL_F13), NT, 2 * FF, 1024}; pg8::StaticOrder S; S.init(NT, 2 * FF, (int)gridDim.x, (int)blockIdx.x);
            pg8::gemm_phase<pg8::EpiSwi, pg8::StaticOrder, true, true>(c.lds3, g, S, pg8::EpiSwi{(bf16_t*)(c.ws + WS_Z), FF, 0}); } SYNC(9);
        if (IN(10)) { pg8::Gemm g{(const bf16_t*)(c.ws + WS_Z), (const bf16_t*)((char*)wl + WL_F2), NT, 1024, FF}; pg8::FfnDownOrder S; S.init((int)gridDim.x, (int)blockIdx.x, FF / 128);
            pg8::gemm_phase<pg8::EpiRes, pg8::FfnDownOrder, true, true>(c.lds3, g, S, pg8::EpiRes{(float*)(c.ws + WS_XB), mvl, 5, xbl, xbc, (float*)(c.ws + WS_PB)}); } SYNC(10);
    }
    mixer_phases<1>(c, lo, hi, args.probe_sub, grid);
    {
        if (IN(18)) { const float* xbl = (const float*)(c.ws + WS_XB);
            if (gridDim.x == 256) {
                if (c.wave < 4) phase_norm<true>(c, 1, 3, c.in[I_N2G] + 1024, NLAT, xbl, xbl + (size_t)NLAT * 1024, nullptr, 16);
                else { phase_conv_m13(c, (int)blockIdx.x * 4 + (c.wave - 4), 1024); phase_conv_m2(c, (int)blockIdx.x * 4 + (c.wave - 4), 1024); }
                __syncthreads();
                if (c.tid < 8) { const int* sel = (const int*)c.lds; int n = 0; for (int q = 0; q < 128; ++q) n += (sel[q] == c.tid) ? 1 : 0; ((int*)(c.ws + CTL_CNT))[blockIdx.x * 8 + c.tid] = n; }
            } else { phase_norm<true>(c, 1, 3, c.in[I_N2G] + 1024, NLAT, xbl, xbl + (size_t)NLAT * 1024); phase_conv_m13(c); phase_conv_m2(c); } } SYNC(18);
        if (IN(19)) { phase_moe_assign(c); } SYNC(19);
        if (IN(20)) { pg8::Gemm g{(const bf16_t*)(c.ws + WS_MXB), (const bf16_t*)(c.ws + WS_M13), 0, 0, 1024}; pg8::MoeOrder S; S.init((const int*)(c.ws + CTL_SEG), 28, (int)gridDim.x, (int)blockIdx.x);
            pg8::gemm_phase<pg8::EpiSwi, pg8::MoeOrder, true, true>(c.lds3, g, S, pg8::EpiSwi{(bf16_t*)(c.ws + WS_MHID), MFF, 28}); } SYNC(20);
        if (IN(22)) { pg8::Gemm g{(const bf16_t*)(c.ws + WS_MHID), (const bf16_t*)c.out, 0, 0, MFF}; pg8::TableOrder S; S.init((const int*)(c.ws + CTL_UTAB), (int)gridDim.x, (int)blockIdx.x);
            pg8::gemm_phase<pg8::EpiStore, pg8::TableOrder, true, true>(c.lds3, g, S, pg8::EpiStore{(bf16_t*)(c.ws + WS_MXB), 1024, 4, (long)((WS_YB2 - WS_MXB) / 2) - 32768l * 1024}); } SYNC(22);
        if (IN(23)) { phase_final(c); }
    }
}
#undef IN
#undef SYNC

extern "C" void kernel_launch(void* const* d_in, const int* in_sizes, int n_in, void* d_out, int out_size, void* d_ws, size_t ws_size, hipStream_t stream) {
    static int grid = 0;
    if (grid == 0) {
        if (n_in != 28 || out_size != NLAT * D || ws_size < WS_END) { fprintf(stderr, "kernel_launch: unexpected shapes (n_in %d out %d ws %zu)\n", n_in, out_size, ws_size); grid = -1; return; }
        int dev = 0, cus = 0, per_cu = 0;
        hipGetDevice(&dev); hipDeviceGetAttribute(&cus, hipDeviceAttributeMultiprocessorCount, dev);
        hipFuncSetAttribute((const void*)mega_fwd, hipFuncAttributeMaxDynamicSharedMemorySize, LDS_BYTES);
        hipOccupancyMaxActiveBlocksPerMultiprocessor(&per_cu, (const void*)mega_fwd, NTHREADS, LDS_BYTES);
        if (per_cu < 1) { fprintf(stderr, "kernel_launch: occupancy query says %d blocks per CU\n", per_cu); per_cu = 1; }
        (void)hipGetLastError();
        grid = cus;
    }
    if (grid < 0) return;
    if (hipMemsetAsync(d_ws, 0, 16384, stream) != hipSuccess) { fprintf(stderr, "kernel_launch: memset of the barrier words failed\n"); return; }
    Args a{};
    for (int i = 0; i < 28; ++i) a.in[i] = (const float*)d_in[i];
    a.out = (float*)d_out; a.ws = (unsigned char*)d_ws;
#ifndef MK_PER_PHASE
#define MK_PER_PHASE 0
#endif
#if MK_PER_PHASE
    for (int ph = 0; ph < NPHASES; ++ph) {
        a.ph_lo = ph; a.ph_hi = ph + 1; void* kargs[] = {&a};
        hipError_t e = hipLaunchCooperativeKernel((const void*)mega_fwd, dim3(grid), dim3(NTHREADS), kargs, LDS_BYTES, stream);
        if (e != hipSuccess) { fprintf(stderr, "launch failed: %s\n", hipGetErrorString(e)); break; }
    }
#else
    a.ph_lo = 0; a.ph_hi = NPHASES; void* kargs[] = {&a};
    hipError_t e = hipLaunchCooperativeKernel((const void*)mega_fwd, dim3(grid), dim3(NTHREADS), kargs, LDS_BYTES, stream);
    if (e != hipSuccess) fprintf(stderr, "launch failed: %s\n", hipGetErrorString(e));
#ifndef PROBE_LO
#define PROBE_LO -1
#define PROBE_HI -1
#endif
#if PROBE_LO >= 0
    (void)hipMemsetAsync(d_ws, 0, 16384, stream);
    a.ph_lo = PROBE_LO; a.ph_hi = PROBE_HI;
#ifdef PROBE_SUB
    a.probe_sub = PROBE_SUB;
#endif
    e = hipLaunchCooperativeKernel((const void*)mega_fwd, dim3(grid), dim3(NTHREADS), kargs, LDS_BYTES, stream);
    if (e != hipSuccess) fprintf(stderr, "probe launch failed: %s\n", hipGetErrorString(e));
#endif
#endif
}
```

```cpp
#include <hip/hip_runtime.h>
#include <hip/hip_cooperative_groups.h>
#include <hip/hip_bf16.h>
#include <cstdio>
#include <cstdint>
namespace cg = cooperative_groups;

#define DEVI __device__ __forceinline__
typedef unsigned short bf16_t;
typedef float f32x4 __attribute__((ext_vector_type(4)));
typedef float f32x2 __attribute__((ext_vector_type(2)));
typedef unsigned u32x4 __attribute__((ext_vector_type(4)));
typedef unsigned u32x2 __attribute__((ext_vector_type(2)));

constexpr int D = 1024, NB = 4, SEQ = 4096, CTXL = 256;
constexpr int NLAT = NB * SEQ, NCTX = NB * CTXL, NT = NLAT + NCTX;
constexpr int SKV = CTXL + SEQ;
constexpr int INC = 2712, ZP = 2816;
constexpr int ZC_QKV = 0, ZC_GATE = 1152, ZC_AQ = 1536, ZC_AK = 1920, ZC_AV = 2048, ZC_MU = 2176, ZC_MV = 2432, ZC_BETA = 2688, ZC_ALPHA = 2700;
constexpr int FF = 2816, MFF = 3584, NE = 8;
constexpr int MAXSLOT = 34816;
constexpr float EPS = 1e-6f;
constexpr float QSCALE = 0.125f * 1.4426950408889634f;

constexpr size_t MiB = 1u << 20, KiB = 1024;
constexpr size_t WS_CTL = 0;
constexpr size_t CTL_ROPE = 32 * KiB;
constexpr size_t CTL_MODV = 64 * KiB;
constexpr size_t CTL_TOPE = 320 * KiB;
constexpr size_t CTL_TOPG = 448 * KiB;
constexpr size_t CTL_CNT = 576 * KiB;
constexpr size_t CTL_SEG = 584 * KiB;
constexpr size_t CTL_TOKSLOT = 592 * KiB;
constexpr size_t CTL_UTAB = 720 * KiB;
constexpr size_t WS_XB = 4 * MiB;
constexpr size_t WS_WL = 72 * MiB;
constexpr size_t WL_WIN = 0;
constexpr size_t WL_WOUT = 11 * MiB;
constexpr size_t WL_F13 = 15 * MiB;
constexpr size_t WL_F2 = 26 * MiB;
static_assert(WL_WIN + (size_t)2 * 2816 * 1024 * 2 <= WL_WOUT && WL_WOUT + (size_t)2 * 1024 * 1024 * 2 <= WL_F13 && WL_F13 + (size_t)5632 * 1024 * 2 <= WL_F2 && WS_WL + WL_F2 + (size_t)1024 * 2816 * 2 <= 104 * MiB, "WL map");
constexpr size_t WS_H = 104 * MiB;
constexpr size_t WS_Z = 138 * MiB;
constexpr size_t WS_MIX = 232 * MiB;
constexpr size_t WS_QA = 266 * MiB;
constexpr size_t WS_QC = 278 * MiB;
constexpr size_t WS_KA = 279 * MiB;
constexpr size_t WS_VA = 284 * MiB;
constexpr size_t WS_DN = 289 * MiB;
constexpr size_t WS_QN = WS_H, WS_KN = WS_H + 13 * MiB;
constexpr size_t DN_VB = 0;
constexpr size_t DN_BG = 13 * MiB;
constexpr size_t DN_O = 15 * MiB;
constexpr size_t WS_SV = 499 * MiB;
constexpr size_t DN_OPS = 66 * MiB;
static_assert(WS_DN + DN_OPS + (size_t)3264 * 46080 <= WS_SV && WS_SV + (size_t)NT * 256 * 2 <= 512 * MiB, "ws");
constexpr size_t WS_MHID = 72 * MiB;
constexpr size_t WS_MXB = 310 * MiB;
constexpr size_t WS_M13 = 378 * MiB;
constexpr size_t WS_M2 = 378 * MiB;
constexpr size_t WS_PB = 232 * MiB;
constexpr size_t WS_YB2 = 440 * MiB;
constexpr size_t WS_END = 512 * MiB;
static_assert(WS_M13 + (size_t)8 * 7168 * 1024 * 2 <= WS_END, "ws");
static_assert(WS_MHID + (size_t)MAXSLOT * 3584 * 2 <= WS_MXB && WS_MXB + (size_t)MAXSLOT * 1024 * 2 <= WS_M13, "ws");
static_assert(WS_H + (size_t)NT * 1024 * 2 <= WS_Z && WS_Z + (size_t)NT * ZP * 2 <= WS_MIX && WS_MIX + (size_t)NT * 1024 * 2 <= WS_QA, "ws");

constexpr int LDS_BYTES = 147456;
constexpr int NTHREADS = 512, NWAVES = 8;

DEVI unsigned f2bf(float f) { unsigned u = __float_as_uint(f); return (u + 0x7fffu + ((u >> 16) & 1u)) >> 16; }
DEVI float bf2f(unsigned h) { return __uint_as_float(h << 16); }
DEVI unsigned pk2(float lo, float hi) { return f2bf(lo) | (f2bf(hi) << 16); }
DEVI float bflo(unsigned w) { return __uint_as_float(w << 16); }
DEVI float bfhi(unsigned w) { return __uint_as_float(w & 0xffff0000u); }
DEVI void unpack8(const u32x4 w, float* v) { v[0] = bflo(w.x); v[1] = bfhi(w.x); v[2] = bflo(w.y); v[3] = bfhi(w.y); v[4] = bflo(w.z); v[5] = bfhi(w.z); v[6] = bflo(w.w); v[7] = bfhi(w.w); }
DEVI u32x4 pack8(const float* v) { u32x4 w; w.x = pk2(v[0], v[1]); w.y = pk2(v[2], v[3]); w.z = pk2(v[4], v[5]); w.w = pk2(v[6], v[7]); return w; }
DEVI float wave_sum(float v) {
#pragma unroll
    for (int o = 1; o < 64; o <<= 1) v += __shfl_xor(v, o);
    return v;
}
DEVI float wave_max(float v) {
#pragma unroll
    for (int o = 1; o < 64; o <<= 1) v = fmaxf(v, __shfl_xor(v, o));
    return v;
}
DEVI float silu_f(float x) { return x * __builtin_amdgcn_rcpf(1.f + __expf(-x)); }
DEVI float gelu_f(float x) { const float u = 0.7978845608028654f * (x + 0.044715f * x * x * x); const float e = __expf(2.f * u); return x * (1.f - __builtin_amdgcn_rcpf(1.f + e)); }
DEVI float softplus_f(float x) { const float e = __expf(-fabsf(x)); const float l = e < 0.01f ? e * (1.f - e * (0.5f - e * 0.33333334f)) : __logf(1.f + e); return fmaxf(x, 0.f) + l; }
DEVI int row_mod(int r) { return r < NLAT ? (r >> 12) : 4; }

struct Args { const float* in[28]; float* out; unsigned char* ws; int ph_lo, ph_hi, probe_sub, pad; };

struct Ctx {
    const float* in[28]; float* out; unsigned char* ws;
    int tid, lane, wave, gw, ngw;
    float* lds;
    __attribute__((address_space(3))) unsigned char* lds3;
};
enum { I_X = 0, I_C, I_CTX, I_CCTX, I_MODW, I_MODB, I_N1G, I_N2G, I_WIN, I_CONVW, I_ALOG, I_DTB, I_DNG, I_QG, I_KG, I_SGUG, I_SGUW, I_SGUB, I_WOUT,
       I_F1, I_F3, I_F2, I_RW, I_RB, I_M1, I_M3, I_M2, I_FNG };

DEVI const float* modv(const Ctx& c, int layer, int r, int which) { return (const float*)(c.ws + CTL_MODV) + ((size_t)(layer * 5 + row_mod(r)) * 6 + which) * 1024; }

template <int MAP>
DEVI int map_row(int n, int add) {
    if (MAP == 1) return n < 1536 ? n : (n < 1560 ? n + 1152 : n - 24);
    if (MAP == 2) return (n >> 7) * 256 + (n & 127) + add;
    return n;
}
template <int MAP>
DEVI void transpose_tiles(const Ctx& c, const float* W, int K, int N, bf16_t* WT, int add, int& base, int wv = -1, int nwv = 0) {
    float* Ls = c.lds + c.wave * (64 * 65);
    const int ntn = (N + 63) / 64, ntiles = (K / 64) * ntn, G = wv < 0 ? c.ngw : nwv, wid = wv < 0 ? c.gw : wv;
    const int nq = c.lane & 15, kr = c.lane >> 4, cch = c.lane & 7, rn = c.lane >> 3;
    int t = (wid - base % G + G) % G;
    base += ntiles;
    f32x4 v[16];
#define TT_LOAD(tile) do { const int kb_ = (tile) / ntn, nb_ = (tile) % ntn, n_ = nb_ * 64 + 4 * nq; \
        _Pragma("unroll") for (int p_ = 0; p_ < 16; ++p_) v[p_] = n_ < N ? __builtin_nontemporal_load((const f32x4*)(W + (size_t)(kb_ * 64 + kr + 4 * p_) * N + n_)) : (f32x4){0.f, 0.f, 0.f, 0.f}; } while (0)
    if (t < ntiles) TT_LOAD(t);
    for (; t < ntiles; t += G) {
#pragma unroll
        for (int p = 0; p < 16; ++p) { float* q = Ls + (kr + 4 * p) * 65 + 4 * nq; q[0] = v[p].x; q[1] = v[p].y; q[2] = v[p].z; q[3] = v[p].w; }
        if (t + G < ntiles) TT_LOAD(t + G);
        __builtin_amdgcn_wave_barrier(); asm volatile("" ::: "memory");
        const int kb = t / ntn, nb = t % ntn;
#pragma unroll
        for (int j = 0; j < 8; ++j) { const int nl = 8 * j + rn, n = nb * 64 + nl; float x[8];
#pragma unroll
            for (int i = 0; i < 8; ++i) x[i] = Ls[(8 * cch + i) * 65 + nl];
            if (n < N) *(u32x4*)(WT + (size_t)map_row<MAP>(n, add) * K + kb * 64 + 8 * cch) = pack8(x); }
        __builtin_amdgcn_wave_barrier(); asm volatile("" ::: "memory");
    }
#undef TT_LOAD
}

DEVI void phase_prologue(const Ctx& c) {
    bf16_t* wl = (bf16_t*)(c.ws + WS_WL);
    int tb = 0;
    for (int l = 0; l < 2; ++l) {
        transpose_tiles<1>(c, c.in[I_WIN] + (size_t)l * 1024 * INC, 1024, INC, (bf16_t*)((char*)wl + WL_WIN) + (size_t)l * ZP * 1024, 0, tb);
        transpose_tiles<0>(c, c.in[I_WOUT] + (size_t)l * 1024 * 1024, 1024, 1024, (bf16_t*)((char*)wl + WL_WOUT) + (size_t)l * 1024 * 1024, 0, tb);
        u32x4* pad = (u32x4*)((bf16_t*)((char*)wl + WL_WIN) + (size_t)l * ZP * 1024 + (size_t)INC * 1024);
        for (int i = c.gw * 64 + c.lane; i < (ZP - INC) * 1024 / 8; i += c.ngw * 64) pad[i] = (u32x4){0u, 0u, 0u, 0u};
    }
    transpose_tiles<2>(c, c.in[I_F1], 1024, FF, (bf16_t*)((char*)wl + WL_F13), 0, tb);
    transpose_tiles<2>(c, c.in[I_F3], 1024, FF, (bf16_t*)((char*)wl + WL_F13), 128, tb);
    transpose_tiles<0>(c, c.in[I_F2], FF, 1024, (bf16_t*)((char*)wl + WL_F2), 0, tb);
    if (blockIdx.x == 0) for (int i = c.tid; i < 2 * 64 * 16; i += NTHREADS) { const int p = i & 15, pos = (i >> 4) & 63, ax = i >> 10;
        const float ang = (float)pos * powf(10000.f, -2.f * (float)p / 32.f); float* tp = (float*)(c.ws + CTL_ROPE) + (ax * 64 + pos) * 32; tp[p] = cosf(ang); tp[16 + p] = sinf(ang); }
    if (blockIdx.x == 0 && c.tid < 32) ((float*)(c.ws + CTL_ROPE))[128 * 32 + c.tid] = c.tid < 16 ? 1.f : 0.f;
    __syncthreads();
    {
        float* sc = c.lds;
        float* part = c.lds + 5 * 1024;
        for (int i = c.tid; i < 5 * 1024; i += NTHREADS) { const int r = i >> 10, k = i & 1023; const float v = r < 4 ? c.in[I_C][r * 1024 + k] : c.in[I_CCTX][k]; sc[i] = silu_f(v); }
        __syncthreads();
        for (int item = blockIdx.x; item < 2 * 96; item += gridDim.x) {
            const int l = item / 96, j = (item % 96) * 64 + c.lane;
            const float* w = c.in[I_MODW] + (size_t)l * 1024 * 6144 + j;
            float a0 = 0.f, a1 = 0.f, a2 = 0.f, a3 = 0.f, a4 = 0.f;
            const int kb = c.wave * 128;
#pragma unroll 4
            for (int k = 0; k < 128; ++k) { const float wv = w[(size_t)(kb + k) * 6144]; a0 += sc[kb + k] * wv; a1 += sc[1024 + kb + k] * wv; a2 += sc[2048 + kb + k] * wv; a3 += sc[3072 + kb + k] * wv; a4 += sc[4096 + kb + k] * wv; }
            float* p = part + c.wave * 320 + c.lane; p[0] = a0; p[64] = a1; p[128] = a2; p[192] = a3; p[256] = a4;
            __syncthreads();
            if (c.tid < 320) { float s = 0.f;
#pragma unroll
                for (int w8 = 0; w8 < 8; ++w8) s += part[w8 * 320 + c.tid];
                const int r = c.tid >> 6, jj = (item % 96) * 64 + (c.tid & 63);
                ((float*)(c.ws + CTL_MODV))[(size_t)(l * 5 + r) * 6144 + jj] = s + c.in[I_MODB][l * 6144 + jj]; }
            __syncthreads();
        }
    }
}

DEVI void phase_conv_m13(const Ctx& c, int wv = -1, int nwv = 0) {
    int tb = 0;
    for (int e = 0; e < NE; ++e) {
        bf16_t* dst = (bf16_t*)(c.ws + WS_M13) + (size_t)e * 7168 * 1024;
        transpose_tiles<2>(c, c.in[I_M1] + (size_t)e * 1024 * MFF, 1024, MFF, dst, 0, tb, wv, nwv);
        transpose_tiles<2>(c, c.in[I_M3] + (size_t)e * 1024 * MFF, 1024, MFF, dst, 128, tb, wv, nwv);
    }
}
DEVI void phase_conv_m2(const Ctx& c, int wv = -1, int nwv = 0) {
    int tb = 0;
    for (int e = 0; e < NE; ++e)
        transpose_tiles<0>(c, c.in[I_M2] + (size_t)e * MFF * 1024, MFF, 1024, (bf16_t*)c.out + (size_t)e * 1024 * MFF, 0, tb, wv, nwv);
}

template <bool ROUTER>
DEVI void phase_norm(const Ctx& c, int layer, int which0, const float* gain, int nrows, const float* src_lat, const float* src_ctx, const float* addp = nullptr, int rpw = 8) {
    bf16_t* H = (bf16_t*)(c.ws + WS_H);
#define NORM_ROW(rr) ((rr) < NLAT ? src_lat + (size_t)(rr) * 1024 : src_ctx + (size_t)((rr) - NLAT) * 1024)
    int* sel = (int*)c.lds;
    const int nvb = nrows / 64;
    int vb = blockIdx.x, i = 0;
    int r = ROUTER ? vb * 64 + c.wave * rpw : c.gw;
    bool valid = ROUTER ? (vb < nvb && c.wave * rpw < 64) : (r < nrows);
    f32x4 v[4];
    if (valid) { const f32x4* xr = (const f32x4*)NORM_ROW(r) + c.lane;
#pragma unroll
        for (int j = 0; j < 4; ++j) v[j] = xr[64 * j]; }
    while (valid) {
        int rn, vbn = vb, in_ = i + 1; bool validn;
        if (ROUTER) { if (in_ == rpw) { in_ = 0; vbn = vb + gridDim.x; } rn = vbn * 64 + c.wave * rpw + in_; validn = vbn < nvb; }
        else { rn = r + c.ngw; validn = rn < nrows; }
        f32x4 vn[4];
        if (validn) { const f32x4* xr = (const f32x4*)NORM_ROW(rn) + c.lane;
#pragma unroll
            for (int j = 0; j < 4; ++j) vn[j] = xr[64 * j]; }
        if (addp && r >= NLAT) { const f32x4* pr = (const f32x4*)(addp + (size_t)(r - NLAT) * 1024) + c.lane;
#pragma unroll
            for (int j = 0; j < 4; ++j) v[j] = v[j] + (pr[64 * j] + pr[64 * j + 262144] + pr[64 * j + 524288]); }
        float ss = 0.f;
#pragma unroll
        for (int j = 0; j < 4; ++j) ss += (v[j].x * v[j].x + v[j].y * v[j].y) + (v[j].z * v[j].z + v[j].w * v[j].w);
        const float rstd = rsqrtf(wave_sum(ss) * (1.f / 1024.f) + EPS);
        const f32x4* g4 = (const f32x4*)gain + c.lane; const f32x4* sh4 = (const f32x4*)modv(c, layer, r, which0) + c.lane; const f32x4* sc4 = (const f32x4*)modv(c, layer, r, which0 + 1) + c.lane;
        u32x2* o8 = (u32x2*)(H + (size_t)r * 1024) + c.lane;
#pragma unroll
        for (int j = 0; j < 4; ++j) { const f32x4 g = g4[64 * j], sh = sh4[64 * j], sc = sc4[64 * j];
            v[j] = v[j] * rstd * g * (1.f + sc) + sh;
            u32x2 o; o.x = pk2(v[j].x, v[j].y); o.y = pk2(v[j].z, v[j].w); o8[64 * j] = o; }
        if (ROUTER) {
            float lg[8];
#pragma unroll
            for (int e = 0; e < 8; ++e) lg[e] = 0.f;
            const float* rw = c.in[I_RW];
#pragma unroll
            for (int j = 0; j < 4; ++j)
#pragma unroll
                for (int q = 0; q < 4; ++q) { const int col = 4 * c.lane + 256 * j + q; const f32x4 w0 = *(const f32x4*)(rw + col * 8), w1 = *(const f32x4*)(rw + col * 8 + 4); const float hv = v[j][q];
                    lg[0] += hv * w0.x; lg[1] += hv * w0.y; lg[2] += hv * w0.z; lg[3] += hv * w0.w; lg[4] += hv * w1.x; lg[5] += hv * w1.y; lg[6] += hv * w1.z; lg[7] += hv * w1.w; }
#pragma unroll
            for (int e = 0; e < 8; ++e) lg[e] = wave_sum(lg[e]) + c.in[I_RB][e];
            int e1 = 0; float l1 = lg[0];
#pragma unroll
            for (int e = 1; e < 8; ++e) if (lg[e] > l1) { l1 = lg[e]; e1 = e; }
            int e2 = -1; float l2 = -3.0e38f;
#pragma unroll
            for (int e = 0; e < 8; ++e) if (e != e1 && lg[e] > l2) { l2 = lg[e]; e2 = e; }
            const float g2 = 1.f / (1.f + expf(l1 - l2)), g1 = 1.f - g2;
            if (c.lane == 0) { int* te = (int*)(c.ws + CTL_TOPE) + r * 2; te[0] = e1; te[1] = e2; float* tg = (float*)(c.ws + CTL_TOPG) + r * 2; tg[0] = g1; tg[1] = g2;
                sel[(c.wave * rpw + i) * 2] = e1; sel[(c.wave * rpw + i) * 2 + 1] = e2; }
            if (rpw == 8 && i == 7) {
                __syncthreads();
                if (c.tid < 8) { int n = 0; for (int q = 0; q < 128; ++q) n += (sel[q] == c.tid) ? 1 : 0; ((int*)(c.ws + CTL_CNT))[vb * 8 + c.tid] = n; }
                __syncthreads();
            }
        }
#pragma unroll
        for (int j = 0; j < 4; ++j) v[j] = vn[j];
        r = rn; vb = vbn; i = in_; valid = validn;
    }
}

#undef NORM_ROW
template <bool DUAL, class BSel, class Epi>
DEVI void gemm_naive(const Ctx& c, const bf16_t* A, int lda, int K, int ntm, int ntn, const BSel& bsel, const Epi& epi) {
    float* As = c.lds; float* Bs = c.lds + 32 * 132; float* Bs2 = c.lds + 2 * 32 * 132;
    const int ty = c.tid >> 4, tx = c.tid & 15, lr = c.tid >> 2, lk = (c.tid & 3) * 8;
    for (int tile = blockIdx.x; tile < ntm * ntn; tile += gridDim.x) {
        const int tm = tile / ntn, tn = tile % ntn;
        const bf16_t* B0 = bsel(tm, tn, 0); if (!B0) continue;
        const bf16_t* B1 = DUAL ? bsel(tm, tn, 1) : B0;
        float acc[4][8], acc2[4][8];
#pragma unroll
        for (int i = 0; i < 4; ++i)
#pragma unroll
            for (int j = 0; j < 8; ++j) { acc[i][j] = 0.f; acc2[i][j] = 0.f; }
        const bf16_t* ap = A + (size_t)(tm * 128 + lr) * lda + lk; const bf16_t* bp = B0 + (size_t)lr * K + lk; const bf16_t* bp2 = B1 + (size_t)lr * K + lk;
        for (int k0 = 0; k0 < K; k0 += 32) {
            const u32x4 av = *(const u32x4*)(ap + k0), bv = *(const u32x4*)(bp + k0); u32x4 bv2 = bv; if (DUAL) bv2 = *(const u32x4*)(bp2 + k0);
            __syncthreads();
#pragma unroll
            for (int q = 0; q < 4; ++q) { As[(lk + 2 * q) * 132 + lr] = bflo(av[q]); As[(lk + 2 * q + 1) * 132 + lr] = bfhi(av[q]);
                Bs[(lk + 2 * q) * 132 + lr] = bflo(bv[q]); Bs[(lk + 2 * q + 1) * 132 + lr] = bfhi(bv[q]);
                if (DUAL) { Bs2[(lk + 2 * q) * 132 + lr] = bflo(bv2[q]); Bs2[(lk + 2 * q + 1) * 132 + lr] = bfhi(bv2[q]); } }
            __syncthreads();
#pragma unroll 4
            for (int kk = 0; kk < 32; ++kk) {
                const f32x4 a = *(const f32x4*)(As + kk * 132 + ty * 4); const f32x4 b0 = *(const f32x4*)(Bs + kk * 132 + tx * 8), b1 = *(const f32x4*)(Bs + kk * 132 + tx * 8 + 4);
#pragma unroll
                for (int i = 0; i < 4; ++i) { acc[i][0] += a[i] * b0.x; acc[i][1] += a[i] * b0.y; acc[i][2] += a[i] * b0.z; acc[i][3] += a[i] * b0.w; acc[i][4] += a[i] * b1.x; acc[i][5] += a[i] * b1.y; acc[i][6] += a[i] * b1.z; acc[i][7] += a[i] * b1.w; }
                if (DUAL) { const f32x4 c0 = *(const f32x4*)(Bs2 + kk * 132 + tx * 8), c1 = *(const f32x4*)(Bs2 + kk * 132 + tx * 8 + 4);
#pragma unroll
                    for (int i = 0; i < 4; ++i) { acc2[i][0] += a[i] * c0.x; acc2[i][1] += a[i] * c0.y; acc2[i][2] += a[i] * c0.z; acc2[i][3] += a[i] * c0.w; acc2[i][4] += a[i] * c1.x; acc2[i][5] += a[i] * c1.y; acc2[i][6] += a[i] * c1.z; acc2[i][7] += a[i] * c1.w; } }
            }
        }
#pragma unroll
        for (int i = 0; i < 4; ++i) epi(tm * 128 + ty * 4 + i, tn * 128 + tx * 8, acc[i], acc2[i]);
    }
}
struct BSelPlain { const bf16_t* Bt; int K; DEVI const bf16_t* operator()(int, int tn, int) const { return Bt + (size_t)tn * 128 * K; } };
struct BSelDual { const bf16_t* Bt; int K; DEVI const bf16_t* operator()(int, int tn, int which) const { return Bt + (size_t)(tn * 256 + which * 128) * K; } };
struct BSelMoe { const bf16_t* Bt; int K; int rows_per_expert; bool dual; const int* seg;
    DEVI const bf16_t* operator()(int tm, int tn, int which) const {
        const int s = tm * 128; if (s >= seg[8]) return nullptr; int e = 0;
#pragma unroll
        for (int q = 1; q < 8; ++q) e += (s >= seg[q]) ? 1 : 0;
        return Bt + (size_t)e * rows_per_expert * K + (size_t)(dual ? tn * 256 + which * 128 : tn * 128) * K; } };
struct EpiStoreBf16 { bf16_t* O; int ldc; DEVI void operator()(int r, int c0, const float* a, const float*) const {
    u32x4 o; o.x = pk2(a[0], a[1]); o.y = pk2(a[2], a[3]); o.z = pk2(a[4], a[5]); o.w = pk2(a[6], a[7]); *(u32x4*)(O + (size_t)r * ldc + c0) = o; } };
struct EpiSwiglu { bf16_t* O; int ldc; DEVI void operator()(int r, int c0, const float* a, const float* b) const {
    float h[8];
#pragma unroll
    for (int j = 0; j < 8; ++j) h[j] = silu_f(a[j]) * b[j];
    u32x4 o; o.x = pk2(h[0], h[1]); o.y = pk2(h[2], h[3]); o.z = pk2(h[4], h[5]); o.w = pk2(h[6], h[7]); *(u32x4*)(O + (size_t)r * ldc + c0) = o; } };
struct EpiResid { float* XB; const float* mv; int which;
    DEVI void operator()(int r, int c0, const float* a, const float*) const {
        const float* g = mv + (size_t)(row_mod(r) * 6 + which) * 1024 + c0; float* x = XB + (size_t)r * 1024 + c0;
        f32x4 x0 = *(f32x4*)x, x1 = *(f32x4*)(x + 4); const f32x4 g0 = *(const f32x4*)g, g1 = *(const f32x4*)(g + 4);
        x0.x += g0.x * a[0]; x0.y += g0.y * a[1]; x0.z += g0.z * a[2]; x0.w += g0.w * a[3]; x1.x += g1.x * a[4]; x1.y += g1.y * a[5]; x1.z += g1.z * a[6]; x1.w += g1.w * a[7];
        *(f32x4*)x = x0; *(f32x4*)(x + 4) = x1; } };

namespace pg8 {
#define PG8_LAS __attribute__((address_space(3)))

typedef short bf16x8 __attribute__((ext_vector_type(8)));


constexpr int MOE_FF = 3584;
constexpr int BM = 256, BK = 64, HALF = 128, HTB = HALF * BK * 2  , STAGE_BYTES = 8 * HTB, NXCD = 8, WGM = 8;

__host__ __device__ __forceinline__ int lds_byte(int r, int c) { const int st = (r >> 4) * 2 + (c >> 5), rr = r & 15, cc = c & 31, ob = rr * 64 + cc * 2; return st * 1024 + (ob ^ (((ob >> 9) & 1) << 5)); }
__host__ __device__ __forceinline__ void stage_rc(int b, int& R, int& C) { const int st = b / 1024, sb = b % 1024, swz = sb ^ (((sb >> 9) & 1) << 5); R = (st >> 1) * 16 + swz / 64; C = (st & 1) * 32 + (swz % 64) / 2; }
__host__ __device__ __forceinline__ int perm32(int rho) { const int n = rho >> 4, i = rho & 15; return 8 * (i >> 2) + 4 * n + (i & 3); }

struct Unit { int pm, pn, ko, nt; };
struct Gemm { const bf16_t* A; const bf16_t* Bt; int M, N, K; };

struct StaticOrder {
    int nM, nN, nwg, G, c;
    __host__ __device__ void init(int M, int N, int G_, int c_) { nM = M / BM; nN = N / BM; nwg = nM * nN; G = G_; c = c_; }
    __host__ __device__ bool next(int i, Unit& u) const {
        const long L = (long)i * G + c; if (L >= nwg) return false;
        int wgid = (int)L; { const int q = nwg / NXCD, r = nwg % NXCD, xcd = wgid % NXCD, off = wgid / NXCD; wgid = (xcd < r ? xcd * (q + 1) : r * (q + 1) + (xcd - r) * q) + off; }
        const int nig = WGM * nN, gid = wgid / nig, fm = gid * WGM, gsz = (nM - fm) < WGM ? (nM - fm) : WGM;
        u.pm = fm + ((wgid % nig) % gsz); u.pn = (wgid % nig) / gsz; u.ko = 0; u.nt = 0; return true;
    }
    __device__ __forceinline__ void a_ready(const Unit&) const {}
    __device__ __forceinline__ void done(const Unit&) const {}
};


__device__ __forceinline__ unsigned cvt_pk_bf16(float lo, float hi) { unsigned r; asm volatile("v_cvt_pk_bf16_f32 %0, %1, %2" : "=v"(r) : "v"(lo), "v"(hi)); return r; }
__device__ __forceinline__ float silu1(float x) { return x * __builtin_amdgcn_rcpf(1.f + __expf(-x)); }
struct EpiStore {
    static constexpr bool PERM = true, AFTER_DRAIN = false;
    bf16_t* O; int ldc; int nN; long d2;
    __device__ __forceinline__ void operator()(const f32x4 (&acc)[2][2][4][2], const Unit& u, int wr, int wc, int fr, int fq) const {
        const int row0 = u.pm * BM + wr * 64 + fr, pnl = nN ? u.pn % nN : u.pn, col0 = pnl * BM + wc * 32 + 8 * fq;
        bf16_t* Ob = O + (u.ko ? d2 + (long)(u.ko / 896 - 1) * (2048l * 1024) : 0l);
#pragma unroll
        for (int ai = 0; ai < 2; ++ai)
#pragma unroll
            for (int m = 0; m < 4; ++m) { bf16_t* rowp = Ob + (size_t)(row0 + ai * HALF + m * 16) * ldc + col0;
#pragma unroll
                for (int bj = 0; bj < 2; ++bj) { const f32x4 v0 = acc[ai][bj][m][0], v1 = acc[ai][bj][m][1];
                    u32x4 w; w.x = cvt_pk_bf16(v0[0], v0[1]); w.y = cvt_pk_bf16(v0[2], v0[3]); w.z = cvt_pk_bf16(v1[0], v1[1]); w.w = cvt_pk_bf16(v1[2], v1[3]);
                    *(u32x4*)(rowp + bj * HALF) = w; } }
    }
};
struct EpiSwi {
    static constexpr bool PERM = true, AFTER_DRAIN = false;
    bf16_t* O; int ldc; int nN;
    __device__ __forceinline__ void operator()(const f32x4 (&acc)[2][2][4][2], const Unit& u, int wr, int wc, int fr, int fq) const {
        const int row0 = u.pm * BM + wr * 64 + fr, pnl = nN ? u.pn % nN : u.pn, col0 = pnl * HALF + wc * 32 + 8 * fq;
#pragma unroll
        for (int ai = 0; ai < 2; ++ai)
#pragma unroll
            for (int m = 0; m < 4; ++m) { bf16_t* rowp = O + (size_t)(row0 + ai * HALF + m * 16) * ldc + col0;
                const f32x4 a0 = acc[ai][0][m][0], a1 = acc[ai][0][m][1], b0 = acc[ai][1][m][0], b1 = acc[ai][1][m][1];
                u32x4 w; w.x = cvt_pk_bf16(silu1(a0[0]) * b0[0], silu1(a0[1]) * b0[1]); w.y = cvt_pk_bf16(silu1(a0[2]) * b0[2], silu1(a0[3]) * b0[3]);
                w.z = cvt_pk_bf16(silu1(a1[0]) * b1[0], silu1(a1[1]) * b1[1]); w.w = cvt_pk_bf16(silu1(a1[2]) * b1[2], silu1(a1[3]) * b1[3]);
                *(u32x4*)rowp = w; }
    }
};
struct EpiRes {
    static constexpr bool PERM = false, AFTER_DRAIN = false;
    float* XB; const float* mv; int which; const float* base_lat; const float* base_ctx;
    float* PB;
    __device__ __forceinline__ void operator()(const f32x4 (&acc)[2][2][4][2], const Unit& u, int wr, int wc, int fr, int fq) const {
        const int row0 = u.pm * BM + wr * 64 + fr, col0 = u.pn * BM + wc * 32 + 4 * fq;
        float* PBp = PB + (size_t)((u.ko >= 1536 ? 1 : 0) + (u.ko >= 2176 ? 1 : 0)) * (1024 * 1024);
#pragma unroll
        for (int ai = 0; ai < 2; ++ai)
#pragma unroll
            for (int m = 0; m < 4; ++m) { const int r = row0 + ai * HALF + m * 16; const float* g = mv + (size_t)((r < 16384 ? (r >> 12) : 4) * 6 + which) * 1024 + col0; float* x = XB + (size_t)r * 1024 + col0;
                const float* bs = (r < 16384 ? base_lat + (size_t)r * 1024 : base_ctx + (size_t)(r - 16384) * 1024) + col0;
#pragma unroll
                for (int bj = 0; bj < 2; ++bj)
#pragma unroll
                    for (int n = 0; n < 2; ++n) { const int o = bj * HALF + n * 16; const f32x4 gv = *(const f32x4*)(g + o);
                        if (u.ko) *(f32x4*)(PBp + (size_t)(r - 16384) * 1024 + col0 + o) = gv * acc[ai][bj][m][n];
                        else { f32x4 xv = *(const f32x4*)(bs + o); xv = xv + gv * acc[ai][bj][m][n]; *(f32x4*)(x + o) = xv; } } }
    }
};
struct FfnDownOrder {
    StaticOrder so;
    __device__ __forceinline__ void init(int G_, int c_) { so.init(16384, 1024, G_, c_); }
    __device__ __forceinline__ bool next(int i, Unit& u) const {
        if (so.next(i, u)) return true;
        const long L = (long)i * so.G + so.c - so.nwg; if (L < 0 || L >= 64) return false;
        const int l = (int)L, q = (l & 7) + 8 * (l >> 5), p = q & 3;
        u.pm = 64 + (q >> 2); u.pn = (l >> 3) & 3; u.ko = (p * 12 - (p == 3 ? 2 : 0)) * 64; u.nt = p < 2 ? 12 : 10; return true; }
    __device__ __forceinline__ void a_ready(const Unit&) const {}
    __device__ __forceinline__ void done(const Unit&) const {}
};
struct MoeOrder {
    StaticOrder so; int nN; int sg[9];
    __device__ __forceinline__ void init(const int* seg, int nN_, int G_, int c_) {
#pragma unroll
        for (int i = 0; i < 9; ++i) sg[i] = seg[i];
        nN = nN_; so.nM = sg[8] >> 8; so.nN = nN_; so.nwg = so.nM * nN_; so.G = G_; so.c = c_; }
    __device__ __forceinline__ bool next(int i, Unit& u) const {
        if (!so.next(i, u)) return false;
        const int s = u.pm * 256; int e = 0;
#pragma unroll
        for (int q = 1; q < 8; ++q) e += (s >= sg[q]) ? 1 : 0;
        u.pn += e * nN; return true; }
    __device__ __forceinline__ void a_ready(const Unit&) const {}
    __device__ __forceinline__ void done(const Unit&) const {}
};
struct TableOrder {
    const int* tab; int n, G, vc;
    __device__ __forceinline__ void init(const int* tab_, int G_, int c_) { tab = tab_ + 4; n = tab_[0]; G = G_; vc = (G_ % 8 == 0) ? (c_ % 8) * (G_ / 8) + c_ / 8 : c_; }
    __device__ __forceinline__ bool next(int i, Unit& u) const { const int L = i * G + vc; if (L >= n) return false; const int* t = tab + 4 * L; u.pm = t[0]; u.pn = t[1]; u.ko = t[2]; u.nt = t[3]; return true; }
    __device__ __forceinline__ void a_ready(const Unit&) const {}
    __device__ __forceinline__ void done(const Unit&) const {}
};
template <class Epi, class Sched, bool ALIGN_EPI = false, bool SP2 = false>
__device__ __forceinline__ void gemm_phase(PG8_LAS unsigned char* lds, const Gemm g, const Sched& S, const Epi& E) {
    const int tid = threadIdx.x, wid = __builtin_amdgcn_readfirstlane(tid >> 6), lane = tid & 63, wr = wid >> 2, wc = wid & 3, fr = lane & 15, fq = lane >> 4;
    const int K = g.K; int nt = K / BK;
    unsigned voffA[2], voffB[2];
#pragma unroll
    for (int i = 0; i < 2; ++i) { int R, C; stage_rc(tid * 16 + i * 8192, R, C); const int Rb = Epi::PERM ? ((R & ~31) + perm32(R & 31)) : R;
        voffA[i] = (unsigned)(R * K + C) * 2u; voffB[i] = (unsigned)(Rb * K + C) * 2u; }
    const size_t kstep = (size_t)(BK * 2);
    const size_t hstep = (size_t)HALF * K * 2;
    const size_t tstep = 2 * hstep;
    const unsigned ldsw = (unsigned)wid * 1024u;
    const int aoff = lds_byte(wr * 64 + fr, fq * 8), boff = lds_byte(wc * 32 + fr, fq * 8);
#define PG8_SA(b, h) (((b) * 2 + (h)) * HTB)
#define PG8_SB(b, h) ((4 + (b) * 2 + (h)) * HTB)
#define PG8_STAGE(bufoff, gbase, voff) do { _Pragma("unroll") for (int _i = 0; _i < 2; ++_i) \
        __builtin_amdgcn_global_load_lds((const unsigned*)((const char*)(gbase) + (voff)[_i]), (PG8_LAS unsigned*)(lds + (bufoff) + ldsw + _i * 8192), 16, 0, 0); } while (0)
#define PG8_LDA(dst, b, h) do { _Pragma("unroll") for (int m = 0; m < 4; ++m) _Pragma("unroll") for (int k = 0; k < 2; ++k) dst[m][k] = *(const PG8_LAS bf16x8*)(lds + PG8_SA(b, h) + aoff + m * 2048 + k * 1024); } while (0)
#define PG8_LDB(dst, b, h) do { _Pragma("unroll") for (int n = 0; n < 2; ++n) _Pragma("unroll") for (int k = 0; k < 2; ++k) dst[n][k] = *(const PG8_LAS bf16x8*)(lds + PG8_SB(b, h) + boff + n * 2048 + k * 1024); } while (0)
#define PG8_MMA(ai, bj, At, Bt) do { __builtin_amdgcn_s_setprio(1); _Pragma("unroll") for (int m = 0; m < 4; ++m) _Pragma("unroll") for (int n = 0; n < 2; ++n) _Pragma("unroll") for (int k = 0; k < 2; ++k) \
        acc[ai][bj][m][n] = __builtin_amdgcn_mfma_f32_16x16x32_bf16(Bt[n][k], At[m][k], acc[ai][bj][m][n], 0, 0, 0); __builtin_amdgcn_s_setprio(0); } while (0)
#define PG8_WAIT_V(n) asm volatile("s_waitcnt vmcnt(" #n ")" ::: "memory")
#define PG8_WAIT_L(n) asm volatile("s_waitcnt lgkmcnt(" #n ")" ::: "memory")
#define PG8_BAR __builtin_amdgcn_s_barrier()
#define PG8_SCHED __builtin_amdgcn_sched_barrier(0)
    Unit cur, nxt; int ui = 0;
    if (!S.next(0, cur)) return;
    if (cur.nt) nt = cur.nt;
    f32x4 acc[2][2][4][2];
#pragma unroll
    for (int a = 0; a < 2; ++a)
#pragma unroll
        for (int b = 0; b < 2; ++b)
#pragma unroll
            for (int m = 0; m < 4; ++m)
#pragma unroll
                for (int n = 0; n < 2; ++n) acc[a][b][m][n] = (f32x4){0.f, 0.f, 0.f, 0.f};
    bf16x8 At[4][2], B0[2][2], B1[2][2];
    const char* cA = (const char*)g.A + (size_t)cur.pm * tstep + (size_t)cur.ko * 2; const char* cB = (const char*)g.Bt + (size_t)cur.pn * tstep + (size_t)cur.ko * 2;
    S.a_ready(cur);
    if constexpr (SP2) {
        PG8_STAGE(PG8_SB(0, 0), cB, voffB); PG8_STAGE(PG8_SB(0, 1), cB + hstep, voffB); PG8_STAGE(PG8_SA(0, 0), cA, voffA); PG8_STAGE(PG8_SA(0, 1), cA + hstep, voffA);
        if (wr == 1) PG8_BAR;
        PG8_WAIT_V(2); PG8_BAR;
        PG8_STAGE(PG8_SB(1, 0), cB + kstep, voffB); PG8_STAGE(PG8_SA(1, 0), cA + kstep, voffA); PG8_STAGE(PG8_SB(1, 1), cB + hstep + kstep, voffB);
        PG8_WAIT_V(6); PG8_BAR;
    } else {
        PG8_STAGE(PG8_SB(0, 0), cB, voffB); PG8_STAGE(PG8_SA(0, 0), cA, voffA); PG8_STAGE(PG8_SB(0, 1), cB + hstep, voffB); PG8_STAGE(PG8_SA(0, 1), cA + hstep, voffA);
        if (wr == 1) PG8_BAR;
        PG8_WAIT_V(4); PG8_BAR;
        PG8_STAGE(PG8_SB(1, 0), cB + kstep, voffB); PG8_STAGE(PG8_SA(1, 0), cA + kstep, voffA); PG8_STAGE(PG8_SB(1, 1), cB + hstep + kstep, voffB);
        PG8_WAIT_V(6); PG8_BAR;
    }
    for (;;) {
        const bool has_next = S.next(ui + 1, nxt);
        const char* nA = has_next ? (const char*)g.A + (size_t)nxt.pm * tstep + (size_t)nxt.ko * 2 : cA; const char* nB = has_next ? (const char*)g.Bt + (size_t)nxt.pn * tstep + (size_t)nxt.ko * 2 : cB;
        for (int t = 0; t < nt; t += 2) {
            const bool last = (t == nt - 2);
            const char* a1 = cA + (size_t)(t + 1) * kstep;
            const char* a2 = last ? nA : cA + (size_t)(t + 2) * kstep; const char* b2 = last ? nB : cB + (size_t)(t + 2) * kstep;
            const char* a3 = a2 + kstep; const char* b3 = b2 + kstep;
            if (last && has_next) S.a_ready(nxt);
            if constexpr (SP2) {
            PG8_LDB(B0, 0, 0); PG8_LDB(B1, 0, 1); PG8_SCHED; PG8_LDA(At, 0, 0); PG8_STAGE(PG8_SA(1, 1), a1 + hstep, voffA);
            PG8_WAIT_V(8); PG8_WAIT_L(0); PG8_BAR; PG8_MMA(0, 0, At, B0); PG8_MMA(0, 1, At, B1); PG8_BAR; PG8_SCHED;
            PG8_LDA(At, 0, 1); PG8_STAGE(PG8_SB(0, 0), b2, voffB); PG8_STAGE(PG8_SB(0, 1), b2 + hstep, voffB); PG8_STAGE(PG8_SA(0, 0), a2, voffA);
            PG8_WAIT_V(8); PG8_WAIT_L(0); PG8_BAR; PG8_MMA(1, 0, At, B0); PG8_MMA(1, 1, At, B1); PG8_BAR; PG8_SCHED;
            PG8_LDB(B0, 1, 0); PG8_LDB(B1, 1, 1); PG8_SCHED; PG8_LDA(At, 1, 0); PG8_STAGE(PG8_SA(0, 1), a2 + hstep, voffA);
            PG8_WAIT_V(8); PG8_WAIT_L(0); PG8_BAR; PG8_MMA(0, 0, At, B0); PG8_MMA(0, 1, At, B1); PG8_BAR; PG8_SCHED;
            PG8_LDA(At, 1, 1); PG8_STAGE(PG8_SB(1, 0), b3, voffB); PG8_STAGE(PG8_SB(1, 1), b3 + hstep, voffB); PG8_STAGE(PG8_SA(1, 0), a3, voffA);
            PG8_WAIT_V(8); PG8_WAIT_L(0); PG8_BAR; PG8_MMA(1, 0, At, B0); PG8_MMA(1, 1, At, B1); PG8_BAR; PG8_SCHED;
            } else {
            PG8_LDB(B0, 0, 0); PG8_SCHED; PG8_LDA(At, 0, 0); PG8_STAGE(PG8_SA(1, 1), a1 + hstep, voffA);
            PG8_WAIT_L(8); PG8_BAR; PG8_WAIT_L(0); PG8_MMA(0, 0, At, B0); PG8_BAR; PG8_SCHED;
            PG8_LDB(B1, 0, 1); PG8_STAGE(PG8_SB(0, 0), b2, voffB);
            PG8_BAR; PG8_WAIT_L(0); PG8_MMA(0, 1, At, B1); PG8_BAR;
            PG8_LDA(At, 0, 1); PG8_STAGE(PG8_SA(0, 0), a2, voffA);
            PG8_BAR; PG8_WAIT_L(0); PG8_MMA(1, 0, At, B0); PG8_BAR; PG8_SCHED;
            PG8_STAGE(PG8_SB(0, 1), b2 + hstep, voffB);
            PG8_WAIT_V(6); PG8_BAR; PG8_MMA(1, 1, At, B1); PG8_BAR;
            PG8_LDB(B0, 1, 0); PG8_SCHED; PG8_LDA(At, 1, 0); PG8_STAGE(PG8_SA(0, 1), a2 + hstep, voffA);
            PG8_WAIT_L(8); PG8_BAR; PG8_WAIT_L(0); PG8_MMA(0, 0, At, B0); PG8_BAR; PG8_SCHED;
            PG8_LDB(B1, 1, 1); PG8_STAGE(PG8_SB(1, 0), b3, voffB);
            PG8_BAR; PG8_WAIT_L(0); PG8_MMA(0, 1, At, B1); PG8_BAR;
            PG8_LDA(At, 1, 1); PG8_STAGE(PG8_SA(1, 0), a3, voffA);
            PG8_BAR; PG8_WAIT_L(0); PG8_MMA(1, 0, At, B0); PG8_BAR; PG8_SCHED;
            PG8_STAGE(PG8_SB(1, 1), b3 + hstep, voffB);
            PG8_WAIT_V(6); PG8_BAR; PG8_MMA(1, 1, At, B1); PG8_BAR;
            }
        }
        if constexpr (ALIGN_EPI) { if (wr == 0) PG8_BAR; }
        if constexpr (!Epi::AFTER_DRAIN) { E(acc, cur, wr, wc, fr, fq); S.done(cur); }
        if (!has_next) break;
#pragma unroll
        for (int a = 0; a < 2; ++a)
#pragma unroll
            for (int b = 0; b < 2; ++b)
#pragma unroll
                for (int m = 0; m < 4; ++m)
#pragma unroll
                    for (int n = 0; n < 2; ++n) acc[a][b][m][n] = (f32x4){0.f, 0.f, 0.f, 0.f};
        cur = nxt; cA = nA; cB = nB; ++ui; nt = cur.nt ? cur.nt : K / BK;
        if constexpr (ALIGN_EPI) { if (wr == 1) PG8_BAR; }
    }
    PG8_WAIT_V(0);
    if constexpr (!ALIGN_EPI) { if (wr == 0) PG8_BAR; }
    PG8_BAR;
    if constexpr (Epi::AFTER_DRAIN) { E.fused(acc, cur, wr, wc, fr, fq, lds, wid, lane); S.done(cur); }
#undef PG8_SA
#undef PG8_SB
#undef PG8_STAGE
#undef PG8_LDA
#undef PG8_LDB
#undef PG8_MMA
#undef PG8_WAIT_V
#undef PG8_WAIT_L
#undef PG8_BAR
#undef PG8_SCHED
}
}

DEVI void row_seq(int r, int& t, int& len) { if (r < NLAT) { t = r & 4095; len = SEQ; } else { t = (r - NLAT) & 255; len = CTXL; } }

#define DPP_F(v, ctrl) __int_as_float(__builtin_amdgcn_update_dpp(0, __float_as_int(v), (ctrl), 0xF, 0xF, true))
DEVI float sum8lanes(float x) { x += DPP_F(x, 0xB1); x += DPP_F(x, 0x4E); x += DPP_F(x, 0x141); return x; }

DEVI void phase_prep(const Ctx& c, int layer, bool need_ctx_q) {
    const bf16_t* Z = (const bf16_t*)(c.ws + WS_Z);
    {
        bf16_t* QN = (bf16_t*)(c.ws + WS_QN); bf16_t* KN = (bf16_t*)(c.ws + WS_KN); bf16_t* VB = (bf16_t*)(c.ws + WS_DN + DN_VB); float* bg = (float*)(c.ws + WS_DN + DN_BG);
        const float* cw = c.in[I_CONVW] + (size_t)layer * 3 * 1152;
        const int lc = c.lane < 48 ? c.lane : 47;
        float w[3][3][8];
#pragma unroll
        for (int th = 0; th < 3; ++th)
#pragma unroll
            for (int tap = 0; tap < 3; ++tap) { const float* wp = cw + tap * 1152 + th * 384 + lc * 8; *(f32x4*)w[th][tap] = *(const f32x4*)wp; *(f32x4*)(w[th][tap] + 4) = *(const f32x4*)(wp + 4); }
        const int dh = c.lane - 48; float alog = 0.f, dtb = 0.f;
        if (c.lane >= 48 && c.lane < 60) { alog = -expf(c.in[I_ALOG][layer * 12 + dh]); dtb = c.in[I_DTB][layer * 12 + dh]; }
        for (int r = c.gw; r < NT; r += c.ngw) {
            int t, len; row_seq(r, t, len);
            const bf16_t* zr = Z + (size_t)r * ZP + lc * 8; const bool hm = t > 0, hp = t < len - 1;
            u32x4 zc[3], zm[3], zp[3];
#pragma unroll
            for (int th = 0; th < 3; ++th) { zc[th] = *(const u32x4*)(zr + th * 384); zm[th] = hm ? *(const u32x4*)(zr + th * 384 - ZP) : (u32x4){0u, 0u, 0u, 0u}; zp[th] = hp ? *(const u32x4*)(zr + th * 384 + ZP) : (u32x4){0u, 0u, 0u, 0u}; }
            float zb = 0.f, za = 0.f;
            if (c.lane >= 48 && c.lane < 60) { zb = bf2f(Z[(size_t)r * ZP + ZC_BETA + dh]); za = bf2f(Z[(size_t)r * ZP + ZC_ALPHA + dh]); }
            u32x4 outw[3];
#pragma unroll
            for (int th = 0; th < 3; ++th) {
                float a[8], b[8], d[8], v[8]; unpack8(zm[th], a); unpack8(zc[th], b); unpack8(zp[th], d);
                float ss = 0.f;
#pragma unroll
                for (int e = 0; e < 8; ++e) { v[e] = silu_f(a[e] * w[th][0][e] + b[e] * w[th][1][e] + d[e] * w[th][2][e]); ss += v[e] * v[e]; }
                if (th < 2) { ss = sum8lanes(ss); const float sc = rsqrtf(ss + EPS) * (th == 0 ? 0.125f : 1.f);
#pragma unroll
                    for (int e = 0; e < 8; ++e) v[e] *= sc; }
                outw[th] = pack8(v);
            }
            if (c.lane < 48) { *(u32x4*)(QN + (size_t)r * 384 + c.lane * 8) = outw[0]; *(u32x4*)(KN + (size_t)r * 384 + c.lane * 8) = outw[1]; *(u32x4*)(VB + (size_t)r * 384 + c.lane * 8) = outw[2]; }
            else if (c.lane < 60) { bg[((size_t)r * 12 + dh) * 2] = __builtin_amdgcn_rcpf(1.f + __expf(-zb)); bg[((size_t)r * 12 + dh) * 2 + 1] = alog * softplus_f(za + dtb); }
        }
    }
    {
        bf16_t* Qa = (bf16_t*)(c.ws + WS_QA); bf16_t* Qc = (bf16_t*)(c.ws + WS_QC); bf16_t* Ka = (bf16_t*)(c.ws + WS_KA); bf16_t* Va = (bf16_t*)(c.ws + WS_VA);
        const float* rope = (const float*)(c.ws + CTL_ROPE);
        const bool isq = c.lane < 48; const int j = c.lane & 7, axis = j >> 2, half = (j >> 1) & 1, p0 = 8 * (j & 1);
        const int col = isq ? ZC_AQ + c.lane * 8 : ZC_AK + (c.lane - 48) * 8;
        float gn[8];
        { const float* gp = (isq ? c.in[I_QG] : c.in[I_KG]) + layer * 64 + 8 * j; *(f32x4*)gn = *(const f32x4*)gp; *(f32x4*)(gn + 4) = *(const f32x4*)(gp + 4); }
        const float qs = isq ? QSCALE : 1.f;
        for (int r0 = c.gw; r0 < NT; r0 += 2 * c.ngw) {
            int rr[2]; bool ok[2]; rr[0] = r0; ok[0] = true; rr[1] = r0 + c.ngw; ok[1] = rr[1] < NT; if (!ok[1]) rr[1] = r0;
            u32x4 zq[2], zv[2]; const float* tp[2];
#pragma unroll
            for (int q = 0; q < 2; ++q) { const int r = rr[q]; zq[q] = *(const u32x4*)(Z + (size_t)r * ZP + col); zv[q] = *(const u32x4*)(Z + (size_t)r * ZP + ZC_AV + (c.lane & 15) * 8);
                const int t = r & 4095; tp[q] = rope + (r < NLAT ? (axis * 64 + (axis == 0 ? (t >> 6) : (t & 63))) * 32 : 128 * 32) + p0; }
#pragma unroll
            for (int q = 0; q < 2; ++q) { const int r = rr[q]; const bool lat = r < NLAT; const int b = lat ? (r >> 12) : ((r - NLAT) >> 8), pos = lat ? CTXL + (r & 4095) : ((r - NLAT) & 255);
                float v[8]; unpack8(zq[q], v);
                float ss = 0.f;
#pragma unroll
                for (int e = 0; e < 8; ++e) ss += v[e] * v[e];
                ss = sum8lanes(ss); const float sc = rsqrtf(ss * (1.f / 64.f) + EPS);
                float cs[8], sn[8]; *(f32x4*)cs = *(const f32x4*)tp[q]; *(f32x4*)(cs + 4) = *(const f32x4*)(tp[q] + 4); *(f32x4*)sn = *(const f32x4*)(tp[q] + 16); *(f32x4*)(sn + 4) = *(const f32x4*)(tp[q] + 20);
#pragma unroll
                for (int e = 0; e < 8; ++e) { v[e] *= sc * gn[e]; const float o = DPP_F(v[e], 0x4E); v[e] = (half == 0 ? v[e] * cs[e] - o * sn[e] : o * sn[e] + v[e] * cs[e]) * qs; }
                const u32x4 w = pack8(v);
                if (ok[q]) {
                    if (isq) { if (lat) *(u32x4*)(Qa + (size_t)r * 384 + c.lane * 8) = w; else if (need_ctx_q) *(u32x4*)(Qc + (size_t)(r - NLAT) * 384 + c.lane * 8) = w; }
                    else *(u32x4*)(Ka + ((size_t)b * SKV + pos) * 128 + (c.lane - 48) * 8) = w;
                    if (c.lane < 16) *(u32x4*)(Va + ((size_t)b * SKV + pos) * 128 + c.lane * 8) = zv[q];
                } }
        }
    }
    {
        bf16_t* SV = (bf16_t*)(c.ws + WS_SV); const int l32 = c.lane & 31;
        float gn[8]; { const float* gp = c.in[I_SGUG] + layer * 256 + l32 * 8; *(f32x4*)gn = *(const f32x4*)gp; *(f32x4*)(gn + 4) = *(const f32x4*)(gp + 4); }
        const int nr = need_ctx_q ? NT : NLAT;
        for (int it = c.gw; it < nr / 2; it += c.ngw) {
            const int r = it * 2 + (c.lane >> 5);
            float v[8]; unpack8(*(const u32x4*)(Z + (size_t)r * ZP + ZC_MV + l32 * 8), v);
            float ss = 0.f;
#pragma unroll
            for (int e = 0; e < 8; ++e) { v[e] = gelu_f(v[e]); ss += v[e] * v[e]; }
            ss = sum8lanes(ss); const float sc = rsqrtf(ss * (1.f / 64.f) + EPS);
#pragma unroll
            for (int e = 0; e < 8; ++e) v[e] *= sc * gn[e];
            *(u32x4*)(SV + (size_t)r * 256 + l32 * 8) = pack8(v);
        }
    }
}
DEVI void phase_dnscan_naive(const Ctx& c) {
    const bf16_t* QN = (const bf16_t*)(c.ws + WS_QN); const bf16_t* KN = (const bf16_t*)(c.ws + WS_KN); const bf16_t* VB = (const bf16_t*)(c.ws + WS_DN + DN_VB);
    const float* BG = (const float*)(c.ws + WS_DN + DN_BG); float* OD = (float*)(c.ws + WS_DN + DN_O);
    float* kqv = c.lds; float* part = c.lds + 256; float* part2 = c.lds + 256 + 512;
    const int e = c.tid & 63, dg = c.tid >> 6;
    for (int seq = blockIdx.x; seq < 48; seq += gridDim.x) {
        const int b = seq / 12, h = (seq >> 1) % 6, dir = seq & 1;
        float S[8];
#pragma unroll
        for (int i = 0; i < 8; ++i) S[i] = 0.f;
        for (int step = 0; step < SKV; ++step) {
            int row;
            if (step < CTXL) { const int t = dir ? CTXL - 1 - step : step; row = NLAT + b * CTXL + t; }
            else { const int u = step - CTXL; const int t = dir ? SEQ - 1 - u : u; row = b * SEQ + t; }
            if (c.wave == 0) kqv[e] = bf2f(KN[(size_t)row * 384 + h * 64 + e]);
            else if (c.wave == 1) kqv[64 + e] = bf2f(QN[(size_t)row * 384 + h * 64 + e]);
            else if (c.wave == 2) kqv[128 + e] = bf2f(VB[(size_t)row * 384 + h * 64 + e]);
            else if (c.wave == 3 && e < 2) { const float v = BG[((size_t)row * 12 + dir * 6 + h) * 2 + e]; kqv[192 + e] = e == 0 ? v : __expf(v); }
            __syncthreads();
            const float a = kqv[193], beta = kqv[192];
            float kd[8], p = 0.f;
#pragma unroll
            for (int i = 0; i < 8; ++i) { kd[i] = kqv[dg * 8 + i]; S[i] *= a; p += S[i] * kd[i]; }
            part[dg * 64 + e] = p;
            __syncthreads();
            float rr = kqv[128 + e];
#pragma unroll
            for (int w = 0; w < 8; ++w) rr -= part[w * 64 + e];
            rr *= beta; float po = 0.f;
#pragma unroll
            for (int i = 0; i < 8; ++i) { S[i] += kd[i] * rr; po += S[i] * kqv[64 + dg * 8 + i]; }
            part2[dg * 64 + e] = po;
            __syncthreads();
            if (dg == 0) { float o = 0.f;
#pragma unroll
                for (int w = 0; w < 8; ++w) o += part2[w * 64 + e];
                OD[((size_t)dir * NT + row) * 384 + h * 64 + e] = o; }
        }
        __syncthreads();
    }
}

DEVI void phase_dnfinish(const Ctx& c, int layer, int nrows) {
    const float* OD = (const float*)(c.ws + WS_DN + DN_O); const bf16_t* Z = (const bf16_t*)(c.ws + WS_Z); bf16_t* MIX = (bf16_t*)(c.ws + WS_MIX);
    float gn[8]; { const float* gp = c.in[I_DNG] + layer * 64 + 8 * (c.lane & 7); *(f32x4*)gn = *(const f32x4*)gp; *(f32x4*)(gn + 4) = *(const f32x4*)(gp + 4); }
    if (c.lane < 48) for (int r = c.gw; r < nrows; r += c.ngw) {
        const float* o0 = OD + (size_t)r * 384 + c.lane * 8; const float* o1 = o0 + (size_t)NT * 384;
        float v[8], g[8]; *(f32x4*)v = *(const f32x4*)o0 + *(const f32x4*)o1; *(f32x4*)(v + 4) = *(const f32x4*)(o0 + 4) + *(const f32x4*)(o1 + 4);
        unpack8(*(const u32x4*)(Z + (size_t)r * ZP + ZC_GATE + c.lane * 8), g);
        float ss = 0.f;
#pragma unroll
        for (int e = 0; e < 8; ++e) ss += v[e] * v[e];
        ss = sum8lanes(ss); const float sc = rsqrtf(ss * (1.f / 64.f) + EPS);
#pragma unroll
        for (int e = 0; e < 8; ++e) v[e] = v[e] * sc * gn[e] * silu_f(g[e]);
        *(u32x4*)(MIX + (size_t)r * 1024 + c.lane * 8) = pack8(v);
    }
}

DEVI void phase_attn_naive(const Ctx& c, bool with_ctx) {
    const bf16_t* Qa = (const bf16_t*)(c.ws + WS_QA); const bf16_t* Qc = (const bf16_t*)(c.ws + WS_QC); const bf16_t* Ka = (const bf16_t*)(c.ws + WS_KA); const bf16_t* Va = (const bf16_t*)(c.ws + WS_VA);
    bf16_t* MIX = (bf16_t*)(c.ws + WS_MIX);
    const int nitems = NLAT * 6 + (with_ctx ? NCTX * 6 : 0);
    for (int it = c.gw; it < nitems; it += c.ngw) {
        int b, hq, nkeys, orow; const bf16_t* qp;
        if (it < NLAT * 6) { const int r = it / 6; hq = it % 6; b = r >> 12; qp = Qa + (size_t)r * 384 + hq * 64; nkeys = SKV; orow = r; }
        else { const int q = it - NLAT * 6, rc = q / 6; hq = q % 6; b = rc >> 8; qp = Qc + (size_t)rc * 384 + hq * 64; nkeys = CTXL; orow = NLAT + rc; }
        const int kvh = hq / 3; const bf16_t* Kp = Ka + (size_t)b * SKV * 128 + kvh * 64; const bf16_t* Vp = Va + (size_t)b * SKV * 128 + kvh * 64;
        u32x4 qv[8];
#pragma unroll
        for (int i = 0; i < 8; ++i) qv[i] = *(const u32x4*)(qp + i * 8);
        float m = -1e30f, l = 0.f, acc = 0.f;
        for (int t0 = 0; t0 < nkeys; t0 += 64) {
            const bf16_t* kp = Kp + (size_t)(t0 + c.lane) * 128; float s = 0.f;
#pragma unroll
            for (int i = 0; i < 8; ++i) { const u32x4 kv = *(const u32x4*)(kp + i * 8);
#pragma unroll
                for (int q = 0; q < 4; ++q) s += bflo(kv[q]) * bflo(qv[i][q]) + bfhi(kv[q]) * bfhi(qv[i][q]); }
            const float mn = fmaxf(m, wave_max(s)); const float alpha = exp2f(m - mn); const float p = exp2f(s - mn);
            l = l * alpha + wave_sum(p); acc *= alpha; m = mn;
#pragma unroll 8
            for (int jj = 0; jj < 64; ++jj) { const float pj = __shfl(p, jj); acc += pj * bf2f(Vp[(size_t)(t0 + jj) * 128 + c.lane]); }
        }
        MIX[(size_t)orow * 1024 + 384 + hq * 64 + c.lane] = (bf16_t)f2bf(acc / l);
    }
}


namespace dn {
using bf16x8 = __attribute__((ext_vector_type(8))) short;
using f32x16 = __attribute__((ext_vector_type(16))) float;
typedef __attribute__((address_space(3))) unsigned char* ldsp;
constexpr int IMG = 46080, NCHK = 68, NSEQ = 48;
constexpr int O_NEGK = 0, O_T = 8192, O_QG = 14336, O_AT = 22528, O_KDT = 28672, O_BV = 36864, O_MISC = 45056;
DEVI int rowmap(int t, int hq) { return (t & 3) + 8 * (t >> 2) + 4 * hq; }
typedef float f32x2_t __attribute__((ext_vector_type(2))); typedef __bf16 bf16x2_t __attribute__((ext_vector_type(2)));
DEVI unsigned cvtpk(float lo, float hi) { f32x2_t v = {lo, hi}; bf16x2_t b = __builtin_convertvector(v, bf16x2_t); return __builtin_bit_cast(unsigned, b); }
#define DN_PACK8(x, s) __builtin_bit_cast(dn::bf16x8, (u32x4){dn::cvtpk((x)[8 * (s)], (x)[8 * (s) + 1]), dn::cvtpk((x)[8 * (s) + 2], (x)[8 * (s) + 3]), dn::cvtpk((x)[8 * (s) + 4], (x)[8 * (s) + 5]), dn::cvtpk((x)[8 * (s) + 6], (x)[8 * (s) + 7])})
#define DN_MFMA(a, b, c) __builtin_amdgcn_mfma_f32_32x32x16_bf16((a), (b), (c), 0, 0, 0)
DEVI u32x4 perm_frag(u32x4 f, int hq) {
    const unsigned s0 = hq ? f.x : f.z, s1 = hq ? f.y : f.w;
    const unsigned r0 = (unsigned)__shfl_xor((int)s0, 32), r1 = (unsigned)__shfl_xor((int)s1, 32);
    u32x4 o; o.x = hq ? r0 : f.x; o.y = hq ? r1 : f.y; o.z = hq ? f.z : r0; o.w = hq ? f.w : r1; return o;
}
DEVI u32x4 scale_frag(u32x4 f, float sc) {
    u32x4 o; o.x = cvtpk(bflo(f.x) * sc, bfhi(f.x) * sc); o.y = cvtpk(bflo(f.y) * sc, bfhi(f.y) * sc); o.z = cvtpk(bflo(f.z) * sc, bfhi(f.z) * sc); o.w = cvtpk(bflo(f.w) * sc, bfhi(f.w) * sc); return o;
}
DEVI bf16x8 ident_frag(int e, int r, int hq) {
    const int js = r - 16 * e - 8 * hq; u32x4 w;
    w.x = (js == 0 ? 0x3F80u : 0u) | (js == 1 ? 0x3F800000u : 0u); w.y = (js == 2 ? 0x3F80u : 0u) | (js == 3 ? 0x3F800000u : 0u);
    w.z = (js == 4 ? 0x3F80u : 0u) | (js == 5 ? 0x3F800000u : 0u); w.w = (js == 6 ? 0x3F80u : 0u) | (js == 7 ? 0x3F800000u : 0u);
    return __builtin_bit_cast(bf16x8, w);
}
DEVI int chunk_base(int b, int dir, int n) {
    if (n < 4) return NLAT + b * CTXL + (dir ? 3 - n : n) * 64;
    return b * SEQ + (dir ? 63 - (n - 4) : n - 4) * 64;
}

DEVI void phase_chunkprep(const Ctx& c) {
    const bf16_t* QN = (const bf16_t*)(c.ws + WS_QN); const bf16_t* KN = (const bf16_t*)(c.ws + WS_KN); const bf16_t* VB = (const bf16_t*)(c.ws + WS_DN + DN_VB);
    const float* BG = (const float*)(c.ws + WS_DN + DN_BG); unsigned char* OPS = c.ws + WS_DN + DN_OPS;
    float* Al = c.lds + c.wave * (17408 / 4);
    float* sgc = Al + 4096; float* sbe = sgc + 64; float* skd = sbe + 64;
    const int l = c.lane, r = l & 31, hq = l >> 5;
    for (int task = c.gw; task < NSEQ * NCHK; task += c.ngw) {
        const int seq = task / NCHK, n = task % NCHK, b = seq / 12, h = (seq >> 1) % 6, dir = seq & 1;
        const int base = chunk_base(b, dir, n);
        unsigned char* img = OPS + (size_t)task * IMG;
        const int myrow = base + (dir ? 63 - l : l);
        const float beta = BG[((size_t)myrow * 12 + dir * 6 + h) * 2]; const float g = BG[((size_t)myrow * 12 + dir * 6 + h) * 2 + 1];
        float gc = g;
#pragma unroll
        for (int o = 1; o < 64; o <<= 1) { const float t = __shfl_up(gc, o); if (l >= o) gc += t; }
        const float glast = __shfl(gc, 63);
        sgc[l] = gc; sbe[l] = beta; skd[l] = __expf(glast - gc);
        if (l == 0) *(float*)(img + O_MISC) = __expf(glast);
        __builtin_amdgcn_wave_barrier(); asm volatile("" ::: "memory");
        u32x4 kf[2][4], qf[2][4];
#pragma unroll
        for (int t = 0; t < 2; ++t) { const int pos = 32 * t + r; const size_t ro = (size_t)(base + (dir ? 63 - pos : pos)) * 384 + h * 64 + 8 * hq;
#pragma unroll
            for (int kk = 0; kk < 4; ++kk) { kf[t][kk] = *(const u32x4*)(KN + ro + 16 * kk); qf[t][kk] = *(const u32x4*)(QN + ro + 16 * kk); } }
#define KF(t, kk) __builtin_bit_cast(bf16x8, kf[t][kk])
#define QF(t, kk) __builtin_bit_cast(bf16x8, qf[t][kk])
#pragma unroll
        for (int tile = 0; tile < 3; ++tile) { const int rb = tile == 2 ? 1 : 0, cb = tile == 0 ? 0 : 1;
            f32x16 G = {}, P = {};
#pragma unroll
            for (int kk = 0; kk < 4; ++kk) { G = DN_MFMA(KF(rb, kk), KF(cb, kk), G); P = DN_MFMA(KF(rb, kk), QF(cb, kk), P); }
            const int lp = 32 * cb + r; const float bl = __shfl(beta, lp), gl = __shfl(gc, lp);
#pragma unroll
            for (int t = 0; t < 16; ++t) { const int rp = 32 * rb + rowmap(t, hq); const float e = __expf(gl - sgc[rp]);
                if (tile == 1) G[t] = -bl * e * G[t]; else Al[rp * 64 + lp] = lp > rp ? bl * e * G[t] : 0.f;
                P[t] = rp <= lp ? P[t] * e : 0.f; }
            if (tile == 1) { *(bf16x8*)(img + O_T + 2 * 1024 + l * 16) = DN_PACK8(G, 0); *(bf16x8*)(img + O_T + 3 * 1024 + l * 16) = DN_PACK8(G, 1); }
            *(bf16x8*)(img + O_AT + (2 * tile + 0) * 1024 + l * 16) = DN_PACK8(P, 0);
            *(bf16x8*)(img + O_AT + (2 * tile + 1) * 1024 + l * 16) = DN_PACK8(P, 1); }
#pragma unroll
        for (int rt = 0; rt < 2; ++rt) { const float gr = __shfl(gc, 32 * rt + r), br = __shfl(beta, 32 * rt + r); const float eg = __expf(gr);
#pragma unroll
            for (int kk = 0; kk < 4; ++kk) {
                *(u32x4*)(img + O_NEGK + (rt * 4 + kk) * 1024 + l * 16) = scale_frag(perm_frag(kf[rt][kk], hq), -br * eg);
                *(u32x4*)(img + O_QG + (rt * 4 + kk) * 1024 + l * 16) = scale_frag(perm_frag(qf[rt][kk], hq), eg); } }
#pragma unroll
        for (int dt = 0; dt < 2; ++dt)
#pragma unroll
            for (int cb = 0; cb < 2; ++cb) { f32x16 X = {};
                X = DN_MFMA(KF(cb, 2 * dt), ident_frag(0, r, hq), X); X = DN_MFMA(KF(cb, 2 * dt + 1), ident_frag(1, r, hq), X);
#pragma unroll
                for (int t = 0; t < 16; ++t) X[t] *= skd[32 * cb + rowmap(t, hq)];
                *(bf16x8*)(img + O_KDT + ((dt * 2 + cb) * 2 + 0) * 1024 + l * 16) = DN_PACK8(X, 0);
                *(bf16x8*)(img + O_KDT + ((dt * 2 + cb) * 2 + 1) * 1024 + l * 16) = DN_PACK8(X, 1); }
        {
            u32x4 vf[2][4];
#pragma unroll
            for (int t = 0; t < 2; ++t) { const int pos = 32 * t + r; const size_t ro = (size_t)(base + (dir ? 63 - pos : pos)) * 384 + h * 64 + 8 * hq;
#pragma unroll
                for (int kk = 0; kk < 4; ++kk) vf[t][kk] = *(const u32x4*)(VB + ro + 16 * kk); }
#pragma unroll
            for (int sl = 0; sl < 2; ++sl)
#pragma unroll
                for (int ct = 0; ct < 2; ++ct) { f32x16 Y = {};
                    Y = DN_MFMA(__builtin_bit_cast(bf16x8, vf[ct][2 * sl]), ident_frag(0, r, hq), Y); Y = DN_MFMA(__builtin_bit_cast(bf16x8, vf[ct][2 * sl + 1]), ident_frag(1, r, hq), Y);
#pragma unroll
                    for (int t = 0; t < 16; ++t) Y[t] *= sbe[32 * ct + rowmap(t, hq)];
                    *(bf16x8*)(img + O_BV + ((sl * 2 + ct) * 64 + l) * 32) = DN_PACK8(Y, 0);
                    *(bf16x8*)(img + O_BV + ((sl * 2 + ct) * 64 + l) * 32 + 16) = DN_PACK8(Y, 1); }
        }
#undef KF
#undef QF
        __builtin_amdgcn_wave_barrier(); asm volatile("" ::: "memory");
        {
            const float* Ab = Al + hq * (32 * 64 + 32);
            float* Tb = Al + hq * (32 * 64) + (hq ? 0 : 32);
#pragma unroll 1
            for (int JB = 3; JB >= 0; --JB) {
                float acc[8];
#pragma unroll
                for (int jj = 0; jj < 8; ++jj) acc[jj] = (r == 8 * JB + jj) ? 1.f : 0.f;
                float tk[24];
#pragma unroll
                for (int k = 8; k < 32; ++k) { const float tv = Tb[k * 64 + r]; tk[k - 8] = (k >= 8 * (JB + 1)) ? tv : 0.f; }
                const float* Aj = Ab + (8 * JB) * 64;
#pragma unroll
                for (int jj = 0; jj < 8; ++jj) { float a0 = 0.f, a1 = 0.f;
#pragma unroll
                    for (int k4 = 2; k4 < 8; ++k4) { const f32x4 av = *(const f32x4*)(Aj + jj * 64 + 4 * k4);
                        a0 += tk[4 * k4 - 8] * av.x + tk[4 * k4 - 6] * av.z; a1 += tk[4 * k4 - 7] * av.y + tk[4 * k4 - 5] * av.w; }
                    acc[jj] -= a0 + a1; }
#pragma unroll
                for (int jj = 6; jj >= 0; --jj) {
                    const f32x4 a0v = *(const f32x4*)(Aj + jj * 64 + 8 * JB), a1v = *(const f32x4*)(Aj + jj * 64 + 8 * JB + 4);
                    const float av[8] = {a0v.x, a0v.y, a0v.z, a0v.w, a1v.x, a1v.y, a1v.z, a1v.w};
                    float a = acc[jj];
#pragma unroll
                    for (int kk = jj + 1; kk < 8; ++kk) a -= acc[kk] * av[kk];
                    acc[jj] = a; }
#pragma unroll
                for (int jj = 0; jj < 8; ++jj) Tb[(8 * JB + jj) * 64 + r] = acc[jj];
            }
            float T[32];
#pragma unroll
            for (int k = 0; k < 32; ++k) T[k] = Tb[k * 64 + r];
#pragma unroll
            for (int s = 0; s < 2; ++s)
#pragma unroll
                for (int h2 = 0; h2 < 2; ++h2) { const int k0 = 16 * s + 4 * h2;
                    u32x4 w; w.x = cvtpk(T[k0], T[k0 + 1]); w.y = cvtpk(T[k0 + 2], T[k0 + 3]); w.z = cvtpk(T[k0 + 8], T[k0 + 9]); w.w = cvtpk(T[k0 + 10], T[k0 + 11]);
                    *(u32x4*)(img + O_T + ((hq ? 4 : 0) + s) * 1024 + (32 * h2 + r) * 16) = w; }
        }
        __builtin_amdgcn_wave_barrier(); asm volatile("" ::: "memory");
    }
}

DEVI void glds16(const void* gsrc, unsigned lds_dst) { unsigned keep;
    asm volatile("s_mov_b32 %0, m0\n\ts_mov_b32 m0, %2\n\ts_nop 0\n\tglobal_load_lds_dwordx4 %1, off\n\ts_mov_b32 m0, %0" : "=&s"(keep) : "v"(gsrc), "s"(lds_dst) : "memory"); }
DEVI void scan_sequence(const Ctx& c, int seq) {
    const unsigned char* OPS = c.ws + WS_DN + DN_OPS + (size_t)seq * NCHK * IMG; float* OD = (float*)(c.ws + WS_DN + DN_O);
    const int b = seq / 12, h = (seq >> 1) % 6, dir = seq & 1;
    const int l = c.lane, r = l & 31, hq = l >> 5, w = c.wave;
    const unsigned lds0 = (unsigned)(uintptr_t)c.lds;
    const bool loader = (w >= 2), consumer = (w < 2);
    constexpr int RSLOT = 36864;
#define DN_ISSUE(step, slot) do { if (loader) { _Pragma("unroll") for (int q_ = 0; q_ < 6; ++q_) { const int p_ = (w - 2) * 6 + q_; \
        glds16(OPS + (size_t)(step) * IMG + p_ * 1024 + l * 16, (unsigned)__builtin_amdgcn_readfirstlane(lds0 + (slot) * RSLOT + p_ * 1024)); } } } while (0)
    f32x16 S0 = {}, S1 = {};
    float gam_n = 0.f; u32x4 bv_n[4] = {};
    if (consumer) { gam_n = *(const float*)(OPS + O_MISC);
        bv_n[0] = *(const u32x4*)(OPS + O_BV + ((w * 2 + 0) * 64 + l) * 32); bv_n[1] = *(const u32x4*)(OPS + O_BV + ((w * 2 + 0) * 64 + l) * 32 + 16);
        bv_n[2] = *(const u32x4*)(OPS + O_BV + ((w * 2 + 1) * 64 + l) * 32); bv_n[3] = *(const u32x4*)(OPS + O_BV + ((w * 2 + 1) * 64 + l) * 32 + 16); }
    DN_ISSUE(0, 0); DN_ISSUE(1, 1);
    int slot = 0;
    for (int n = 0; n < NCHK; ++n) {
        if (loader) { if (n + 1 < NCHK) asm volatile("s_waitcnt vmcnt(6)" ::: "memory"); else asm volatile("s_waitcnt vmcnt(0)" ::: "memory"); }
        asm volatile("s_barrier" ::: "memory");
        if (n + 2 < NCHK) { const int s2 = slot == 0 ? 2 : slot - 1; DN_ISSUE(n + 2, s2); }
        if (consumer) {
            const ldsp img = c.lds3 + slot * RSLOT; const int sl = w;
#define DN_A(off, f) (*(const __attribute__((address_space(3))) bf16x8*)(img + (off) + (f) * 1024 + l * 16))
            const float gamma = gam_n; const u32x4 a = bv_n[0], bq = bv_n[1], a1 = bv_n[2], b1 = bv_n[3];
            if (n + 1 < NCHK) { const unsigned char* g2 = OPS + (size_t)(n + 1) * IMG;
                gam_n = *(const float*)(g2 + O_MISC);
                bv_n[0] = *(const u32x4*)(g2 + O_BV + ((sl * 2 + 0) * 64 + l) * 32); bv_n[1] = *(const u32x4*)(g2 + O_BV + ((sl * 2 + 0) * 64 + l) * 32 + 16);
                bv_n[2] = *(const u32x4*)(g2 + O_BV + ((sl * 2 + 1) * 64 + l) * 32); bv_n[3] = *(const u32x4*)(g2 + O_BV + ((sl * 2 + 1) * 64 + l) * 32 + 16); }
            const bf16x8 sb00 = DN_PACK8(S0, 0), sb01 = DN_PACK8(S0, 1), sb10 = DN_PACK8(S1, 0), sb11 = DN_PACK8(S1, 1);
            f32x16 v0, v1;
            {
#pragma unroll
              for (int q = 0; q < 4; ++q) { v0[2 * q] = bflo(a[q]); v0[2 * q + 1] = bfhi(a[q]); v0[8 + 2 * q] = bflo(bq[q]); v0[8 + 2 * q + 1] = bfhi(bq[q]);
                  v1[2 * q] = bflo(a1[q]); v1[2 * q + 1] = bfhi(a1[q]); v1[8 + 2 * q] = bflo(b1[q]); v1[8 + 2 * q + 1] = bfhi(b1[q]); } }
            v0 = DN_MFMA(DN_A(O_NEGK, 0), sb00, v0); v1 = DN_MFMA(DN_A(O_NEGK, 4), sb00, v1);
            v0 = DN_MFMA(DN_A(O_NEGK, 1), sb01, v0); v1 = DN_MFMA(DN_A(O_NEGK, 5), sb01, v1);
            v0 = DN_MFMA(DN_A(O_NEGK, 2), sb10, v0); v1 = DN_MFMA(DN_A(O_NEGK, 6), sb10, v1);
            v0 = DN_MFMA(DN_A(O_NEGK, 3), sb11, v0); v1 = DN_MFMA(DN_A(O_NEGK, 7), sb11, v1);
            __builtin_amdgcn_sched_barrier(0);
            const bf16x8 vb00 = DN_PACK8(v0, 0), vb01 = DN_PACK8(v0, 1);
            f32x16 n0 = {}, n1 = {};
            n0 = DN_MFMA(DN_A(O_T, 0), vb00, n0); n0 = DN_MFMA(DN_A(O_T, 1), vb01, n0);
            const bf16x8 nb00 = DN_PACK8(n0, 0), nb01 = DN_PACK8(n0, 1);
            v1 = DN_MFMA(DN_A(O_T, 2), nb00, v1); v1 = DN_MFMA(DN_A(O_T, 3), nb01, v1);
            const bf16x8 xb10 = DN_PACK8(v1, 0), xb11 = DN_PACK8(v1, 1);
            n1 = DN_MFMA(DN_A(O_T, 4), xb10, n1); n1 = DN_MFMA(DN_A(O_T, 5), xb11, n1);
            const bf16x8 nb10 = DN_PACK8(n1, 0), nb11 = DN_PACK8(n1, 1);
            __builtin_amdgcn_sched_barrier(0);
            f32x16 o0 = {}, o1 = {};
            o0 = DN_MFMA(DN_A(O_QG, 0), sb00, o0); o1 = DN_MFMA(DN_A(O_QG, 4), sb00, o1);
            o0 = DN_MFMA(DN_A(O_QG, 1), sb01, o0); o1 = DN_MFMA(DN_A(O_QG, 5), sb01, o1);
            o0 = DN_MFMA(DN_A(O_QG, 2), sb10, o0); o1 = DN_MFMA(DN_A(O_QG, 6), sb10, o1);
            o0 = DN_MFMA(DN_A(O_QG, 3), sb11, o0); o1 = DN_MFMA(DN_A(O_QG, 7), sb11, o1);
            o0 = DN_MFMA(DN_A(O_AT, 0), nb00, o0); o1 = DN_MFMA(DN_A(O_AT, 2), nb00, o1);
            o0 = DN_MFMA(DN_A(O_AT, 1), nb01, o0); o1 = DN_MFMA(DN_A(O_AT, 3), nb01, o1);
            o1 = DN_MFMA(DN_A(O_AT, 4), nb10, o1); o1 = DN_MFMA(DN_A(O_AT, 5), nb11, o1);
            __builtin_amdgcn_sched_barrier(0);
            {
                const int base = chunk_base(b, dir, n); float* od = OD + (size_t)dir * NT * 384 + h * 64 + 32 * sl + r;
#pragma unroll
                for (int t = 0; t < 16; ++t) { const int i0 = rowmap(t, hq), i1 = 32 + i0;
                    od[(size_t)(base + (dir ? 63 - i0 : i0)) * 384] = o0[t]; od[(size_t)(base + (dir ? 63 - i1 : i1)) * 384] = o1[t]; }
            }
            __builtin_amdgcn_sched_barrier(0);
#pragma unroll
            for (int t = 0; t < 16; ++t) { S0[t] *= gamma; S1[t] *= gamma; }
            S0 = DN_MFMA(DN_A(O_KDT, 0), nb00, S0); S1 = DN_MFMA(DN_A(O_KDT, 4), nb00, S1);
            S0 = DN_MFMA(DN_A(O_KDT, 1), nb01, S0); S1 = DN_MFMA(DN_A(O_KDT, 5), nb01, S1);
            S0 = DN_MFMA(DN_A(O_KDT, 2), nb10, S0); S1 = DN_MFMA(DN_A(O_KDT, 6), nb10, S1);
            S0 = DN_MFMA(DN_A(O_KDT, 3), nb11, S0); S1 = DN_MFMA(DN_A(O_KDT, 7), nb11, S1);
#undef DN_A
        }
        slot = slot == 2 ? 0 : slot + 1;
    }
    asm volatile("s_waitcnt vmcnt(0) lgkmcnt(0)\n\ts_barrier" ::: "memory");
#undef DN_ISSUE
}
}

DEVI void phase_sgu(const Ctx& c, int layer, bool need_ctx) {
    using dn::bf16x8; using dn::f32x16;
    const bf16_t* Z = (const bf16_t*)(c.ws + WS_Z); const bf16_t* SV = (const bf16_t*)(c.ws + WS_SV); bf16_t* MIX = (bf16_t*)(c.ws + WS_MIX);
    const float* sw = c.in[I_SGUW] + (size_t)layer * 4 * 128 * 128; const float* sb = c.in[I_SGUB] + layer * 512;
    const int nchunks = (need_ctx ? NT : NLAT) / 128; const int l = c.lane, r = l & 31, hq = l >> 5;
    const bf16x8 id0 = dn::ident_frag(0, r, hq), id1 = dn::ident_frag(1, r, hq);
    for (int sit = c.gw; sit < nchunks * 32; sit += c.ngw) {
        const int it = sit >> 2, itile = sit & 3, ch = it >> 3, g = (it >> 1) & 3, dvb = it & 1, r0 = ch * 128;
        bf16x8 yb[4][2];
#pragma unroll
        for (int jt = 0; jt < 4; ++jt) { const bf16_t* sp = SV + (size_t)(r0 + 32 * jt + r) * 256 + g * 64 + 32 * dvb + 8 * hq;
            f32x16 Y = {};
            Y = DN_MFMA(__builtin_bit_cast(bf16x8, *(const u32x4*)sp), id0, Y); Y = DN_MFMA(__builtin_bit_cast(bf16x8, *(const u32x4*)(sp + 16)), id1, Y);
            yb[jt][0] = DN_PACK8(Y, 0); yb[jt][1] = DN_PACK8(Y, 1); }
        const float* wg = sw + (size_t)g * 128 * 128;
        {
            f32x16 C = {}; const float* wr = wg + (size_t)(32 * itile + r) * 128 + 4 * hq;
#pragma unroll
            for (int jt = 0; jt < 4; ++jt)
#pragma unroll
                for (int sI = 0; sI < 2; ++sI) { const f32x4 w0 = *(const f32x4*)(wr + 32 * jt + 16 * sI), w1 = *(const f32x4*)(wr + 32 * jt + 16 * sI + 8);
                    u32x4 a; a.x = dn::cvtpk(w0.x, w0.y); a.y = dn::cvtpk(w0.z, w0.w); a.z = dn::cvtpk(w1.x, w1.y); a.w = dn::cvtpk(w1.z, w1.w);
                    C = DN_MFMA(__builtin_bit_cast(bf16x8, a), yb[jt][sI], C); }
#pragma unroll
            for (int t = 0; t < 16; ++t) { const int i = 32 * itile + dn::rowmap(t, hq); const size_t row = (size_t)(r0 + i);
                const float u = gelu_f(bf2f(Z[row * ZP + ZC_MU + g * 64 + 32 * dvb + r]));
                MIX[row * 1024 + 768 + g * 64 + 32 * dvb + r] = (bf16_t)f2bf(u * (C[t] + sb[g * 128 + i])); }
        }
    }
}

namespace attn_body {
using bf16=__hip_bfloat16;
using bf16x8=__attribute__((ext_vector_type(8)))short;
using s16x4=__attribute__((ext_vector_type(4)))short;
using f32x16=__attribute__((ext_vector_type(16)))float;
using u32x4=__attribute__((ext_vector_type(4)))unsigned;
constexpr int D=64,QP=384,KVP=128,OP=1024;
constexpr int NW=8,QBLK=32,QB=QBLK*NW,KVBLK=64;
constexpr int ATTN_UNIT_ROWS=QB;
__device__ __forceinline__ int crow(int r,int hi){return (r&3)+8*(r>>2)+4*hi;}
#define SBAR() __builtin_amdgcn_sched_barrier(0)
__device__ __forceinline__ void cmask(f32x16&p0,f32x16&p1,int jb,int qrel,int hi){
  const float NEG=-INFINITY; int kb=64*jb+4*hi;
  #pragma unroll
  for(int r=0;r<16;++r){int kv=kb+(r&3)+8*(r>>2); if(kv>qrel)p0[r]=NEG; if(kv+32>qrel)p1[r]=NEG;}
}

constexpr int NSLOT=3, SLOTB=8192;
constexpr int LDS_K=0, LDS_V=NSLOT*SLOTB, LDS_WS=2*NSLOT*SLOTB, LDS_OST=LDS_WS+NW*64*4, LDS_BYTES=LDS_OST+NW*4096;
constexpr float C2=0.125f*1.4426950408889634f;
__device__ __forceinline__ void glds16(const void*gsrc,unsigned lds_dst){unsigned keep;
  asm volatile("s_mov_b32 %0, m0\n\ts_mov_b32 m0, %2\n\ts_nop 0\n\tglobal_load_lds_dwordx4 %1, off\n\ts_mov_b32 m0, %0":"=&s"(keep):"v"(gsrc),"s"(lds_dst):"memory");}
__device__ __forceinline__ float max3f(float a,float b,float c){float r;asm("v_max3_f32 %0, %1, %2, %3":"=v"(r):"v"(a),"v"(b),"v"(c));return r;}
__device__ __forceinline__ float max2f(float a,float b){float r;asm("v_max_f32_e32 %0, %1, %2":"=v"(r):"v"(a),"v"(b));return r;}
__device__ __forceinline__ float fadd_s(float a,float b){float r;asm("v_add_f32_e32 %0, %1, %2":"=v"(r):"v"(a),"v"(b));return r;}
__device__ __forceinline__ float fsub_s(float a,float b){float r;asm("v_sub_f32_e32 %0, %1, %2":"=v"(r):"v"(a),"v"(b));return r;}
typedef float f32x2_t __attribute__((ext_vector_type(2))); typedef __bf16 bf16x2_t __attribute__((ext_vector_type(2)));
__device__ __forceinline__ unsigned cvtpk_s(float lo,float hi){f32x2_t v={lo,hi};bf16x2_t b=__builtin_convertvector(v,bf16x2_t);return __builtin_bit_cast(unsigned,b);}
#define WAIT_BAR(N) asm volatile("s_waitcnt vmcnt(" #N ") lgkmcnt(0)\n\ts_barrier":::"memory")

__device__ __forceinline__ void qkt(f32x16&p0,f32x16&p1,const char*Kslot,const bf16x8*qr,const f32x16&negm,int r32,int hi){
  const char*kb=Kslot+hi*1024+r32*16;
  #pragma unroll
  for(int d0=0;d0<4;++d0){
    const bf16x8 b0=*reinterpret_cast<const bf16x8*>(kb+d0*2048);
    const bf16x8 b1=*reinterpret_cast<const bf16x8*>(kb+d0*2048+512);
    if(d0==0){p0=__builtin_amdgcn_mfma_f32_32x32x16_bf16(b0,qr[0],negm,0,0,0);p1=__builtin_amdgcn_mfma_f32_32x32x16_bf16(b1,qr[0],negm,0,0,0);}
    else{p0=__builtin_amdgcn_mfma_f32_32x32x16_bf16(b0,qr[d0],p0,0,0,0);p1=__builtin_amdgcn_mfma_f32_32x32x16_bf16(b1,qr[d0],p1,0,0,0);}}
}
typedef __attribute__((address_space(3))) const char* lds_cptr;
typedef short v4i16_t __attribute__((ext_vector_type(4)));
__device__ __forceinline__ void kload8(bf16x8*kf,lds_cptr kp){
  kf[0]=*(const __attribute__((address_space(3))) bf16x8*)(kp);      kf[1]=*(const __attribute__((address_space(3))) bf16x8*)(kp+512);
  kf[2]=*(const __attribute__((address_space(3))) bf16x8*)(kp+2048); kf[3]=*(const __attribute__((address_space(3))) bf16x8*)(kp+2560);
  kf[4]=*(const __attribute__((address_space(3))) bf16x8*)(kp+4096); kf[5]=*(const __attribute__((address_space(3))) bf16x8*)(kp+4608);
  kf[6]=*(const __attribute__((address_space(3))) bf16x8*)(kp+6144); kf[7]=*(const __attribute__((address_space(3))) bf16x8*)(kp+6656);
}
__device__ __forceinline__ void kload2(bf16x8*kf,lds_cptr kp,int j){ kf[2*j]=*(const __attribute__((address_space(3))) bf16x8*)(kp+j*2048); kf[2*j+1]=*(const __attribute__((address_space(3))) bf16x8*)(kp+j*2048+512); }
__device__ __forceinline__ s16x4 vtr(lds_cptr p){ return __builtin_bit_cast(s16x4,__builtin_amdgcn_ds_read_tr16_b64_v4i16((__attribute__((address_space(3))) v4i16_t*)p)); }
__device__ __forceinline__ float rowmax(const f32x16&p0,const f32x16&p1){
  float a=max3f(p0[0],p0[1],p1[0]),b=max3f(p0[2],p0[3],p1[1]);a=max3f(a,p1[2],p1[3]);
  #pragma unroll
  for(int r=4;r<16;r+=4){a=max3f(a,p0[r],p0[r+1]);b=max3f(b,p0[r+2],p0[r+3]);a=max3f(a,p1[r],p1[r+1]);b=max3f(b,p1[r+2],p1[r+3]);}
  const float m=max2f(a,b);
  auto rr=__builtin_amdgcn_permlane32_swap(__float_as_uint(m),__float_as_uint(m),false,false);
  return max2f(__uint_as_float(rr[0]),__uint_as_float(rr[1]));
}
__device__ __forceinline__ void pv(f32x16*o,int vb,bf16x8 pa0,bf16x8 pa1,bf16x8 pa2,bf16x8 pa3){
  #pragma unroll
  for(int d0=0;d0<2;++d0){s16x4 lo[4],hi[4];
    #pragma unroll
    for(int ks=0;ks<4;++ks){
      asm volatile("ds_read_b64_tr_b16 %0,%1 offset:%c2":"=&v"(lo[ks]):"v"(vb),"i"(d0*4096+ks*1024):"memory");
      asm volatile("ds_read_b64_tr_b16 %0,%1 offset:%c2":"=&v"(hi[ks]):"v"(vb),"i"(d0*4096+ks*1024+512):"memory");}
    asm volatile("s_waitcnt lgkmcnt(0)":::"memory");SBAR();
    #define PK(k) (bf16x8){lo[k][0],lo[k][1],lo[k][2],lo[k][3],hi[k][0],hi[k][1],hi[k][2],hi[k][3]}
    o[d0]=__builtin_amdgcn_mfma_f32_32x32x16_bf16(pa0,PK(0),o[d0],0,0,0);
    o[d0]=__builtin_amdgcn_mfma_f32_32x32x16_bf16(pa1,PK(1),o[d0],0,0,0);
    o[d0]=__builtin_amdgcn_mfma_f32_32x32x16_bf16(pa2,PK(2),o[d0],0,0,0);
    o[d0]=__builtin_amdgcn_mfma_f32_32x32x16_bf16(pa3,PK(3),o[d0],0,0,0);
    #undef PK
  }
}

#ifndef ATTN_STORE16
#define ATTN_STORE16(p,v) (*(u32x4*)(p)=(v))
#endif
template<int THRL> __device__ __forceinline__ void attn_unit(const bf16*Qu,const bf16*__restrict__ Kh,const bf16*__restrict__ Vh,const int NT,bf16*Ou,char*shm){
  const int tid=threadIdx.x,lane=tid&63,r32=lane&31,hi=lane>>5; const int wid=__builtin_amdgcn_readfirstlane(tid>>6);
  const bf16*Qw=Qu+(long)(wid*QBLK)*QP;
  const unsigned lds0=(unsigned)(uintptr_t)shm;
  float*wsf=(float*)(shm+LDS_WS)+wid*64;
  const bf16*ksrc=Kh+(long)lane*KVP+wid*8;
  const bf16*vsrc=Vh+(long)(16*(wid&3)+(lane>>2))*KVP+(wid>>2)*32+(lane&3)*8;
  const unsigned kdst=lds0+LDS_K+wid*1024, vdst=lds0+LDS_V+wid*1024;
  #define DMA_K(t,slot) glds16(ksrc+(long)(t)*KVBLK*KVP,(unsigned)__builtin_amdgcn_readfirstlane(kdst+(slot)))
  #define DMA_V(t,slot) glds16(vsrc+(long)(t)*KVBLK*KVP,(unsigned)__builtin_amdgcn_readfirstlane(vdst+(slot)))
  const int vb0=(int)(lds0+LDS_V)+((lane>>4)&1)*32+(lane&3)*8+(4*hi+((lane&15)>>2))*64;
  const char*Kbase=shm+LDS_K; bf16x8 kf[8];
  const lds_cptr shm3=(lds_cptr)shm; const lds_cptr kp0=shm3+LDS_K+hi*1024+r32*16; const lds_cptr vp0=shm3+LDS_V+((lane>>4)&1)*32+(lane&3)*8+(4*hi+((lane&15)>>2))*64;
  DMA_K(0,0);DMA_V(0,0);DMA_K(1,SLOTB);
  bf16x8 qr[4];
  #pragma unroll
  for(int d0=0;d0<4;++d0)qr[d0]=*reinterpret_cast<const bf16x8*>(&Qw[(long)r32*QP+d0*16+hi*8]);
  float mhat=0.f,l_reg=0.f;f32x16 o[2];o[0]=f32x16{};o[1]=f32x16{};f32x16 negm=f32x16{};asm volatile("":"+v"(negm));
  #define CMASK(P0,P1,t) do{}while(0)
  bool resc=false;
  #define START(P0,P1) do{ const float rm=rowmax(P0,P1); resc=false; \
    { const float dl=rm; mhat=fadd_s(mhat,dl); \
      _Pragma("unroll") for(int r=0;r<16;++r){P0[r]=fsub_s(P0[r],dl);P1[r]=fsub_s(P1[r],dl);} \
      _Pragma("unroll") for(int r=0;r<16;++r)negm[r]=-mhat; asm volatile("":"+v"(negm)); } \
    _Pragma("unroll") for(int r=0;r<16;++r)P0[r]=__builtin_amdgcn_exp2f(P0[r]); }while(0)
  #define RESC() do{ if(resc){ asm volatile("s_waitcnt lgkmcnt(0)":::"memory"); \
      _Pragma("unroll") for(int d_=0;d_<2;++d_) _Pragma("unroll") for(int r=0;r<16;++r)o[d_][r]*=wsf[crow(r,hi)]; } }while(0)
  f32x16 pA0,pA1,pB0,pB1;
  int sl_prev=0,sl_cur=0,sl_next=SLOTB;
  #define ROT() do{sl_prev=sl_cur;sl_cur=sl_next;sl_next=(sl_next==(NSLOT-1)*SLOTB)?0:sl_next+SLOTB;}while(0)
  DMA_K(2,2*SLOTB);
  WAIT_BAR(3);
  qkt(pA0,pA1,Kbase,qr,negm,r32,hi);asm volatile("s_nop 15\n\ts_nop 7":"+v"(pA0),"+v"(pA1));CMASK(pA0,pA1,0);
  START(pA0,pA1);
  _Pragma("unroll") for(int r=0;r<16;++r)pA1[r]=__builtin_amdgcn_exp2f(pA1[r]);
  WAIT_BAR(0);
  DMA_K(3,0);DMA_V(1,SLOTB);
  ROT();
  kload8(kf,kp0+sl_cur);
  WAIT_BAR(2);
  s16x4 vlo[8],vhi[8]; u32x4 pw0,pw1,pw2,pw3;
  #define PKW(P,B) cvtpk_s(P[B],P[B+1])
  #define PAF(k) __builtin_bit_cast(bf16x8,pw##k)
  #define VFR(i) (bf16x8){vlo[i][0],vlo[i][1],vlo[i][2],vlo[i][3],vhi[i][0],vhi[i][1],vhi[i][2],vhi[i][3]}
  #define PIN(x) asm volatile("":"+v"(x))
  #define MX3(a,b,c) __builtin_fmaxf(__builtin_fmaxf((a),(b)),(c))
  #define GAPA(MF,A0,A1,A2,A3,W0,W1,PW) do{ MF; sacc+=A0; sacc+=A1; sacc+=A2; sacc+=A3; PIN(sacc); W0; W1; PIN(PW); SBAR(); }while(0)
  #define EX(v) __builtin_amdgcn_exp2f(v)
  #define GAPB(MF,X,B) do{ MF; X[B]=EX(X[B]); X[B+1]=EX(X[B+1]); X[B+2]=EX(X[B+2]); X[B+3]=EX(X[B+3]); PIN(X); SBAR(); }while(0)
  #define VRD(i) do{ vlo[i]=vtr(vp_+(((i)>>2)*4096+((i)&3)*1024)); vhi[i]=vtr(vp_+(((i)>>2)*4096+((i)&3)*1024+512)); }while(0)
  #define KRD(G,j) do{ if(G){ kload2(kf,kp0+sl_next,j); SBAR(); } }while(0)
  #define STEP(C0,C1,P0,P1,t,GK,GV,GL) do{ SBAR(); \
    const lds_cptr vp_=vp0+sl_prev; \
    VRD(0); SBAR(); float sacc=(P0[0]+P0[1]); \
    GAPA(C0=__builtin_amdgcn_mfma_f32_32x32x16_bf16(kf[0],qr[0],negm,0,0,0), P0[2],P0[3],P0[4],P0[5],     pw0[0]=PKW(P0,0), pw0[1]=PKW(P0,2), pw0); \
    VRD(4); SBAR(); GAPA(C1=__builtin_amdgcn_mfma_f32_32x32x16_bf16(kf[1],qr[0],negm,0,0,0), P0[6],P0[7],P0[8],P0[9],     pw0[2]=PKW(P0,4), pw0[3]=PKW(P0,6), pw0); \
    VRD(1); SBAR(); GAPA(C0=__builtin_amdgcn_mfma_f32_32x32x16_bf16(kf[2],qr[1],C0,0,0,0),   P0[10],P0[11],P0[12],P0[13], pw1[0]=PKW(P0,8), pw1[1]=PKW(P0,10), pw1); \
    VRD(5); SBAR(); GAPA(C1=__builtin_amdgcn_mfma_f32_32x32x16_bf16(kf[3],qr[1],C1,0,0,0),   P0[14],P0[15],P1[0],P1[1],   pw1[2]=PKW(P0,12),pw1[3]=PKW(P0,14), pw1); \
    VRD(2); SBAR(); GAPA(C0=__builtin_amdgcn_mfma_f32_32x32x16_bf16(kf[4],qr[2],C0,0,0,0),   P1[2],P1[3],P1[4],P1[5],     pw2[0]=PKW(P1,0), pw2[1]=PKW(P1,2), pw2); \
    VRD(6); SBAR(); GAPA(C1=__builtin_amdgcn_mfma_f32_32x32x16_bf16(kf[5],qr[2],C1,0,0,0),   P1[6],P1[7],P1[8],P1[9],     pw2[2]=PKW(P1,4), pw2[3]=PKW(P1,6), pw2); \
    VRD(3); SBAR(); GAPA(C0=__builtin_amdgcn_mfma_f32_32x32x16_bf16(kf[6],qr[3],C0,0,0,0),   P1[10],P1[11],P1[12],P1[13], pw3[0]=PKW(P1,8), pw3[1]=PKW(P1,10), pw3); \
    VRD(7); SBAR(); GAPA(C1=__builtin_amdgcn_mfma_f32_32x32x16_bf16(kf[7],qr[3],C1,0,0,0),   P1[14],P1[15],0.f,0.f,       pw3[2]=PKW(P1,12),pw3[3]=PKW(P1,14), pw3); \
    l_reg+=sacc; \
    if(GK){DMA_K((t)+3,sl_cur);} if(GV){DMA_V((t)+1,sl_next);} \
    CMASK(C0,C1,t); \
    { float a=MX3(C0[0],C0[1],C1[0]),b=MX3(C0[2],C0[3],C1[1]); a=MX3(a,C1[2],C1[3]); \
      _Pragma("unroll") for(int r=4;r<16;r+=4){a=MX3(a,C0[r],C0[r+1]);b=MX3(b,C0[r+2],C0[r+3]);a=MX3(a,C1[r],C1[r+1]);b=MX3(b,C1[r+2],C1[r+3]);} \
      float rm=__builtin_fmaxf(a,b); { auto rr=__builtin_amdgcn_permlane32_swap(__float_as_uint(rm),__float_as_uint(rm),false,false); rm=__builtin_fmaxf(__uint_as_float(rr[0]),__uint_as_float(rr[1])); } \
      resc=false; \
      if(__builtin_expect(__any(rm>(float)THRL),0)){ const float dl=__builtin_fmaxf(rm,0.f); mhat+=dl; \
        _Pragma("unroll") for(int r=0;r<16;++r){C0[r]-=dl;C1[r]-=dl;} \
        _Pragma("unroll") for(int r=0;r<16;++r)negm[r]=-mhat; asm volatile("":"+v"(negm)); \
        const float f=__builtin_amdgcn_exp2f(-dl); l_reg*=f; if(hi==0)wsf[r32]=f; resc=true; } } \
    SBAR(); \
    GAPB(o[0]=__builtin_amdgcn_mfma_f32_32x32x16_bf16(PAF(0),VFR(0),o[0],0,0,0), C0,0); \
    GAPB(o[1]=__builtin_amdgcn_mfma_f32_32x32x16_bf16(PAF(0),VFR(4),o[1],0,0,0), C0,4); \
    KRD(GL,0); GAPB(o[0]=__builtin_amdgcn_mfma_f32_32x32x16_bf16(PAF(1),VFR(1),o[0],0,0,0), C0,8); \
    KRD(GL,1); GAPB(o[1]=__builtin_amdgcn_mfma_f32_32x32x16_bf16(PAF(1),VFR(5),o[1],0,0,0), C0,12); \
    KRD(GL,2); GAPB(o[0]=__builtin_amdgcn_mfma_f32_32x32x16_bf16(PAF(2),VFR(2),o[0],0,0,0), C1,0); \
    KRD(GL,3); GAPB(o[1]=__builtin_amdgcn_mfma_f32_32x32x16_bf16(PAF(2),VFR(6),o[1],0,0,0), C1,4); \
    GAPB(o[0]=__builtin_amdgcn_mfma_f32_32x32x16_bf16(PAF(3),VFR(3),o[0],0,0,0), C1,8); \
    GAPB(o[1]=__builtin_amdgcn_mfma_f32_32x32x16_bf16(PAF(3),VFR(7),o[1],0,0,0), C1,12); \
    }while(0)
  int t=1;
  #undef CMASK
  #define CMASK(P0,P1,t) do{}while(0)
  for(;t+5<NT;t+=2){
    STEP(pB0,pB1,pA0,pA1,t,true,true,true);     WAIT_BAR(2); RESC(); ROT();
    STEP(pA0,pA1,pB0,pB1,t+1,true,true,true);   WAIT_BAR(2); RESC(); ROT();
  }
  #undef CMASK
  #define CMASK(P0,P1,t) do{}while(0)
  #define ENDW(tt) do{ if((tt)+3<NT){WAIT_BAR(2);} else if((tt)+2<NT){WAIT_BAR(1);} else {WAIT_BAR(0);} }while(0)
  for(;t+1<NT;t+=2){
    STEP(pB0,pB1,pA0,pA1,t,(t+3<NT),(t+1<NT),(t+1<NT));       ENDW(t);   RESC(); ROT();
    STEP(pA0,pA1,pB0,pB1,t+1,(t+4<NT),(t+2<NT),(t+2<NT));     ENDW(t+1); RESC(); ROT();
  }
  STEP(pB0,pB1,pA0,pA1,NT-1,false,false,false); RESC();
  { float sacc=pB0[0]+pB0[1]; _Pragma("unroll") for(int r=2;r<16;++r)sacc+=pB0[r]; _Pragma("unroll") for(int r=0;r<16;++r)sacc+=pB1[r]; l_reg+=sacc;
    pw0=(u32x4){PKW(pB0,0),PKW(pB0,2),PKW(pB0,4),PKW(pB0,6)};pw1=(u32x4){PKW(pB0,8),PKW(pB0,10),PKW(pB0,12),PKW(pB0,14)};pw2=(u32x4){PKW(pB1,0),PKW(pB1,2),PKW(pB1,4),PKW(pB1,6)};pw3=(u32x4){PKW(pB1,8),PKW(pB1,10),PKW(pB1,12),PKW(pB1,14)};
    SBAR(); pv(o,vb0+sl_cur,PAF(0),PAF(1),PAF(2),PAF(3)); }
  #undef PKW
  #undef PAF
  #undef VFR
  #undef PIN
  #undef MX3
  #undef GAPA
  #undef GAPB
  #undef EX
  #undef VRD
  #undef KRD
  #undef STEP
  #undef ENDW
  {auto rr=__builtin_amdgcn_permlane32_swap(__float_as_uint(l_reg),__float_as_uint(l_reg),false,false);l_reg=__uint_as_float(rr[0])+__uint_as_float(rr[1]);}
  if(hi==0)wsf[32+r32]=l_reg;asm volatile("s_waitcnt lgkmcnt(0)":::"memory");
  float rli[16];
  #pragma unroll
  for(int r=0;r<16;++r)rli[r]=__builtin_amdgcn_rcpf(wsf[32+crow(r,hi)]);
  bf16*Ow=Ou+(long)(wid*QBLK)*OP;
  { bf16*stg=(bf16*)(shm+LDS_OST)+wid*2048;
    #pragma unroll
    for(int r=0;r<16;++r){const int orow=crow(r,hi);
      #pragma unroll
      for(int d0=0;d0<2;++d0)stg[orow*64+d0*32+r32]=__float2bfloat16(o[d0][r]*rli[r]);}
    asm volatile("s_waitcnt lgkmcnt(0)":::"memory");
    #pragma unroll
    for(int i=0;i<4;++i){const int row=i*8+(lane>>3),ch=lane&7; const u32x4 v=*(const u32x4*)(stg+row*64+ch*8); ATTN_STORE16(Ow+(long)row*OP+ch*8,v);} }
  asm volatile("s_waitcnt lgkmcnt(0)\n\ts_barrier":::"memory");
  #undef DMA_K
  #undef DMA_V
  #undef CMASK
  #undef START
  #undef RESC
  #undef ROT
}
constexpr int ATTN_LDS_BYTES=LDS_BYTES;
#undef SBAR
#undef WAIT_BAR
}

DEVI void attn_unit_run(const Ctx& c, int u) {
    using attn_body::bf16;
    const bf16* Qa = (const bf16*)(c.ws + WS_QA); const bf16* Qc = (const bf16*)(c.ws + WS_QC); const bf16* Ka = (const bf16*)(c.ws + WS_KA); const bf16* Va = (const bf16*)(c.ws + WS_VA);
    bf16* MIX = (bf16*)(c.ws + WS_MIX);
    if (u < 384) { const int grp = u / 48, rem = u % 48, g = rem >> 4, qb = rem & 15, b = grp >> 1, kvh = grp & 1, hq = kvh * 3 + g;
        attn_body::attn_unit<8>(Qa + (size_t)(b * SEQ + qb * 256) * 384 + hq * 64, Ka + (size_t)b * SKV * 128 + kvh * 64, Va + (size_t)b * SKV * 128 + kvh * 64, SKV / 64,
                                MIX + (size_t)(b * SEQ + qb * 256) * 1024 + 384 + hq * 64, (char*)c.lds); }
    else { const int uc = u - 384, b = uc / 6, hq = uc % 6, kvh = hq / 3;
        attn_body::attn_unit<8>(Qc + (size_t)(b * CTXL) * 384 + hq * 64, Ka + (size_t)b * SKV * 128 + kvh * 64, Va + (size_t)b * SKV * 128 + kvh * 64, CTXL / 64,
                                MIX + (size_t)(NLAT + b * CTXL) * 1024 + 384 + hq * 64, (char*)c.lds); }
}
template <bool FAST_SCAN>
DEVI void phase_mixer_fast(const Ctx& c, bool with_ctx, int psub = 0) {
    const int G = gridDim.x, bx = blockIdx.x; const int nunits = 384 + (with_ctx ? 24 : 0);
    if (G == 256) {
        const int vcu = (bx & 7) * 32 + (bx >> 3), x = vcu >> 5, j = vcu & 31;
        if (FAST_SCAN && j < 6) { if (!(psub & 4)) dn::scan_sequence(c, x * 6 + j); return; }
        if (psub & 8) return;
        if (!FAST_SCAN) { for (int u = vcu; u < nunits; u += 256) attn_unit_run(c, u); return; }
        const int jp = j - 6;
        attn_unit_run(c, 48 * x + jp);
        if (jp < 22) attn_unit_run(c, 48 * x + 26 + jp);
        else if (with_ctx && jp < 25) attn_unit_run(c, 384 + (x >> 1) * 6 + (x & 1) * 3 + (jp - 22));
    } else {
        if (FAST_SCAN) for (int sq = bx; sq < 48; sq += G) dn::scan_sequence(c, sq);
        for (int u = bx; u < nunits; u += G) attn_unit_run(c, u);
    }
}

DEVI void phase_moe_assign(const Ctx& c) {
    int* cnt = (int*)c.lds;
    int* misc = (int*)c.lds + 2048;
    int* slots = (int*)c.lds + 2048 + 64;
    const int* gcnt = (const int*)(c.ws + CTL_CNT); const int* tope = (const int*)(c.ws + CTL_TOPE);
    const bf16_t* H = (const bf16_t*)(c.ws + WS_H); bf16_t* XBm = (bf16_t*)(c.ws + WS_MXB);
    for (int i = c.tid; i < 2048; i += NTHREADS) cnt[i] = gcnt[i];
    __syncthreads();
    if (c.tid < 8) { int tot = 0; for (int v = 0; v < 256; ++v) tot += cnt[v * 8 + c.tid]; misc[8 + c.tid] = tot; }
    __syncthreads();
    if (c.tid == 0) { int s = 0; for (int e = 0; e < 8; ++e) { misc[16 + e] = s; s += (misc[8 + e] + 255) & ~255; } misc[24] = s;
        if (blockIdx.x == 0) { int* seg = (int*)(c.ws + CTL_SEG); for (int e = 0; e <= 8; ++e) seg[e] = misc[16 + e]; for (int e = 0; e < 8; ++e) seg[16 + e] = misc[8 + e];
            for (int e = 0; e < 8; ++e) for (int pm = misc[16 + e] >> 8; pm < (misc[16 + e + 1] >> 8); ++pm) seg[32 + pm] = e; } }
    __syncthreads();
    if (blockIdx.x == 0) {
        int* ut = (int*)(c.ws + CTL_UTAB); const int nu = (misc[24] >> 8) * 4, ntab = nu <= 512 ? nu : 512 + 4 * (nu - 512);
        if (c.tid == 0) ut[0] = ntab;
        for (int L = c.tid; L < ntab; L += NTHREADS) { const int unit = L < 512 ? L : 512 + ((L - 512) >> 2), pm = unit >> 2; int e = 0;
            for (int q = 1; q < 8; ++q) e += (pm * 256 >= misc[16 + q]) ? 1 : 0;
            ut[4 + 4 * L] = pm; ut[4 + 4 * L + 1] = (unit & 3) + 4 * e; ut[4 + 4 * L + 2] = L < 512 ? 0 : ((L - 512) & 3) * (MFF / 4); ut[4 + 4 * L + 3] = L < 512 ? 0 : MFF / 256; } }
    for (int vb = blockIdx.x; vb < 256; vb += gridDim.x) {
        int* sel = slots + 128;
        if (c.tid < 128) sel[c.tid] = tope[vb * 128 + c.tid];
        __syncthreads();
        if (c.tid < 8) { int bs = 0; for (int v = 0; v < vb; ++v) bs += cnt[v * 8 + c.tid];
            int rank = misc[16 + c.tid] + bs;
            for (int i = 0; i < 128; ++i) if (sel[i] == c.tid) { slots[i] = rank; ++rank; } }
        __syncthreads();
        if (c.tid < 128) ((int*)(c.ws + CTL_TOKSLOT))[vb * 128 + c.tid] = slots[c.tid];
        for (int a = c.wave; a < 128; a += NWAVES) { const int row = vb * 64 + (a >> 1); const int slot = slots[a];
            const u32x4* src = (const u32x4*)(H + (size_t)row * 1024) + c.lane; u32x4* dst = (u32x4*)(XBm + (size_t)slot * 1024) + c.lane; dst[0] = src[0]; dst[64] = src[64]; }
        __syncthreads();
    }
    for (int e = 0; e < 8; ++e) { const int p0 = misc[16 + e] + misc[8 + e], p1 = misc[16 + e + 1];
        for (int s = p0 + c.gw; s < p1; s += c.ngw) { u32x4* dst = (u32x4*)(XBm + (size_t)s * 1024) + c.lane; dst[0] = (u32x4){0u, 0u, 0u, 0u}; dst[64] = (u32x4){0u, 0u, 0u, 0u}; } }
}

DEVI u32x2 zsum3(const u32x2* z) { const u32x2 a = z[0], b = z[2048 * 256], d = z[2 * 2048 * 256]; u32x2 o;
    o.x = pk2(bflo(a.x) + bflo(b.x) + bflo(d.x), bfhi(a.x) + bfhi(b.x) + bfhi(d.x)); o.y = pk2(bflo(a.y) + bflo(b.y) + bflo(d.y), bfhi(a.y) + bfhi(b.y) + bfhi(d.y)); return o; }
DEVI void phase_final(const Ctx& c) {
    const float* xb = (const float*)(c.ws + WS_XB); const bf16_t* YB = (const bf16_t*)(c.ws + WS_MXB); const bf16_t* YB2 = (const bf16_t*)(c.ws + WS_YB2);
    const int* ts = (const int*)(c.ws + CTL_TOKSLOT); const float* tg = (const float*)(c.ws + CTL_TOPG);
    struct Sc { int s1, s2; float g1, g2; };
    struct Dt { u32x2 a[4], b[4], za[4], zb[4]; f32x4 x[4]; };
#define FIN_SC(sc, r) do { sc.s1 = ts[(r) * 2]; sc.s2 = ts[(r) * 2 + 1]; sc.g1 = tg[(r) * 2]; sc.g2 = tg[(r) * 2 + 1]; } while (0)
#define FIN_DT(dt, sc, r) do { const u32x2* y1_ = (const u32x2*)(YB + (size_t)sc.s1 * 1024) + c.lane; const u32x2* y2_ = (const u32x2*)(YB + (size_t)sc.s2 * 1024) + c.lane; \
        const u32x2* z1_ = (const u32x2*)(YB2 + (size_t)(sc.s1 >= 32768 ? sc.s1 - 32768 : 0) * 1024) + c.lane; const u32x2* z2_ = (const u32x2*)(YB2 + (size_t)(sc.s2 >= 32768 ? sc.s2 - 32768 : 0) * 1024) + c.lane; \
        const f32x4* xr_ = (const f32x4*)(xb + (size_t)(r) * 1024) + c.lane; \
        _Pragma("unroll") for (int j_ = 0; j_ < 4; ++j_) { dt.a[j_] = y1_[64 * j_]; dt.b[j_] = y2_[64 * j_]; dt.x[j_] = xr_[64 * j_]; \
            dt.za[j_] = sc.s1 >= 32768 ? zsum3(z1_ + 64 * j_) : (u32x2){0u, 0u}; dt.zb[j_] = sc.s2 >= 32768 ? zsum3(z2_ + 64 * j_) : (u32x2){0u, 0u}; } } while (0)
    int r = c.gw; if (r >= NLAT) return;
    Sc sc0, sc1, sc2; Dt d0, d1;
    FIN_SC(sc0, r); sc1 = sc0; sc2 = sc0;
    if (r + c.ngw < NLAT) FIN_SC(sc1, r + c.ngw);
    FIN_DT(d0, sc0, r); d1 = d0;
    for (; r < NLAT; r += c.ngw) {
        if (r + 2 * c.ngw < NLAT) FIN_SC(sc2, r + 2 * c.ngw);
        if (r + c.ngw < NLAT) FIN_DT(d1, sc1, r + c.ngw);
        const float g1 = sc0.g1, g2 = sc0.g2; const f32x4* gt = (const f32x4*)modv(c, 1, r, 5) + c.lane;
        f32x4 v[4]; float ss = 0.f;
#pragma unroll
        for (int j = 0; j < 4; ++j) { const u32x2 a = d0.a[j], b = d0.b[j], p = d0.za[j], q = d0.zb[j]; const f32x4 g = gt[64 * j]; f32x4 y;
            y.x = g1 * (bflo(a.x) + bflo(p.x)) + g2 * (bflo(b.x) + bflo(q.x)); y.y = g1 * (bfhi(a.x) + bfhi(p.x)) + g2 * (bfhi(b.x) + bfhi(q.x));
            y.z = g1 * (bflo(a.y) + bflo(p.y)) + g2 * (bflo(b.y) + bflo(q.y)); y.w = g1 * (bfhi(a.y) + bfhi(p.y)) + g2 * (bfhi(b.y) + bfhi(q.y));
            v[j] = d0.x[j] + g * y; ss += (v[j].x * v[j].x + v[j].y * v[j].y) + (v[j].z * v[j].z + v[j].w * v[j].w); }
        const float rstd = rsqrtf(wave_sum(ss) * (1.f / 1024.f) + EPS);
        const f32x4* fg = (const f32x4*)c.in[I_FNG] + c.lane; f32x4* o = (f32x4*)(c.out + (size_t)r * 1024) + c.lane;
#pragma unroll
        for (int j = 0; j < 4; ++j) o[64 * j] = v[j] * rstd * fg[64 * j];
        sc0 = sc1; sc1 = sc2; d0 = d1;
    }
#undef FIN_SC
#undef FIN_DT
}

#define LAS __attribute__((address_space(3)))
#define XB_TMO      128
#define XB_XCNT(j)  (256  + 64 * (j))
#define XB_XSUB(j)  (1280 + 64 * (j))
#define XB_XGEN(j)  (2304 + 64 * (j))
#define XB_TOP      3328
#define XB_TOPGEN   3392
#define XCD_BAR_WORDS 3456
#define XB_SPIN_CAP (1u << 18)

__device__ __forceinline__ unsigned xb_ld(unsigned* p)              { return __hip_atomic_load(p, __ATOMIC_RELAXED, __HIP_MEMORY_SCOPE_AGENT); }
__device__ __forceinline__ unsigned xb_add(unsigned* p, unsigned v) { return __hip_atomic_fetch_add(p, v, __ATOMIC_RELAXED, __HIP_MEMORY_SCOPE_AGENT); }
__device__ __forceinline__ unsigned xb_xcc_id() { return (unsigned)__builtin_amdgcn_s_getreg((3 << 11) | 20) & 0xFu; }
#define XB_SPIN(cond, bar) do { unsigned _sp = 0; while (cond) { __builtin_amdgcn_s_sleep(1); \
    if ((++_sp & 255u) == 0u) { if (xb_ld(&(bar)[XB_TMO])) break; if (_sp > XB_SPIN_CAP) { atomicAdd(&(bar)[XB_TMO], 1u); break; } } } } while (0)

struct XcdBarrier {
    unsigned* bar; unsigned x;
    volatile LAS unsigned* st;
};

__device__ __forceinline__ XcdBarrier xcd_barrier_post(unsigned* bar, volatile LAS unsigned* st) {
    XcdBarrier b; b.bar = bar; b.x = xb_xcc_id(); b.st = st;
    if (threadIdx.x == 0) (void)xb_add(&bar[XB_XCNT(b.x)], 1u);
    return b;
}
__device__ __forceinline__ void xcd_barrier_complete(unsigned* bar, unsigned x, unsigned& nloc, unsigned& nx) {
    const unsigned G = gridDim.x * gridDim.y * gridDim.z;
    unsigned sum, cnt, mine, sp = 0u;
    for (;;) {
        sum = 0u; cnt = 0u; mine = 0u;
#pragma unroll
        for (unsigned j = 0; j < 16; ++j) { const unsigned c = xb_ld(&bar[XB_XCNT(j)]); sum += c; cnt += (c > 0u) ? 1u : 0u; mine = (j == x) ? c : mine; }
        if (sum == G) break;
        __builtin_amdgcn_s_sleep(1);
        if ((++sp & 255u) == 0u) { if (xb_ld(&bar[XB_TMO])) break; if (sp > XB_SPIN_CAP) { atomicAdd(&bar[XB_TMO], 1u); break; } }
    }
    nloc = mine > 0u ? mine : 1u; nx = cnt > 0u ? cnt : 1u;
}

__device__ __forceinline__ void xcd_barrier(const XcdBarrier& b) {
    asm volatile("s_waitcnt vmcnt(0)" ::: "memory");
    __syncthreads();
    if (threadIdx.x == 0) {
        unsigned* bar = b.bar;
        __builtin_amdgcn_s_waitcnt(0);
        unsigned nloc = b.st[0], nx = b.st[1];
        if (nloc == 0u) { xcd_barrier_complete(bar, b.x, nloc, nx); b.st[0] = nloc; b.st[1] = nx; }
        const unsigned old = xb_add(&bar[XB_XSUB(b.x)], 1u);
        const unsigned gen = old / nloc;
        if (old + 1u == (gen + 1u) * nloc) {
            __builtin_amdgcn_fence(__ATOMIC_RELEASE, "agent");
            asm volatile("s_waitcnt vmcnt(0)" ::: "memory");
            const unsigned og = xb_add(&bar[XB_TOP], 1u);
            const unsigned tg = og / nx;
            if (og + 1u == (tg + 1u) * nx) xb_add(&bar[XB_TOPGEN], 1u);
            else XB_SPIN(xb_ld(&bar[XB_TOPGEN]) == tg, bar);
            __builtin_amdgcn_fence(__ATOMIC_ACQUIRE, "agent");
            xb_add(&bar[XB_XGEN(b.x)], 1u);
            asm volatile("s_waitcnt vmcnt(0)" ::: "memory");
        } else {
            XB_SPIN(xb_ld(&bar[XB_XGEN(b.x)]) == gen, bar);
            __builtin_amdgcn_fence(__ATOMIC_ACQUIRE, "agent");
            asm volatile("s_waitcnt vmcnt(0)" ::: "memory");
        }
    }
    __syncthreads();
}

#ifndef FAST_DN
#define FAST_DN 1
#endif
constexpr int NPHASES = 24;
#define IN(k) (lo <= (k) && (k) < hi)
#define SYNC(k) do { if (IN(k) && IN((k) + 1)) xcd_barrier(grid); } while (0)
template <int LAYER>
DEVI void mixer_phases(const Ctx& c, int lo, int hi, int psub, const XcdBarrier& grid) {
    constexpr int P = 1 + LAYER * 10;
    bf16_t* wl = (bf16_t*)(c.ws + WS_WL);
    const float* mvl = (const float*)(c.ws + CTL_MODV) + (size_t)LAYER * 5 * 6144;
    const float* xl = LAYER == 0 ? c.in[I_X] : (const float*)(c.ws + WS_XB); const float* xc = LAYER == 0 ? c.in[I_CTX] : (const float*)(c.ws + WS_XB) + (size_t)NLAT * 1024;
    if (IN(P)) { phase_norm<false>(c, LAYER, 0, c.in[I_N1G] + LAYER * 1024, NT, xl, xc, LAYER == 1 ? (const float*)(c.ws + WS_PB) : nullptr); } SYNC(P);
    if (IN(P + 1)) { const bf16_t* bt = (const bf16_t*)((char*)wl + WL_WIN) + (size_t)LAYER * ZP * 1024;
        pg8::Gemm g{(const bf16_t*)(c.ws + WS_H), bt, NT, ZP, 1024}; pg8::StaticOrder S; S.init(NT, ZP, (int)gridDim.x, (int)blockIdx.x);
        pg8::gemm_phase<pg8::EpiStore, pg8::StaticOrder, true, true>(c.lds3, g, S, pg8::EpiStore{(bf16_t*)(c.ws + WS_Z), ZP, 0, 0l}); } SYNC(P + 1);
    if (IN(P + 2)) { phase_prep(c, LAYER, LAYER == 0); } SYNC(P + 2);
#if FAST_DN
    if (IN(P + 3)) { if (!(psub & 1)) dn::phase_chunkprep(c); if (!(psub & 2)) phase_sgu(c, LAYER, LAYER == 0); } SYNC(P + 3);
    if (IN(P + 4)) { phase_mixer_fast<true>(c, LAYER == 0, psub); } SYNC(P + 4);
#else
    if (IN(P + 3)) { phase_sgu(c, LAYER, LAYER == 0); } SYNC(P + 3);
    if (IN(P + 4)) { phase_dnscan_naive(c); phase_mixer_fast<false>(c, LAYER == 0); } SYNC(P + 4);
#endif
    if (IN(P + 5)) { phase_dnfinish(c, LAYER, LAYER == 0 ? NT : NLAT); } SYNC(P + 5);
    if (IN(P + 6)) { const bf16_t* bt = (const bf16_t*)((char*)wl + WL_WOUT) + (size_t)LAYER * 1024 * 1024;
        constexpr int MR = LAYER == 0 ? NT : NLAT;
        pg8::Gemm g{(const bf16_t*)(c.ws + WS_MIX), bt, MR, 1024, 1024}; pg8::StaticOrder S; S.init(MR, 1024, (int)gridDim.x, (int)blockIdx.x);
        pg8::gemm_phase<pg8::EpiRes, pg8::StaticOrder, true, true>(c.lds3, g, S, pg8::EpiRes{(float*)(c.ws + WS_XB), mvl, 2, xl, xc, nullptr}); } SYNC(P + 6);
}

__global__ void __launch_bounds__(NTHREADS, 2) mega_fwd(Args args) {
    extern __shared__ __attribute__((aligned(16))) unsigned char lds_raw[];
    Ctx c;
#pragma unroll
    for (int i = 0; i < 28; ++i) c.in[i] = args.in[i];
    c.out = args.out; c.ws = args.ws; c.tid = threadIdx.x; c.lane = c.tid & 63; c.wave = __builtin_amdgcn_readfirstlane(c.tid >> 6);
    c.gw = blockIdx.x * NWAVES + c.wave; c.ngw = gridDim.x * NWAVES; c.lds = (float*)lds_raw; c.lds3 = (__attribute__((address_space(3))) unsigned char*)lds_raw;
    bf16_t* wl = (bf16_t*)(c.ws + WS_WL);
    const int lo = args.ph_lo, hi = args.ph_hi;
    volatile LAS unsigned* bst = (volatile LAS unsigned*)(c.lds3 + LDS_BYTES - 64);
    if (c.tid < 16) bst[c.tid] = 0u;
    __syncthreads();
    const XcdBarrier grid = xcd_barrier_post((unsigned*)(c.ws + WS_CTL), bst);
    if (IN(0)) { phase_prologue(c); } SYNC(0);
    mixer_phases<0>(c, lo, hi, args.probe_sub, grid);
    {
        const float* mvl = (const float*)(c.ws + CTL_MODV);
        const float* xbl = (const float*)(c.ws + WS_XB); const float* xbc = xbl + (size_t)NLAT * 1024;
        if (IN(8)) { phase_norm<false>(c, 0, 3, c.in[I_N2G], NT, xbl, xbc); } SYNC(8);
        if (IN(9)) { pg8::Gemm g{(const bf16_t*)(c.ws + WS_H), (const bf16_t*)((char*)wl + WL_F13), NT, 2 * FF, 1024}; pg8::StaticOrder S; S.init(NT, 2 * FF, (int)gridDim.x, (int)blockIdx.x);
            pg8::gemm_phase<pg8::EpiSwi, pg8::StaticOrder, true, true>(c.lds3, g, S, pg8::EpiSwi{(bf16_t*)(c.ws + WS_Z), FF, 0}); } SYNC(9);
        if (IN(10)) { pg8::Gemm g{(const bf16_t*)(c.ws + WS_Z), (const bf16_t*)((char*)wl + WL_F2), NT, 1024, FF}; pg8::FfnDownOrder S; S.init((int)gridDim.x, (int)blockIdx.x);
            pg8::gemm_phase<pg8::EpiRes, pg8::FfnDownOrder, true, true>(c.lds3, g, S, pg8::EpiRes{(float*)(c.ws + WS_XB), mvl, 5, xbl, xbc, (float*)(c.ws + WS_PB)}); } SYNC(10);
    }
    mixer_phases<1>(c, lo, hi, args.probe_sub, grid);
    {
        if (IN(18)) { const float* xbl = (const float*)(c.ws + WS_XB);
            if (gridDim.x == 256) {
                if (c.wave < 4) phase_norm<true>(c, 1, 3, c.in[I_N2G] + 1024, NLAT, xbl, xbl + (size_t)NLAT * 1024, nullptr, 16);
                else { phase_conv_m13(c, (int)blockIdx.x * 4 + (c.wave - 4), 1024); phase_conv_m2(c, (int)blockIdx.x * 4 + (c.wave - 4), 1024); }
                __syncthreads();
                if (c.tid < 8) { const int* sel = (const int*)c.lds; int n = 0; for (int q = 0; q < 128; ++q) n += (sel[q] == c.tid) ? 1 : 0; ((int*)(c.ws + CTL_CNT))[blockIdx.x * 8 + c.tid] = n; }
            } else { phase_norm<true>(c, 1, 3, c.in[I_N2G] + 1024, NLAT, xbl, xbl + (size_t)NLAT * 1024); phase_conv_m13(c); phase_conv_m2(c); } } SYNC(18);
        if (IN(19)) { phase_moe_assign(c); } SYNC(19);
        if (IN(20)) { pg8::Gemm g{(const bf16_t*)(c.ws + WS_MXB), (const bf16_t*)(c.ws + WS_M13), 0, 0, 1024}; pg8::MoeOrder S; S.init((const int*)(c.ws + CTL_SEG), 28, (int)gridDim.x, (int)blockIdx.x);
            pg8::gemm_phase<pg8::EpiSwi, pg8::MoeOrder, true, true>(c.lds3, g, S, pg8::EpiSwi{(bf16_t*)(c.ws + WS_MHID), MFF, 28}); } SYNC(20);
        if (IN(22)) { pg8::Gemm g{(const bf16_t*)(c.ws + WS_MHID), (const bf16_t*)c.out, 0, 0, MFF}; pg8::TableOrder S; S.init((const int*)(c.ws + CTL_UTAB), (int)gridDim.x, (int)blockIdx.x);
            pg8::gemm_phase<pg8::EpiStore, pg8::TableOrder, true, true>(c.lds3, g, S, pg8::EpiStore{(bf16_t*)(c.ws + WS_MXB), 1024, 4, (long)((WS_YB2 - WS_MXB) / 2) - 32768l * 1024}); } SYNC(22);
        if (IN(23)) { phase_final(c); }
    }
}
#undef IN
#undef SYNC

extern "C" void kernel_launch(void* const* d_in, const int* in_sizes, int n_in, void* d_out, int out_size, void* d_ws, size_t ws_size, hipStream_t stream) {
    static int grid = 0;
    if (grid == 0) {
        if (n_in != 28 || out_size != NLAT * D || ws_size < WS_END) { fprintf(stderr, "kernel_launch: unexpected shapes (n_in %d out %d ws %zu)\n", n_in, out_size, ws_size); grid = -1; return; }
        int dev = 0, cus = 0, per_cu = 0;
        hipGetDevice(&dev); hipDeviceGetAttribute(&cus, hipDeviceAttributeMultiprocessorCount, dev);
        hipFuncSetAttribute((const void*)mega_fwd, hipFuncAttributeMaxDynamicSharedMemorySize, LDS_BYTES);
        hipOccupancyMaxActiveBlocksPerMultiprocessor(&per_cu, (const void*)mega_fwd, NTHREADS, LDS_BYTES);
        if (per_cu < 1) { fprintf(stderr, "kernel_launch: occupancy query says %d blocks per CU\n", per_cu); per_cu = 1; }
        (void)hipGetLastError();
        grid = cus;
    }
    if (grid < 0) return;
    if (hipMemsetAsync(d_ws, 0, 16384, stream) != hipSuccess) { fprintf(stderr, "kernel_launch: memset of the barrier words failed\n"); return; }
    Args a{};
    for (int i = 0; i < 28; ++i) a.in[i] = (const float*)d_in[i];
    a.out = (float*)d_out; a.ws = (unsigned char*)d_ws;
#ifndef MK_PER_PHASE
#define MK_PER_PHASE 0
#endif
#if MK_PER_PHASE
    for (int ph = 0; ph < NPHASES; ++ph) {
        a.ph_lo = ph; a.ph_hi = ph + 1; void* kargs[] = {&a};
        hipError_t e = hipLaunchCooperativeKernel((const void*)mega_fwd, dim3(grid), dim3(NTHREADS), kargs, LDS_BYTES, stream);
        if (e != hipSuccess) { fprintf(stderr, "launch failed: %s\n", hipGetErrorString(e)); break; }
    }
#else
    a.ph_lo = 0; a.ph_hi = NPHASES; void* kargs[] = {&a};
    hipError_t e = hipLaunchCooperativeKernel((const void*)mega_fwd, dim3(grid), dim3(NTHREADS), kargs, LDS_BYTES, stream);
    if (e != hipSuccess) fprintf(stderr, "launch failed: %s\n", hipGetErrorString(e));
#ifndef PROBE_LO
#define PROBE_LO -1
#define PROBE_HI -1
#endif
#if PROBE_LO >= 0
    (void)hipMemsetAsync(d_ws, 0, 16384, stream);
    a.ph_lo = PROBE_LO; a.ph_hi = PROBE_HI;
#ifdef PROBE_SUB
    a.probe_sub = PROBE_SUB;
#endif
    e = hipLaunchCooperativeKernel((const void*)mega_fwd, dim3(grid), dim3(NTHREADS), kargs, LDS_BYTES, stream);
    if (e != hipSuccess) fprintf(stderr, "probe launch failed: %s\n", hipGetErrorString(e));
#endif
#endif
}
```

```cpp
#include <hip/hip_runtime.h>
#include <hip/hip_cooperative_groups.h>
#include <hip/hip_bf16.h>
#include <cstdio>
#include <cstdint>
namespace cg = cooperative_groups;

#define DEVI __device__ __forceinline__
typedef unsigned short bf16_t;
typedef float f32x4 __attribute__((ext_vector_type(4)));
typedef float f32x2 __attribute__((ext_vector_type(2)));
typedef unsigned u32x4 __attribute__((ext_vector_type(4)));
typedef unsigned u32x2 __attribute__((ext_vector_type(2)));

constexpr int D = 1024, NB = 4, SEQ = 4096, CTXL = 256;
constexpr int NLAT = NB * SEQ, NCTX = NB * CTXL, NT = NLAT + NCTX;
constexpr int SKV = CTXL + SEQ;
constexpr int INC = 2712, ZP = 2816;
constexpr int ZC_QKV = 0, ZC_GATE = 1152, ZC_AQ = 1536, ZC_AK = 1920, ZC_AV = 2048, ZC_MU = 2176, ZC_MV = 2432, ZC_BETA = 2688, ZC_ALPHA = 2700;
constexpr int FF = 2816, MFF = 3584, NE = 8;
constexpr int MAXSLOT = 34816;
constexpr float EPS = 1e-6f;
constexpr float QSCALE = 0.125f * 1.4426950408889634f;

constexpr size_t MiB = 1u << 20, KiB = 1024;
constexpr size_t WS_CTL = 0;
constexpr size_t CTL_ROPE = 32 * KiB;
constexpr size_t CTL_MODV = 64 * KiB;
constexpr size_t CTL_TOPE = 320 * KiB;
constexpr size_t CTL_TOPG = 448 * KiB;
constexpr size_t CTL_CNT = 576 * KiB;
constexpr size_t CTL_SEG = 584 * KiB;
constexpr size_t CTL_TOKSLOT = 592 * KiB;
constexpr size_t CTL_UTAB = 720 * KiB;
constexpr size_t WS_XB = 4 * MiB;
constexpr size_t WS_WL = 72 * MiB;
constexpr size_t WL_WIN = 0;
constexpr size_t WL_WOUT = 11 * MiB;
constexpr size_t WL_F13 = 15 * MiB;
constexpr size_t WL_F2 = 26 * MiB;
static_assert(WL_WIN + (size_t)2 * 2816 * 1024 * 2 <= WL_WOUT && WL_WOUT + (size_t)2 * 1024 * 1024 * 2 <= WL_F13 && WL_F13 + (size_t)5632 * 1024 * 2 <= WL_F2 && WS_WL + WL_F2 + (size_t)1024 * 2816 * 2 <= 104 * MiB, "WL map");
constexpr size_t WS_H = 104 * MiB;
constexpr size_t WS_Z = 138 * MiB;
constexpr size_t WS_MIX = 232 * MiB;
constexpr size_t WS_QA = 266 * MiB;
constexpr size_t WS_QC = 278 * MiB;
constexpr size_t WS_KA = 279 * MiB;
constexpr size_t WS_VA = 284 * MiB;
constexpr size_t WS_DN = 289 * MiB;
constexpr size_t WS_QN = WS_H, WS_KN = WS_H + 13 * MiB;
constexpr size_t DN_VB = 0;
constexpr size_t DN_BG = 13 * MiB;
constexpr size_t DN_O = 15 * MiB;
constexpr size_t WS_SV = 499 * MiB;
constexpr size_t DN_OPS = 66 * MiB;
static_assert(WS_DN + DN_OPS + (size_t)3264 * 46080 <= WS_SV && WS_SV + (size_t)NT * 256 * 2 <= 512 * MiB, "ws");
constexpr size_t WS_MHID = 72 * MiB;
constexpr size_t WS_MXB = 310 * MiB;
constexpr size_t WS_M13 = 378 * MiB;
constexpr size_t WS_M2 = 378 * MiB;
constexpr size_t WS_PB = 232 * MiB;
constexpr size_t WS_YB2 = 440 * MiB;
constexpr size_t WS_END = 512 * MiB;
static_assert(WS_M13 + (size_t)8 * 7168 * 1024 * 2 <= WS_END, "ws");
static_assert(WS_MHID + (size_t)MAXSLOT * 3584 * 2 <= WS_MXB && WS_MXB + (size_t)MAXSLOT * 1024 * 2 <= WS_M13, "ws");
static_assert(WS_H + (size_t)NT * 1024 * 2 <= WS_Z && WS_Z + (size_t)NT * ZP * 2 <= WS_MIX && WS_MIX + (size_t)NT * 1024 * 2 <= WS_QA, "ws");

constexpr int LDS_BYTES = 147456;
constexpr int NTHREADS = 512, NWAVES = 8;

DEVI unsigned f2bf(float f) { unsigned u = __float_as_uint(f); return (u + 0x7fffu + ((u >> 16) & 1u)) >> 16; }
DEVI float bf2f(unsigned h) { return __uint_as_float(h << 16); }
DEVI unsigned pk2(float lo, float hi) { return f2bf(lo) | (f2bf(hi) << 16); }
DEVI float bflo(unsigned w) { return __uint_as_float(w << 16); }
DEVI float bfhi(unsigned w) { return __uint_as_float(w & 0xffff0000u); }
DEVI void unpack8(const u32x4 w, float* v) { v[0] = bflo(w.x); v[1] = bfhi(w.x); v[2] = bflo(w.y); v[3] = bfhi(w.y); v[4] = bflo(w.z); v[5] = bfhi(w.z); v[6] = bflo(w.w); v[7] = bfhi(w.w); }
DEVI u32x4 pack8(const float* v) { u32x4 w; w.x = pk2(v[0], v[1]); w.y = pk2(v[2], v[3]); w.z = pk2(v[4], v[5]); w.w = pk2(v[6], v[7]); return w; }
DEVI float wave_sum(float v) {
#pragma unroll
    for (int o = 1; o < 64; o <<= 1) v += __shfl_xor(v, o);
    return v;
}
DEVI float wave_max(float v) {
#pragma unroll
    for (int o = 1; o < 64; o <<= 1) v = fmaxf(v, __shfl_xor(v, o));
    return v;
}
DEVI float silu_f(float x) { return x * __builtin_amdgcn_rcpf(1.f + __expf(-x)); }
DEVI float gelu_f(float x) { const float u = 0.7978845608028654f * (x + 0.044715f * x * x * x); const float e = __expf(2.f * u); return x * (1.f - __builtin_amdgcn_rcpf(1.f + e)); }
DEVI float softplus_f(float x) { const float e = __expf(-fabsf(x)); const float l = e < 0.01f ? e * (1.f - e * (0.5f - e * 0.33333334f)) : __logf(1.f + e); return fmaxf(x, 0.f) + l; }
DEVI int row_mod(int r) { return r < NLAT ? (r >> 12) : 4; }

struct Args { const float* in[28]; float* out; unsigned char* ws; int ph_lo, ph_hi, probe_sub, pad; };

struct Ctx {
    const float* in[28]; float* out; unsigned char* ws;
    int tid, lane, wave, gw, ngw;
    float* lds;
    __attribute__((address_space(3))) unsigned char* lds3;
};
enum { I_X = 0, I_C, I_CTX, I_CCTX, I_MODW, I_MODB, I_N1G, I_N2G, I_WIN, I_CONVW, I_ALOG, I_DTB, I_DNG, I_QG, I_KG, I_SGUG, I_SGUW, I_SGUB, I_WOUT,
       I_F1, I_F3, I_F2, I_RW, I_RB, I_M1, I_M3, I_M2, I_FNG };

DEVI const float* modv(const Ctx& c, int layer, int r, int which) { return (const float*)(c.ws + CTL_MODV) + ((size_t)(layer * 5 + row_mod(r)) * 6 + which) * 1024; }

template <int MAP>
DEVI int map_row(int n, int add) {
    if (MAP == 1) return n < 1536 ? n : (n < 1560 ? n + 1152 : n - 24);
    if (MAP == 2) return (n >> 7) * 256 + (n & 127) + add;
    return n;
}
template <int MAP>
DEVI void transpose_tiles(const Ctx& c, const float* W, int K, int N, bf16_t* WT, int add, int& base, int wv = -1, int nwv = 0) {
    float* Ls = c.lds + c.wave * (64 * 65);
    const int ntn = (N + 63) / 64, ntiles = (K / 64) * ntn, G = wv < 0 ? c.ngw : nwv, wid = wv < 0 ? c.gw : wv;
    const int nq = c.lane & 15, kr = c.lane >> 4, cch = c.lane & 7, rn = c.lane >> 3;
    int t = (wid - base % G + G) % G;
    base += ntiles;
    f32x4 v[16];
#define TT_LOAD(tile) do { const int kb_ = (tile) / ntn, nb_ = (tile) % ntn, n_ = nb_ * 64 + 4 * nq; \
        _Pragma("unroll") for (int p_ = 0; p_ < 16; ++p_) v[p_] = n_ < N ? __builtin_nontemporal_load((const f32x4*)(W + (size_t)(kb_ * 64 + kr + 4 * p_) * N + n_)) : (f32x4){0.f, 0.f, 0.f, 0.f}; } while (0)
    if (t < ntiles) TT_LOAD(t);
    for (; t < ntiles; t += G) {
#pragma unroll
        for (int p = 0; p < 16; ++p) { float* q = Ls + (kr + 4 * p) * 65 + 4 * nq; q[0] = v[p].x; q[1] = v[p].y; q[2] = v[p].z; q[3] = v[p].w; }
        if (t + G < ntiles) TT_LOAD(t + G);
        __builtin_amdgcn_wave_barrier(); asm volatile("" ::: "memory");
        const int kb = t / ntn, nb = t % ntn;
#pragma unroll
        for (int j = 0; j < 8; ++j) { const int nl = 8 * j + rn, n = nb * 64 + nl; float x[8];
#pragma unroll
            for (int i = 0; i < 8; ++i) x[i] = Ls[(8 * cch + i) * 65 + nl];
            if (n < N) *(u32x4*)(WT + (size_t)map_row<MAP>(n, add) * K + kb * 64 + 8 * cch) = pack8(x); }
        __builtin_amdgcn_wave_barrier(); asm volatile("" ::: "memory");
    }
#undef TT_LOAD
}

DEVI void phase_prologue(const Ctx& c) {
    bf16_t* wl = (bf16_t*)(c.ws + WS_WL);
    int tb = 0;
    for (int l = 0; l < 2; ++l) {
        transpose_tiles<1>(c, c.in[I_WIN] + (size_t)l * 1024 * INC, 1024, INC, (bf16_t*)((char*)wl + WL_WIN) + (size_t)l * ZP * 1024, 0, tb);
        transpose_tiles<0>(c, c.in[I_WOUT] + (size_t)l * 1024 * 1024, 1024, 1024, (bf16_t*)((char*)wl + WL_WOUT) + (size_t)l * 1024 * 1024, 0, tb);
        u32x4* pad = (u32x4*)((bf16_t*)((char*)wl + WL_WIN) + (size_t)l * ZP * 1024 + (size_t)INC * 1024);
        for (int i = c.gw * 64 + c.lane; i < (ZP - INC) * 1024 / 8; i += c.ngw * 64) pad[i] = (u32x4){0u, 0u, 0u, 0u};
    }
    transpose_tiles<2>(c, c.in[I_F1], 1024, FF, (bf16_t*)((char*)wl + WL_F13), 0, tb);
    transpose_tiles<2>(c, c.in[I_F3], 1024, FF, (bf16_t*)((char*)wl + WL_F13), 128, tb);
    transpose_tiles<0>(c, c.in[I_F2], FF, 1024, (bf16_t*)((char*)wl + WL_F2), 0, tb);
    if (blockIdx.x == 0) for (int i = c.tid; i < 2 * 64 * 16; i += NTHREADS) { const int p = i & 15, pos = (i >> 4) & 63, ax = i >> 10;
        const float ang = (float)pos * powf(10000.f, -2.f * (float)p / 32.f); float* tp = (float*)(c.ws + CTL_ROPE) + (ax * 64 + pos) * 32; tp[p] = cosf(ang); tp[16 + p] = sinf(ang); }
    if (blockIdx.x == 0 && c.tid < 32) ((float*)(c.ws + CTL_ROPE))[128 * 32 + c.tid] = c.tid < 16 ? 1.f : 0.f;
    __syncthreads();
    {
        float* sc = c.lds;
        float* part = c.lds + 5 * 1024;
        for (int i = c.tid; i < 5 * 1024; i += NTHREADS) { const int r = i >> 10, k = i & 1023; const float v = r < 4 ? c.in[I_C][r * 1024 + k] : c.in[I_CCTX][k]; sc[i] = silu_f(v); }
        __syncthreads();
        for (int item = blockIdx.x; item < 2 * 96; item += gridDim.x) {
            const int l = item / 96, j = (item % 96) * 64 + c.lane;
            const float* w = c.in[I_MODW] + (size_t)l * 1024 * 6144 + j;
            float a0 = 0.f, a1 = 0.f, a2 = 0.f, a3 = 0.f, a4 = 0.f;
            const int kb = c.wave * 128;
#pragma unroll 4
            for (int k = 0; k < 128; ++k) { const float wv = w[(size_t)(kb + k) * 6144]; a0 += sc[kb + k] * wv; a1 += sc[1024 + kb + k] * wv; a2 += sc[2048 + kb + k] * wv; a3 += sc[3072 + kb + k] * wv; a4 += sc[4096 + kb + k] * wv; }
            float* p = part + c.wave * 320 + c.lane; p[0] = a0; p[64] = a1; p[128] = a2; p[192] = a3; p[256] = a4;
            __syncthreads();
            if (c.tid < 320) { float s = 0.f;
#pragma unroll
                for (int w8 = 0; w8 < 8; ++w8) s += part[w8 * 320 + c.tid];
                const int r = c.tid >> 6, jj = (item % 96) * 64 + (c.tid & 63);
                ((float*)(c.ws + CTL_MODV))[(size_t)(l * 5 + r) * 6144 + jj] = s + c.in[I_MODB][l * 6144 + jj]; }
            __syncthreads();
        }
    }
}

DEVI void phase_conv_m13(const Ctx& c, int wv = -1, int nwv = 0) {
    int tb = 0;
    for (int e = 0; e < NE; ++e) {
        bf16_t* dst = (bf16_t*)(c.ws + WS_M13) + (size_t)e * 7168 * 1024;
        transpose_tiles<2>(c, c.in[I_M1] + (size_t)e * 1024 * MFF, 1024, MFF, dst, 0, tb, wv, nwv);
        transpose_tiles<2>(c, c.in[I_M3] + (size_t)e * 1024 * MFF, 1024, MFF, dst, 128, tb, wv, nwv);
    }
}
DEVI void phase_conv_m2(const Ctx& c, int wv = -1, int nwv = 0, int e0 = 0, int e1 = NE) {
    int tb = 0;
    for (int e = e0; e < e1; ++e)
        transpose_tiles<0>(c, c.in[I_M2] + (size_t)e * MFF * 1024, MFF, 1024, (bf16_t*)c.out + (size_t)e * 1024 * MFF, 0, tb, wv, nwv);
}

template <bool ROUTER>
DEVI void phase_norm(const Ctx& c, int layer, int which0, const float* gain, int nrows, const float* src_lat, const float* src_ctx, const float* addp = nullptr, int rpw = 8) {
    bf16_t* H = (bf16_t*)(c.ws + WS_H);
#define NORM_ROW(rr) ((rr) < NLAT ? src_lat + (size_t)(rr) * 1024 : src_ctx + (size_t)((rr) - NLAT) * 1024)
    int* sel = (int*)c.lds;
    const int nvb = nrows / 64;
    int vb = blockIdx.x, i = 0;
    int r = ROUTER ? vb * 64 + c.wave * rpw : c.gw;
    bool valid = ROUTER ? (vb < nvb && c.wave * rpw < 64) : (r < nrows);
    f32x4 v[4];
    if (valid) { const f32x4* xr = (const f32x4*)NORM_ROW(r) + c.lane;
#pragma unroll
        for (int j = 0; j < 4; ++j) v[j] = xr[64 * j]; }
    while (valid) {
        int rn, vbn = vb, in_ = i + 1; bool validn;
        if (ROUTER) { if (in_ == rpw) { in_ = 0; vbn = vb + gridDim.x; } rn = vbn * 64 + c.wave * rpw + in_; validn = vbn < nvb; }
        else { rn = r + c.ngw; validn = rn < nrows; }
        f32x4 vn[4];
        if (validn) { const f32x4* xr = (const f32x4*)NORM_ROW(rn) + c.lane;
#pragma unroll
            for (int j = 0; j < 4; ++j) vn[j] = xr[64 * j]; }
        if (addp && r >= NLAT) { const f32x4* pr = (const f32x4*)(addp + (size_t)(r - NLAT) * 1024) + c.lane;
#pragma unroll
            for (int j = 0; j < 4; ++j) v[j] = v[j] + (pr[64 * j] + pr[64 * j + 262144] + pr[64 * j + 524288]); }
        float ss = 0.f;
#pragma unroll
        for (int j = 0; j < 4; ++j) ss += (v[j].x * v[j].x + v[j].y * v[j].y) + (v[j].z * v[j].z + v[j].w * v[j].w);
        const float rstd = rsqrtf(wave_sum(ss) * (1.f / 1024.f) + EPS);
        const f32x4* g4 = (const f32x4*)gain + c.lane; const f32x4* sh4 = (const f32x4*)modv(c, layer, r, which0) + c.lane; const f32x4* sc4 = (const f32x4*)modv(c, layer, r, which0 + 1) + c.lane;
        u32x2* o8 = (u32x2*)(H + (size_t)r * 1024) + c.lane;
#pragma unroll
        for (int j = 0; j < 4; ++j) { const f32x4 g = g4[64 * j], sh = sh4[64 * j], sc = sc4[64 * j];
            v[j] = v[j] * rstd * g * (1.f + sc) + sh;
            u32x2 o; o.x = pk2(v[j].x, v[j].y); o.y = pk2(v[j].z, v[j].w); o8[64 * j] = o; }
        if (ROUTER) {
            float lg[8];
#pragma unroll
            for (int e = 0; e < 8; ++e) lg[e] = 0.f;
            const float* rw = c.in[I_RW];
#pragma unroll
            for (int j = 0; j < 4; ++j)
#pragma unroll
                for (int q = 0; q < 4; ++q) { const int col = 4 * c.lane + 256 * j + q; const f32x4 w0 = *(const f32x4*)(rw + col * 8), w1 = *(const f32x4*)(rw + col * 8 + 4); const float hv = v[j][q];
                    lg[0] += hv * w0.x; lg[1] += hv * w0.y; lg[2] += hv * w0.z; lg[3] += hv * w0.w; lg[4] += hv * w1.x; lg[5] += hv * w1.y; lg[6] += hv * w1.z; lg[7] += hv * w1.w; }
#pragma unroll
            for (int e = 0; e < 8; ++e) lg[e] = wave_sum(lg[e]) + c.in[I_RB][e];
            int e1 = 0; float l1 = lg[0];
#pragma unroll
            for (int e = 1; e < 8; ++e) if (lg[e] > l1) { l1 = lg[e]; e1 = e; }
            int e2 = -1; float l2 = -3.0e38f;
#pragma unroll
            for (int e = 0; e < 8; ++e) if (e != e1 && lg[e] > l2) { l2 = lg[e]; e2 = e; }
            const float g2 = 1.f / (1.f + expf(l1 - l2)), g1 = 1.f - g2;
            if (c.lane == 0) { int* te = (int*)(c.ws + CTL_TOPE) + r * 2; te[0] = e1; te[1] = e2; float* tg = (float*)(c.ws + CTL_TOPG) + r * 2; tg[0] = g1; tg[1] = g2;
                sel[(c.wave * rpw + i) * 2] = e1; sel[(c.wave * rpw + i) * 2 + 1] = e2; }
            if (rpw == 8 && i == 7) {
                __syncthreads();
                if (c.tid < 8) { int n = 0; for (int q = 0; q < 128; ++q) n += (sel[q] == c.tid) ? 1 : 0; ((int*)(c.ws + CTL_CNT))[vb * 8 + c.tid] = n; }
                __syncthreads();
            }
        }
#pragma unroll
        for (int j = 0; j < 4; ++j) v[j] = vn[j];
        r = rn; vb = vbn; i = in_; valid = validn;
    }
}

DEVI void norm_router_rows16(const Ctx& c, const float* gain, const float* src, const f32x4* rwl, int* sel) {
    bf16_t* H = (bf16_t*)(c.ws + WS_H);
    const int r0 = blockIdx.x * 64 + c.wave * 16;
    const f32x4* g4 = (const f32x4*)gain + c.lane; const f32x4* sh4 = (const f32x4*)modv(c, 1, r0, 3) + c.lane; const f32x4* sc4 = (const f32x4*)modv(c, 1, r0, 4) + c.lane;
    auto ld = [&](f32x4 (&v)[4], const int i) __attribute__((always_inline)) { const f32x4* xr = (const f32x4*)(src + (size_t)(r0 + i) * 1024) + c.lane;
#pragma unroll
        for (int j = 0; j < 4; ++j) v[j] = xr[64 * j]; };
    auto row = [&](f32x4 (&v)[4], const int i) __attribute__((always_inline)) {
        const int r = r0 + i; float ss = 0.f;
#pragma unroll
        for (int j = 0; j < 4; ++j) ss += (v[j].x * v[j].x + v[j].y * v[j].y) + (v[j].z * v[j].z + v[j].w * v[j].w);
        const float rstd = rsqrtf(wave_sum(ss) * (1.f / 1024.f) + EPS);
        u32x2* o8 = (u32x2*)(H + (size_t)r * 1024) + c.lane;
#pragma unroll
        for (int j = 0; j < 4; ++j) { const f32x4 g = g4[64 * j], sh = sh4[64 * j], sc = sc4[64 * j];
            v[j] = v[j] * rstd * g * (1.f + sc) + sh;
            u32x2 o; o.x = pk2(v[j].x, v[j].y); o.y = pk2(v[j].z, v[j].w); o8[64 * j] = o; }
        float lg[8];
#pragma unroll
        for (int e = 0; e < 8; ++e) lg[e] = 0.f;
#pragma unroll
        for (int j = 0; j < 4; ++j)
#pragma unroll
            for (int q = 0; q < 4; ++q) { const f32x4 w0 = rwl[((4 * j + q) * 2) * 64 + c.lane], w1 = rwl[((4 * j + q) * 2 + 1) * 64 + c.lane]; const float hv = v[j][q];
                lg[0] += hv * w0.x; lg[1] += hv * w0.y; lg[2] += hv * w0.z; lg[3] += hv * w0.w; lg[4] += hv * w1.x; lg[5] += hv * w1.y; lg[6] += hv * w1.z; lg[7] += hv * w1.w; }
#pragma unroll
        for (int e = 0; e < 8; ++e) lg[e] = wave_sum(lg[e]) + c.in[I_RB][e];
        int e1 = 0; float l1 = lg[0];
#pragma unroll
        for (int e = 1; e < 8; ++e) if (lg[e] > l1) { l1 = lg[e]; e1 = e; }
        int e2 = -1; float l2 = -3.0e38f;
#pragma unroll
        for (int e = 0; e < 8; ++e) if (e != e1 && lg[e] > l2) { l2 = lg[e]; e2 = e; }
        const float g2 = 1.f / (1.f + expf(l1 - l2)), g1 = 1.f - g2;
        if (c.lane == 0) { int* te = (int*)(c.ws + CTL_TOPE) + r * 2; te[0] = e1; te[1] = e2; float* tg = (float*)(c.ws + CTL_TOPG) + r * 2; tg[0] = g1; tg[1] = g2;
            sel[(c.wave * 16 + i) * 2] = e1; sel[(c.wave * 16 + i) * 2 + 1] = e2; }
    };
    f32x4 A[4], B[4], C[4];
    ld(A, 0); ld(B, 1); ld(C, 2);
    for (int i = 0; i < 15; i += 3) { row(A, i); ld(A, i + 3); row(B, i + 1); if (i + 4 < 16) ld(B, i + 4); row(C, i + 2); if (i + 5 < 16) ld(C, i + 5); }
    row(A, 15);
}

#undef NORM_ROW
template <bool DUAL, class BSel, class Epi>
DEVI void gemm_naive(const Ctx& c, const bf16_t* A, int lda, int K, int ntm, int ntn, const BSel& bsel, const Epi& epi) {
    float* As = c.lds; float* Bs = c.lds + 32 * 132; float* Bs2 = c.lds + 2 * 32 * 132;
    const int ty = c.tid >> 4, tx = c.tid & 15, lr = c.tid >> 2, lk = (c.tid & 3) * 8;
    for (int tile = blockIdx.x; tile < ntm * ntn; tile += gridDim.x) {
        const int tm = tile / ntn, tn = tile % ntn;
        const bf16_t* B0 = bsel(tm, tn, 0); if (!B0) continue;
        const bf16_t* B1 = DUAL ? bsel(tm, tn, 1) : B0;
        float acc[4][8], acc2[4][8];
#pragma unroll
        for (int i = 0; i < 4; ++i)
#pragma unroll
            for (int j = 0; j < 8; ++j) { acc[i][j] = 0.f; acc2[i][j] = 0.f; }
        const bf16_t* ap = A + (size_t)(tm * 128 + lr) * lda + lk; const bf16_t* bp = B0 + (size_t)lr * K + lk; const bf16_t* bp2 = B1 + (size_t)lr * K + lk;
        for (int k0 = 0; k0 < K; k0 += 32) {
            const u32x4 av = *(const u32x4*)(ap + k0), bv = *(const u32x4*)(bp + k0); u32x4 bv2 = bv; if (DUAL) bv2 = *(const u32x4*)(bp2 + k0);
            __syncthreads();
#pragma unroll
            for (int q = 0; q < 4; ++q) { As[(lk + 2 * q) * 132 + lr] = bflo(av[q]); As[(lk + 2 * q + 1) * 132 + lr] = bfhi(av[q]);
                Bs[(lk + 2 * q) * 132 + lr] = bflo(bv[q]); Bs[(lk + 2 * q + 1) * 132 + lr] = bfhi(bv[q]);
                if (DUAL) { Bs2[(lk + 2 * q) * 132 + lr] = bflo(bv2[q]); Bs2[(lk + 2 * q + 1) * 132 + lr] = bfhi(bv2[q]); } }
            __syncthreads();
#pragma unroll 4
            for (int kk = 0; kk < 32; ++kk) {
                const f32x4 a = *(const f32x4*)(As + kk * 132 + ty * 4); const f32x4 b0 = *(const f32x4*)(Bs + kk * 132 + tx * 8), b1 = *(const f32x4*)(Bs + kk * 132 + tx * 8 + 4);
#pragma unroll
                for (int i = 0; i < 4; ++i) { acc[i][0] += a[i] * b0.x; acc[i][1] += a[i] * b0.y; acc[i][2] += a[i] * b0.z; acc[i][3] += a[i] * b0.w; acc[i][4] += a[i] * b1.x; acc[i][5] += a[i] * b1.y; acc[i][6] += a[i] * b1.z; acc[i][7] += a[i] * b1.w; }
                if (DUAL) { const f32x4 c0 = *(const f32x4*)(Bs2 + kk * 132 + tx * 8), c1 = *(const f32x4*)(Bs2 + kk * 132 + tx * 8 + 4);
#pragma unroll
                    for (int i = 0; i < 4; ++i) { acc2[i][0] += a[i] * c0.x; acc2[i][1] += a[i] * c0.y; acc2[i][2] += a[i] * c0.z; acc2[i][3] += a[i] * c0.w; acc2[i][4] += a[i] * c1.x; acc2[i][5] += a[i] * c1.y; acc2[i][6] += a[i] * c1.z; acc2[i][7] += a[i] * c1.w; } }
            }
        }
#pragma unroll
        for (int i = 0; i < 4; ++i) epi(tm * 128 + ty * 4 + i, tn * 128 + tx * 8, acc[i], acc2[i]);
    }
}
struct BSelPlain { const bf16_t* Bt; int K; DEVI const bf16_t* operator()(int, int tn, int) const { return Bt + (size_t)tn * 128 * K; } };
struct BSelDual { const bf16_t* Bt; int K; DEVI const bf16_t* operator()(int, int tn, int which) const { return Bt + (size_t)(tn * 256 + which * 128) * K; } };
struct BSelMoe { const bf16_t* Bt; int K; int rows_per_expert; bool dual; const int* seg;
    DEVI const bf16_t* operator()(int tm, int tn, int which) const {
        const int s = tm * 128; if (s >= seg[8]) return nullptr; int e = 0;
#pragma unroll
        for (int q = 1; q < 8; ++q) e += (s >= seg[q]) ? 1 : 0;
        return Bt + (size_t)e * rows_per_expert * K + (size_t)(dual ? tn * 256 + which * 128 : tn * 128) * K; } };
struct EpiStoreBf16 { bf16_t* O; int ldc; DEVI void operator()(int r, int c0, const float* a, const float*) const {
    u32x4 o; o.x = pk2(a[0], a[1]); o.y = pk2(a[2], a[3]); o.z = pk2(a[4], a[5]); o.w = pk2(a[6], a[7]); *(u32x4*)(O + (size_t)r * ldc + c0) = o; } };
struct EpiSwiglu { bf16_t* O; int ldc; DEVI void operator()(int r, int c0, const float* a, const float* b) const {
    float h[8];
#pragma unroll
    for (int j = 0; j < 8; ++j) h[j] = silu_f(a[j]) * b[j];
    u32x4 o; o.x = pk2(h[0], h[1]); o.y = pk2(h[2], h[3]); o.z = pk2(h[4], h[5]); o.w = pk2(h[6], h[7]); *(u32x4*)(O + (size_t)r * ldc + c0) = o; } };
struct EpiResid { float* XB; const float* mv; int which;
    DEVI void operator()(int r, int c0, const float* a, const float*) const {
        const float* g = mv + (size_t)(row_mod(r) * 6 + which) * 1024 + c0; float* x = XB + (size_t)r * 1024 + c0;
        f32x4 x0 = *(f32x4*)x, x1 = *(f32x4*)(x + 4); const f32x4 g0 = *(const f32x4*)g, g1 = *(const f32x4*)(g + 4);
        x0.x += g0.x * a[0]; x0.y += g0.y * a[1]; x0.z += g0.z * a[2]; x0.w += g0.w * a[3]; x1.x += g1.x * a[4]; x1.y += g1.y * a[5]; x1.z += g1.z * a[6]; x1.w += g1.w * a[7];
        *(f32x4*)x = x0; *(f32x4*)(x + 4) = x1; } };

namespace pg8 {
#define PG8_LAS __attribute__((address_space(3)))

typedef short bf16x8 __attribute__((ext_vector_type(8)));


constexpr int MOE_FF = 3584;
constexpr int BM = 256, BK = 64, HALF = 128, HTB = HALF * BK * 2  , STAGE_BYTES = 8 * HTB, NXCD = 8, WGM = 8;

__host__ __device__ __forceinline__ int lds_byte(int r, int c) { const int st = (r >> 4) * 2 + (c >> 5), rr = r & 15, cc = c & 31, ob = rr * 64 + cc * 2; return st * 1024 + (ob ^ (((ob >> 9) & 1) << 5)); }
__host__ __device__ __forceinline__ void stage_rc(int b, int& R, int& C) { const int st = b / 1024, sb = b % 1024, swz = sb ^ (((sb >> 9) & 1) << 5); R = (st >> 1) * 16 + swz / 64; C = (st & 1) * 32 + (swz % 64) / 2; }
__host__ __device__ __forceinline__ int perm32(int rho) { const int n = rho >> 4, i = rho & 15; return 8 * (i >> 2) + 4 * n + (i & 3); }

struct Unit { int pm, pn, ko, nt; };
struct Gemm { const bf16_t* A; const bf16_t* Bt; int M, N, K; };

struct StaticOrder {
    int nM, nN, nwg, G, c;
    __host__ __device__ void init(int M, int N, int G_, int c_) { nM = M / BM; nN = N / BM; nwg = nM * nN; G = G_; c = c_; }
    __host__ __device__ bool next(int i, Unit& u) const {
        const long L = (long)i * G + c; if (L >= nwg) return false;
        int wgid = (int)L; { const int q = nwg / NXCD, r = nwg % NXCD, xcd = wgid % NXCD, off = wgid / NXCD; wgid = (xcd < r ? xcd * (q + 1) : r * (q + 1) + (xcd - r) * q) + off; }
        const int nig = WGM * nN, gid = wgid / nig, fm = gid * WGM, gsz = (nM - fm) < WGM ? (nM - fm) : WGM;
        u.pm = fm + ((wgid % nig) % gsz); u.pn = (wgid % nig) / gsz; u.ko = 0; u.nt = 0; return true;
    }
    __device__ __forceinline__ void a_ready(const Unit&) const {}
    __device__ __forceinline__ void done(const Unit&) const {}
};


__device__ __forceinline__ unsigned cvt_pk_bf16(float lo, float hi) { unsigned r; asm volatile("v_cvt_pk_bf16_f32 %0, %1, %2" : "=v"(r) : "v"(lo), "v"(hi)); return r; }
__device__ __forceinline__ float silu1(float x) { return x * __builtin_amdgcn_rcpf(1.f + __expf(-x)); }
struct EpiStore {
    static constexpr bool PERM = true, AFTER_DRAIN = false;
    bf16_t* O; int ldc; int nN; long d2;
    __device__ __forceinline__ void operator()(const f32x4 (&acc)[2][2][4][2], const Unit& u, int wr, int wc, int fr, int fq) const {
        const int row0 = u.pm * BM + wr * 64 + fr, pnl = nN ? u.pn % nN : u.pn, col0 = pnl * BM + wc * 32 + 8 * fq;
        bf16_t* Ob = O + (u.ko ? d2 + (long)(u.ko / 896 - 1) * (2048l * 1024) : 0l);
#pragma unroll
        for (int ai = 0; ai < 2; ++ai)
#pragma unroll
            for (int m = 0; m < 4; ++m) { bf16_t* rowp = Ob + (size_t)(row0 + ai * HALF + m * 16) * ldc + col0;
#pragma unroll
                for (int bj = 0; bj < 2; ++bj) { const f32x4 v0 = acc[ai][bj][m][0], v1 = acc[ai][bj][m][1];
                    u32x4 w; w.x = cvt_pk_bf16(v0[0], v0[1]); w.y = cvt_pk_bf16(v0[2], v0[3]); w.z = cvt_pk_bf16(v1[0], v1[1]); w.w = cvt_pk_bf16(v1[2], v1[3]);
                    *(u32x4*)(rowp + bj * HALF) = w; } }
    }
};
struct EpiSwi {
    static constexpr bool PERM = true, AFTER_DRAIN = false;
    bf16_t* O; int ldc; int nN;
    __device__ __forceinline__ void operator()(const f32x4 (&acc)[2][2][4][2], const Unit& u, int wr, int wc, int fr, int fq) const {
        const int row0 = u.pm * BM + wr * 64 + fr, pnl = nN ? u.pn % nN : u.pn, col0 = pnl * HALF + wc * 32 + 8 * fq;
#pragma unroll
        for (int ai = 0; ai < 2; ++ai)
#pragma unroll
            for (int m = 0; m < 4; ++m) { bf16_t* rowp = O + (size_t)(row0 + ai * HALF + m * 16) * ldc + col0;
                const f32x4 a0 = acc[ai][0][m][0], a1 = acc[ai][0][m][1], b0 = acc[ai][1][m][0], b1 = acc[ai][1][m][1];
                u32x4 w; w.x = cvt_pk_bf16(silu1(a0[0]) * b0[0], silu1(a0[1]) * b0[1]); w.y = cvt_pk_bf16(silu1(a0[2]) * b0[2], silu1(a0[3]) * b0[3]);
                w.z = cvt_pk_bf16(silu1(a1[0]) * b1[0], silu1(a1[1]) * b1[1]); w.w = cvt_pk_bf16(silu1(a1[2]) * b1[2], silu1(a1[3]) * b1[3]);
                *(u32x4*)rowp = w; }
    }
};
struct EpiRes {
    static constexpr bool PERM = false, AFTER_DRAIN = false;
    float* XB; const float* mv; int which; const float* base_lat; const float* base_ctx;
    float* PB;
    __device__ __forceinline__ void operator()(const f32x4 (&acc)[2][2][4][2], const Unit& u, int wr, int wc, int fr, int fq) const {
        const int row0 = u.pm * BM + wr * 64 + fr, col0 = u.pn * BM + wc * 32 + 4 * fq;
        float* PBp = PB + (size_t)((u.ko >= 1536 ? 1 : 0) + (u.ko >= 2176 ? 1 : 0)) * (1024 * 1024);
#pragma unroll
        for (int ai = 0; ai < 2; ++ai)
#pragma unroll
            for (int m = 0; m < 4; ++m) { const int r = row0 + ai * HALF + m * 16; const float* g = mv + (size_t)((r < 16384 ? (r >> 12) : 4) * 6 + which) * 1024 + col0; float* x = XB + (size_t)r * 1024 + col0;
                const float* bs = (r < 16384 ? base_lat + (size_t)r * 1024 : base_ctx + (size_t)(r - 16384) * 1024) + col0;
#pragma unroll
                for (int bj = 0; bj < 2; ++bj)
#pragma unroll
                    for (int n = 0; n < 2; ++n) { const int o = bj * HALF + n * 16; const f32x4 gv = *(const f32x4*)(g + o);
                        if (u.ko) *(f32x4*)(PBp + (size_t)(r - 16384) * 1024 + col0 + o) = gv * acc[ai][bj][m][n];
                        else { f32x4 xv = *(const f32x4*)(bs + o); xv = xv + gv * acc[ai][bj][m][n]; *(f32x4*)(x + o) = xv; } } }
    }
};
struct FfnDownOrder {
    StaticOrder so;
    __device__ __forceinline__ void init(int G_, int c_) { so.init(16384, 1024, G_, c_); }
    __device__ __forceinline__ bool next(int i, Unit& u) const {
        if (so.next(i, u)) return true;
        const long L = (long)i * so.G + so.c - so.nwg; if (L < 0 || L >= 64) return false;
        const int l = (int)L, q = (l & 7) + 8 * (l >> 5), p = q & 3;
        u.pm = 64 + (q >> 2); u.pn = (l >> 3) & 3; u.ko = (p * 12 - (p == 3 ? 2 : 0)) * 64; u.nt = p < 2 ? 12 : 10; return true; }
    __device__ __forceinline__ void a_ready(const Unit&) const {}
    __device__ __forceinline__ void done(const Unit&) const {}
};
struct MoeOrder {
    StaticOrder so; int nN; int sg[9];
    __device__ __forceinline__ void init(const int* seg, int nN_, int G_, int c_) {
#pragma unroll
        for (int i = 0; i < 9; ++i) sg[i] = seg[i];
        nN = nN_; so.nM = sg[8] >> 8; so.nN = nN_; so.nwg = so.nM * nN_; so.G = G_; so.c = c_; }
    __device__ __forceinline__ bool next(int i, Unit& u) const {
        if (!so.next(i, u)) return false;
        const int s = u.pm * 256; int e = 0;
#pragma unroll
        for (int q = 1; q < 8; ++q) e += (s >= sg[q]) ? 1 : 0;
        u.pn += e * nN; return true; }
    __device__ __forceinline__ void a_ready(const Unit&) const {}
    __device__ __forceinline__ void done(const Unit&) const {}
};
struct TableOrder {
    const int* tab; int n, G, vc;
    __device__ __forceinline__ void init(const int* tab_, int G_, int c_) { tab = tab_ + 4; n = tab_[0]; G = G_; vc = (G_ % 8 == 0) ? (c_ % 8) * (G_ / 8) + c_ / 8 : c_; }
    __device__ __forceinline__ bool next(int i, Unit& u) const { const int L = i * G + vc; if (L >= n) return false; const int* t = tab + 4 * L; u.pm = t[0]; u.pn = t[1]; u.ko = t[2]; u.nt = t[3]; return true; }
    __device__ __forceinline__ void a_ready(const Unit&) const {}
    __device__ __forceinline__ void done(const Unit&) const {}
};
template <class Epi, class Sched, bool ALIGN_EPI = false, bool SP2 = false>
__device__ __forceinline__ void gemm_phase(PG8_LAS unsigned char* lds, const Gemm g, const Sched& S, const Epi& E) {
    const int tid = threadIdx.x, wid = __builtin_amdgcn_readfirstlane(tid >> 6), lane = tid & 63, wr = wid >> 2, wc = wid & 3, fr = lane & 15, fq = lane >> 4;
    const int K = g.K; int nt = K / BK;
    unsigned voffA[2], voffB[2];
#pragma unroll
    for (int i = 0; i < 2; ++i) { int R, C; stage_rc(tid * 16 + i * 8192, R, C); const int Rb = Epi::PERM ? ((R & ~31) + perm32(R & 31)) : R;
        voffA[i] = (unsigned)(R * K + C) * 2u; voffB[i] = (unsigned)(Rb * K + C) * 2u; }
    const size_t kstep = (size_t)(BK * 2);
    const size_t hstep = (size_t)HALF * K * 2;
    const size_t tstep = 2 * hstep;
    const unsigned ldsw = (unsigned)wid * 1024u;
    const int aoff = lds_byte(wr * 64 + fr, fq * 8), boff = lds_byte(wc * 32 + fr, fq * 8);
#define PG8_SA(b, h) (((b) * 2 + (h)) * HTB)
#define PG8_SB(b, h) ((4 + (b) * 2 + (h)) * HTB)
#define PG8_STAGE(bufoff, gbase, voff) do { _Pragma("unroll") for (int _i = 0; _i < 2; ++_i) \
        __builtin_amdgcn_global_load_lds((const unsigned*)((const char*)(gbase) + (voff)[_i]), (PG8_LAS unsigned*)(lds + (bufoff) + ldsw + _i * 8192), 16, 0, 0); } while (0)
#define PG8_LDA(dst, b, h) do { _Pragma("unroll") for (int m = 0; m < 4; ++m) _Pragma("unroll") for (int k = 0; k < 2; ++k) dst[m][k] = *(const PG8_LAS bf16x8*)(lds + PG8_SA(b, h) + aoff + m * 2048 + k * 1024); } while (0)
#define PG8_LDB(dst, b, h) do { _Pragma("unroll") for (int n = 0; n < 2; ++n) _Pragma("unroll") for (int k = 0; k < 2; ++k) dst[n][k] = *(const PG8_LAS bf16x8*)(lds + PG8_SB(b, h) + boff + n * 2048 + k * 1024); } while (0)
#define PG8_MMA(ai, bj, At, Bt) do { __builtin_amdgcn_s_setprio(1); _Pragma("unroll") for (int m = 0; m < 4; ++m) _Pragma("unroll") for (int n = 0; n < 2; ++n) _Pragma("unroll") for (int k = 0; k < 2; ++k) \
        acc[ai][bj][m][n] = __builtin_amdgcn_mfma_f32_16x16x32_bf16(Bt[n][k], At[m][k], acc[ai][bj][m][n], 0, 0, 0); __builtin_amdgcn_s_setprio(0); } while (0)
#define PG8_WAIT_V(n) asm volatile("s_waitcnt vmcnt(" #n ")" ::: "memory")
#define PG8_WAIT_L(n) asm volatile("s_waitcnt lgkmcnt(" #n ")" ::: "memory")
#define PG8_BAR __builtin_amdgcn_s_barrier()
#define PG8_SCHED __builtin_amdgcn_sched_barrier(0)
    Unit cur, nxt; int ui = 0;
    if (!S.next(0, cur)) return;
    if (cur.nt) nt = cur.nt;
    f32x4 acc[2][2][4][2];
#pragma unroll
    for (int a = 0; a < 2; ++a)
#pragma unroll
        for (int b = 0; b < 2; ++b)
#pragma unroll
            for (int m = 0; m < 4; ++m)
#pragma unroll
                for (int n = 0; n < 2; ++n) acc[a][b][m][n] = (f32x4){0.f, 0.f, 0.f, 0.f};
    bf16x8 At[4][2], B0[2][2], B1[2][2];
    const char* cA = (const char*)g.A + (size_t)cur.pm * tstep + (size_t)cur.ko * 2; const char* cB = (const char*)g.Bt + (size_t)cur.pn * tstep + (size_t)cur.ko * 2;
    S.a_ready(cur);
    if constexpr (SP2) {
        PG8_STAGE(PG8_SB(0, 0), cB, voffB); PG8_STAGE(PG8_SB(0, 1), cB + hstep, voffB); PG8_STAGE(PG8_SA(0, 0), cA, voffA); PG8_STAGE(PG8_SA(0, 1), cA + hstep, voffA);
        if (wr == 1) PG8_BAR;
        PG8_WAIT_V(2); PG8_BAR;
        PG8_STAGE(PG8_SB(1, 0), cB + kstep, voffB); PG8_STAGE(PG8_SA(1, 0), cA + kstep, voffA); PG8_STAGE(PG8_SB(1, 1), cB + hstep + kstep, voffB);
        PG8_WAIT_V(6); PG8_BAR;
    } else {
        PG8_STAGE(PG8_SB(0, 0), cB, voffB); PG8_STAGE(PG8_SA(0, 0), cA, voffA); PG8_STAGE(PG8_SB(0, 1), cB + hstep, voffB); PG8_STAGE(PG8_SA(0, 1), cA + hstep, voffA);
        if (wr == 1) PG8_BAR;
        PG8_WAIT_V(4); PG8_BAR;
        PG8_STAGE(PG8_SB(1, 0), cB + kstep, voffB); PG8_STAGE(PG8_SA(1, 0), cA + kstep, voffA); PG8_STAGE(PG8_SB(1, 1), cB + hstep + kstep, voffB);
        PG8_WAIT_V(6); PG8_BAR;
    }
    for (;;) {
        const bool has_next = S.next(ui + 1, nxt);
        const char* nA = has_next ? (const char*)g.A + (size_t)nxt.pm * tstep + (size_t)nxt.ko * 2 : cA; const char* nB = has_next ? (const char*)g.Bt + (size_t)nxt.pn * tstep + (size_t)nxt.ko * 2 : cB;
        for (int t = 0; t < nt; t += 2) {
            const bool last = (t == nt - 2);
            const char* a1 = cA + (size_t)(t + 1) * kstep;
            const char* a2 = last ? nA : cA + (size_t)(t + 2) * kstep; const char* b2 = last ? nB : cB + (size_t)(t + 2) * kstep;
            const char* a3 = a2 + kstep; const char* b3 = b2 + kstep;
            if (last && has_next) S.a_ready(nxt);
            if constexpr (SP2) {
            PG8_LDB(B0, 0, 0); PG8_LDB(B1, 0, 1); PG8_SCHED; PG8_LDA(At, 0, 0); PG8_STAGE(PG8_SA(1, 1), a1 + hstep, voffA);
            PG8_WAIT_V(8); PG8_WAIT_L(0); PG8_BAR; PG8_MMA(0, 0, At, B0); PG8_MMA(0, 1, At, B1); PG8_BAR; PG8_SCHED;
            PG8_LDA(At, 0, 1); PG8_STAGE(PG8_SB(0, 0), b2, voffB); PG8_STAGE(PG8_SB(0, 1), b2 + hstep, voffB); PG8_STAGE(PG8_SA(0, 0), a2, voffA);
            PG8_WAIT_V(8); PG8_WAIT_L(0); PG8_BAR; PG8_MMA(1, 0, At, B0); PG8_MMA(1, 1, At, B1); PG8_BAR; PG8_SCHED;
            PG8_LDB(B0, 1, 0); PG8_LDB(B1, 1, 1); PG8_SCHED; PG8_LDA(At, 1, 0); PG8_STAGE(PG8_SA(0, 1), a2 + hstep, voffA);
            PG8_WAIT_V(8); PG8_WAIT_L(0); PG8_BAR; PG8_MMA(0, 0, At, B0); PG8_MMA(0, 1, At, B1); PG8_BAR; PG8_SCHED;
            PG8_LDA(At, 1, 1); PG8_STAGE(PG8_SB(1, 0), b3, voffB); PG8_STAGE(PG8_SB(1, 1), b3 + hstep, voffB); PG8_STAGE(PG8_SA(1, 0), a3, voffA);
            PG8_WAIT_V(8); PG8_WAIT_L(0); PG8_BAR; PG8_MMA(1, 0, At, B0); PG8_MMA(1, 1, At, B1); PG8_BAR; PG8_SCHED;
            } else {
            PG8_LDB(B0, 0, 0); PG8_SCHED; PG8_LDA(At, 0, 0); PG8_STAGE(PG8_SA(1, 1), a1 + hstep, voffA);
            PG8_WAIT_L(8); PG8_BAR; PG8_WAIT_L(0); PG8_MMA(0, 0, At, B0); PG8_BAR; PG8_SCHED;
            PG8_LDB(B1, 0, 1); PG8_STAGE(PG8_SB(0, 0), b2, voffB);
            PG8_BAR; PG8_WAIT_L(0); PG8_MMA(0, 1, At, B1); PG8_BAR;
            PG8_LDA(At, 0, 1); PG8_STAGE(PG8_SA(0, 0), a2, voffA);
            PG8_BAR; PG8_WAIT_L(0); PG8_MMA(1, 0, At, B0); PG8_BAR; PG8_SCHED;
            PG8_STAGE(PG8_SB(0, 1), b2 + hstep, voffB);
            PG8_WAIT_V(6); PG8_BAR; PG8_MMA(1, 1, At, B1); PG8_BAR;
            PG8_LDB(B0, 1, 0); PG8_SCHED; PG8_LDA(At, 1, 0); PG8_STAGE(PG8_SA(0, 1), a2 + hstep, voffA);
            PG8_WAIT_L(8); PG8_BAR; PG8_WAIT_L(0); PG8_MMA(0, 0, At, B0); PG8_BAR; PG8_SCHED;
            PG8_LDB(B1, 1, 1); PG8_STAGE(PG8_SB(1, 0), b3, voffB);
            PG8_BAR; PG8_WAIT_L(0); PG8_MMA(0, 1, At, B1); PG8_BAR;
            PG8_LDA(At, 1, 1); PG8_STAGE(PG8_SA(1, 0), a3, voffA);
            PG8_BAR; PG8_WAIT_L(0); PG8_MMA(1, 0, At, B0); PG8_BAR; PG8_SCHED;
            PG8_STAGE(PG8_SB(1, 1), b3 + hstep, voffB);
            PG8_WAIT_V(6); PG8_BAR; PG8_MMA(1, 1, At, B1); PG8_BAR;
            }
        }
        if constexpr (ALIGN_EPI) { if (wr == 0) PG8_BAR; }
        if constexpr (!Epi::AFTER_DRAIN) { E(acc, cur, wr, wc, fr, fq); S.done(cur); }
        if (!has_next) break;
#pragma unroll
        for (int a = 0; a < 2; ++a)
#pragma unroll
            for (int b = 0; b < 2; ++b)
#pragma unroll
                for (int m = 0; m < 4; ++m)
#pragma unroll
                    for (int n = 0; n < 2; ++n) acc[a][b][m][n] = (f32x4){0.f, 0.f, 0.f, 0.f};
        cur = nxt; cA = nA; cB = nB; ++ui; nt = cur.nt ? cur.nt : K / BK;
        if constexpr (ALIGN_EPI) { if (wr == 1) PG8_BAR; }
    }
    PG8_WAIT_V(0);
    if constexpr (!ALIGN_EPI) { if (wr == 0) PG8_BAR; }
    PG8_BAR;
    if constexpr (Epi::AFTER_DRAIN) { E.fused(acc, cur, wr, wc, fr, fq, lds, wid, lane); S.done(cur); }
#undef PG8_SA
#undef PG8_SB
#undef PG8_STAGE
#undef PG8_LDA
#undef PG8_LDB
#undef PG8_MMA
#undef PG8_WAIT_V
#undef PG8_WAIT_L
#undef PG8_BAR
#undef PG8_SCHED
}
}

DEVI void row_seq(int r, int& t, int& len) { if (r < NLAT) { t = r & 4095; len = SEQ; } else { t = (r - NLAT) & 255; len = CTXL; } }

#define DPP_F(v, ctrl) __int_as_float(__builtin_amdgcn_update_dpp(0, __float_as_int(v), (ctrl), 0xF, 0xF, true))
DEVI float sum8lanes(float x) { x += DPP_F(x, 0xB1); x += DPP_F(x, 0x4E); x += DPP_F(x, 0x141); return x; }

DEVI void phase_prep(const Ctx& c, int layer, bool need_ctx_q) {
    const bf16_t* Z = (const bf16_t*)(c.ws + WS_Z);
    {
        bf16_t* QN = (bf16_t*)(c.ws + WS_QN); bf16_t* KN = (bf16_t*)(c.ws + WS_KN); bf16_t* VB = (bf16_t*)(c.ws + WS_DN + DN_VB); float* bg = (float*)(c.ws + WS_DN + DN_BG);
        const float* cw = c.in[I_CONVW] + (size_t)layer * 3 * 1152;
        const int lc = c.lane < 48 ? c.lane : 47;
        float w[3][3][8];
#pragma unroll
        for (int th = 0; th < 3; ++th)
#pragma unroll
            for (int tap = 0; tap < 3; ++tap) { const float* wp = cw + tap * 1152 + th * 384 + lc * 8; *(f32x4*)w[th][tap] = *(const f32x4*)wp; *(f32x4*)(w[th][tap] + 4) = *(const f32x4*)(wp + 4); }
        const int dh = c.lane - 48; float alog = 0.f, dtb = 0.f;
        if (c.lane >= 48 && c.lane < 60) { alog = -expf(c.in[I_ALOG][layer * 12 + dh]); dtb = c.in[I_DTB][layer * 12 + dh]; }
        for (int r = c.gw; r < NT; r += c.ngw) {
            int t, len; row_seq(r, t, len);
            const bf16_t* zr = Z + (size_t)r * ZP + lc * 8; const bool hm = t > 0, hp = t < len - 1;
            u32x4 zc[3], zm[3], zp[3];
#pragma unroll
            for (int th = 0; th < 3; ++th) { zc[th] = *(const u32x4*)(zr + th * 384); zm[th] = hm ? *(const u32x4*)(zr + th * 384 - ZP) : (u32x4){0u, 0u, 0u, 0u}; zp[th] = hp ? *(const u32x4*)(zr + th * 384 + ZP) : (u32x4){0u, 0u, 0u, 0u}; }
            float zb = 0.f, za = 0.f;
            if (c.lane >= 48 && c.lane < 60) { zb = bf2f(Z[(size_t)r * ZP + ZC_BETA + dh]); za = bf2f(Z[(size_t)r * ZP + ZC_ALPHA + dh]); }
            u32x4 outw[3];
#pragma unroll
            for (int th = 0; th < 3; ++th) {
                float a[8], b[8], d[8], v[8]; unpack8(zm[th], a); unpack8(zc[th], b); unpack8(zp[th], d);
                float ss = 0.f;
#pragma unroll
                for (int e = 0; e < 8; ++e) { v[e] = silu_f(a[e] * w[th][0][e] + b[e] * w[th][1][e] + d[e] * w[th][2][e]); ss += v[e] * v[e]; }
                if (th < 2) { ss = sum8lanes(ss); const float sc = rsqrtf(ss + EPS) * (th == 0 ? 0.125f : 1.f);
#pragma unroll
                    for (int e = 0; e < 8; ++e) v[e] *= sc; }
                outw[th] = pack8(v);
            }
            if (c.lane < 48) { *(u32x4*)(QN + (size_t)r * 384 + c.lane * 8) = outw[0]; *(u32x4*)(KN + (size_t)r * 384 + c.lane * 8) = outw[1]; *(u32x4*)(VB + (size_t)r * 384 + c.lane * 8) = outw[2]; }
            else if (c.lane < 60) { bg[((size_t)r * 12 + dh) * 2] = __builtin_amdgcn_rcpf(1.f + __expf(-zb)); bg[((size_t)r * 12 + dh) * 2 + 1] = alog * softplus_f(za + dtb); }
        }
    }
    {
        bf16_t* Qa = (bf16_t*)(c.ws + WS_QA); bf16_t* Qc = (bf16_t*)(c.ws + WS_QC); bf16_t* Ka = (bf16_t*)(c.ws + WS_KA); bf16_t* Va = (bf16_t*)(c.ws + WS_VA);
        const float* rope = (const float*)(c.ws + CTL_ROPE);
        const bool isq = c.lane < 48; const int j = c.lane & 7, axis = j >> 2, half = (j >> 1) & 1, p0 = 8 * (j & 1);
        const int col = isq ? ZC_AQ + c.lane * 8 : ZC_AK + (c.lane - 48) * 8;
        float gn[8];
        { const float* gp = (isq ? c.in[I_QG] : c.in[I_KG]) + layer * 64 + 8 * j; *(f32x4*)gn = *(const f32x4*)gp; *(f32x4*)(gn + 4) = *(const f32x4*)(gp + 4); }
        const float qs = isq ? QSCALE : 1.f;
        for (int r0 = c.gw; r0 < NT; r0 += 2 * c.ngw) {
            int rr[2]; bool ok[2]; rr[0] = r0; ok[0] = true; rr[1] = r0 + c.ngw; ok[1] = rr[1] < NT; if (!ok[1]) rr[1] = r0;
            u32x4 zq[2], zv[2]; const float* tp[2];
#pragma unroll
            for (int q = 0; q < 2; ++q) { const int r = rr[q]; zq[q] = *(const u32x4*)(Z + (size_t)r * ZP + col); zv[q] = *(const u32x4*)(Z + (size_t)r * ZP + ZC_AV + (c.lane & 15) * 8);
                const int t = r & 4095; tp[q] = rope + (r < NLAT ? (axis * 64 + (axis == 0 ? (t >> 6) : (t & 63))) * 32 : 128 * 32) + p0; }
#pragma unroll
            for (int q = 0; q < 2; ++q) { const int r = rr[q]; const bool lat = r < NLAT; const int b = lat ? (r >> 12) : ((r - NLAT) >> 8), pos = lat ? CTXL + (r & 4095) : ((r - NLAT) & 255);
                float v[8]; unpack8(zq[q], v);
                float ss = 0.f;
#pragma unroll
                for (int e = 0; e < 8; ++e) ss += v[e] * v[e];
                ss = sum8lanes(ss); const float sc = rsqrtf(ss * (1.f / 64.f) + EPS);
                float cs[8], sn[8]; *(f32x4*)cs = *(const f32x4*)tp[q]; *(f32x4*)(cs + 4) = *(const f32x4*)(tp[q] + 4); *(f32x4*)sn = *(const f32x4*)(tp[q] + 16); *(f32x4*)(sn + 4) = *(const f32x4*)(tp[q] + 20);
#pragma unroll
                for (int e = 0; e < 8; ++e) { v[e] *= sc * gn[e]; const float o = DPP_F(v[e], 0x4E); v[e] = (half == 0 ? v[e] * cs[e] - o * sn[e] : o * sn[e] + v[e] * cs[e]) * qs; }
                const u32x4 w = pack8(v);
                if (ok[q]) {
                    if (isq) { if (lat) *(u32x4*)(Qa + (size_t)r * 384 + c.lane * 8) = w; else if (need_ctx_q) *(u32x4*)(Qc + (size_t)(r - NLAT) * 384 + c.lane * 8) = w; }
                    else *(u32x4*)(Ka + ((size_t)b * SKV + pos) * 128 + (c.lane - 48) * 8) = w;
                    if (c.lane < 16) *(u32x4*)(Va + ((size_t)b * SKV + pos) * 128 + c.lane * 8) = zv[q];
                } }
        }
    }
    {
        bf16_t* SV = (bf16_t*)(c.ws + WS_SV); const int l32 = c.lane & 31;
        float gn[8]; { const float* gp = c.in[I_SGUG] + layer * 256 + l32 * 8; *(f32x4*)gn = *(const f32x4*)gp; *(f32x4*)(gn + 4) = *(const f32x4*)(gp + 4); }
        const int nr = need_ctx_q ? NT : NLAT;
        for (int it = c.gw; it < nr / 2; it += c.ngw) {
            const int r = it * 2 + (c.lane >> 5);
            float v[8]; unpack8(*(const u32x4*)(Z + (size_t)r * ZP + ZC_MV + l32 * 8), v);
            float ss = 0.f;
#pragma unroll
            for (int e = 0; e < 8; ++e) { v[e] = gelu_f(v[e]); ss += v[e] * v[e]; }
            ss = sum8lanes(ss); const float sc = rsqrtf(ss * (1.f / 64.f) + EPS);
#pragma unroll
            for (int e = 0; e < 8; ++e) v[e] *= sc * gn[e];
            *(u32x4*)(SV + (size_t)r * 256 + l32 * 8) = pack8(v);
        }
    }
}
DEVI void phase_dnscan_naive(const Ctx& c) {
    const bf16_t* QN = (const bf16_t*)(c.ws + WS_QN); const bf16_t* KN = (const bf16_t*)(c.ws + WS_KN); const bf16_t* VB = (const bf16_t*)(c.ws + WS_DN + DN_VB);
    const float* BG = (const float*)(c.ws + WS_DN + DN_BG); float* OD = (float*)(c.ws + WS_DN + DN_O);
    float* kqv = c.lds; float* part = c.lds + 256; float* part2 = c.lds + 256 + 512;
    const int e = c.tid & 63, dg = c.tid >> 6;
    for (int seq = blockIdx.x; seq < 48; seq += gridDim.x) {
        const int b = seq / 12, h = (seq >> 1) % 6, dir = seq & 1;
        float S[8];
#pragma unroll
        for (int i = 0; i < 8; ++i) S[i] = 0.f;
        for (int step = 0; step < SKV; ++step) {
            int row;
            if (step < CTXL) { const int t = dir ? CTXL - 1 - step : step; row = NLAT + b * CTXL + t; }
            else { const int u = step - CTXL; const int t = dir ? SEQ - 1 - u : u; row = b * SEQ + t; }
            if (c.wave == 0) kqv[e] = bf2f(KN[(size_t)row * 384 + h * 64 + e]);
            else if (c.wave == 1) kqv[64 + e] = bf2f(QN[(size_t)row * 384 + h * 64 + e]);
            else if (c.wave == 2) kqv[128 + e] = bf2f(VB[(size_t)row * 384 + h * 64 + e]);
            else if (c.wave == 3 && e < 2) { const float v = BG[((size_t)row * 12 + dir * 6 + h) * 2 + e]; kqv[192 + e] = e == 0 ? v : __expf(v); }
            __syncthreads();
            const float a = kqv[193], beta = kqv[192];
            float kd[8], p = 0.f;
#pragma unroll
            for (int i = 0; i < 8; ++i) { kd[i] = kqv[dg * 8 + i]; S[i] *= a; p += S[i] * kd[i]; }
            part[dg * 64 + e] = p;
            __syncthreads();
            float rr = kqv[128 + e];
#pragma unroll
            for (int w = 0; w < 8; ++w) rr -= part[w * 64 + e];
            rr *= beta; float po = 0.f;
#pragma unroll
            for (int i = 0; i < 8; ++i) { S[i] += kd[i] * rr; po += S[i] * kqv[64 + dg * 8 + i]; }
            part2[dg * 64 + e] = po;
            __syncthreads();
            if (dg == 0) { float o = 0.f;
#pragma unroll
                for (int w = 0; w < 8; ++w) o += part2[w * 64 + e];
                OD[((size_t)dir * NT + row) * 384 + h * 64 + e] = o; }
        }
        __syncthreads();
    }
}

DEVI void phase_dnfinish(const Ctx& c, int layer, int nrows) {
    const float* OD = (const float*)(c.ws + WS_DN + DN_O); const bf16_t* Z = (const bf16_t*)(c.ws + WS_Z); bf16_t* MIX = (bf16_t*)(c.ws + WS_MIX);
    float gn[8]; { const float* gp = c.in[I_DNG] + layer * 64 + 8 * (c.lane & 7); *(f32x4*)gn = *(const f32x4*)gp; *(f32x4*)(gn + 4) = *(const f32x4*)(gp + 4); }
    if (c.lane < 48) for (int r = c.gw; r < nrows; r += c.ngw) {
        const float* o0 = OD + (size_t)r * 384 + c.lane * 8; const float* o1 = o0 + (size_t)NT * 384;
        float v[8], g[8]; *(f32x4*)v = *(const f32x4*)o0 + *(const f32x4*)o1; *(f32x4*)(v + 4) = *(const f32x4*)(o0 + 4) + *(const f32x4*)(o1 + 4);
        unpack8(*(const u32x4*)(Z + (size_t)r * ZP + ZC_GATE + c.lane * 8), g);
        float ss = 0.f;
#pragma unroll
        for (int e = 0; e < 8; ++e) ss += v[e] * v[e];
        ss = sum8lanes(ss); const float sc = rsqrtf(ss * (1.f / 64.f) + EPS);
#pragma unroll
        for (int e = 0; e < 8; ++e) v[e] = v[e] * sc * gn[e] * silu_f(g[e]);
        *(u32x4*)(MIX + (size_t)r * 1024 + c.lane * 8) = pack8(v);
    }
}

DEVI void phase_attn_naive(const Ctx& c, bool with_ctx) {
    const bf16_t* Qa = (const bf16_t*)(c.ws + WS_QA); const bf16_t* Qc = (const bf16_t*)(c.ws + WS_QC); const bf16_t* Ka = (const bf16_t*)(c.ws + WS_KA); const bf16_t* Va = (const bf16_t*)(c.ws + WS_VA);
    bf16_t* MIX = (bf16_t*)(c.ws + WS_MIX);
    const int nitems = NLAT * 6 + (with_ctx ? NCTX * 6 : 0);
    for (int it = c.gw; it < nitems; it += c.ngw) {
        int b, hq, nkeys, orow; const bf16_t* qp;
        if (it < NLAT * 6) { const int r = it / 6; hq = it % 6; b = r >> 12; qp = Qa + (size_t)r * 384 + hq * 64; nkeys = SKV; orow = r; }
        else { const int q = it - NLAT * 6, rc = q / 6; hq = q % 6; b = rc >> 8; qp = Qc + (size_t)rc * 384 + hq * 64; nkeys = CTXL; orow = NLAT + rc; }
        const int kvh = hq / 3; const bf16_t* Kp = Ka + (size_t)b * SKV * 128 + kvh * 64; const bf16_t* Vp = Va + (size_t)b * SKV * 128 + kvh * 64;
        u32x4 qv[8];
#pragma unroll
        for (int i = 0; i < 8; ++i) qv[i] = *(const u32x4*)(qp + i * 8);
        float m = -1e30f, l = 0.f, acc = 0.f;
        for (int t0 = 0; t0 < nkeys; t0 += 64) {
            const bf16_t* kp = Kp + (size_t)(t0 + c.lane) * 128; float s = 0.f;
#pragma unroll
            for (int i = 0; i < 8; ++i) { const u32x4 kv = *(const u32x4*)(kp + i * 8);
#pragma unroll
                for (int q = 0; q < 4; ++q) s += bflo(kv[q]) * bflo(qv[i][q]) + bfhi(kv[q]) * bfhi(qv[i][q]); }
            const float mn = fmaxf(m, wave_max(s)); const float alpha = exp2f(m - mn); const float p = exp2f(s - mn);
            l = l * alpha + wave_sum(p); acc *= alpha; m = mn;
#pragma unroll 8
            for (int jj = 0; jj < 64; ++jj) { const float pj = __shfl(p, jj); acc += pj * bf2f(Vp[(size_t)(t0 + jj) * 128 + c.lane]); }
        }
        MIX[(size_t)orow * 1024 + 384 + hq * 64 + c.lane] = (bf16_t)f2bf(acc / l);
    }
}


namespace dn {
using bf16x8 = __attribute__((ext_vector_type(8))) short;
using f32x16 = __attribute__((ext_vector_type(16))) float;
typedef __attribute__((address_space(3))) unsigned char* ldsp;
constexpr int IMG = 46080, NCHK = 68, NSEQ = 48;
constexpr int O_NEGK = 0, O_T = 8192, O_QG = 14336, O_AT = 22528, O_KDT = 28672, O_BV = 36864, O_MISC = 45056;
DEVI int rowmap(int t, int hq) { return (t & 3) + 8 * (t >> 2) + 4 * hq; }
typedef float f32x2_t __attribute__((ext_vector_type(2))); typedef __bf16 bf16x2_t __attribute__((ext_vector_type(2)));
DEVI unsigned cvtpk(float lo, float hi) { f32x2_t v = {lo, hi}; bf16x2_t b = __builtin_convertvector(v, bf16x2_t); return __builtin_bit_cast(unsigned, b); }
#define DN_PACK8(x, s) __builtin_bit_cast(dn::bf16x8, (u32x4){dn::cvtpk((x)[8 * (s)], (x)[8 * (s) + 1]), dn::cvtpk((x)[8 * (s) + 2], (x)[8 * (s) + 3]), dn::cvtpk((x)[8 * (s) + 4], (x)[8 * (s) + 5]), dn::cvtpk((x)[8 * (s) + 6], (x)[8 * (s) + 7])})
#define DN_MFMA(a, b, c) __builtin_amdgcn_mfma_f32_32x32x16_bf16((a), (b), (c), 0, 0, 0)
DEVI u32x4 perm_frag(u32x4 f, int hq) {
    const unsigned s0 = hq ? f.x : f.z, s1 = hq ? f.y : f.w;
    const unsigned r0 = (unsigned)__shfl_xor((int)s0, 32), r1 = (unsigned)__shfl_xor((int)s1, 32);
    u32x4 o; o.x = hq ? r0 : f.x; o.y = hq ? r1 : f.y; o.z = hq ? f.z : r0; o.w = hq ? f.w : r1; return o;
}
DEVI u32x4 scale_frag(u32x4 f, float sc) {
    u32x4 o; o.x = cvtpk(bflo(f.x) * sc, bfhi(f.x) * sc); o.y = cvtpk(bflo(f.y) * sc, bfhi(f.y) * sc); o.z = cvtpk(bflo(f.z) * sc, bfhi(f.z) * sc); o.w = cvtpk(bflo(f.w) * sc, bfhi(f.w) * sc); return o;
}
DEVI bf16x8 ident_frag(int e, int r, int hq) {
    const int js = r - 16 * e - 8 * hq; u32x4 w;
    w.x = (js == 0 ? 0x3F80u : 0u) | (js == 1 ? 0x3F800000u : 0u); w.y = (js == 2 ? 0x3F80u : 0u) | (js == 3 ? 0x3F800000u : 0u);
    w.z = (js == 4 ? 0x3F80u : 0u) | (js == 5 ? 0x3F800000u : 0u); w.w = (js == 6 ? 0x3F80u : 0u) | (js == 7 ? 0x3F800000u : 0u);
    return __builtin_bit_cast(bf16x8, w);
}
DEVI int chunk_base(int b, int dir, int n) {
    if (n < 4) return NLAT + b * CTXL + (dir ? 3 - n : n) * 64;
    return b * SEQ + (dir ? 63 - (n - 4) : n - 4) * 64;
}

DEVI void phase_chunkprep(const Ctx& c) {
    const bf16_t* QN = (const bf16_t*)(c.ws + WS_QN); const bf16_t* KN = (const bf16_t*)(c.ws + WS_KN); const bf16_t* VB = (const bf16_t*)(c.ws + WS_DN + DN_VB);
    const float* BG = (const float*)(c.ws + WS_DN + DN_BG); unsigned char* OPS = c.ws + WS_DN + DN_OPS;
    float* Al = c.lds + c.wave * (17408 / 4);
    float* sgc = Al + 4096; float* sbe = sgc + 64; float* skd = sbe + 64;
    const int l = c.lane, r = l & 31, hq = l >> 5;
    for (int task = c.gw; task < NSEQ * NCHK; task += c.ngw) {
        const int seq = task / NCHK, n = task % NCHK, b = seq / 12, h = (seq >> 1) % 6, dir = seq & 1;
        const int base = chunk_base(b, dir, n);
        unsigned char* img = OPS + (size_t)task * IMG;
        const int myrow = base + (dir ? 63 - l : l);
        const float beta = BG[((size_t)myrow * 12 + dir * 6 + h) * 2]; const float g = BG[((size_t)myrow * 12 + dir * 6 + h) * 2 + 1];
        float gc = g;
#pragma unroll
        for (int o = 1; o < 64; o <<= 1) { const float t = __shfl_up(gc, o); if (l >= o) gc += t; }
        const float glast = __shfl(gc, 63);
        sgc[l] = gc; sbe[l] = beta; skd[l] = __expf(glast - gc);
        if (l == 0) *(float*)(img + O_MISC) = __expf(glast);
        __builtin_amdgcn_wave_barrier(); asm volatile("" ::: "memory");
        u32x4 kf[2][4], qf[2][4];
#pragma unroll
        for (int t = 0; t < 2; ++t) { const int pos = 32 * t + r; const size_t ro = (size_t)(base + (dir ? 63 - pos : pos)) * 384 + h * 64 + 8 * hq;
#pragma unroll
            for (int kk = 0; kk < 4; ++kk) { kf[t][kk] = *(const u32x4*)(KN + ro + 16 * kk); qf[t][kk] = *(const u32x4*)(QN + ro + 16 * kk); } }
#define KF(t, kk) __builtin_bit_cast(bf16x8, kf[t][kk])
#define QF(t, kk) __builtin_bit_cast(bf16x8, qf[t][kk])
#pragma unroll
        for (int tile = 0; tile < 3; ++tile) { const int rb = tile == 2 ? 1 : 0, cb = tile == 0 ? 0 : 1;
            f32x16 G = {}, P = {};
#pragma unroll
            for (int kk = 0; kk < 4; ++kk) { G = DN_MFMA(KF(rb, kk), KF(cb, kk), G); P = DN_MFMA(KF(rb, kk), QF(cb, kk), P); }
            const int lp = 32 * cb + r; const float bl = __shfl(beta, lp), gl = __shfl(gc, lp);
#pragma unroll
            for (int t = 0; t < 16; ++t) { const int rp = 32 * rb + rowmap(t, hq); const float e = __expf(gl - sgc[rp]);
                if (tile == 1) G[t] = -bl * e * G[t]; else Al[rp * 64 + lp] = lp > rp ? bl * e * G[t] : 0.f;
                P[t] = rp <= lp ? P[t] * e : 0.f; }
            if (tile == 1) { *(bf16x8*)(img + O_T + 2 * 1024 + l * 16) = DN_PACK8(G, 0); *(bf16x8*)(img + O_T + 3 * 1024 + l * 16) = DN_PACK8(G, 1); }
            *(bf16x8*)(img + O_AT + (2 * tile + 0) * 1024 + l * 16) = DN_PACK8(P, 0);
            *(bf16x8*)(img + O_AT + (2 * tile + 1) * 1024 + l * 16) = DN_PACK8(P, 1); }
#pragma unroll
        for (int rt = 0; rt < 2; ++rt) { const float gr = __shfl(gc, 32 * rt + r), br = __shfl(beta, 32 * rt + r); const float eg = __expf(gr);
#pragma unroll
            for (int kk = 0; kk < 4; ++kk) {
                *(u32x4*)(img + O_NEGK + (rt * 4 + kk) * 1024 + l * 16) = scale_frag(perm_frag(kf[rt][kk], hq), -br * eg);
                *(u32x4*)(img + O_QG + (rt * 4 + kk) * 1024 + l * 16) = scale_frag(perm_frag(qf[rt][kk], hq), eg); } }
#pragma unroll
        for (int dt = 0; dt < 2; ++dt)
#pragma unroll
            for (int cb = 0; cb < 2; ++cb) { f32x16 X = {};
                X = DN_MFMA(KF(cb, 2 * dt), ident_frag(0, r, hq), X); X = DN_MFMA(KF(cb, 2 * dt + 1), ident_frag(1, r, hq), X);
#pragma unroll
                for (int t = 0; t < 16; ++t) X[t] *= skd[32 * cb + rowmap(t, hq)];
                *(bf16x8*)(img + O_KDT + ((dt * 2 + cb) * 2 + 0) * 1024 + l * 16) = DN_PACK8(X, 0);
                *(bf16x8*)(img + O_KDT + ((dt * 2 + cb) * 2 + 1) * 1024 + l * 16) = DN_PACK8(X, 1); }
        {
            u32x4 vf[2][4];
#pragma unroll
            for (int t = 0; t < 2; ++t) { const int pos = 32 * t + r; const size_t ro = (size_t)(base + (dir ? 63 - pos : pos)) * 384 + h * 64 + 8 * hq;
#pragma unroll
                for (int kk = 0; kk < 4; ++kk) vf[t][kk] = *(const u32x4*)(VB + ro + 16 * kk); }
#pragma unroll
            for (int sl = 0; sl < 2; ++sl)
#pragma unroll
                for (int ct = 0; ct < 2; ++ct) { f32x16 Y = {};
                    Y = DN_MFMA(__builtin_bit_cast(bf16x8, vf[ct][2 * sl]), ident_frag(0, r, hq), Y); Y = DN_MFMA(__builtin_bit_cast(bf16x8, vf[ct][2 * sl + 1]), ident_frag(1, r, hq), Y);
#pragma unroll
                    for (int t = 0; t < 16; ++t) Y[t] *= sbe[32 * ct + rowmap(t, hq)];
                    *(bf16x8*)(img + O_BV + ((sl * 2 + ct) * 64 + l) * 32) = DN_PACK8(Y, 0);
                    *(bf16x8*)(img + O_BV + ((sl * 2 + ct) * 64 + l) * 32 + 16) = DN_PACK8(Y, 1); }
        }
#undef KF
#undef QF
        __builtin_amdgcn_wave_barrier(); asm volatile("" ::: "memory");
        {
            const float* Ab = Al + hq * (32 * 64 + 32);
            float* Tb = Al + hq * (32 * 64) + (hq ? 0 : 32);
#pragma unroll 1
            for (int JB = 3; JB >= 0; --JB) {
                float acc[8];
#pragma unroll
                for (int jj = 0; jj < 8; ++jj) acc[jj] = (r == 8 * JB + jj) ? 1.f : 0.f;
                float tk[24];
#pragma unroll
                for (int k = 8; k < 32; ++k) { const float tv = Tb[k * 64 + r]; tk[k - 8] = (k >= 8 * (JB + 1)) ? tv : 0.f; }
                const float* Aj = Ab + (8 * JB) * 64;
#pragma unroll
                for (int jj = 0; jj < 8; ++jj) { float a0 = 0.f, a1 = 0.f;
#pragma unroll
                    for (int k4 = 2; k4 < 8; ++k4) { const f32x4 av = *(const f32x4*)(Aj + jj * 64 + 4 * k4);
                        a0 += tk[4 * k4 - 8] * av.x + tk[4 * k4 - 6] * av.z; a1 += tk[4 * k4 - 7] * av.y + tk[4 * k4 - 5] * av.w; }
                    acc[jj] -= a0 + a1; }
#pragma unroll
                for (int jj = 6; jj >= 0; --jj) {
                    const f32x4 a0v = *(const f32x4*)(Aj + jj * 64 + 8 * JB), a1v = *(const f32x4*)(Aj + jj * 64 + 8 * JB + 4);
                    const float av[8] = {a0v.x, a0v.y, a0v.z, a0v.w, a1v.x, a1v.y, a1v.z, a1v.w};
                    float a = acc[jj];
#pragma unroll
                    for (int kk = jj + 1; kk < 8; ++kk) a -= acc[kk] * av[kk];
                    acc[jj] = a; }
#pragma unroll
                for (int jj = 0; jj < 8; ++jj) Tb[(8 * JB + jj) * 64 + r] = acc[jj];
            }
            float T[32];
#pragma unroll
            for (int k = 0; k < 32; ++k) T[k] = Tb[k * 64 + r];
#pragma unroll
            for (int s = 0; s < 2; ++s)
#pragma unroll
                for (int h2 = 0; h2 < 2; ++h2) { const int k0 = 16 * s + 4 * h2;
                    u32x4 w; w.x = cvtpk(T[k0], T[k0 + 1]); w.y = cvtpk(T[k0 + 2], T[k0 + 3]); w.z = cvtpk(T[k0 + 8], T[k0 + 9]); w.w = cvtpk(T[k0 + 10], T[k0 + 11]);
                    *(u32x4*)(img + O_T + ((hq ? 4 : 0) + s) * 1024 + (32 * h2 + r) * 16) = w; }
        }
        __builtin_amdgcn_wave_barrier(); asm volatile("" ::: "memory");
    }
}

DEVI void glds16(const void* gsrc, unsigned lds_dst) { unsigned keep;
    asm volatile("s_mov_b32 %0, m0\n\ts_mov_b32 m0, %2\n\ts_nop 0\n\tglobal_load_lds_dwordx4 %1, off\n\ts_mov_b32 m0, %0" : "=&s"(keep) : "v"(gsrc), "s"(lds_dst) : "memory"); }
DEVI void scan_sequence(const Ctx& c, int seq) {
    const unsigned char* OPS = c.ws + WS_DN + DN_OPS + (size_t)seq * NCHK * IMG; float* OD = (float*)(c.ws + WS_DN + DN_O);
    const int b = seq / 12, h = (seq >> 1) % 6, dir = seq & 1;
    const int l = c.lane, r = l & 31, hq = l >> 5, w = c.wave;
    const unsigned lds0 = (unsigned)(uintptr_t)c.lds;
    const bool loader = (w >= 2), consumer = (w < 2);
    constexpr int RSLOT = 36864;
#define DN_ISSUE(step, slot) do { if (loader) { _Pragma("unroll") for (int q_ = 0; q_ < 6; ++q_) { const int p_ = (w - 2) * 6 + q_; \
        glds16(OPS + (size_t)(step) * IMG + p_ * 1024 + l * 16, (unsigned)__builtin_amdgcn_readfirstlane(lds0 + (slot) * RSLOT + p_ * 1024)); } } } while (0)
    f32x16 S0 = {}, S1 = {};
    float gam_n = 0.f; u32x4 bv_n[4] = {};
    if (consumer) { gam_n = *(const float*)(OPS + O_MISC);
        bv_n[0] = *(const u32x4*)(OPS + O_BV + ((w * 2 + 0) * 64 + l) * 32); bv_n[1] = *(const u32x4*)(OPS + O_BV + ((w * 2 + 0) * 64 + l) * 32 + 16);
        bv_n[2] = *(const u32x4*)(OPS + O_BV + ((w * 2 + 1) * 64 + l) * 32); bv_n[3] = *(const u32x4*)(OPS + O_BV + ((w * 2 + 1) * 64 + l) * 32 + 16); }
    DN_ISSUE(0, 0); DN_ISSUE(1, 1);
    int slot = 0;
    for (int n = 0; n < NCHK; ++n) {
        if (loader) { if (n + 1 < NCHK) asm volatile("s_waitcnt vmcnt(6)" ::: "memory"); else asm volatile("s_waitcnt vmcnt(0)" ::: "memory"); }
        asm volatile("s_barrier" ::: "memory");
        if (n + 2 < NCHK) { const int s2 = slot == 0 ? 2 : slot - 1; DN_ISSUE(n + 2, s2); }
        if (consumer) {
            const ldsp img = c.lds3 + slot * RSLOT; const int sl = w;
#define DN_A(off, f) (*(const __attribute__((address_space(3))) bf16x8*)(img + (off) + (f) * 1024 + l * 16))
            const float gamma = gam_n; const u32x4 a = bv_n[0], bq = bv_n[1], a1 = bv_n[2], b1 = bv_n[3];
            if (n + 1 < NCHK) { const unsigned char* g2 = OPS + (size_t)(n + 1) * IMG;
                gam_n = *(const float*)(g2 + O_MISC);
                bv_n[0] = *(const u32x4*)(g2 + O_BV + ((sl * 2 + 0) * 64 + l) * 32); bv_n[1] = *(const u32x4*)(g2 + O_BV + ((sl * 2 + 0) * 64 + l) * 32 + 16);
                bv_n[2] = *(const u32x4*)(g2 + O_BV + ((sl * 2 + 1) * 64 + l) * 32); bv_n[3] = *(const u32x4*)(g2 + O_BV + ((sl * 2 + 1) * 64 + l) * 32 + 16); }
            const bf16x8 sb00 = DN_PACK8(S0, 0), sb01 = DN_PACK8(S0, 1), sb10 = DN_PACK8(S1, 0), sb11 = DN_PACK8(S1, 1);
            f32x16 v0, v1;
            {
#pragma unroll
              for (int q = 0; q < 4; ++q) { v0[2 * q] = bflo(a[q]); v0[2 * q + 1] = bfhi(a[q]); v0[8 + 2 * q] = bflo(bq[q]); v0[8 + 2 * q + 1] = bfhi(bq[q]);
                  v1[2 * q] = bflo(a1[q]); v1[2 * q + 1] = bfhi(a1[q]); v1[8 + 2 * q] = bflo(b1[q]); v1[8 + 2 * q + 1] = bfhi(b1[q]); } }
            v0 = DN_MFMA(DN_A(O_NEGK, 0), sb00, v0); v1 = DN_MFMA(DN_A(O_NEGK, 4), sb00, v1);
            v0 = DN_MFMA(DN_A(O_NEGK, 1), sb01, v0); v1 = DN_MFMA(DN_A(O_NEGK, 5), sb01, v1);
            v0 = DN_MFMA(DN_A(O_NEGK, 2), sb10, v0); v1 = DN_MFMA(DN_A(O_NEGK, 6), sb10, v1);
            v0 = DN_MFMA(DN_A(O_NEGK, 3), sb11, v0); v1 = DN_MFMA(DN_A(O_NEGK, 7), sb11, v1);
            __builtin_amdgcn_sched_barrier(0);
            const bf16x8 vb00 = DN_PACK8(v0, 0), vb01 = DN_PACK8(v0, 1);
            f32x16 n0 = {}, n1 = {};
            n0 = DN_MFMA(DN_A(O_T, 0), vb00, n0); n0 = DN_MFMA(DN_A(O_T, 1), vb01, n0);
            const bf16x8 nb00 = DN_PACK8(n0, 0), nb01 = DN_PACK8(n0, 1);
            v1 = DN_MFMA(DN_A(O_T, 2), nb00, v1); v1 = DN_MFMA(DN_A(O_T, 3), nb01, v1);
            const bf16x8 xb10 = DN_PACK8(v1, 0), xb11 = DN_PACK8(v1, 1);
            n1 = DN_MFMA(DN_A(O_T, 4), xb10, n1); n1 = DN_MFMA(DN_A(O_T, 5), xb11, n1);
            const bf16x8 nb10 = DN_PACK8(n1, 0), nb11 = DN_PACK8(n1, 1);
            __builtin_amdgcn_sched_barrier(0);
            f32x16 o0 = {}, o1 = {};
            o0 = DN_MFMA(DN_A(O_QG, 0), sb00, o0); o1 = DN_MFMA(DN_A(O_QG, 4), sb00, o1);
            o0 = DN_MFMA(DN_A(O_QG, 1), sb01, o0); o1 = DN_MFMA(DN_A(O_QG, 5), sb01, o1);
            o0 = DN_MFMA(DN_A(O_QG, 2), sb10, o0); o1 = DN_MFMA(DN_A(O_QG, 6), sb10, o1);
            o0 = DN_MFMA(DN_A(O_QG, 3), sb11, o0); o1 = DN_MFMA(DN_A(O_QG, 7), sb11, o1);
            o0 = DN_MFMA(DN_A(O_AT, 0), nb00, o0); o1 = DN_MFMA(DN_A(O_AT, 2), nb00, o1);
            o0 = DN_MFMA(DN_A(O_AT, 1), nb01, o0); o1 = DN_MFMA(DN_A(O_AT, 3), nb01, o1);
            o1 = DN_MFMA(DN_A(O_AT, 4), nb10, o1); o1 = DN_MFMA(DN_A(O_AT, 5), nb11, o1);
            __builtin_amdgcn_sched_barrier(0);
            {
                const int base = chunk_base(b, dir, n); float* od = OD + (size_t)dir * NT * 384 + h * 64 + 32 * sl + r;
#pragma unroll
                for (int t = 0; t < 16; ++t) { const int i0 = rowmap(t, hq), i1 = 32 + i0;
                    od[(size_t)(base + (dir ? 63 - i0 : i0)) * 384] = o0[t]; od[(size_t)(base + (dir ? 63 - i1 : i1)) * 384] = o1[t]; }
            }
            __builtin_amdgcn_sched_barrier(0);
#pragma unroll
            for (int t = 0; t < 16; ++t) { S0[t] *= gamma; S1[t] *= gamma; }
            S0 = DN_MFMA(DN_A(O_KDT, 0), nb00, S0); S1 = DN_MFMA(DN_A(O_KDT, 4), nb00, S1);
            S0 = DN_MFMA(DN_A(O_KDT, 1), nb01, S0); S1 = DN_MFMA(DN_A(O_KDT, 5), nb01, S1);
            S0 = DN_MFMA(DN_A(O_KDT, 2), nb10, S0); S1 = DN_MFMA(DN_A(O_KDT, 6), nb10, S1);
            S0 = DN_MFMA(DN_A(O_KDT, 3), nb11, S0); S1 = DN_MFMA(DN_A(O_KDT, 7), nb11, S1);
#undef DN_A
        }
        slot = slot == 2 ? 0 : slot + 1;
    }
    asm volatile("s_waitcnt vmcnt(0) lgkmcnt(0)\n\ts_barrier" ::: "memory");
#undef DN_ISSUE
}
}

DEVI void phase_sgu(const Ctx& c, int layer, bool need_ctx) {
    using dn::bf16x8; using dn::f32x16;
    const bf16_t* Z = (const bf16_t*)(c.ws + WS_Z); const bf16_t* SV = (const bf16_t*)(c.ws + WS_SV); bf16_t* MIX = (bf16_t*)(c.ws + WS_MIX);
    const float* sw = c.in[I_SGUW] + (size_t)layer * 4 * 128 * 128; const float* sb = c.in[I_SGUB] + layer * 512;
    const int nchunks = (need_ctx ? NT : NLAT) / 128; const int l = c.lane, r = l & 31, hq = l >> 5;
    const bf16x8 id0 = dn::ident_frag(0, r, hq), id1 = dn::ident_frag(1, r, hq);
    for (int sit = c.gw; sit < nchunks * 32; sit += c.ngw) {
        const int it = sit >> 2, itile = sit & 3, ch = it >> 3, g = (it >> 1) & 3, dvb = it & 1, r0 = ch * 128;
        bf16x8 yb[4][2];
#pragma unroll
        for (int jt = 0; jt < 4; ++jt) { const bf16_t* sp = SV + (size_t)(r0 + 32 * jt + r) * 256 + g * 64 + 32 * dvb + 8 * hq;
            f32x16 Y = {};
            Y = DN_MFMA(__builtin_bit_cast(bf16x8, *(const u32x4*)sp), id0, Y); Y = DN_MFMA(__builtin_bit_cast(bf16x8, *(const u32x4*)(sp + 16)), id1, Y);
            yb[jt][0] = DN_PACK8(Y, 0); yb[jt][1] = DN_PACK8(Y, 1); }
        const float* wg = sw + (size_t)g * 128 * 128;
        {
            f32x16 C = {}; const float* wr = wg + (size_t)(32 * itile + r) * 128 + 4 * hq;
#pragma unroll
            for (int jt = 0; jt < 4; ++jt)
#pragma unroll
                for (int sI = 0; sI < 2; ++sI) { const f32x4 w0 = *(const f32x4*)(wr + 32 * jt + 16 * sI), w1 = *(const f32x4*)(wr + 32 * jt + 16 * sI + 8);
                    u32x4 a; a.x = dn::cvtpk(w0.x, w0.y); a.y = dn::cvtpk(w0.z, w0.w); a.z = dn::cvtpk(w1.x, w1.y); a.w = dn::cvtpk(w1.z, w1.w);
                    C = DN_MFMA(__builtin_bit_cast(bf16x8, a), yb[jt][sI], C); }
#pragma unroll
            for (int t = 0; t < 16; ++t) { const int i = 32 * itile + dn::rowmap(t, hq); const size_t row = (size_t)(r0 + i);
                const float u = gelu_f(bf2f(Z[row * ZP + ZC_MU + g * 64 + 32 * dvb + r]));
                MIX[row * 1024 + 768 + g * 64 + 32 * dvb + r] = (bf16_t)f2bf(u * (C[t] + sb[g * 128 + i])); }
        }
    }
}

namespace attn_body {
using bf16=__hip_bfloat16;
using bf16x8=__attribute__((ext_vector_type(8)))short;
using s16x4=__attribute__((ext_vector_type(4)))short;
using f32x16=__attribute__((ext_vector_type(16)))float;
using u32x4=__attribute__((ext_vector_type(4)))unsigned;
constexpr int D=64,QP=384,KVP=128,OP=1024;
constexpr int NW=8,QBLK=32,QB=QBLK*NW,KVBLK=64;
constexpr int ATTN_UNIT_ROWS=QB;
__device__ __forceinline__ int crow(int r,int hi){return (r&3)+8*(r>>2)+4*hi;}
#define SBAR() __builtin_amdgcn_sched_barrier(0)
__device__ __forceinline__ void cmask(f32x16&p0,f32x16&p1,int jb,int qrel,int hi){
  const float NEG=-INFINITY; int kb=64*jb+4*hi;
  #pragma unroll
  for(int r=0;r<16;++r){int kv=kb+(r&3)+8*(r>>2); if(kv>qrel)p0[r]=NEG; if(kv+32>qrel)p1[r]=NEG;}
}

constexpr int NSLOT=3, SLOTB=8192;
constexpr int LDS_K=0, LDS_V=NSLOT*SLOTB, LDS_WS=2*NSLOT*SLOTB, LDS_OST=LDS_WS+NW*64*4, LDS_BYTES=LDS_OST+NW*4096;
constexpr float C2=0.125f*1.4426950408889634f;
__device__ __forceinline__ void glds16(const void*gsrc,unsigned lds_dst){unsigned keep;
  asm volatile("s_mov_b32 %0, m0\n\ts_mov_b32 m0, %2\n\ts_nop 0\n\tglobal_load_lds_dwordx4 %1, off\n\ts_mov_b32 m0, %0":"=&s"(keep):"v"(gsrc),"s"(lds_dst):"memory");}
__device__ __forceinline__ float max3f(float a,float b,float c){float r;asm("v_max3_f32 %0, %1, %2, %3":"=v"(r):"v"(a),"v"(b),"v"(c));return r;}
__device__ __forceinline__ float max2f(float a,float b){float r;asm("v_max_f32_e32 %0, %1, %2":"=v"(r):"v"(a),"v"(b));return r;}
__device__ __forceinline__ float fadd_s(float a,float b){float r;asm("v_add_f32_e32 %0, %1, %2":"=v"(r):"v"(a),"v"(b));return r;}
__device__ __forceinline__ float fsub_s(float a,float b){float r;asm("v_sub_f32_e32 %0, %1, %2":"=v"(r):"v"(a),"v"(b));return r;}
typedef float f32x2_t __attribute__((ext_vector_type(2))); typedef __bf16 bf16x2_t __attribute__((ext_vector_type(2)));
__device__ __forceinline__ unsigned cvtpk_s(float lo,float hi){f32x2_t v={lo,hi};bf16x2_t b=__builtin_convertvector(v,bf16x2_t);return __builtin_bit_cast(unsigned,b);}
#define WAIT_BAR(N) asm volatile("s_waitcnt vmcnt(" #N ") lgkmcnt(0)\n\ts_barrier":::"memory")

__device__ __forceinline__ void qkt(f32x16&p0,f32x16&p1,const char*Kslot,const bf16x8*qr,const f32x16&negm,int r32,int hi){
  const char*kb=Kslot+hi*1024+r32*16;
  #pragma unroll
  for(int d0=0;d0<4;++d0){
    const bf16x8 b0=*reinterpret_cast<const bf16x8*>(kb+d0*2048);
    const bf16x8 b1=*reinterpret_cast<const bf16x8*>(kb+d0*2048+512);
    if(d0==0){p0=__builtin_amdgcn_mfma_f32_32x32x16_bf16(b0,qr[0],negm,0,0,0);p1=__builtin_amdgcn_mfma_f32_32x32x16_bf16(b1,qr[0],negm,0,0,0);}
    else{p0=__builtin_amdgcn_mfma_f32_32x32x16_bf16(b0,qr[d0],p0,0,0,0);p1=__builtin_amdgcn_mfma_f32_32x32x16_bf16(b1,qr[d0],p1,0,0,0);}}
}
typedef __attribute__((address_space(3))) const char* lds_cptr;
typedef short v4i16_t __attribute__((ext_vector_type(4)));
__device__ __forceinline__ void kload8(bf16x8*kf,lds_cptr kp){
  kf[0]=*(const __attribute__((address_space(3))) bf16x8*)(kp);      kf[1]=*(const __attribute__((address_space(3))) bf16x8*)(kp+512);
  kf[2]=*(const __attribute__((address_space(3))) bf16x8*)(kp+2048); kf[3]=*(const __attribute__((address_space(3))) bf16x8*)(kp+2560);
  kf[4]=*(const __attribute__((address_space(3))) bf16x8*)(kp+4096); kf[5]=*(const __attribute__((address_space(3))) bf16x8*)(kp+4608);
  kf[6]=*(const __attribute__((address_space(3))) bf16x8*)(kp+6144); kf[7]=*(const __attribute__((address_space(3))) bf16x8*)(kp+6656);
}
__device__ __forceinline__ void kload2(bf16x8*kf,lds_cptr kp,int j){ kf[2*j]=*(const __attribute__((address_space(3))) bf16x8*)(kp+j*2048); kf[2*j+1]=*(const __attribute__((address_space(3))) bf16x8*)(kp+j*2048+512); }
__device__ __forceinline__ s16x4 vtr(lds_cptr p){ return __builtin_bit_cast(s16x4,__builtin_amdgcn_ds_read_tr16_b64_v4i16((__attribute__((address_space(3))) v4i16_t*)p)); }
__device__ __forceinline__ float rowmax(const f32x16&p0,const f32x16&p1){
  float a=max3f(p0[0],p0[1],p1[0]),b=max3f(p0[2],p0[3],p1[1]);a=max3f(a,p1[2],p1[3]);
  #pragma unroll
  for(int r=4;r<16;r+=4){a=max3f(a,p0[r],p0[r+1]);b=max3f(b,p0[r+2],p0[r+3]);a=max3f(a,p1[r],p1[r+1]);b=max3f(b,p1[r+2],p1[r+3]);}
  const float m=max2f(a,b);
  auto rr=__builtin_amdgcn_permlane32_swap(__float_as_uint(m),__float_as_uint(m),false,false);
  return max2f(__uint_as_float(rr[0]),__uint_as_float(rr[1]));
}
__device__ __forceinline__ void pv(f32x16*o,int vb,bf16x8 pa0,bf16x8 pa1,bf16x8 pa2,bf16x8 pa3){
  #pragma unroll
  for(int d0=0;d0<2;++d0){s16x4 lo[4],hi[4];
    #pragma unroll
    for(int ks=0;ks<4;++ks){
      asm volatile("ds_read_b64_tr_b16 %0,%1 offset:%c2":"=&v"(lo[ks]):"v"(vb),"i"(d0*4096+ks*1024):"memory");
      asm volatile("ds_read_b64_tr_b16 %0,%1 offset:%c2":"=&v"(hi[ks]):"v"(vb),"i"(d0*4096+ks*1024+512):"memory");}
    asm volatile("s_waitcnt lgkmcnt(0)":::"memory");SBAR();
    #define PK(k) (bf16x8){lo[k][0],lo[k][1],lo[k][2],lo[k][3],hi[k][0],hi[k][1],hi[k][2],hi[k][3]}
    o[d0]=__builtin_amdgcn_mfma_f32_32x32x16_bf16(pa0,PK(0),o[d0],0,0,0);
    o[d0]=__builtin_amdgcn_mfma_f32_32x32x16_bf16(pa1,PK(1),o[d0],0,0,0);
    o[d0]=__builtin_amdgcn_mfma_f32_32x32x16_bf16(pa2,PK(2),o[d0],0,0,0);
    o[d0]=__builtin_amdgcn_mfma_f32_32x32x16_bf16(pa3,PK(3),o[d0],0,0,0);
    #undef PK
  }
}

#ifndef ATTN_STORE16
#define ATTN_STORE16(p,v) (*(u32x4*)(p)=(v))
#endif
template<int THRL> __device__ __forceinline__ void attn_unit(const bf16*Qu,const bf16*__restrict__ Kh,const bf16*__restrict__ Vh,const int NT,bf16*Ou,char*shm){
  const int tid=threadIdx.x,lane=tid&63,r32=lane&31,hi=lane>>5; const int wid=__builtin_amdgcn_readfirstlane(tid>>6);
  const bf16*Qw=Qu+(long)(wid*QBLK)*QP;
  const unsigned lds0=(unsigned)(uintptr_t)shm;
  float*wsf=(float*)(shm+LDS_WS)+wid*64;
  const bf16*ksrc=Kh+(long)lane*KVP+wid*8;
  const bf16*vsrc=Vh+(long)(16*(wid&3)+(lane>>2))*KVP+(wid>>2)*32+(lane&3)*8;
  const unsigned kdst=lds0+LDS_K+wid*1024, vdst=lds0+LDS_V+wid*1024;
  #define DMA_K(t,slot) glds16(ksrc+(long)(t)*KVBLK*KVP,(unsigned)__builtin_amdgcn_readfirstlane(kdst+(slot)))
  #define DMA_V(t,slot) glds16(vsrc+(long)(t)*KVBLK*KVP,(unsigned)__builtin_amdgcn_readfirstlane(vdst+(slot)))
  const int vb0=(int)(lds0+LDS_V)+((lane>>4)&1)*32+(lane&3)*8+(4*hi+((lane&15)>>2))*64;
  const char*Kbase=shm+LDS_K; bf16x8 kf[8];
  const lds_cptr shm3=(lds_cptr)shm; const lds_cptr kp0=shm3+LDS_K+hi*1024+r32*16; const lds_cptr vp0=shm3+LDS_V+((lane>>4)&1)*32+(lane&3)*8+(4*hi+((lane&15)>>2))*64;
  DMA_K(0,0);DMA_V(0,0);DMA_K(1,SLOTB);
  bf16x8 qr[4];
  #pragma unroll
  for(int d0=0;d0<4;++d0)qr[d0]=*reinterpret_cast<const bf16x8*>(&Qw[(long)r32*QP+d0*16+hi*8]);
  float mhat=0.f,l_reg=0.f;f32x16 o[2];o[0]=f32x16{};o[1]=f32x16{};f32x16 negm=f32x16{};asm volatile("":"+v"(negm));
  #define CMASK(P0,P1,t) do{}while(0)
  bool resc=false;
  #define START(P0,P1) do{ const float rm=rowmax(P0,P1); resc=false; \
    { const float dl=rm; mhat=fadd_s(mhat,dl); \
      _Pragma("unroll") for(int r=0;r<16;++r){P0[r]=fsub_s(P0[r],dl);P1[r]=fsub_s(P1[r],dl);} \
      _Pragma("unroll") for(int r=0;r<16;++r)negm[r]=-mhat; asm volatile("":"+v"(negm)); } \
    _Pragma("unroll") for(int r=0;r<16;++r)P0[r]=__builtin_amdgcn_exp2f(P0[r]); }while(0)
  #define RESC() do{ if(resc){ asm volatile("s_waitcnt lgkmcnt(0)":::"memory"); \
      _Pragma("unroll") for(int d_=0;d_<2;++d_) _Pragma("unroll") for(int r=0;r<16;++r)o[d_][r]*=wsf[crow(r,hi)]; } }while(0)
  f32x16 pA0,pA1,pB0,pB1;
  int sl_prev=0,sl_cur=0,sl_next=SLOTB;
  #define ROT() do{sl_prev=sl_cur;sl_cur=sl_next;sl_next=(sl_next==(NSLOT-1)*SLOTB)?0:sl_next+SLOTB;}while(0)
  DMA_K(2,2*SLOTB);
  WAIT_BAR(3);
  qkt(pA0,pA1,Kbase,qr,negm,r32,hi);asm volatile("s_nop 15\n\ts_nop 7":"+v"(pA0),"+v"(pA1));CMASK(pA0,pA1,0);
  START(pA0,pA1);
  _Pragma("unroll") for(int r=0;r<16;++r)pA1[r]=__builtin_amdgcn_exp2f(pA1[r]);
  WAIT_BAR(0);
  DMA_K(3,0);DMA_V(1,SLOTB);
  ROT();
  kload8(kf,kp0+sl_cur);
  WAIT_BAR(2);
  s16x4 vlo[8],vhi[8]; u32x4 pw0,pw1,pw2,pw3;
  #define PKW(P,B) cvtpk_s(P[B],P[B+1])
  #define PAF(k) __builtin_bit_cast(bf16x8,pw##k)
  #define VFR(i) (bf16x8){vlo[i][0],vlo[i][1],vlo[i][2],vlo[i][3],vhi[i][0],vhi[i][1],vhi[i][2],vhi[i][3]}
  #define PIN(x) asm volatile("":"+v"(x))
  #define MX3(a,b,c) __builtin_fmaxf(__builtin_fmaxf((a),(b)),(c))
  #define GAPA(MF,A0,A1,A2,A3,W0,W1,PW) do{ MF; sacc+=A0; sacc+=A1; sacc+=A2; sacc+=A3; PIN(sacc); W0; W1; PIN(PW); SBAR(); }while(0)
  #define EX(v) __builtin_amdgcn_exp2f(v)
  #define GAPB(MF,X,B) do{ MF; X[B]=EX(X[B]); X[B+1]=EX(X[B+1]); X[B+2]=EX(X[B+2]); X[B+3]=EX(X[B+3]); PIN(X); SBAR(); }while(0)
  #define VRD(i) do{ vlo[i]=vtr(vp_+(((i)>>2)*4096+((i)&3)*1024)); vhi[i]=vtr(vp_+(((i)>>2)*4096+((i)&3)*1024+512)); }while(0)
  #define KRD(G,j) do{ if(G){ kload2(kf,kp0+sl_next,j); SBAR(); } }while(0)
  #define STEP(C0,C1,P0,P1,t,GK,GV,GL) do{ SBAR(); \
    const lds_cptr vp_=vp0+sl_prev; \
    VRD(0); SBAR(); float sacc=(P0[0]+P0[1]); \
    GAPA(C0=__builtin_amdgcn_mfma_f32_32x32x16_bf16(kf[0],qr[0],negm,0,0,0), P0[2],P0[3],P0[4],P0[5],     pw0[0]=PKW(P0,0), pw0[1]=PKW(P0,2), pw0); \
    VRD(4); SBAR(); GAPA(C1=__builtin_amdgcn_mfma_f32_32x32x16_bf16(kf[1],qr[0],negm,0,0,0), P0[6],P0[7],P0[8],P0[9],     pw0[2]=PKW(P0,4), pw0[3]=PKW(P0,6), pw0); \
    VRD(1); SBAR(); GAPA(C0=__builtin_amdgcn_mfma_f32_32x32x16_bf16(kf[2],qr[1],C0,0,0,0),   P0[10],P0[11],P0[12],P0[13], pw1[0]=PKW(P0,8), pw1[1]=PKW(P0,10), pw1); \
    VRD(5); SBAR(); GAPA(C1=__builtin_amdgcn_mfma_f32_32x32x16_bf16(kf[3],qr[1],C1,0,0,0),   P0[14],P0[15],P1[0],P1[1],   pw1[2]=PKW(P0,12),pw1[3]=PKW(P0,14), pw1); \
    VRD(2); SBAR(); GAPA(C0=__builtin_amdgcn_mfma_f32_32x32x16_bf16(kf[4],qr[2],C0,0,0,0),   P1[2],P1[3],P1[4],P1[5],     pw2[0]=PKW(P1,0), pw2[1]=PKW(P1,2), pw2); \
    VRD(6); SBAR(); GAPA(C1=__builtin_amdgcn_mfma_f32_32x32x16_bf16(kf[5],qr[2],C1,0,0,0),   P1[6],P1[7],P1[8],P1[9],     pw2[2]=PKW(P1,4), pw2[3]=PKW(P1,6), pw2); \
    VRD(3); SBAR(); GAPA(C0=__builtin_amdgcn_mfma_f32_32x32x16_bf16(kf[6],qr[3],C0,0,0,0),   P1[10],P1[11],P1[12],P1[13], pw3[0]=PKW(P1,8), pw3[1]=PKW(P1,10), pw3); \
    VRD(7); SBAR(); GAPA(C1=__builtin_amdgcn_mfma_f32_32x32x16_bf16(kf[7],qr[3],C1,0,0,0),   P1[14],P1[15],0.f,0.f,       pw3[2]=PKW(P1,12),pw3[3]=PKW(P1,14), pw3); \
    l_reg+=sacc; \
    if(GK){DMA_K((t)+3,sl_cur);} if(GV){DMA_V((t)+1,sl_next);} \
    CMASK(C0,C1,t); \
    { float a=MX3(C0[0],C0[1],C1[0]),b=MX3(C0[2],C0[3],C1[1]); a=MX3(a,C1[2],C1[3]); \
      _Pragma("unroll") for(int r=4;r<16;r+=4){a=MX3(a,C0[r],C0[r+1]);b=MX3(b,C0[r+2],C0[r+3]);a=MX3(a,C1[r],C1[r+1]);b=MX3(b,C1[r+2],C1[r+3]);} \
      float rm=__builtin_fmaxf(a,b); { auto rr=__builtin_amdgcn_permlane32_swap(__float_as_uint(rm),__float_as_uint(rm),false,false); rm=__builtin_fmaxf(__uint_as_float(rr[0]),__uint_as_float(rr[1])); } \
      resc=false; \
      if(__builtin_expect(__any(rm>(float)THRL),0)){ const float dl=__builtin_fmaxf(rm,0.f); mhat+=dl; \
        _Pragma("unroll") for(int r=0;r<16;++r){C0[r]-=dl;C1[r]-=dl;} \
        _Pragma("unroll") for(int r=0;r<16;++r)negm[r]=-mhat; asm volatile("":"+v"(negm)); \
        const float f=__builtin_amdgcn_exp2f(-dl); l_reg*=f; if(hi==0)wsf[r32]=f; resc=true; } } \
    SBAR(); \
    GAPB(o[0]=__builtin_amdgcn_mfma_f32_32x32x16_bf16(PAF(0),VFR(0),o[0],0,0,0), C0,0); \
    GAPB(o[1]=__builtin_amdgcn_mfma_f32_32x32x16_bf16(PAF(0),VFR(4),o[1],0,0,0), C0,4); \
    KRD(GL,0); GAPB(o[0]=__builtin_amdgcn_mfma_f32_32x32x16_bf16(PAF(1),VFR(1),o[0],0,0,0), C0,8); \
    KRD(GL,1); GAPB(o[1]=__builtin_amdgcn_mfma_f32_32x32x16_bf16(PAF(1),VFR(5),o[1],0,0,0), C0,12); \
    KRD(GL,2); GAPB(o[0]=__builtin_amdgcn_mfma_f32_32x32x16_bf16(PAF(2),VFR(2),o[0],0,0,0), C1,0); \
    KRD(GL,3); GAPB(o[1]=__builtin_amdgcn_mfma_f32_32x32x16_bf16(PAF(2),VFR(6),o[1],0,0,0), C1,4); \
    GAPB(o[0]=__builtin_amdgcn_mfma_f32_32x32x16_bf16(PAF(3),VFR(3),o[0],0,0,0), C1,8); \
    GAPB(o[1]=__builtin_amdgcn_mfma_f32_32x32x16_bf16(PAF(3),VFR(7),o[1],0,0,0), C1,12); \
    }while(0)
  int t=1;
  #undef CMASK
  #define CMASK(P0,P1,t) do{}while(0)
  for(;t+5<NT;t+=2){
    STEP(pB0,pB1,pA0,pA1,t,true,true,true);     WAIT_BAR(2); RESC(); ROT();
    STEP(pA0,pA1,pB0,pB1,t+1,true,true,true);   WAIT_BAR(2); RESC(); ROT();
  }
  #undef CMASK
  #define CMASK(P0,P1,t) do{}while(0)
  #define ENDW(tt) do{ if((tt)+3<NT){WAIT_BAR(2);} else if((tt)+2<NT){WAIT_BAR(1);} else {WAIT_BAR(0);} }while(0)
  for(;t+1<NT;t+=2){
    STEP(pB0,pB1,pA0,pA1,t,(t+3<NT),(t+1<NT),(t+1<NT));       ENDW(t);   RESC(); ROT();
    STEP(pA0,pA1,pB0,pB1,t+1,(t+4<NT),(t+2<NT),(t+2<NT));     ENDW(t+1); RESC(); ROT();
  }
  STEP(pB0,pB1,pA0,pA1,NT-1,false,false,false); RESC();
  { float sacc=pB0[0]+pB0[1]; _Pragma("unroll") for(int r=2;r<16;++r)sacc+=pB0[r]; _Pragma("unroll") for(int r=0;r<16;++r)sacc+=pB1[r]; l_reg+=sacc;
    pw0=(u32x4){PKW(pB0,0),PKW(pB0,2),PKW(pB0,4),PKW(pB0,6)};pw1=(u32x4){PKW(pB0,8),PKW(pB0,10),PKW(pB0,12),PKW(pB0,14)};pw2=(u32x4){PKW(pB1,0),PKW(pB1,2),PKW(pB1,4),PKW(pB1,6)};pw3=(u32x4){PKW(pB1,8),PKW(pB1,10),PKW(pB1,12),PKW(pB1,14)};
    SBAR(); pv(o,vb0+sl_cur,PAF(0),PAF(1),PAF(2),PAF(3)); }
  #undef PKW
  #undef PAF
  #undef VFR
  #undef PIN
  #undef MX3
  #undef GAPA
  #undef GAPB
  #undef EX
  #undef VRD
  #undef KRD
  #undef STEP
  #undef ENDW
  {auto rr=__builtin_amdgcn_permlane32_swap(__float_as_uint(l_reg),__float_as_uint(l_reg),false,false);l_reg=__uint_as_float(rr[0])+__uint_as_float(rr[1]);}
  if(hi==0)wsf[32+r32]=l_reg;asm volatile("s_waitcnt lgkmcnt(0)":::"memory");
  float rli[16];
  #pragma unroll
  for(int r=0;r<16;++r)rli[r]=__builtin_amdgcn_rcpf(wsf[32+crow(r,hi)]);
  bf16*Ow=Ou+(long)(wid*QBLK)*OP;
  { bf16*stg=(bf16*)(shm+LDS_OST)+wid*2048;
    #pragma unroll
    for(int r=0;r<16;++r){const int orow=crow(r,hi);
      #pragma unroll
      for(int d0=0;d0<2;++d0)stg[orow*64+d0*32+r32]=__float2bfloat16(o[d0][r]*rli[r]);}
    asm volatile("s_waitcnt lgkmcnt(0)":::"memory");
    #pragma unroll
    for(int i=0;i<4;++i){const int row=i*8+(lane>>3),ch=lane&7; const u32x4 v=*(const u32x4*)(stg+row*64+ch*8); ATTN_STORE16(Ow+(long)row*OP+ch*8,v);} }
  asm volatile("s_waitcnt lgkmcnt(0)\n\ts_barrier":::"memory");
  #undef DMA_K
  #undef DMA_V
  #undef CMASK
  #undef START
  #undef RESC
  #undef ROT
}
constexpr int ATTN_LDS_BYTES=LDS_BYTES;
#undef SBAR
#undef WAIT_BAR
}

DEVI void attn_unit_run(const Ctx& c, int u) {
    using attn_body::bf16;
    const bf16* Qa = (const bf16*)(c.ws + WS_QA); const bf16* Qc = (const bf16*)(c.ws + WS_QC); const bf16* Ka = (const bf16*)(c.ws + WS_KA); const bf16* Va = (const bf16*)(c.ws + WS_VA);
    bf16* MIX = (bf16*)(c.ws + WS_MIX);
    if (u < 384) { const int grp = u / 48, rem = u % 48, g = rem >> 4, qb = rem & 15, b = grp >> 1, kvh = grp & 1, hq = kvh * 3 + g;
        attn_body::attn_unit<8>(Qa + (size_t)(b * SEQ + qb * 256) * 384 + hq * 64, Ka + (size_t)b * SKV * 128 + kvh * 64, Va + (size_t)b * SKV * 128 + kvh * 64, SKV / 64,
                                MIX + (size_t)(b * SEQ + qb * 256) * 1024 + 384 + hq * 64, (char*)c.lds); }
    else { const int uc = u - 384, b = uc / 6, hq = uc % 6, kvh = hq / 3;
        attn_body::attn_unit<8>(Qc + (size_t)(b * CTXL) * 384 + hq * 64, Ka + (size_t)b * SKV * 128 + kvh * 64, Va + (size_t)b * SKV * 128 + kvh * 64, CTXL / 64,
                                MIX + (size_t)(NLAT + b * CTXL) * 1024 + 384 + hq * 64, (char*)c.lds); }
}
template <bool FAST_SCAN>
DEVI void phase_mixer_fast(const Ctx& c, bool with_ctx, int psub = 0) {
    const int G = gridDim.x, bx = blockIdx.x; const int nunits = 384 + (with_ctx ? 24 : 0);
    if (G == 256) {
        const int vcu = (bx & 7) * 32 + (bx >> 3), x = vcu >> 5, j = vcu & 31;
        if (FAST_SCAN && j < 6) { if (!(psub & 4)) dn::scan_sequence(c, x * 6 + j); return; }
        if (psub & 8) return;
        if (!FAST_SCAN) { for (int u = vcu; u < nunits; u += 256) attn_unit_run(c, u); return; }
        const int jp = j - 6;
        attn_unit_run(c, 48 * x + jp);
        if (jp < 22) attn_unit_run(c, 48 * x + 26 + jp);
        else if (with_ctx && jp < 25) attn_unit_run(c, 384 + (x >> 1) * 6 + (x & 1) * 3 + (jp - 22));
    } else {
        if (FAST_SCAN) for (int sq = bx; sq < 48; sq += G) dn::scan_sequence(c, sq);
        for (int u = bx; u < nunits; u += G) attn_unit_run(c, u);
    }
}

DEVI void phase_moe_assign(const Ctx& c) {
    int* cnt = (int*)c.lds;
    int* misc = (int*)c.lds + 2048;
    int* slots = (int*)c.lds + 2048 + 64;
    const int* gcnt = (const int*)(c.ws + CTL_CNT); const int* tope = (const int*)(c.ws + CTL_TOPE);
    const bf16_t* H = (const bf16_t*)(c.ws + WS_H); bf16_t* XBm = (bf16_t*)(c.ws + WS_MXB);
    for (int i = c.tid; i < 2048; i += NTHREADS) cnt[i] = gcnt[i];
    __syncthreads();
    if (c.tid < 8) { int tot = 0; for (int v = 0; v < 256; ++v) tot += cnt[v * 8 + c.tid]; misc[8 + c.tid] = tot; }
    __syncthreads();
    if (c.tid == 0) { int s = 0; for (int e = 0; e < 8; ++e) { misc[16 + e] = s; s += (misc[8 + e] + 255) & ~255; } misc[24] = s;
        if (blockIdx.x == 0) { int* seg = (int*)(c.ws + CTL_SEG); for (int e = 0; e <= 8; ++e) seg[e] = misc[16 + e]; for (int e = 0; e < 8; ++e) seg[16 + e] = misc[8 + e];
            for (int e = 0; e < 8; ++e) for (int pm = misc[16 + e] >> 8; pm < (misc[16 + e + 1] >> 8); ++pm) seg[32 + pm] = e; } }
    __syncthreads();
    if (blockIdx.x == 0) {
        int* ut = (int*)(c.ws + CTL_UTAB); const int nu = (misc[24] >> 8) * 4, ntab = nu <= 512 ? nu : 512 + 4 * (nu - 512);
        if (c.tid == 0) ut[0] = ntab;
        for (int L = c.tid; L < ntab; L += NTHREADS) { const int unit = L < 512 ? L : 512 + ((L - 512) >> 2), pm = unit >> 2; int e = 0;
            for (int q = 1; q < 8; ++q) e += (pm * 256 >= misc[16 + q]) ? 1 : 0;
            ut[4 + 4 * L] = pm; ut[4 + 4 * L + 1] = (unit & 3) + 4 * e; ut[4 + 4 * L + 2] = L < 512 ? 0 : ((L - 512) & 3) * (MFF / 4); ut[4 + 4 * L + 3] = L < 512 ? 0 : MFF / 256; } }
    for (int vb = blockIdx.x; vb < 256; vb += gridDim.x) {
        int* sel = slots + 128;
        if (c.tid < 128) sel[c.tid] = tope[vb * 128 + c.tid];
        __syncthreads();
        if (c.tid < 8) { int bs = 0; for (int v = 0; v < vb; ++v) bs += cnt[v * 8 + c.tid];
            int rank = misc[16 + c.tid] + bs;
            for (int i = 0; i < 128; ++i) if (sel[i] == c.tid) { slots[i] = rank; ++rank; } }
        __syncthreads();
        if (c.tid < 128) ((int*)(c.ws + CTL_TOKSLOT))[vb * 128 + c.tid] = slots[c.tid];
        for (int a = c.wave; a < 128; a += NWAVES) { const int row = vb * 64 + (a >> 1); const int slot = slots[a];
            const u32x4* src = (const u32x4*)(H + (size_t)row * 1024) + c.lane; u32x4* dst = (u32x4*)(XBm + (size_t)slot * 1024) + c.lane; dst[0] = src[0]; dst[64] = src[64]; }
        __syncthreads();
    }
    for (int e = 0; e < 8; ++e) { const int p0 = misc[16 + e] + misc[8 + e], p1 = misc[16 + e + 1];
        for (int s = p0 + c.gw; s < p1; s += c.ngw) { u32x4* dst = (u32x4*)(XBm + (size_t)s * 1024) + c.lane; dst[0] = (u32x4){0u, 0u, 0u, 0u}; dst[64] = (u32x4){0u, 0u, 0u, 0u}; } }
}

DEVI u32x2 zsum3(const u32x2* z) { const u32x2 a = z[0], b = z[2048 * 256], d = z[2 * 2048 * 256]; u32x2 o;
    o.x = pk2(bflo(a.x) + bflo(b.x) + bflo(d.x), bfhi(a.x) + bfhi(b.x) + bfhi(d.x)); o.y = pk2(bflo(a.y) + bflo(b.y) + bflo(d.y), bfhi(a.y) + bfhi(b.y) + bfhi(d.y)); return o; }
DEVI void phase_final(const Ctx& c) {
    const float* xb = (const float*)(c.ws + WS_XB); const bf16_t* YB = (const bf16_t*)(c.ws + WS_MXB); const bf16_t* YB2 = (const bf16_t*)(c.ws + WS_YB2);
    const int* ts = (const int*)(c.ws + CTL_TOKSLOT); const float* tg = (const float*)(c.ws + CTL_TOPG);
    struct Sc { int s1, s2; float g1, g2; };
    struct Dt { u32x2 a[4], b[4], za[4], zb[4]; f32x4 x[4]; };
#define FIN_SC(sc, r) do { sc.s1 = ts[(r) * 2]; sc.s2 = ts[(r) * 2 + 1]; sc.g1 = tg[(r) * 2]; sc.g2 = tg[(r) * 2 + 1]; } while (0)
#define FIN_DT(dt, sc, r) do { const u32x2* y1_ = (const u32x2*)(YB + (size_t)sc.s1 * 1024) + c.lane; const u32x2* y2_ = (const u32x2*)(YB + (size_t)sc.s2 * 1024) + c.lane; \
        const u32x2* z1_ = (const u32x2*)(YB2 + (size_t)(sc.s1 >= 32768 ? sc.s1 - 32768 : 0) * 1024) + c.lane; const u32x2* z2_ = (const u32x2*)(YB2 + (size_t)(sc.s2 >= 32768 ? sc.s2 - 32768 : 0) * 1024) + c.lane; \
        const f32x4* xr_ = (const f32x4*)(xb + (size_t)(r) * 1024) + c.lane; \
        _Pragma("unroll") for (int j_ = 0; j_ < 4; ++j_) { dt.a[j_] = y1_[64 * j_]; dt.b[j_] = y2_[64 * j_]; dt.x[j_] = xr_[64 * j_]; \
            dt.za[j_] = sc.s1 >= 32768 ? zsum3(z1_ + 64 * j_) : (u32x2){0u, 0u}; dt.zb[j_] = sc.s2 >= 32768 ? zsum3(z2_ + 64 * j_) : (u32x2){0u, 0u}; } } while (0)
    int r = c.gw; if (r >= NLAT) return;
    Sc sc0, sc1, sc2; Dt d0, d1;
    FIN_SC(sc0, r); sc1 = sc0; sc2 = sc0;
    if (r + c.ngw < NLAT) FIN_SC(sc1, r + c.ngw);
    FIN_DT(d0, sc0, r); d1 = d0;
    for (; r < NLAT; r += c.ngw) {
        if (r + 2 * c.ngw < NLAT) FIN_SC(sc2, r + 2 * c.ngw);
        if (r + c.ngw < NLAT) FIN_DT(d1, sc1, r + c.ngw);
        const float g1 = sc0.g1, g2 = sc0.g2; const f32x4* gt = (const f32x4*)modv(c, 1, r, 5) + c.lane;
        f32x4 v[4]; float ss = 0.f;
#pragma unroll
        for (int j = 0; j < 4; ++j) { const u32x2 a = d0.a[j], b = d0.b[j], p = d0.za[j], q = d0.zb[j]; const f32x4 g = gt[64 * j]; f32x4 y;
            y.x = g1 * (bflo(a.x) + bflo(p.x)) + g2 * (bflo(b.x) + bflo(q.x)); y.y = g1 * (bfhi(a.x) + bfhi(p.x)) + g2 * (bfhi(b.x) + bfhi(q.x));
            y.z = g1 * (bflo(a.y) + bflo(p.y)) + g2 * (bflo(b.y) + bflo(q.y)); y.w = g1 * (bfhi(a.y) + bfhi(p.y)) + g2 * (bfhi(b.y) + bfhi(q.y));
            v[j] = d0.x[j] + g * y; ss += (v[j].x * v[j].x + v[j].y * v[j].y) + (v[j].z * v[j].z + v[j].w * v[j].w); }
        const float rstd = rsqrtf(wave_sum(ss) * (1.f / 1024.f) + EPS);
        const f32x4* fg = (const f32x4*)c.in[I_FNG] + c.lane; f32x4* o = (f32x4*)(c.out + (size_t)r * 1024) + c.lane;
#pragma unroll
        for (int j = 0; j < 4; ++j) o[64 * j] = v[j] * rstd * fg[64 * j];
        sc0 = sc1; sc1 = sc2; d0 = d1;
    }
#undef FIN_SC
#undef FIN_DT
}

#define LAS __attribute__((address_space(3)))
#define XB_TMO      128
#define XB_XCNT(j)  (256  + 64 * (j))
#define XB_XSUB(j)  (1280 + 64 * (j))
#define XB_XGEN(j)  (2304 + 64 * (j))
#define XB_TOP      3328
#define XB_TOPGEN   3392
#define XCD_BAR_WORDS 3456
#define XB_SPIN_CAP (1u << 18)

__device__ __forceinline__ unsigned xb_ld(unsigned* p)              { return __hip_atomic_load(p, __ATOMIC_RELAXED, __HIP_MEMORY_SCOPE_AGENT); }
__device__ __forceinline__ unsigned xb_add(unsigned* p, unsigned v) { return __hip_atomic_fetch_add(p, v, __ATOMIC_RELAXED, __HIP_MEMORY_SCOPE_AGENT); }
__device__ __forceinline__ unsigned xb_xcc_id() { return (unsigned)__builtin_amdgcn_s_getreg((3 << 11) | 20) & 0xFu; }
#define XB_SPIN(cond, bar) do { unsigned _sp = 0; while (cond) { __builtin_amdgcn_s_sleep(1); \
    if ((++_sp & 255u) == 0u) { if (xb_ld(&(bar)[XB_TMO])) break; if (_sp > XB_SPIN_CAP) { atomicAdd(&(bar)[XB_TMO], 1u); break; } } } } while (0)

struct XcdBarrier {
    unsigned* bar; unsigned x;
    volatile LAS unsigned* st;
};

__device__ __forceinline__ XcdBarrier xcd_barrier_post(unsigned* bar, volatile LAS unsigned* st) {
    XcdBarrier b; b.bar = bar; b.x = xb_xcc_id(); b.st = st;
    if (threadIdx.x == 0) (void)xb_add(&bar[XB_XCNT(b.x)], 1u);
    return b;
}
__device__ __forceinline__ void xcd_barrier_complete(unsigned* bar, unsigned x, unsigned& nloc, unsigned& nx) {
    const unsigned G = gridDim.x * gridDim.y * gridDim.z;
    unsigned sum, cnt, mine, sp = 0u;
    for (;;) {
        sum = 0u; cnt = 0u; mine = 0u;
#pragma unroll
        for (unsigned j = 0; j < 16; ++j) { const unsigned c = xb_ld(&bar[XB_XCNT(j)]); sum += c; cnt += (c > 0u) ? 1u : 0u; mine = (j == x) ? c : mine; }
        if (sum == G) break;
        __builtin_amdgcn_s_sleep(1);
        if ((++sp & 255u) == 0u) { if (xb_ld(&bar[XB_TMO])) break; if (sp > XB_SPIN_CAP) { atomicAdd(&bar[XB_TMO], 1u); break; } }
    }
    nloc = mine > 0u ? mine : 1u; nx = cnt > 0u ? cnt : 1u;
}

__device__ __forceinline__ void xcd_barrier(const XcdBarrier& b) {
    asm volatile("s_waitcnt vmcnt(0)" ::: "memory");
    __syncthreads();
    if (threadIdx.x == 0) {
        unsigned* bar = b.bar;
        __builtin_amdgcn_s_waitcnt(0);
        unsigned nloc = b.st[0], nx = b.st[1];
        if (nloc == 0u) { xcd_barrier_complete(bar, b.x, nloc, nx); b.st[0] = nloc; b.st[1] = nx; }
        const unsigned old = xb_add(&bar[XB_XSUB(b.x)], 1u);
        const unsigned gen = old / nloc;
        if (old + 1u == (gen + 1u) * nloc) {
            __builtin_amdgcn_fence(__ATOMIC_RELEASE, "agent");
            asm volatile("s_waitcnt vmcnt(0)" ::: "memory");
            const unsigned og = xb_add(&bar[XB_TOP], 1u);
            const unsigned tg = og / nx;
            if (og + 1u == (tg + 1u) * nx) xb_add(&bar[XB_TOPGEN], 1u);
            else XB_SPIN(xb_ld(&bar[XB_TOPGEN]) == tg, bar);
            __builtin_amdgcn_fence(__ATOMIC_ACQUIRE, "agent");
            xb_add(&bar[XB_XGEN(b.x)], 1u);
            asm volatile("s_waitcnt vmcnt(0)" ::: "memory");
        } else {
            XB_SPIN(xb_ld(&bar[XB_XGEN(b.x)]) == gen, bar);
            __builtin_amdgcn_fence(__ATOMIC_ACQUIRE, "agent");
            asm volatile("s_waitcnt vmcnt(0)" ::: "memory");
        }
    }
    __syncthreads();
}

#ifndef FAST_DN
#define FAST_DN 1
#endif
constexpr int NPHASES = 24;
#define IN(k) (lo <= (k) && (k) < hi)
#define SYNC(k) do { if (IN(k) && IN((k) + 1)) xcd_barrier(grid); } while (0)
template <int LAYER>
DEVI void mixer_phases(const Ctx& c, int lo, int hi, int psub, const XcdBarrier& grid) {
    constexpr int P = 1 + LAYER * 10;
    bf16_t* wl = (bf16_t*)(c.ws + WS_WL);
    const float* mvl = (const float*)(c.ws + CTL_MODV) + (size_t)LAYER * 5 * 6144;
    const float* xl = LAYER == 0 ? c.in[I_X] : (const float*)(c.ws + WS_XB); const float* xc = LAYER == 0 ? c.in[I_CTX] : (const float*)(c.ws + WS_XB) + (size_t)NLAT * 1024;
    if (IN(P)) { phase_norm<false>(c, LAYER, 0, c.in[I_N1G] + LAYER * 1024, NT, xl, xc, LAYER == 1 ? (const float*)(c.ws + WS_PB) : nullptr); } SYNC(P);
    if (IN(P + 1)) { const bf16_t* bt = (const bf16_t*)((char*)wl + WL_WIN) + (size_t)LAYER * ZP * 1024;
        pg8::Gemm g{(const bf16_t*)(c.ws + WS_H), bt, NT, ZP, 1024}; pg8::StaticOrder S; S.init(NT, ZP, (int)gridDim.x, (int)blockIdx.x);
        pg8::gemm_phase<pg8::EpiStore, pg8::StaticOrder, true, true>(c.lds3, g, S, pg8::EpiStore{(bf16_t*)(c.ws + WS_Z), ZP, 0, 0l}); } SYNC(P + 1);
    if (IN(P + 2)) { phase_prep(c, LAYER, LAYER == 0); } SYNC(P + 2);
#if FAST_DN
    if (IN(P + 3)) { if (!(psub & 1)) dn::phase_chunkprep(c); if (!(psub & 2)) phase_sgu(c, LAYER, LAYER == 0); } SYNC(P + 3);
    if (IN(P + 4)) { phase_mixer_fast<true>(c, LAYER == 0, psub); } SYNC(P + 4);
#else
    if (IN(P + 3)) { phase_sgu(c, LAYER, LAYER == 0); } SYNC(P + 3);
    if (IN(P + 4)) { phase_dnscan_naive(c); phase_mixer_fast<false>(c, LAYER == 0); } SYNC(P + 4);
#endif
    if (IN(P + 5)) { phase_dnfinish(c, LAYER, LAYER == 0 ? NT : NLAT); } SYNC(P + 5);
    if (IN(P + 6)) { const bf16_t* bt = (const bf16_t*)((char*)wl + WL_WOUT) + (size_t)LAYER * 1024 * 1024;
        constexpr int MR = LAYER == 0 ? NT : NLAT;
        pg8::Gemm g{(const bf16_t*)(c.ws + WS_MIX), bt, MR, 1024, 1024}; pg8::StaticOrder S; S.init(MR, 1024, (int)gridDim.x, (int)blockIdx.x);
        pg8::gemm_phase<pg8::EpiRes, pg8::StaticOrder, true, true>(c.lds3, g, S, pg8::EpiRes{(float*)(c.ws + WS_XB), mvl, 2, xl, xc, nullptr});
        if (LAYER == 0 && gridDim.x == 256 && blockIdx.x >= 16) phase_conv_m2(c, ((int)blockIdx.x - 16) * NWAVES + c.wave, 240 * NWAVES, 0, 4); } SYNC(P + 6);
}

__global__ void __launch_bounds__(NTHREADS, 2) mega_fwd(Args args) {
    extern __shared__ __attribute__((aligned(16))) unsigned char lds_raw[];
    Ctx c;
#pragma unroll
    for (int i = 0; i < 28; ++i) c.in[i] = args.in[i];
    c.out = args.out; c.ws = args.ws; c.tid = threadIdx.x; c.lane = c.tid & 63; c.wave = __builtin_amdgcn_readfirstlane(c.tid >> 6);
    c.gw = blockIdx.x * NWAVES + c.wave; c.ngw = gridDim.x * NWAVES; c.lds = (float*)lds_raw; c.lds3 = (__attribute__((address_space(3))) unsigned char*)lds_raw;
    bf16_t* wl = (bf16_t*)(c.ws + WS_WL);
    const int lo = args.ph_lo, hi = args.ph_hi;
    volatile LAS unsigned* bst = (volatile LAS unsigned*)(c.lds3 + LDS_BYTES - 64);
    if (c.tid < 16) bst[c.tid] = 0u;
    __syncthreads();
    const XcdBarrier grid = xcd_barrier_post((unsigned*)(c.ws + WS_CTL), bst);
    if (IN(0)) { phase_prologue(c); } SYNC(0);
    mixer_phases<0>(c, lo, hi, args.probe_sub, grid);
    {
        const float* mvl = (const float*)(c.ws + CTL_MODV);
        const float* xbl = (const float*)(c.ws + WS_XB); const float* xbc = xbl + (size_t)NLAT * 1024;
        if (IN(8)) { phase_norm<false>(c, 0, 3, c.in[I_N2G], NT, xbl, xbc); } SYNC(8);
        if (IN(9)) { pg8::Gemm g{(const bf16_t*)(c.ws + WS_H), (const bf16_t*)((char*)wl + WL_F13), NT, 2 * FF, 1024}; pg8::StaticOrder S; S.init(NT, 2 * FF, (int)gridDim.x, (int)blockIdx.x);
            pg8::gemm_phase<pg8::EpiSwi, pg8::StaticOrder, true, true>(c.lds3, g, S, pg8::EpiSwi{(bf16_t*)(c.ws + WS_Z), FF, 0}); } SYNC(9);
        if (IN(10)) { pg8::Gemm g{(const bf16_t*)(c.ws + WS_Z), (const bf16_t*)((char*)wl + WL_F2), NT, 1024, FF}; pg8::FfnDownOrder S; S.init((int)gridDim.x, (int)blockIdx.x);
            pg8::gemm_phase<pg8::EpiRes, pg8::FfnDownOrder, true, true>(c.lds3, g, S, pg8::EpiRes{(float*)(c.ws + WS_XB), mvl, 5, xbl, xbc, (float*)(c.ws + WS_PB)});
            if (gridDim.x == 256 && blockIdx.x >= 64) phase_conv_m2(c, ((int)blockIdx.x - 64) * NWAVES + c.wave, 192 * NWAVES, 4, 7); } SYNC(10);
    }
    mixer_phases<1>(c, lo, hi, args.probe_sub, grid);
    {
        if (IN(18)) { const float* xbl = (const float*)(c.ws + WS_XB);
            if (gridDim.x == 256) {
                {
                    f32x4* rwl = (f32x4*)(c.lds + 256);
                    for (int idx = c.tid; idx < 2048; idx += NTHREADS) { const int ln = idx & 63, hf = (idx >> 6) & 1, jq = idx >> 7, col = 4 * ln + 256 * (jq >> 2) + (jq & 3);
                        rwl[idx] = *(const f32x4*)(c.in[I_RW] + col * 8 + 4 * hf); }
                    __syncthreads(); }
                if (c.wave < 4) norm_router_rows16(c, c.in[I_N2G] + 1024, xbl, (const f32x4*)(c.lds + 256), (int*)c.lds);
                else { phase_conv_m13(c, (int)blockIdx.x * 4 + (c.wave - 4), 1024); phase_conv_m2(c, (int)blockIdx.x * 4 + (c.wave - 4), 1024, 7, 8); }
                __syncthreads();
                if (c.tid < 8) { const int* sel = (const int*)c.lds; int n = 0; for (int q = 0; q < 128; ++q) n += (sel[q] == c.tid) ? 1 : 0; ((int*)(c.ws + CTL_CNT))[blockIdx.x * 8 + c.tid] = n; }
            } else { phase_norm<true>(c, 1, 3, c.in[I_N2G] + 1024, NLAT, xbl, xbl + (size_t)NLAT * 1024); phase_conv_m13(c); phase_conv_m2(c); } } SYNC(18);
        if (IN(19)) { phase_moe_assign(c); } SYNC(19);
        if (IN(20)) { pg8::Gemm g{(const bf16_t*)(c.ws + WS_MXB), (const bf16_t*)(c.ws + WS_M13), 0, 0, 1024}; pg8::MoeOrder S; S.init((const int*)(c.ws + CTL_SEG), 28, (int)gridDim.x, (int)blockIdx.x);
            pg8::gemm_phase<pg8::EpiSwi, pg8::MoeOrder, true, true>(c.lds3, g, S, pg8::EpiSwi{(bf16_t*)(c.ws + WS_MHID), MFF, 28}); } SYNC(20);
        if (IN(22)) { pg8::Gemm g{(const bf16_t*)(c.ws + WS_MHID), (const bf16_t*)c.out, 0, 0, MFF}; pg8::TableOrder S; S.init((const int*)(c.ws + CTL_UTAB), (int)gridDim.x, (int)blockIdx.x);
            pg8::gemm_phase<pg8::EpiStore, pg8::TableOrder, true, true>(c.lds3, g, S, pg8::EpiStore{(bf16_t*)(c.ws + WS_MXB), 1024, 4, (long)((WS_YB2 - WS_MXB) / 2) - 32768l * 1024}); } SYNC(22);
        if (IN(23)) { phase_final(c); }
    }
}
#undef IN
#undef SYNC

extern "C" void kernel_launch(void* const* d_in, const int* in_sizes, int n_in, void* d_out, int out_size, void* d_ws, size_t ws_size, hipStream_t stream) {
    static int grid = 0;
    if (grid == 0) {
        if (n_in != 28 || out_size != NLAT * D || ws_size < WS_END) { fprintf(stderr, "kernel_launch: unexpected shapes (n_in %d out %d ws %zu)\n", n_in, out_size, ws_size); grid = -1; return; }
        int dev = 0, cus = 0, per_cu = 0;
        hipGetDevice(&dev); hipDeviceGetAttribute(&cus, hipDeviceAttributeMultiprocessorCount, dev);
        hipFuncSetAttribute((const void*)mega_fwd, hipFuncAttributeMaxDynamicSharedMemorySize, LDS_BYTES);
        hipOccupancyMaxActiveBlocksPerMultiprocessor(&per_cu, (const void*)mega_fwd, NTHREADS, LDS_BYTES);
        if (per_cu < 1) { fprintf(stderr, "kernel_launch: occupancy query says %d blocks per CU\n", per_cu); per_cu = 1; }
        (void)hipGetLastError();
        grid = cus;
    }
    if (grid < 0) return;
    if (hipMemsetAsync(d_ws, 0, 16384, stream) != hipSuccess) { fprintf(stderr, "kernel_launch: memset of the barrier words failed\n"); return; }
    Args a{};
    for (int i = 0; i < 28; ++i) a.in[i] = (const float*)d_in[i];
    a.out = (float*)d_out; a.ws = (unsigned char*)d_ws;
#ifndef MK_PER_PHASE
#define MK_PER_PHASE 0
#endif
#if MK_PER_PHASE
    for (int ph = 0; ph < NPHASES; ++ph) {
        a.ph_lo = ph; a.ph_hi = ph + 1; void* kargs[] = {&a};
        hipError_t e = hipLaunchCooperativeKernel((const void*)mega_fwd, dim3(grid), dim3(NTHREADS), kargs, LDS_BYTES, stream);
        if (e != hipSuccess) { fprintf(stderr, "launch failed: %s\n", hipGetErrorString(e)); break; }
    }
#else
    a.ph_lo = 0; a.ph_hi = NPHASES; void* kargs[] = {&a};
    hipError_t e = hipLaunchCooperativeKernel((const void*)mega_fwd, dim3(grid), dim3(NTHREADS), kargs, LDS_BYTES, stream);
    if (e != hipSuccess) fprintf(stderr, "launch failed: %s\n", hipGetErrorString(e));
#ifndef PROBE_LO
#define PROBE_LO -1
#define PROBE_HI -1
#endif
#if PROBE_LO >= 0
    (void)hipMemsetAsync(d_ws, 0, 16384, stream);
    a.ph_lo = PROBE_LO; a.ph_hi = PROBE_HI;
#ifdef PROBE_SUB
    a.probe_sub = PROBE_SUB;
#endif
    e = hipLaunchCooperativeKernel((const void*)mega_fwd, dim3(grid), dim3(NTHREADS), kargs, LDS_BYTES, stream);
    if (e != hipSuccess) fprintf(stderr, "probe launch failed: %s\n", hipGetErrorString(e));
#endif
#endif
}
```

```cpp
#include <hip/hip_runtime.h>
#include <hip/hip_cooperative_groups.h>
#include <hip/hip_bf16.h>
#include <cstdio>
#include <cstdint>
namespace cg = cooperative_groups;

#define DEVI __device__ __forceinline__
typedef unsigned short bf16_t;
typedef float f32x4 __attribute__((ext_vector_type(4)));
typedef float f32x2 __attribute__((ext_vector_type(2)));
typedef unsigned u32x4 __attribute__((ext_vector_type(4)));
typedef unsigned u32x2 __attribute__((ext_vector_type(2)));

constexpr int D = 1024, NB = 4, SEQ = 4096, CTXL = 256;
constexpr int NLAT = NB * SEQ, NCTX = NB * CTXL, NT = NLAT + NCTX;
constexpr int SKV = CTXL + SEQ;
constexpr int INC = 2712, ZP = 2816;
constexpr int ZC_QKV = 0, ZC_GATE = 1152, ZC_AQ = 1536, ZC_AK = 1920, ZC_AV = 2048, ZC_MU = 2176, ZC_MV = 2432, ZC_BETA = 2688, ZC_ALPHA = 2700;
constexpr int FF = 2816, MFF = 3584, NE = 8;
constexpr int MAXSLOT = 34816;
constexpr float EPS = 1e-6f;
constexpr float QSCALE = 0.125f * 1.4426950408889634f;

constexpr size_t MiB = 1u << 20, KiB = 1024;
constexpr size_t WS_CTL = 0;
constexpr size_t CTL_ROPE = 32 * KiB;
constexpr size_t CTL_MODV = 64 * KiB;
constexpr size_t CTL_TOPE = 320 * KiB;
constexpr size_t CTL_TOPG = 448 * KiB;
constexpr size_t CTL_CNT = 576 * KiB;
constexpr size_t CTL_SEG = 584 * KiB;
constexpr size_t CTL_TOKSLOT = 592 * KiB;
constexpr size_t CTL_UTAB = 720 * KiB;
constexpr size_t WS_XB = 4 * MiB;
constexpr size_t WS_WL = 72 * MiB;
constexpr size_t WL_WIN = 0;
constexpr size_t WL_WOUT = 11 * MiB;
constexpr size_t WL_F13 = 15 * MiB;
constexpr size_t WL_F2 = 26 * MiB;
static_assert(WL_WIN + (size_t)2 * 2816 * 1024 * 2 <= WL_WOUT && WL_WOUT + (size_t)2 * 1024 * 1024 * 2 <= WL_F13 && WL_F13 + (size_t)5632 * 1024 * 2 <= WL_F2 && WS_WL + WL_F2 + (size_t)1024 * 2816 * 2 <= 104 * MiB, "WL map");
constexpr size_t WS_H = 104 * MiB;
constexpr size_t WS_Z = 138 * MiB;
constexpr size_t WS_MIX = 232 * MiB;
constexpr size_t WS_QA = 266 * MiB;
constexpr size_t WS_QC = 278 * MiB;
constexpr size_t WS_KA = 279 * MiB;
constexpr size_t WS_VA = 284 * MiB;
constexpr size_t WS_DN = 289 * MiB;
constexpr size_t WS_QN = WS_H, WS_KN = WS_H + 13 * MiB;
constexpr size_t DN_VB = 0;
constexpr size_t DN_BG = 13 * MiB;
constexpr size_t DN_O = 15 * MiB;
constexpr size_t WS_SV = 499 * MiB;
constexpr size_t DN_OPS = 66 * MiB;
static_assert(WS_DN + DN_OPS + (size_t)3264 * 46080 <= WS_SV && WS_SV + (size_t)NT * 256 * 2 <= 512 * MiB, "ws");
constexpr size_t WS_MHID = 72 * MiB;
constexpr size_t WS_MXB = 310 * MiB;
constexpr size_t WS_M13 = 378 * MiB;
constexpr size_t WS_M2 = 378 * MiB;
constexpr size_t WS_PB = 232 * MiB;
constexpr size_t WS_YB2 = 440 * MiB;
constexpr size_t WS_END = 512 * MiB;
static_assert(WS_M13 + (size_t)8 * 7168 * 1024 * 2 <= WS_END, "ws");
static_assert(WS_MHID + (size_t)MAXSLOT * 3584 * 2 <= WS_MXB && WS_MXB + (size_t)MAXSLOT * 1024 * 2 <= WS_M13, "ws");
static_assert(WS_H + (size_t)NT * 1024 * 2 <= WS_Z && WS_Z + (size_t)NT * ZP * 2 <= WS_MIX && WS_MIX + (size_t)NT * 1024 * 2 <= WS_QA, "ws");

constexpr int LDS_BYTES = 147456;
constexpr int NTHREADS = 512, NWAVES = 8;

DEVI unsigned f2bf(float f) { unsigned u = __float_as_uint(f); return (u + 0x7fffu + ((u >> 16) & 1u)) >> 16; }
DEVI float bf2f(unsigned h) { return __uint_as_float(h << 16); }
DEVI unsigned pk2(float lo, float hi) { return f2bf(lo) | (f2bf(hi) << 16); }
DEVI float bflo(unsigned w) { return __uint_as_float(w << 16); }
DEVI float bfhi(unsigned w) { return __uint_as_float(w & 0xffff0000u); }
DEVI void unpack8(const u32x4 w, float* v) { v[0] = bflo(w.x); v[1] = bfhi(w.x); v[2] = bflo(w.y); v[3] = bfhi(w.y); v[4] = bflo(w.z); v[5] = bfhi(w.z); v[6] = bflo(w.w); v[7] = bfhi(w.w); }
DEVI u32x4 pack8(const float* v) { u32x4 w; w.x = pk2(v[0], v[1]); w.y = pk2(v[2], v[3]); w.z = pk2(v[4], v[5]); w.w = pk2(v[6], v[7]); return w; }
DEVI float wave_sum(float v) {
#pragma unroll
    for (int o = 1; o < 64; o <<= 1) v += __shfl_xor(v, o);
    return v;
}
DEVI float wave_max(float v) {
#pragma unroll
    for (int o = 1; o < 64; o <<= 1) v = fmaxf(v, __shfl_xor(v, o));
    return v;
}
DEVI float silu_f(float x) { return x * __builtin_amdgcn_rcpf(1.f + __expf(-x)); }
DEVI float gelu_f(float x) { const float u = 0.7978845608028654f * (x + 0.044715f * x * x * x); const float e = __expf(2.f * u); return x * (1.f - __builtin_amdgcn_rcpf(1.f + e)); }
DEVI float softplus_f(float x) { const float e = __expf(-fabsf(x)); const float l = e < 0.01f ? e * (1.f - e * (0.5f - e * 0.33333334f)) : __logf(1.f + e); return fmaxf(x, 0.f) + l; }
DEVI int row_mod(int r) { return r < NLAT ? (r >> 12) : 4; }

struct Args { const float* in[28]; float* out; unsigned char* ws; int ph_lo, ph_hi, probe_sub, pad; };

struct Ctx {
    const float* in[28]; float* out; unsigned char* ws;
    int tid, lane, wave, gw, ngw;
    float* lds;
    __attribute__((address_space(3))) unsigned char* lds3;
};
enum { I_X = 0, I_C, I_CTX, I_CCTX, I_MODW, I_MODB, I_N1G, I_N2G, I_WIN, I_CONVW, I_ALOG, I_DTB, I_DNG, I_QG, I_KG, I_SGUG, I_SGUW, I_SGUB, I_WOUT,
       I_F1, I_F3, I_F2, I_RW, I_RB, I_M1, I_M3, I_M2, I_FNG };

DEVI const float* modv(const Ctx& c, int layer, int r, int which) { return (const float*)(c.ws + CTL_MODV) + ((size_t)(layer * 5 + row_mod(r)) * 6 + which) * 1024; }

template <int MAP>
DEVI int map_row(int n, int add) {
    if (MAP == 1) return n < 1536 ? n : (n < 1560 ? n + 1152 : n - 24);
    if (MAP == 2) return (n >> 7) * 256 + (n & 127) + add;
    return n;
}
template <int MAP>
DEVI void transpose_tiles(const Ctx& c, const float* W, int K, int N, bf16_t* WT, int add, int& base, int wv = -1, int nwv = 0) {
    float* Ls = c.lds + c.wave * (64 * 65);
    const int ntn = (N + 63) / 64, ntiles = (K / 64) * ntn, G = wv < 0 ? c.ngw : nwv, wid = wv < 0 ? c.gw : wv;
    const int nq = c.lane & 15, kr = c.lane >> 4, cch = c.lane & 7, rn = c.lane >> 3;
    int t = (wid - base % G + G) % G;
    base += ntiles;
    f32x4 v[16];
#define TT_LOAD(tile) do { const int kb_ = (tile) / ntn, nb_ = (tile) % ntn, n_ = nb_ * 64 + 4 * nq; \
        _Pragma("unroll") for (int p_ = 0; p_ < 16; ++p_) v[p_] = n_ < N ? __builtin_nontemporal_load((const f32x4*)(W + (size_t)(kb_ * 64 + kr + 4 * p_) * N + n_)) : (f32x4){0.f, 0.f, 0.f, 0.f}; } while (0)
    if (t < ntiles) TT_LOAD(t);
    for (; t < ntiles; t += G) {
#pragma unroll
        for (int p = 0; p < 16; ++p) { float* q = Ls + (kr + 4 * p) * 65 + 4 * nq; q[0] = v[p].x; q[1] = v[p].y; q[2] = v[p].z; q[3] = v[p].w; }
        if (t + G < ntiles) TT_LOAD(t + G);
        __builtin_amdgcn_wave_barrier(); asm volatile("" ::: "memory");
        const int kb = t / ntn, nb = t % ntn;
#pragma unroll
        for (int j = 0; j < 8; ++j) { const int nl = 8 * j + rn, n = nb * 64 + nl; float x[8];
#pragma unroll
            for (int i = 0; i < 8; ++i) x[i] = Ls[(8 * cch + i) * 65 + nl];
            if (n < N) *(u32x4*)(WT + (size_t)map_row<MAP>(n, add) * K + kb * 64 + 8 * cch) = pack8(x); }
        __builtin_amdgcn_wave_barrier(); asm volatile("" ::: "memory");
    }
#undef TT_LOAD
}

DEVI void phase_prologue(const Ctx& c) {
    bf16_t* wl = (bf16_t*)(c.ws + WS_WL);
    int tb = 0;
    for (int l = 0; l < 2; ++l) {
        transpose_tiles<1>(c, c.in[I_WIN] + (size_t)l * 1024 * INC, 1024, INC, (bf16_t*)((char*)wl + WL_WIN) + (size_t)l * ZP * 1024, 0, tb);
        transpose_tiles<0>(c, c.in[I_WOUT] + (size_t)l * 1024 * 1024, 1024, 1024, (bf16_t*)((char*)wl + WL_WOUT) + (size_t)l * 1024 * 1024, 0, tb);
        u32x4* pad = (u32x4*)((bf16_t*)((char*)wl + WL_WIN) + (size_t)l * ZP * 1024 + (size_t)INC * 1024);
        for (int i = c.gw * 64 + c.lane; i < (ZP - INC) * 1024 / 8; i += c.ngw * 64) pad[i] = (u32x4){0u, 0u, 0u, 0u};
    }
    transpose_tiles<2>(c, c.in[I_F1], 1024, FF, (bf16_t*)((char*)wl + WL_F13), 0, tb);
    transpose_tiles<2>(c, c.in[I_F3], 1024, FF, (bf16_t*)((char*)wl + WL_F13), 128, tb);
    transpose_tiles<0>(c, c.in[I_F2], FF, 1024, (bf16_t*)((char*)wl + WL_F2), 0, tb);
    if (blockIdx.x == 0) for (int i = c.tid; i < 2 * 64 * 16; i += NTHREADS) { const int p = i & 15, pos = (i >> 4) & 63, ax = i >> 10;
        const float ang = (float)pos * powf(10000.f, -2.f * (float)p / 32.f); float* tp = (float*)(c.ws + CTL_ROPE) + (ax * 64 + pos) * 32; tp[p] = cosf(ang); tp[16 + p] = sinf(ang); }
    if (blockIdx.x == 0 && c.tid < 32) ((float*)(c.ws + CTL_ROPE))[128 * 32 + c.tid] = c.tid < 16 ? 1.f : 0.f;
    __syncthreads();
    {
        float* sc = c.lds;
        float* part = c.lds + 5 * 1024;
        for (int i = c.tid; i < 5 * 1024; i += NTHREADS) { const int r = i >> 10, k = i & 1023; const float v = r < 4 ? c.in[I_C][r * 1024 + k] : c.in[I_CCTX][k]; sc[i] = silu_f(v); }
        __syncthreads();
        for (int item = blockIdx.x; item < 2 * 96; item += gridDim.x) {
            const int l = item / 96, j = (item % 96) * 64 + c.lane;
            const float* w = c.in[I_MODW] + (size_t)l * 1024 * 6144 + j;
            float a0 = 0.f, a1 = 0.f, a2 = 0.f, a3 = 0.f, a4 = 0.f;
            const int kb = c.wave * 128;
#pragma unroll 4
            for (int k = 0; k < 128; ++k) { const float wv = w[(size_t)(kb + k) * 6144]; a0 += sc[kb + k] * wv; a1 += sc[1024 + kb + k] * wv; a2 += sc[2048 + kb + k] * wv; a3 += sc[3072 + kb + k] * wv; a4 += sc[4096 + kb + k] * wv; }
            float* p = part + c.wave * 320 + c.lane; p[0] = a0; p[64] = a1; p[128] = a2; p[192] = a3; p[256] = a4;
            __syncthreads();
            if (c.tid < 320) { float s = 0.f;
#pragma unroll
                for (int w8 = 0; w8 < 8; ++w8) s += part[w8 * 320 + c.tid];
                const int r = c.tid >> 6, jj = (item % 96) * 64 + (c.tid & 63);
                ((float*)(c.ws + CTL_MODV))[(size_t)(l * 5 + r) * 6144 + jj] = s + c.in[I_MODB][l * 6144 + jj]; }
            __syncthreads();
        }
    }
}

DEVI void phase_conv_m13(const Ctx& c, int wv = -1, int nwv = 0) {
    int tb = 0;
    for (int e = 0; e < NE; ++e) {
        bf16_t* dst = (bf16_t*)(c.ws + WS_M13) + (size_t)e * 7168 * 1024;
        transpose_tiles<2>(c, c.in[I_M1] + (size_t)e * 1024 * MFF, 1024, MFF, dst, 0, tb, wv, nwv);
        transpose_tiles<2>(c, c.in[I_M3] + (size_t)e * 1024 * MFF, 1024, MFF, dst, 128, tb, wv, nwv);
    }
}
DEVI void phase_conv_m2(const Ctx& c, int wv = -1, int nwv = 0, int e0 = 0, int e1 = NE) {
    int tb = 0;
    for (int e = e0; e < e1; ++e)
        transpose_tiles<0>(c, c.in[I_M2] + (size_t)e * MFF * 1024, MFF, 1024, (bf16_t*)c.out + (size_t)e * 1024 * MFF, 0, tb, wv, nwv);
}

template <bool ROUTER>
DEVI void phase_norm(const Ctx& c, int layer, int which0, const float* gain, int nrows, const float* src_lat, const float* src_ctx, const float* addp = nullptr, int rpw = 8) {
    bf16_t* H = (bf16_t*)(c.ws + WS_H);
#define NORM_ROW(rr) ((rr) < NLAT ? src_lat + (size_t)(rr) * 1024 : src_ctx + (size_t)((rr) - NLAT) * 1024)
    int* sel = (int*)c.lds;
    const int nvb = nrows / 64;
    int vb = blockIdx.x, i = 0;
    int r = ROUTER ? vb * 64 + c.wave * rpw : c.wave * (int)gridDim.x + (int)blockIdx.x;
    bool valid = ROUTER ? (vb < nvb && c.wave * rpw < 64) : (r < nrows);
    f32x4 v[4];
    if (valid) { const f32x4* xr = (const f32x4*)NORM_ROW(r) + c.lane;
#pragma unroll
        for (int j = 0; j < 4; ++j) v[j] = xr[64 * j]; }
    while (valid) {
        int rn, vbn = vb, in_ = i + 1; bool validn;
        if (ROUTER) { if (in_ == rpw) { in_ = 0; vbn = vb + gridDim.x; } rn = vbn * 64 + c.wave * rpw + in_; validn = vbn < nvb; }
        else { rn = r + c.ngw; validn = rn < nrows; }
        f32x4 vn[4];
        if (validn) { const f32x4* xr = (const f32x4*)NORM_ROW(rn) + c.lane;
#pragma unroll
            for (int j = 0; j < 4; ++j) vn[j] = xr[64 * j]; }
        if (addp && r >= NLAT) { const f32x4* pr = (const f32x4*)(addp + (size_t)(r - NLAT) * 1024) + c.lane;
#pragma unroll
            for (int j = 0; j < 4; ++j) v[j] = v[j] + (pr[64 * j] + pr[64 * j + 262144] + pr[64 * j + 524288]); }
        float ss = 0.f;
#pragma unroll
        for (int j = 0; j < 4; ++j) ss += (v[j].x * v[j].x + v[j].y * v[j].y) + (v[j].z * v[j].z + v[j].w * v[j].w);
        const float rstd = rsqrtf(wave_sum(ss) * (1.f / 1024.f) + EPS);
        const f32x4* g4 = (const f32x4*)gain + c.lane; const f32x4* sh4 = (const f32x4*)modv(c, layer, r, which0) + c.lane; const f32x4* sc4 = (const f32x4*)modv(c, layer, r, which0 + 1) + c.lane;
        u32x2* o8 = (u32x2*)(H + (size_t)r * 1024) + c.lane;
#pragma unroll
        for (int j = 0; j < 4; ++j) { const f32x4 g = g4[64 * j], sh = sh4[64 * j], sc = sc4[64 * j];
            v[j] = v[j] * rstd * g * (1.f + sc) + sh;
            u32x2 o; o.x = pk2(v[j].x, v[j].y); o.y = pk2(v[j].z, v[j].w); o8[64 * j] = o; }
        if (ROUTER) {
            float lg[8];
#pragma unroll
            for (int e = 0; e < 8; ++e) lg[e] = 0.f;
            const float* rw = c.in[I_RW];
#pragma unroll
            for (int j = 0; j < 4; ++j)
#pragma unroll
                for (int q = 0; q < 4; ++q) { const int col = 4 * c.lane + 256 * j + q; const f32x4 w0 = *(const f32x4*)(rw + col * 8), w1 = *(const f32x4*)(rw + col * 8 + 4); const float hv = v[j][q];
                    lg[0] += hv * w0.x; lg[1] += hv * w0.y; lg[2] += hv * w0.z; lg[3] += hv * w0.w; lg[4] += hv * w1.x; lg[5] += hv * w1.y; lg[6] += hv * w1.z; lg[7] += hv * w1.w; }
#pragma unroll
            for (int e = 0; e < 8; ++e) lg[e] = wave_sum(lg[e]) + c.in[I_RB][e];
            int e1 = 0; float l1 = lg[0];
#pragma unroll
            for (int e = 1; e < 8; ++e) if (lg[e] > l1) { l1 = lg[e]; e1 = e; }
            int e2 = -1; float l2 = -3.0e38f;
#pragma unroll
            for (int e = 0; e < 8; ++e) if (e != e1 && lg[e] > l2) { l2 = lg[e]; e2 = e; }
            const float g2 = 1.f / (1.f + expf(l1 - l2)), g1 = 1.f - g2;
            if (c.lane == 0) { int* te = (int*)(c.ws + CTL_TOPE) + r * 2; te[0] = e1; te[1] = e2; float* tg = (float*)(c.ws + CTL_TOPG) + r * 2; tg[0] = g1; tg[1] = g2;
                sel[(c.wave * rpw + i) * 2] = e1; sel[(c.wave * rpw + i) * 2 + 1] = e2; }
            if (rpw == 8 && i == 7) {
                __syncthreads();
                if (c.tid < 8) { int n = 0; for (int q = 0; q < 128; ++q) n += (sel[q] == c.tid) ? 1 : 0; ((int*)(c.ws + CTL_CNT))[vb * 8 + c.tid] = n; }
                __syncthreads();
            }
        }
#pragma unroll
        for (int j = 0; j < 4; ++j) v[j] = vn[j];
        r = rn; vb = vbn; i = in_; valid = validn;
    }
}

DEVI void norm_router_rows16(const Ctx& c, const float* gain, const float* src, const f32x4* rwl, int* sel) {
    bf16_t* H = (bf16_t*)(c.ws + WS_H);
    const int r0 = blockIdx.x * 64 + c.wave * 16;
    const f32x4* g4 = (const f32x4*)gain + c.lane; const f32x4* sh4 = (const f32x4*)modv(c, 1, r0, 3) + c.lane; const f32x4* sc4 = (const f32x4*)modv(c, 1, r0, 4) + c.lane;
    auto ld = [&](f32x4 (&v)[4], const int i) __attribute__((always_inline)) { const f32x4* xr = (const f32x4*)(src + (size_t)(r0 + i) * 1024) + c.lane;
#pragma unroll
        for (int j = 0; j < 4; ++j) v[j] = xr[64 * j]; };
    auto row = [&](f32x4 (&v)[4], const int i) __attribute__((always_inline)) {
        const int r = r0 + i; float ss = 0.f;
#pragma unroll
        for (int j = 0; j < 4; ++j) ss += (v[j].x * v[j].x + v[j].y * v[j].y) + (v[j].z * v[j].z + v[j].w * v[j].w);
        const float rstd = rsqrtf(wave_sum(ss) * (1.f / 1024.f) + EPS);
        u32x2* o8 = (u32x2*)(H + (size_t)r * 1024) + c.lane;
#pragma unroll
        for (int j = 0; j < 4; ++j) { const f32x4 g = g4[64 * j], sh = sh4[64 * j], sc = sc4[64 * j];
            v[j] = v[j] * rstd * g * (1.f + sc) + sh;
            u32x2 o; o.x = pk2(v[j].x, v[j].y); o.y = pk2(v[j].z, v[j].w); o8[64 * j] = o; }
        float lg[8];
#pragma unroll
        for (int e = 0; e < 8; ++e) lg[e] = 0.f;
#pragma unroll
        for (int j = 0; j < 4; ++j)
#pragma unroll
            for (int q = 0; q < 4; ++q) { const f32x4 w0 = rwl[((4 * j + q) * 2) * 64 + c.lane], w1 = rwl[((4 * j + q) * 2 + 1) * 64 + c.lane]; const float hv = v[j][q];
                lg[0] += hv * w0.x; lg[1] += hv * w0.y; lg[2] += hv * w0.z; lg[3] += hv * w0.w; lg[4] += hv * w1.x; lg[5] += hv * w1.y; lg[6] += hv * w1.z; lg[7] += hv * w1.w; }
#pragma unroll
        for (int e = 0; e < 8; ++e) lg[e] = wave_sum(lg[e]) + c.in[I_RB][e];
        int e1 = 0; float l1 = lg[0];
#pragma unroll
        for (int e = 1; e < 8; ++e) if (lg[e] > l1) { l1 = lg[e]; e1 = e; }
        int e2 = -1; float l2 = -3.0e38f;
#pragma unroll
        for (int e = 0; e < 8; ++e) if (e != e1 && lg[e] > l2) { l2 = lg[e]; e2 = e; }
        const float g2 = 1.f / (1.f + expf(l1 - l2)), g1 = 1.f - g2;
        if (c.lane == 0) { int* te = (int*)(c.ws + CTL_TOPE) + r * 2; te[0] = e1; te[1] = e2; float* tg = (float*)(c.ws + CTL_TOPG) + r * 2; tg[0] = g1; tg[1] = g2;
            sel[(c.wave * 16 + i) * 2] = e1; sel[(c.wave * 16 + i) * 2 + 1] = e2; }
    };
    f32x4 A[4], B[4], C[4];
    ld(A, 0); ld(B, 1); ld(C, 2);
    for (int i = 0; i < 15; i += 3) { row(A, i); ld(A, i + 3); row(B, i + 1); if (i + 4 < 16) ld(B, i + 4); row(C, i + 2); if (i + 5 < 16) ld(C, i + 5); }
    row(A, 15);
}

#undef NORM_ROW
template <bool DUAL, class BSel, class Epi>
DEVI void gemm_naive(const Ctx& c, const bf16_t* A, int lda, int K, int ntm, int ntn, const BSel& bsel, const Epi& epi) {
    float* As = c.lds; float* Bs = c.lds + 32 * 132; float* Bs2 = c.lds + 2 * 32 * 132;
    const int ty = c.tid >> 4, tx = c.tid & 15, lr = c.tid >> 2, lk = (c.tid & 3) * 8;
    for (int tile = blockIdx.x; tile < ntm * ntn; tile += gridDim.x) {
        const int tm = tile / ntn, tn = tile % ntn;
        const bf16_t* B0 = bsel(tm, tn, 0); if (!B0) continue;
        const bf16_t* B1 = DUAL ? bsel(tm, tn, 1) : B0;
        float acc[4][8], acc2[4][8];
#pragma unroll
        for (int i = 0; i < 4; ++i)
#pragma unroll
            for (int j = 0; j < 8; ++j) { acc[i][j] = 0.f; acc2[i][j] = 0.f; }
        const bf16_t* ap = A + (size_t)(tm * 128 + lr) * lda + lk; const bf16_t* bp = B0 + (size_t)lr * K + lk; const bf16_t* bp2 = B1 + (size_t)lr * K + lk;
        for (int k0 = 0; k0 < K; k0 += 32) {
            const u32x4 av = *(const u32x4*)(ap + k0), bv = *(const u32x4*)(bp + k0); u32x4 bv2 = bv; if (DUAL) bv2 = *(const u32x4*)(bp2 + k0);
            __syncthreads();
#pragma unroll
            for (int q = 0; q < 4; ++q) { As[(lk + 2 * q) * 132 + lr] = bflo(av[q]); As[(lk + 2 * q + 1) * 132 + lr] = bfhi(av[q]);
                Bs[(lk + 2 * q) * 132 + lr] = bflo(bv[q]); Bs[(lk + 2 * q + 1) * 132 + lr] = bfhi(bv[q]);
                if (DUAL) { Bs2[(lk + 2 * q) * 132 + lr] = bflo(bv2[q]); Bs2[(lk + 2 * q + 1) * 132 + lr] = bfhi(bv2[q]); } }
            __syncthreads();
#pragma unroll 4
            for (int kk = 0; kk < 32; ++kk) {
                const f32x4 a = *(const f32x4*)(As + kk * 132 + ty * 4); const f32x4 b0 = *(const f32x4*)(Bs + kk * 132 + tx * 8), b1 = *(const f32x4*)(Bs + kk * 132 + tx * 8 + 4);
#pragma unroll
                for (int i = 0; i < 4; ++i) { acc[i][0] += a[i] * b0.x; acc[i][1] += a[i] * b0.y; acc[i][2] += a[i] * b0.z; acc[i][3] += a[i] * b0.w; acc[i][4] += a[i] * b1.x; acc[i][5] += a[i] * b1.y; acc[i][6] += a[i] * b1.z; acc[i][7] += a[i] * b1.w; }
                if (DUAL) { const f32x4 c0 = *(const f32x4*)(Bs2 + kk * 132 + tx * 8), c1 = *(const f32x4*)(Bs2 + kk * 132 + tx * 8 + 4);
#pragma unroll
                    for (int i = 0; i < 4; ++i) { acc2[i][0] += a[i] * c0.x; acc2[i][1] += a[i] * c0.y; acc2[i][2] += a[i] * c0.z; acc2[i][3] += a[i] * c0.w; acc2[i][4] += a[i] * c1.x; acc2[i][5] += a[i] * c1.y; acc2[i][6] += a[i] * c1.z; acc2[i][7] += a[i] * c1.w; } }
            }
        }
#pragma unroll
        for (int i = 0; i < 4; ++i) epi(tm * 128 + ty * 4 + i, tn * 128 + tx * 8, acc[i], acc2[i]);
    }
}
struct BSelPlain { const bf16_t* Bt; int K; DEVI const bf16_t* operator()(int, int tn, int) const { return Bt + (size_t)tn * 128 * K; } };
struct BSelDual { const bf16_t* Bt; int K; DEVI const bf16_t* operator()(int, int tn, int which) const { return Bt + (size_t)(tn * 256 + which * 128) * K; } };
struct BSelMoe { const bf16_t* Bt; int K; int rows_per_expert; bool dual; const int* seg;
    DEVI const bf16_t* operator()(int tm, int tn, int which) const {
        const int s = tm * 128; if (s >= seg[8]) return nullptr; int e = 0;
#pragma unroll
        for (int q = 1; q < 8; ++q) e += (s >= seg[q]) ? 1 : 0;
        return Bt + (size_t)e * rows_per_expert * K + (size_t)(dual ? tn * 256 + which * 128 : tn * 128) * K; } };
struct EpiStoreBf16 { bf16_t* O; int ldc; DEVI void operator()(int r, int c0, const float* a, const float*) const {
    u32x4 o; o.x = pk2(a[0], a[1]); o.y = pk2(a[2], a[3]); o.z = pk2(a[4], a[5]); o.w = pk2(a[6], a[7]); *(u32x4*)(O + (size_t)r * ldc + c0) = o; } };
struct EpiSwiglu { bf16_t* O; int ldc; DEVI void operator()(int r, int c0, const float* a, const float* b) const {
    float h[8];
#pragma unroll
    for (int j = 0; j < 8; ++j) h[j] = silu_f(a[j]) * b[j];
    u32x4 o; o.x = pk2(h[0], h[1]); o.y = pk2(h[2], h[3]); o.z = pk2(h[4], h[5]); o.w = pk2(h[6], h[7]); *(u32x4*)(O + (size_t)r * ldc + c0) = o; } };
struct EpiResid { float* XB; const float* mv; int which;
    DEVI void operator()(int r, int c0, const float* a, const float*) const {
        const float* g = mv + (size_t)(row_mod(r) * 6 + which) * 1024 + c0; float* x = XB + (size_t)r * 1024 + c0;
        f32x4 x0 = *(f32x4*)x, x1 = *(f32x4*)(x + 4); const f32x4 g0 = *(const f32x4*)g, g1 = *(const f32x4*)(g + 4);
        x0.x += g0.x * a[0]; x0.y += g0.y * a[1]; x0.z += g0.z * a[2]; x0.w += g0.w * a[3]; x1.x += g1.x * a[4]; x1.y += g1.y * a[5]; x1.z += g1.z * a[6]; x1.w += g1.w * a[7];
        *(f32x4*)x = x0; *(f32x4*)(x + 4) = x1; } };

namespace pg8 {
#define PG8_LAS __attribute__((address_space(3)))

typedef short bf16x8 __attribute__((ext_vector_type(8)));


constexpr int MOE_FF = 3584;
constexpr int BM = 256, BK = 64, HALF = 128, HTB = HALF * BK * 2  , STAGE_BYTES = 8 * HTB, NXCD = 8, WGM = 8;

__host__ __device__ __forceinline__ int lds_byte(int r, int c) { const int st = (r >> 4) * 2 + (c >> 5), rr = r & 15, cc = c & 31, ob = rr * 64 + cc * 2; return st * 1024 + (ob ^ (((ob >> 9) & 1) << 5)); }
__host__ __device__ __forceinline__ void stage_rc(int b, int& R, int& C) { const int st = b / 1024, sb = b % 1024, swz = sb ^ (((sb >> 9) & 1) << 5); R = (st >> 1) * 16 + swz / 64; C = (st & 1) * 32 + (swz % 64) / 2; }
__host__ __device__ __forceinline__ int perm32(int rho) { const int n = rho >> 4, i = rho & 15; return 8 * (i >> 2) + 4 * n + (i & 3); }

struct Unit { int pm, pn, ko, nt; };
struct Gemm { const bf16_t* A; const bf16_t* Bt; int M, N, K; };

struct StaticOrder {
    int nM, nN, nwg, G, c;
    __host__ __device__ void init(int M, int N, int G_, int c_) { nM = M / BM; nN = N / BM; nwg = nM * nN; G = G_; c = c_; }
    __host__ __device__ bool next(int i, Unit& u) const {
        const long L = (long)i * G + c; if (L >= nwg) return false;
        int wgid = (int)L; { const int q = nwg / NXCD, r = nwg % NXCD, xcd = wgid % NXCD, off = wgid / NXCD; wgid = (xcd < r ? xcd * (q + 1) : r * (q + 1) + (xcd - r) * q) + off; }
        const int nig = WGM * nN, gid = wgid / nig, fm = gid * WGM, gsz = (nM - fm) < WGM ? (nM - fm) : WGM;
        u.pm = fm + ((wgid % nig) % gsz); u.pn = (wgid % nig) / gsz; u.ko = 0; u.nt = 0; return true;
    }
    __device__ __forceinline__ void a_ready(const Unit&) const {}
    __device__ __forceinline__ void done(const Unit&) const {}
};


__device__ __forceinline__ unsigned cvt_pk_bf16(float lo, float hi) { unsigned r; asm volatile("v_cvt_pk_bf16_f32 %0, %1, %2" : "=v"(r) : "v"(lo), "v"(hi)); return r; }
__device__ __forceinline__ float silu1(float x) { return x * __builtin_amdgcn_rcpf(1.f + __expf(-x)); }
struct EpiStore {
    static constexpr bool PERM = true, AFTER_DRAIN = false;
    bf16_t* O; int ldc; int nN; long d2;
    __device__ __forceinline__ void operator()(const f32x4 (&acc)[2][2][4][2], const Unit& u, int wr, int wc, int fr, int fq) const {
        const int row0 = u.pm * BM + wr * 64 + fr, pnl = nN ? u.pn % nN : u.pn, col0 = pnl * BM + wc * 32 + 8 * fq;
        bf16_t* Ob = O + (u.ko ? d2 + (long)(u.ko / 896 - 1) * (2048l * 1024) : 0l);
#pragma unroll
        for (int ai = 0; ai < 2; ++ai)
#pragma unroll
            for (int m = 0; m < 4; ++m) { bf16_t* rowp = Ob + (size_t)(row0 + ai * HALF + m * 16) * ldc + col0;
#pragma unroll
                for (int bj = 0; bj < 2; ++bj) { const f32x4 v0 = acc[ai][bj][m][0], v1 = acc[ai][bj][m][1];
                    u32x4 w; w.x = cvt_pk_bf16(v0[0], v0[1]); w.y = cvt_pk_bf16(v0[2], v0[3]); w.z = cvt_pk_bf16(v1[0], v1[1]); w.w = cvt_pk_bf16(v1[2], v1[3]);
                    *(u32x4*)(rowp + bj * HALF) = w; } }
    }
};
struct EpiSwi {
    static constexpr bool PERM = true, AFTER_DRAIN = false;
    bf16_t* O; int ldc; int nN;
    __device__ __forceinline__ void operator()(const f32x4 (&acc)[2][2][4][2], const Unit& u, int wr, int wc, int fr, int fq) const {
        const int row0 = u.pm * BM + wr * 64 + fr, pnl = nN ? u.pn % nN : u.pn, col0 = pnl * HALF + wc * 32 + 8 * fq;
#pragma unroll
        for (int ai = 0; ai < 2; ++ai)
#pragma unroll
            for (int m = 0; m < 4; ++m) { bf16_t* rowp = O + (size_t)(row0 + ai * HALF + m * 16) * ldc + col0;
                const f32x4 a0 = acc[ai][0][m][0], a1 = acc[ai][0][m][1], b0 = acc[ai][1][m][0], b1 = acc[ai][1][m][1];
                u32x4 w; w.x = cvt_pk_bf16(silu1(a0[0]) * b0[0], silu1(a0[1]) * b0[1]); w.y = cvt_pk_bf16(silu1(a0[2]) * b0[2], silu1(a0[3]) * b0[3]);
                w.z = cvt_pk_bf16(silu1(a1[0]) * b1[0], silu1(a1[1]) * b1[1]); w.w = cvt_pk_bf16(silu1(a1[2]) * b1[2], silu1(a1[3]) * b1[3]);
                *(u32x4*)rowp = w; }
    }
};
struct EpiRes {
    static constexpr bool PERM = false, AFTER_DRAIN = false;
    float* XB; const float* mv; int which; const float* base_lat; const float* base_ctx;
    float* PB;
    __device__ __forceinline__ void operator()(const f32x4 (&acc)[2][2][4][2], const Unit& u, int wr, int wc, int fr, int fq) const {
        const int row0 = u.pm * BM + wr * 64 + fr, col0 = u.pn * BM + wc * 32 + 4 * fq;
        float* PBp = PB + (size_t)((u.ko >= 1536 ? 1 : 0) + (u.ko >= 2176 ? 1 : 0)) * (1024 * 1024);
#pragma unroll
        for (int ai = 0; ai < 2; ++ai)
#pragma unroll
            for (int m = 0; m < 4; ++m) { const int r = row0 + ai * HALF + m * 16; const float* g = mv + (size_t)((r < 16384 ? (r >> 12) : 4) * 6 + which) * 1024 + col0; float* x = XB + (size_t)r * 1024 + col0;
                const float* bs = (r < 16384 ? base_lat + (size_t)r * 1024 : base_ctx + (size_t)(r - 16384) * 1024) + col0;
#pragma unroll
                for (int bj = 0; bj < 2; ++bj)
#pragma unroll
                    for (int n = 0; n < 2; ++n) { const int o = bj * HALF + n * 16; const f32x4 gv = *(const f32x4*)(g + o);
                        if (u.ko) *(f32x4*)(PBp + (size_t)(r - 16384) * 1024 + col0 + o) = gv * acc[ai][bj][m][n];
                        else { f32x4 xv = *(const f32x4*)(bs + o); xv = xv + gv * acc[ai][bj][m][n]; *(f32x4*)(x + o) = xv; } } }
    }
};
struct FfnDownOrder {
    StaticOrder so;
    __device__ __forceinline__ void init(int G_, int c_) { so.init(16384, 1024, G_, c_); }
    __device__ __forceinline__ bool next(int i, Unit& u) const {
        if (so.next(i, u)) return true;
        const long L = (long)i * so.G + so.c - so.nwg; if (L < 0 || L >= 64) return false;
        const int l = (int)L, q = (l & 7) + 8 * (l >> 5), p = q & 3;
        u.pm = 64 + (q >> 2); u.pn = (l >> 3) & 3; u.ko = (p * 12 - (p == 3 ? 2 : 0)) * 64; u.nt = p < 2 ? 12 : 10; return true; }
    __device__ __forceinline__ void a_ready(const Unit&) const {}
    __device__ __forceinline__ void done(const Unit&) const {}
};
struct MoeOrder {
    StaticOrder so; int nN; int sg[9];
    __device__ __forceinline__ void init(const int* seg, int nN_, int G_, int c_) {
#pragma unroll
        for (int i = 0; i < 9; ++i) sg[i] = seg[i];
        nN = nN_; so.nM = sg[8] >> 8; so.nN = nN_; so.nwg = so.nM * nN_; so.G = G_; so.c = c_; }
    __device__ __forceinline__ bool next(int i, Unit& u) const {
        if (!so.next(i, u)) return false;
        const int s = u.pm * 256; int e = 0;
#pragma unroll
        for (int q = 1; q < 8; ++q) e += (s >= sg[q]) ? 1 : 0;
        u.pn += e * nN; return true; }
    __device__ __forceinline__ void a_ready(const Unit&) const {}
    __device__ __forceinline__ void done(const Unit&) const {}
};
struct TableOrder {
    const int* tab; int n, G, vc;
    __device__ __forceinline__ void init(const int* tab_, int G_, int c_) { tab = tab_ + 4; n = tab_[0]; G = G_; vc = (G_ % 8 == 0) ? (c_ % 8) * (G_ / 8) + c_ / 8 : c_; }
    __device__ __forceinline__ bool next(int i, Unit& u) const { const int L = i * G + vc; if (L >= n) return false; const int* t = tab + 4 * L; u.pm = t[0]; u.pn = t[1]; u.ko = t[2]; u.nt = t[3]; return true; }
    __device__ __forceinline__ void a_ready(const Unit&) const {}
    __device__ __forceinline__ void done(const Unit&) const {}
};
template <class Epi, class Sched, bool ALIGN_EPI = false, bool SP2 = false>
__device__ __forceinline__ void gemm_phase(PG8_LAS unsigned char* lds, const Gemm g, const Sched& S, const Epi& E) {
    const int tid = threadIdx.x, wid = __builtin_amdgcn_readfirstlane(tid >> 6), lane = tid & 63, wr = wid >> 2, wc = wid & 3, fr = lane & 15, fq = lane >> 4;
    const int K = g.K; int nt = K / BK;
    unsigned voffA[2], voffB[2];
#pragma unroll
    for (int i = 0; i < 2; ++i) { int R, C; stage_rc(tid * 16 + i * 8192, R, C); const int Rb = Epi::PERM ? ((R & ~31) + perm32(R & 31)) : R;
        voffA[i] = (unsigned)(R * K + C) * 2u; voffB[i] = (unsigned)(Rb * K + C) * 2u; }
    const size_t kstep = (size_t)(BK * 2);
    const size_t hstep = (size_t)HALF * K * 2;
    const size_t tstep = 2 * hstep;
    const unsigned ldsw = (unsigned)wid * 1024u;
    const int aoff = lds_byte(wr * 64 + fr, fq * 8), boff = lds_byte(wc * 32 + fr, fq * 8);
#define PG8_SA(b, h) (((b) * 2 + (h)) * HTB)
#define PG8_SB(b, h) ((4 + (b) * 2 + (h)) * HTB)
#define PG8_STAGE(bufoff, gbase, voff) do { _Pragma("unroll") for (int _i = 0; _i < 2; ++_i) \
        __builtin_amdgcn_global_load_lds((const unsigned*)((const char*)(gbase) + (voff)[_i]), (PG8_LAS unsigned*)(lds + (bufoff) + ldsw + _i * 8192), 16, 0, 0); } while (0)
#define PG8_LDA(dst, b, h) do { _Pragma("unroll") for (int m = 0; m < 4; ++m) _Pragma("unroll") for (int k = 0; k < 2; ++k) dst[m][k] = *(const PG8_LAS bf16x8*)(lds + PG8_SA(b, h) + aoff + m * 2048 + k * 1024); } while (0)
#define PG8_LDB(dst, b, h) do { _Pragma("unroll") for (int n = 0; n < 2; ++n) _Pragma("unroll") for (int k = 0; k < 2; ++k) dst[n][k] = *(const PG8_LAS bf16x8*)(lds + PG8_SB(b, h) + boff + n * 2048 + k * 1024); } while (0)
#define PG8_MMA(ai, bj, At, Bt) do { __builtin_amdgcn_s_setprio(1); _Pragma("unroll") for (int m = 0; m < 4; ++m) _Pragma("unroll") for (int n = 0; n < 2; ++n) _Pragma("unroll") for (int k = 0; k < 2; ++k) \
        acc[ai][bj][m][n] = __builtin_amdgcn_mfma_f32_16x16x32_bf16(Bt[n][k], At[m][k], acc[ai][bj][m][n], 0, 0, 0); __builtin_amdgcn_s_setprio(0); } while (0)
#define PG8_WAIT_V(n) asm volatile("s_waitcnt vmcnt(" #n ")" ::: "memory")
#define PG8_WAIT_L(n) asm volatile("s_waitcnt lgkmcnt(" #n ")" ::: "memory")
#define PG8_BAR __builtin_amdgcn_s_barrier()
#define PG8_SCHED __builtin_amdgcn_sched_barrier(0)
    Unit cur, nxt; int ui = 0;
    if (!S.next(0, cur)) return;
    if (cur.nt) nt = cur.nt;
    f32x4 acc[2][2][4][2];
#pragma unroll
    for (int a = 0; a < 2; ++a)
#pragma unroll
        for (int b = 0; b < 2; ++b)
#pragma unroll
            for (int m = 0; m < 4; ++m)
#pragma unroll
                for (int n = 0; n < 2; ++n) acc[a][b][m][n] = (f32x4){0.f, 0.f, 0.f, 0.f};
    bf16x8 At[4][2], B0[2][2], B1[2][2];
    const char* cA = (const char*)g.A + (size_t)cur.pm * tstep + (size_t)cur.ko * 2; const char* cB = (const char*)g.Bt + (size_t)cur.pn * tstep + (size_t)cur.ko * 2;
    S.a_ready(cur);
    if constexpr (SP2) {
        PG8_STAGE(PG8_SB(0, 0), cB, voffB); PG8_STAGE(PG8_SB(0, 1), cB + hstep, voffB); PG8_STAGE(PG8_SA(0, 0), cA, voffA); PG8_STAGE(PG8_SA(0, 1), cA + hstep, voffA);
        if (wr == 1) PG8_BAR;
        PG8_WAIT_V(2); PG8_BAR;
        PG8_STAGE(PG8_SB(1, 0), cB + kstep, voffB); PG8_STAGE(PG8_SA(1, 0), cA + kstep, voffA); PG8_STAGE(PG8_SB(1, 1), cB + hstep + kstep, voffB);
        PG8_WAIT_V(6); PG8_BAR;
    } else {
        PG8_STAGE(PG8_SB(0, 0), cB, voffB); PG8_STAGE(PG8_SA(0, 0), cA, voffA); PG8_STAGE(PG8_SB(0, 1), cB + hstep, voffB); PG8_STAGE(PG8_SA(0, 1), cA + hstep, voffA);
        if (wr == 1) PG8_BAR;
        PG8_WAIT_V(4); PG8_BAR;
        PG8_STAGE(PG8_SB(1, 0), cB + kstep, voffB); PG8_STAGE(PG8_SA(1, 0), cA + kstep, voffA); PG8_STAGE(PG8_SB(1, 1), cB + hstep + kstep, voffB);
        PG8_WAIT_V(6); PG8_BAR;
    }
    for (;;) {
        const bool has_next = S.next(ui + 1, nxt);
        const char* nA = has_next ? (const char*)g.A + (size_t)nxt.pm * tstep + (size_t)nxt.ko * 2 : cA; const char* nB = has_next ? (const char*)g.Bt + (size_t)nxt.pn * tstep + (size_t)nxt.ko * 2 : cB;
        for (int t = 0; t < nt; t += 2) {
            const bool last = (t == nt - 2);
            const char* a1 = cA + (size_t)(t + 1) * kstep;
            const char* a2 = last ? nA : cA + (size_t)(t + 2) * kstep; const char* b2 = last ? nB : cB + (size_t)(t + 2) * kstep;
            const char* a3 = a2 + kstep; const char* b3 = b2 + kstep;
            if (last && has_next) S.a_ready(nxt);
            if constexpr (SP2) {
            PG8_LDB(B0, 0, 0); PG8_LDB(B1, 0, 1); PG8_SCHED; PG8_LDA(At, 0, 0); PG8_STAGE(PG8_SA(1, 1), a1 + hstep, voffA);
            PG8_WAIT_V(8); PG8_WAIT_L(0); PG8_BAR; PG8_MMA(0, 0, At, B0); PG8_MMA(0, 1, At, B1); PG8_BAR; PG8_SCHED;
            PG8_LDA(At, 0, 1); PG8_STAGE(PG8_SB(0, 0), b2, voffB); PG8_STAGE(PG8_SB(0, 1), b2 + hstep, voffB); PG8_STAGE(PG8_SA(0, 0), a2, voffA);
            PG8_WAIT_V(8); PG8_WAIT_L(0); PG8_BAR; PG8_MMA(1, 0, At, B0); PG8_MMA(1, 1, At, B1); PG8_BAR; PG8_SCHED;
            PG8_LDB(B0, 1, 0); PG8_LDB(B1, 1, 1); PG8_SCHED; PG8_LDA(At, 1, 0); PG8_STAGE(PG8_SA(0, 1), a2 + hstep, voffA);
            PG8_WAIT_V(8); PG8_WAIT_L(0); PG8_BAR; PG8_MMA(0, 0, At, B0); PG8_MMA(0, 1, At, B1); PG8_BAR; PG8_SCHED;
            PG8_LDA(At, 1, 1); PG8_STAGE(PG8_SB(1, 0), b3, voffB); PG8_STAGE(PG8_SB(1, 1), b3 + hstep, voffB); PG8_STAGE(PG8_SA(1, 0), a3, voffA);
            PG8_WAIT_V(8); PG8_WAIT_L(0); PG8_BAR; PG8_MMA(1, 0, At, B0); PG8_MMA(1, 1, At, B1); PG8_BAR; PG8_SCHED;
            } else {
            PG8_LDB(B0, 0, 0); PG8_SCHED; PG8_LDA(At, 0, 0); PG8_STAGE(PG8_SA(1, 1), a1 + hstep, voffA);
            PG8_WAIT_L(8); PG8_BAR; PG8_WAIT_L(0); PG8_MMA(0, 0, At, B0); PG8_BAR; PG8_SCHED;
            PG8_LDB(B1, 0, 1); PG8_STAGE(PG8_SB(0, 0), b2, voffB);
            PG8_BAR; PG8_WAIT_L(0); PG8_MMA(0, 1, At, B1); PG8_BAR;
            PG8_LDA(At, 0, 1); PG8_STAGE(PG8_SA(0, 0), a2, voffA);
            PG8_BAR; PG8_WAIT_L(0); PG8_MMA(1, 0, At, B0); PG8_BAR; PG8_SCHED;
            PG8_STAGE(PG8_SB(0, 1), b2 + hstep, voffB);
            PG8_WAIT_V(6); PG8_BAR; PG8_MMA(1, 1, At, B1); PG8_BAR;
            PG8_LDB(B0, 1, 0); PG8_SCHED; PG8_LDA(At, 1, 0); PG8_STAGE(PG8_SA(0, 1), a2 + hstep, voffA);
            PG8_WAIT_L(8); PG8_BAR; PG8_WAIT_L(0); PG8_MMA(0, 0, At, B0); PG8_BAR; PG8_SCHED;
            PG8_LDB(B1, 1, 1); PG8_STAGE(PG8_SB(1, 0), b3, voffB);
            PG8_BAR; PG8_WAIT_L(0); PG8_MMA(0, 1, At, B1); PG8_BAR;
            PG8_LDA(At, 1, 1); PG8_STAGE(PG8_SA(1, 0), a3, voffA);
            PG8_BAR; PG8_WAIT_L(0); PG8_MMA(1, 0, At, B0); PG8_BAR; PG8_SCHED;
            PG8_STAGE(PG8_SB(1, 1), b3 + hstep, voffB);
            PG8_WAIT_V(6); PG8_BAR; PG8_MMA(1, 1, At, B1); PG8_BAR;
            }
        }
        if constexpr (ALIGN_EPI) { if (wr == 0) PG8_BAR; }
        if constexpr (!Epi::AFTER_DRAIN) { E(acc, cur, wr, wc, fr, fq); S.done(cur); }
        if (!has_next) break;
#pragma unroll
        for (int a = 0; a < 2; ++a)
#pragma unroll
            for (int b = 0; b < 2; ++b)
#pragma unroll
                for (int m = 0; m < 4; ++m)
#pragma unroll
                    for (int n = 0; n < 2; ++n) acc[a][b][m][n] = (f32x4){0.f, 0.f, 0.f, 0.f};
        cur = nxt; cA = nA; cB = nB; ++ui; nt = cur.nt ? cur.nt : K / BK;
        if constexpr (ALIGN_EPI) { if (wr == 1) PG8_BAR; }
    }
    PG8_WAIT_V(0);
    if constexpr (!ALIGN_EPI) { if (wr == 0) PG8_BAR; }
    PG8_BAR;
    if constexpr (Epi::AFTER_DRAIN) { E.fused(acc, cur, wr, wc, fr, fq, lds, wid, lane); S.done(cur); }
#undef PG8_SA
#undef PG8_SB
#undef PG8_STAGE
#undef PG8_LDA
#undef PG8_LDB
#undef PG8_MMA
#undef PG8_WAIT_V
#undef PG8_WAIT_L
#undef PG8_BAR
#undef PG8_SCHED
}
}

DEVI void row_seq(int r, int& t, int& len) { if (r < NLAT) { t = r & 4095; len = SEQ; } else { t = (r - NLAT) & 255; len = CTXL; } }

#define DPP_F(v, ctrl) __int_as_float(__builtin_amdgcn_update_dpp(0, __float_as_int(v), (ctrl), 0xF, 0xF, true))
DEVI float sum8lanes(float x) { x += DPP_F(x, 0xB1); x += DPP_F(x, 0x4E); x += DPP_F(x, 0x141); return x; }

DEVI void phase_prep(const Ctx& c, int layer, bool need_ctx_q) {
    const bf16_t* Z = (const bf16_t*)(c.ws + WS_Z);
    const int vg = c.wave * (int)gridDim.x + (int)blockIdx.x, vgb = (vg + c.ngw / 2) % c.ngw, vgc = (vg + c.ngw - c.ngw / 4) % c.ngw;
    {
        bf16_t* QN = (bf16_t*)(c.ws + WS_QN); bf16_t* KN = (bf16_t*)(c.ws + WS_KN); bf16_t* VB = (bf16_t*)(c.ws + WS_DN + DN_VB); float* bg = (float*)(c.ws + WS_DN + DN_BG);
        const float* cw = c.in[I_CONVW] + (size_t)layer * 3 * 1152;
        const int lc = c.lane < 48 ? c.lane : 47;
        float w[3][3][8];
#pragma unroll
        for (int th = 0; th < 3; ++th)
#pragma unroll
            for (int tap = 0; tap < 3; ++tap) { const float* wp = cw + tap * 1152 + th * 384 + lc * 8; *(f32x4*)w[th][tap] = *(const f32x4*)wp; *(f32x4*)(w[th][tap] + 4) = *(const f32x4*)(wp + 4); }
        const int dh = c.lane - 48; float alog = 0.f, dtb = 0.f;
        if (c.lane >= 48 && c.lane < 60) { alog = -expf(c.in[I_ALOG][layer * 12 + dh]); dtb = c.in[I_DTB][layer * 12 + dh]; }
        for (int p = vg; p < NT / 2; p += c.ngw) {
            const int ra = 2 * p; int t, len; row_seq(ra, t, len);
            const bf16_t* zr = Z + (size_t)ra * ZP + lc * 8; const bool hm = t > 0, hp = t + 1 < len - 1;
            u32x4 z0[3], z1[3], z2[3], z3[3];
#pragma unroll
            for (int th = 0; th < 3; ++th) { z1[th] = *(const u32x4*)(zr + th * 384); z2[th] = *(const u32x4*)(zr + th * 384 + ZP);
                z0[th] = hm ? *(const u32x4*)(zr + th * 384 - ZP) : (u32x4){0u, 0u, 0u, 0u}; z3[th] = hp ? *(const u32x4*)(zr + th * 384 + 2 * ZP) : (u32x4){0u, 0u, 0u, 0u}; }
            float zb[2] = {0.f, 0.f}, za[2] = {0.f, 0.f};
            if (c.lane >= 48 && c.lane < 60) { zb[0] = bf2f(Z[(size_t)ra * ZP + ZC_BETA + dh]); za[0] = bf2f(Z[(size_t)ra * ZP + ZC_ALPHA + dh]); zb[1] = bf2f(Z[(size_t)(ra + 1) * ZP + ZC_BETA + dh]); za[1] = bf2f(Z[(size_t)(ra + 1) * ZP + ZC_ALPHA + dh]); }
#pragma unroll
            for (int q = 0; q < 2; ++q) { const int r = ra + q;
                u32x4 outw[3];
#pragma unroll
                for (int th = 0; th < 3; ++th) {
                    float a[8], b[8], d[8], v[8]; unpack8(q == 0 ? z0[th] : z1[th], a); unpack8(q == 0 ? z1[th] : z2[th], b); unpack8(q == 0 ? z2[th] : z3[th], d);
                    float ss = 0.f;
#pragma unroll
                    for (int e = 0; e < 8; ++e) { v[e] = silu_f(a[e] * w[th][0][e] + b[e] * w[th][1][e] + d[e] * w[th][2][e]); ss += v[e] * v[e]; }
                    if (th < 2) { ss = sum8lanes(ss); const float sc = rsqrtf(ss + EPS) * (th == 0 ? 0.125f : 1.f);
#pragma unroll
                        for (int e = 0; e < 8; ++e) v[e] *= sc; }
                    outw[th] = pack8(v);
                }
                if (c.lane < 48) { *(u32x4*)(QN + (size_t)r * 384 + c.lane * 8) = outw[0]; *(u32x4*)(KN + (size_t)r * 384 + c.lane * 8) = outw[1]; *(u32x4*)(VB + (size_t)r * 384 + c.lane * 8) = outw[2]; }
                else if (c.lane < 60) { bg[((size_t)r * 12 + dh) * 2] = __builtin_amdgcn_rcpf(1.f + __expf(-zb[q])); bg[((size_t)r * 12 + dh) * 2 + 1] = alog * softplus_f(za[q] + dtb); } }
        }
    }
    {
        bf16_t* Qa = (bf16_t*)(c.ws + WS_QA); bf16_t* Qc = (bf16_t*)(c.ws + WS_QC); bf16_t* Ka = (bf16_t*)(c.ws + WS_KA); bf16_t* Va = (bf16_t*)(c.ws + WS_VA);
        const float* rope = (const float*)(c.ws + CTL_ROPE);
        const bool isq = c.lane < 48; const int j = c.lane & 7, axis = j >> 2, half = (j >> 1) & 1, p0 = 8 * (j & 1);
        const int col = isq ? ZC_AQ + c.lane * 8 : ZC_AK + (c.lane - 48) * 8;
        float gn[8];
        { const float* gp = (isq ? c.in[I_QG] : c.in[I_KG]) + layer * 64 + 8 * j; *(f32x4*)gn = *(const f32x4*)gp; *(f32x4*)(gn + 4) = *(const f32x4*)(gp + 4); }
        const float qs = isq ? QSCALE : 1.f;
        for (int r0 = vgb; r0 < NT; r0 += 2 * c.ngw) {
            int rr[2]; bool ok[2]; rr[0] = r0; ok[0] = true; rr[1] = r0 + c.ngw; ok[1] = rr[1] < NT; if (!ok[1]) rr[1] = r0;
            u32x4 zq[2], zv[2]; const float* tp[2];
#pragma unroll
            for (int q = 0; q < 2; ++q) { const int r = rr[q]; zq[q] = *(const u32x4*)(Z + (size_t)r * ZP + col); zv[q] = *(const u32x4*)(Z + (size_t)r * ZP + ZC_AV + (c.lane & 15) * 8);
                const int t = r & 4095; tp[q] = rope + (r < NLAT ? (axis * 64 + (axis == 0 ? (t >> 6) : (t & 63))) * 32 : 128 * 32) + p0; }
#pragma unroll
            for (int q = 0; q < 2; ++q) { const int r = rr[q]; const bool lat = r < NLAT; const int b = lat ? (r >> 12) : ((r - NLAT) >> 8), pos = lat ? CTXL + (r & 4095) : ((r - NLAT) & 255);
                float v[8]; unpack8(zq[q], v);
                float ss = 0.f;
#pragma unroll
                for (int e = 0; e < 8; ++e) ss += v[e] * v[e];
                ss = sum8lanes(ss); const float sc = rsqrtf(ss * (1.f / 64.f) + EPS);
                float cs[8], sn[8]; *(f32x4*)cs = *(const f32x4*)tp[q]; *(f32x4*)(cs + 4) = *(const f32x4*)(tp[q] + 4); *(f32x4*)sn = *(const f32x4*)(tp[q] + 16); *(f32x4*)(sn + 4) = *(const f32x4*)(tp[q] + 20);
#pragma unroll
                for (int e = 0; e < 8; ++e) { v[e] *= sc * gn[e]; const float o = DPP_F(v[e], 0x4E); v[e] = (half == 0 ? v[e] * cs[e] - o * sn[e] : o * sn[e] + v[e] * cs[e]) * qs; }
                const u32x4 w = pack8(v);
                if (ok[q]) {
                    if (isq) { if (lat) *(u32x4*)(Qa + (size_t)r * 384 + c.lane * 8) = w; else if (need_ctx_q) *(u32x4*)(Qc + (size_t)(r - NLAT) * 384 + c.lane * 8) = w; }
                    else *(u32x4*)(Ka + ((size_t)b * SKV + pos) * 128 + (c.lane - 48) * 8) = w;
                    if (c.lane < 16) *(u32x4*)(Va + ((size_t)b * SKV + pos) * 128 + c.lane * 8) = zv[q];
                } }
        }
    }
    {
        bf16_t* SV = (bf16_t*)(c.ws + WS_SV); const int l32 = c.lane & 31;
        float gn[8]; { const float* gp = c.in[I_SGUG] + layer * 256 + l32 * 8; *(f32x4*)gn = *(const f32x4*)gp; *(f32x4*)(gn + 4) = *(const f32x4*)(gp + 4); }
        const int nr = need_ctx_q ? NT : NLAT;
        for (int it = vgc; it < nr / 2; it += c.ngw) {
            const int r = it * 2 + (c.lane >> 5);
            float v[8]; unpack8(*(const u32x4*)(Z + (size_t)r * ZP + ZC_MV + l32 * 8), v);
            float ss = 0.f;
#pragma unroll
            for (int e = 0; e < 8; ++e) { v[e] = gelu_f(v[e]); ss += v[e] * v[e]; }
            ss = sum8lanes(ss); const float sc = rsqrtf(ss * (1.f / 64.f) + EPS);
#pragma unroll
            for (int e = 0; e < 8; ++e) v[e] *= sc * gn[e];
            *(u32x4*)(SV + (size_t)r * 256 + l32 * 8) = pack8(v);
        }
    }
}
DEVI void phase_dnscan_naive(const Ctx& c) {
    const bf16_t* QN = (const bf16_t*)(c.ws + WS_QN); const bf16_t* KN = (const bf16_t*)(c.ws + WS_KN); const bf16_t* VB = (const bf16_t*)(c.ws + WS_DN + DN_VB);
    const float* BG = (const float*)(c.ws + WS_DN + DN_BG); float* OD = (float*)(c.ws + WS_DN + DN_O);
    float* kqv = c.lds; float* part = c.lds + 256; float* part2 = c.lds + 256 + 512;
    const int e = c.tid & 63, dg = c.tid >> 6;
    for (int seq = blockIdx.x; seq < 48; seq += gridDim.x) {
        const int b = seq / 12, h = (seq >> 1) % 6, dir = seq & 1;
        float S[8];
#pragma unroll
        for (int i = 0; i < 8; ++i) S[i] = 0.f;
        for (int step = 0; step < SKV; ++step) {
            int row;
            if (step < CTXL) { const int t = dir ? CTXL - 1 - step : step; row = NLAT + b * CTXL + t; }
            else { const int u = step - CTXL; const int t = dir ? SEQ - 1 - u : u; row = b * SEQ + t; }
            if (c.wave == 0) kqv[e] = bf2f(KN[(size_t)row * 384 + h * 64 + e]);
            else if (c.wave == 1) kqv[64 + e] = bf2f(QN[(size_t)row * 384 + h * 64 + e]);
            else if (c.wave == 2) kqv[128 + e] = bf2f(VB[(size_t)row * 384 + h * 64 + e]);
            else if (c.wave == 3 && e < 2) { const float v = BG[((size_t)row * 12 + dir * 6 + h) * 2 + e]; kqv[192 + e] = e == 0 ? v : __expf(v); }
            __syncthreads();
            const float a = kqv[193], beta = kqv[192];
            float kd[8], p = 0.f;
#pragma unroll
            for (int i = 0; i < 8; ++i) { kd[i] = kqv[dg * 8 + i]; S[i] *= a; p += S[i] * kd[i]; }
            part[dg * 64 + e] = p;
            __syncthreads();
            float rr = kqv[128 + e];
#pragma unroll
            for (int w = 0; w < 8; ++w) rr -= part[w * 64 + e];
            rr *= beta; float po = 0.f;
#pragma unroll
            for (int i = 0; i < 8; ++i) { S[i] += kd[i] * rr; po += S[i] * kqv[64 + dg * 8 + i]; }
            part2[dg * 64 + e] = po;
            __syncthreads();
            if (dg == 0) { float o = 0.f;
#pragma unroll
                for (int w = 0; w < 8; ++w) o += part2[w * 64 + e];
                OD[((size_t)dir * NT + row) * 384 + h * 64 + e] = o; }
        }
        __syncthreads();
    }
}

DEVI void phase_dnfinish(const Ctx& c, int layer, int nrows) {
    const float* OD = (const float*)(c.ws + WS_DN + DN_O); const bf16_t* Z = (const bf16_t*)(c.ws + WS_Z); bf16_t* MIX = (bf16_t*)(c.ws + WS_MIX);
    float gn[8]; { const float* gp = c.in[I_DNG] + layer * 64 + 8 * (c.lane & 7); *(f32x4*)gn = *(const f32x4*)gp; *(f32x4*)(gn + 4) = *(const f32x4*)(gp + 4); }
    if (c.lane < 48) for (int r = c.wave * (int)gridDim.x + (int)blockIdx.x; r < nrows; r += c.ngw) {
        const float* o0 = OD + (size_t)r * 384 + c.lane * 8; const float* o1 = o0 + (size_t)NT * 384;
        float v[8], g[8]; *(f32x4*)v = *(const f32x4*)o0 + *(const f32x4*)o1; *(f32x4*)(v + 4) = *(const f32x4*)(o0 + 4) + *(const f32x4*)(o1 + 4);
        unpack8(*(const u32x4*)(Z + (size_t)r * ZP + ZC_GATE + c.lane * 8), g);
        float ss = 0.f;
#pragma unroll
        for (int e = 0; e < 8; ++e) ss += v[e] * v[e];
        ss = sum8lanes(ss); const float sc = rsqrtf(ss * (1.f / 64.f) + EPS);
#pragma unroll
        for (int e = 0; e < 8; ++e) v[e] = v[e] * sc * gn[e] * silu_f(g[e]);
        *(u32x4*)(MIX + (size_t)r * 1024 + c.lane * 8) = pack8(v);
    }
}

DEVI void phase_attn_naive(const Ctx& c, bool with_ctx) {
    const bf16_t* Qa = (const bf16_t*)(c.ws + WS_QA); const bf16_t* Qc = (const bf16_t*)(c.ws + WS_QC); const bf16_t* Ka = (const bf16_t*)(c.ws + WS_KA); const bf16_t* Va = (const bf16_t*)(c.ws + WS_VA);
    bf16_t* MIX = (bf16_t*)(c.ws + WS_MIX);
    const int nitems = NLAT * 6 + (with_ctx ? NCTX * 6 : 0);
    for (int it = c.gw; it < nitems; it += c.ngw) {
        int b, hq, nkeys, orow; const bf16_t* qp;
        if (it < NLAT * 6) { const int r = it / 6; hq = it % 6; b = r >> 12; qp = Qa + (size_t)r * 384 + hq * 64; nkeys = SKV; orow = r; }
        else { const int q = it - NLAT * 6, rc = q / 6; hq = q % 6; b = rc >> 8; qp = Qc + (size_t)rc * 384 + hq * 64; nkeys = CTXL; orow = NLAT + rc; }
        const int kvh = hq / 3; const bf16_t* Kp = Ka + (size_t)b * SKV * 128 + kvh * 64; const bf16_t* Vp = Va + (size_t)b * SKV * 128 + kvh * 64;
        u32x4 qv[8];
#pragma unroll
        for (int i = 0; i < 8; ++i) qv[i] = *(const u32x4*)(qp + i * 8);
        float m = -1e30f, l = 0.f, acc = 0.f;
        for (int t0 = 0; t0 < nkeys; t0 += 64) {
            const bf16_t* kp = Kp + (size_t)(t0 + c.lane) * 128; float s = 0.f;
#pragma unroll
            for (int i = 0; i < 8; ++i) { const u32x4 kv = *(const u32x4*)(kp + i * 8);
#pragma unroll
                for (int q = 0; q < 4; ++q) s += bflo(kv[q]) * bflo(qv[i][q]) + bfhi(kv[q]) * bfhi(qv[i][q]); }
            const float mn = fmaxf(m, wave_max(s)); const float alpha = exp2f(m - mn); const float p = exp2f(s - mn);
            l = l * alpha + wave_sum(p); acc *= alpha; m = mn;
#pragma unroll 8
            for (int jj = 0; jj < 64; ++jj) { const float pj = __shfl(p, jj); acc += pj * bf2f(Vp[(size_t)(t0 + jj) * 128 + c.lane]); }
        }
        MIX[(size_t)orow * 1024 + 384 + hq * 64 + c.lane] = (bf16_t)f2bf(acc / l);
    }
}


namespace dn {
using bf16x8 = __attribute__((ext_vector_type(8))) short;
using f32x16 = __attribute__((ext_vector_type(16))) float;
typedef __attribute__((address_space(3))) unsigned char* ldsp;
constexpr int IMG = 46080, NCHK = 68, NSEQ = 48;
constexpr int O_NEGK = 0, O_T = 8192, O_QG = 14336, O_AT = 22528, O_KDT = 28672, O_BV = 36864, O_MISC = 45056;
DEVI int rowmap(int t, int hq) { return (t & 3) + 8 * (t >> 2) + 4 * hq; }
typedef float f32x2_t __attribute__((ext_vector_type(2))); typedef __bf16 bf16x2_t __attribute__((ext_vector_type(2)));
DEVI unsigned cvtpk(float lo, float hi) { f32x2_t v = {lo, hi}; bf16x2_t b = __builtin_convertvector(v, bf16x2_t); return __builtin_bit_cast(unsigned, b); }
#define DN_PACK8(x, s) __builtin_bit_cast(dn::bf16x8, (u32x4){dn::cvtpk((x)[8 * (s)], (x)[8 * (s) + 1]), dn::cvtpk((x)[8 * (s) + 2], (x)[8 * (s) + 3]), dn::cvtpk((x)[8 * (s) + 4], (x)[8 * (s) + 5]), dn::cvtpk((x)[8 * (s) + 6], (x)[8 * (s) + 7])})
#define DN_MFMA(a, b, c) __builtin_amdgcn_mfma_f32_32x32x16_bf16((a), (b), (c), 0, 0, 0)
DEVI u32x4 perm_frag(u32x4 f, int hq) {
    const unsigned s0 = hq ? f.x : f.z, s1 = hq ? f.y : f.w;
    const unsigned r0 = (unsigned)__shfl_xor((int)s0, 32), r1 = (unsigned)__shfl_xor((int)s1, 32);
    u32x4 o; o.x = hq ? r0 : f.x; o.y = hq ? r1 : f.y; o.z = hq ? f.z : r0; o.w = hq ? f.w : r1; return o;
}
DEVI u32x4 scale_frag(u32x4 f, float sc) {
    u32x4 o; o.x = cvtpk(bflo(f.x) * sc, bfhi(f.x) * sc); o.y = cvtpk(bflo(f.y) * sc, bfhi(f.y) * sc); o.z = cvtpk(bflo(f.z) * sc, bfhi(f.z) * sc); o.w = cvtpk(bflo(f.w) * sc, bfhi(f.w) * sc); return o;
}
DEVI bf16x8 ident_frag(int e, int r, int hq) {
    const int js = r - 16 * e - 8 * hq; u32x4 w;
    w.x = (js == 0 ? 0x3F80u : 0u) | (js == 1 ? 0x3F800000u : 0u); w.y = (js == 2 ? 0x3F80u : 0u) | (js == 3 ? 0x3F800000u : 0u);
    w.z = (js == 4 ? 0x3F80u : 0u) | (js == 5 ? 0x3F800000u : 0u); w.w = (js == 6 ? 0x3F80u : 0u) | (js == 7 ? 0x3F800000u : 0u);
    return __builtin_bit_cast(bf16x8, w);
}
DEVI int chunk_base(int b, int dir, int n) {
    if (n < 4) return NLAT + b * CTXL + (dir ? 3 - n : n) * 64;
    return b * SEQ + (dir ? 63 - (n - 4) : n - 4) * 64;
}

DEVI void phase_chunkprep(const Ctx& c) {
    const bf16_t* QN = (const bf16_t*)(c.ws + WS_QN); const bf16_t* KN = (const bf16_t*)(c.ws + WS_KN); const bf16_t* VB = (const bf16_t*)(c.ws + WS_DN + DN_VB);
    const float* BG = (const float*)(c.ws + WS_DN + DN_BG); unsigned char* OPS = c.ws + WS_DN + DN_OPS;
    float* Al = c.lds + c.wave * (17408 / 4);
    float* sgc = Al + 4096; float* sbe = sgc + 64; float* skd = sbe + 64;
    const int l = c.lane, r = l & 31, hq = l >> 5;
    for (int task = c.wave * (int)gridDim.x + (int)blockIdx.x; task < NSEQ * NCHK; task += c.ngw) {
        const int seq = task / NCHK, n = task % NCHK, b = seq / 12, h = (seq >> 1) % 6, dir = seq & 1;
        const int base = chunk_base(b, dir, n);
        unsigned char* img = OPS + (size_t)task * IMG;
        const int myrow = base + (dir ? 63 - l : l);
        const float beta = BG[((size_t)myrow * 12 + dir * 6 + h) * 2]; const float g = BG[((size_t)myrow * 12 + dir * 6 + h) * 2 + 1];
        float gc = g;
#pragma unroll
        for (int o = 1; o < 64; o <<= 1) { const float t = __shfl_up(gc, o); if (l >= o) gc += t; }
        const float glast = __shfl(gc, 63);
        sgc[l] = gc; sbe[l] = beta; skd[l] = __expf(glast - gc);
        if (l == 0) *(float*)(img + O_MISC) = __expf(glast);
        __builtin_amdgcn_wave_barrier(); asm volatile("" ::: "memory");
        u32x4 kf[2][4], qf[2][4];
#pragma unroll
        for (int t = 0; t < 2; ++t) { const int pos = 32 * t + r; const size_t ro = (size_t)(base + (dir ? 63 - pos : pos)) * 384 + h * 64 + 8 * hq;
#pragma unroll
            for (int kk = 0; kk < 4; ++kk) { kf[t][kk] = *(const u32x4*)(KN + ro + 16 * kk); qf[t][kk] = *(const u32x4*)(QN + ro + 16 * kk); } }
#define KF(t, kk) __builtin_bit_cast(bf16x8, kf[t][kk])
#define QF(t, kk) __builtin_bit_cast(bf16x8, qf[t][kk])
#pragma unroll
        for (int tile = 0; tile < 3; ++tile) { const int rb = tile == 2 ? 1 : 0, cb = tile == 0 ? 0 : 1;
            f32x16 G = {}, P = {};
#pragma unroll
            for (int kk = 0; kk < 4; ++kk) { G = DN_MFMA(KF(rb, kk), KF(cb, kk), G); P = DN_MFMA(KF(rb, kk), QF(cb, kk), P); }
            const int lp = 32 * cb + r; const float bl = __shfl(beta, lp), gl = __shfl(gc, lp);
#pragma unroll
            for (int t = 0; t < 16; ++t) { const int rp = 32 * rb + rowmap(t, hq); const float e = __expf(gl - sgc[rp]);
                if (tile == 1) G[t] = -bl * e * G[t]; else Al[rp * 64 + lp] = lp > rp ? bl * e * G[t] : 0.f;
                P[t] = rp <= lp ? P[t] * e : 0.f; }
            if (tile == 1) { *(bf16x8*)(img + O_T + 2 * 1024 + l * 16) = DN_PACK8(G, 0); *(bf16x8*)(img + O_T + 3 * 1024 + l * 16) = DN_PACK8(G, 1); }
            *(bf16x8*)(img + O_AT + (2 * tile + 0) * 1024 + l * 16) = DN_PACK8(P, 0);
            *(bf16x8*)(img + O_AT + (2 * tile + 1) * 1024 + l * 16) = DN_PACK8(P, 1); }
#pragma unroll
        for (int rt = 0; rt < 2; ++rt) { const float gr = __shfl(gc, 32 * rt + r), br = __shfl(beta, 32 * rt + r); const float eg = __expf(gr);
#pragma unroll
            for (int kk = 0; kk < 4; ++kk) {
                *(u32x4*)(img + O_NEGK + (rt * 4 + kk) * 1024 + l * 16) = scale_frag(perm_frag(kf[rt][kk], hq), -br * eg);
                *(u32x4*)(img + O_QG + (rt * 4 + kk) * 1024 + l * 16) = scale_frag(perm_frag(qf[rt][kk], hq), eg); } }
#pragma unroll
        for (int dt = 0; dt < 2; ++dt)
#pragma unroll
            for (int cb = 0; cb < 2; ++cb) { f32x16 X = {};
                X = DN_MFMA(KF(cb, 2 * dt), ident_frag(0, r, hq), X); X = DN_MFMA(KF(cb, 2 * dt + 1), ident_frag(1, r, hq), X);
#pragma unroll
                for (int t = 0; t < 16; ++t) X[t] *= skd[32 * cb + rowmap(t, hq)];
                *(bf16x8*)(img + O_KDT + ((dt * 2 + cb) * 2 + 0) * 1024 + l * 16) = DN_PACK8(X, 0);
                *(bf16x8*)(img + O_KDT + ((dt * 2 + cb) * 2 + 1) * 1024 + l * 16) = DN_PACK8(X, 1); }
        {
            u32x4 vf[2][4];
#pragma unroll
            for (int t = 0; t < 2; ++t) { const int pos = 32 * t + r; const size_t ro = (size_t)(base + (dir ? 63 - pos : pos)) * 384 + h * 64 + 8 * hq;
#pragma unroll
                for (int kk = 0; kk < 4; ++kk) vf[t][kk] = *(const u32x4*)(VB + ro + 16 * kk); }
#pragma unroll
            for (int sl = 0; sl < 2; ++sl)
#pragma unroll
                for (int ct = 0; ct < 2; ++ct) { f32x16 Y = {};
                    Y = DN_MFMA(__builtin_bit_cast(bf16x8, vf[ct][2 * sl]), ident_frag(0, r, hq), Y); Y = DN_MFMA(__builtin_bit_cast(bf16x8, vf[ct][2 * sl + 1]), ident_frag(1, r, hq), Y);
#pragma unroll
                    for (int t = 0; t < 16; ++t) Y[t] *= sbe[32 * ct + rowmap(t, hq)];
                    *(bf16x8*)(img + O_BV + ((sl * 2 + ct) * 64 + l) * 32) = DN_PACK8(Y, 0);
                    *(bf16x8*)(img + O_BV + ((sl * 2 + ct) * 64 + l) * 32 + 16) = DN_PACK8(Y, 1); }
        }
#undef KF
#undef QF
        __builtin_amdgcn_wave_barrier(); asm volatile("" ::: "memory");
        {
            const float* Ab = Al + hq * (32 * 64 + 32);
            float* Tb = Al + hq * (32 * 64) + (hq ? 0 : 32);
#pragma unroll 1
            for (int JB = 3; JB >= 0; --JB) {
                float acc[8];
#pragma unroll
                for (int jj = 0; jj < 8; ++jj) acc[jj] = (r == 8 * JB + jj) ? 1.f : 0.f;
                float tk[24];
#pragma unroll
                for (int k = 8; k < 32; ++k) { const float tv = Tb[k * 64 + r]; tk[k - 8] = (k >= 8 * (JB + 1)) ? tv : 0.f; }
                const float* Aj = Ab + (8 * JB) * 64;
#pragma unroll
                for (int jj = 0; jj < 8; ++jj) { float a0 = 0.f, a1 = 0.f;
#pragma unroll
                    for (int k4 = 2; k4 < 8; ++k4) { const f32x4 av = *(const f32x4*)(Aj + jj * 64 + 4 * k4);
                        a0 += tk[4 * k4 - 8] * av.x + tk[4 * k4 - 6] * av.z; a1 += tk[4 * k4 - 7] * av.y + tk[4 * k4 - 5] * av.w; }
                    acc[jj] -= a0 + a1; }
#pragma unroll
                for (int jj = 6; jj >= 0; --jj) {
                    const f32x4 a0v = *(const f32x4*)(Aj + jj * 64 + 8 * JB), a1v = *(const f32x4*)(Aj + jj * 64 + 8 * JB + 4);
                    const float av[8] = {a0v.x, a0v.y, a0v.z, a0v.w, a1v.x, a1v.y, a1v.z, a1v.w};
                    float a = acc[jj];
#pragma unroll
                    for (int kk = jj + 1; kk < 8; ++kk) a -= acc[kk] * av[kk];
                    acc[jj] = a; }
#pragma unroll
                for (int jj = 0; jj < 8; ++jj) Tb[(8 * JB + jj) * 64 + r] = acc[jj];
            }
            float T[32];
#pragma unroll
            for (int k = 0; k < 32; ++k) T[k] = Tb[k * 64 + r];
#pragma unroll
            for (int s = 0; s < 2; ++s)
#pragma unroll
                for (int h2 = 0; h2 < 2; ++h2) { const int k0 = 16 * s + 4 * h2;
                    u32x4 w; w.x = cvtpk(T[k0], T[k0 + 1]); w.y = cvtpk(T[k0 + 2], T[k0 + 3]); w.z = cvtpk(T[k0 + 8], T[k0 + 9]); w.w = cvtpk(T[k0 + 10], T[k0 + 11]);
                    *(u32x4*)(img + O_T + ((hq ? 4 : 0) + s) * 1024 + (32 * h2 + r) * 16) = w; }
        }
        __builtin_amdgcn_wave_barrier(); asm volatile("" ::: "memory");
    }
}

DEVI void glds16(const void* gsrc, unsigned lds_dst) { unsigned keep;
    asm volatile("s_mov_b32 %0, m0\n\ts_mov_b32 m0, %2\n\ts_nop 0\n\tglobal_load_lds_dwordx4 %1, off\n\ts_mov_b32 m0, %0" : "=&s"(keep) : "v"(gsrc), "s"(lds_dst) : "memory"); }
DEVI void scan_sequence(const Ctx& c, int seq) {
    const unsigned char* OPS = c.ws + WS_DN + DN_OPS + (size_t)seq * NCHK * IMG; float* OD = (float*)(c.ws + WS_DN + DN_O);
    const int b = seq / 12, h = (seq >> 1) % 6, dir = seq & 1;
    const int l = c.lane, r = l & 31, hq = l >> 5, w = c.wave;
    const unsigned lds0 = (unsigned)(uintptr_t)c.lds;
    const bool loader = (w >= 2), consumer = (w < 2);
    constexpr int RSLOT = 36864;
#define DN_ISSUE(step, slot) do { if (loader) { _Pragma("unroll") for (int q_ = 0; q_ < 6; ++q_) { const int p_ = (w - 2) * 6 + q_; \
        glds16(OPS + (size_t)(step) * IMG + p_ * 1024 + l * 16, (unsigned)__builtin_amdgcn_readfirstlane(lds0 + (slot) * RSLOT + p_ * 1024)); } } } while (0)
    f32x16 S0 = {}, S1 = {};
    float gam_n = 0.f; u32x4 bv_n[4] = {};
    if (consumer) { gam_n = *(const float*)(OPS + O_MISC);
        bv_n[0] = *(const u32x4*)(OPS + O_BV + ((w * 2 + 0) * 64 + l) * 32); bv_n[1] = *(const u32x4*)(OPS + O_BV + ((w * 2 + 0) * 64 + l) * 32 + 16);
        bv_n[2] = *(const u32x4*)(OPS + O_BV + ((w * 2 + 1) * 64 + l) * 32); bv_n[3] = *(const u32x4*)(OPS + O_BV + ((w * 2 + 1) * 64 + l) * 32 + 16); }
    DN_ISSUE(0, 0); DN_ISSUE(1, 1);
    int slot = 0;
    for (int n = 0; n < NCHK; ++n) {
        if (loader) { if (n + 1 < NCHK) asm volatile("s_waitcnt vmcnt(6)" ::: "memory"); else asm volatile("s_waitcnt vmcnt(0)" ::: "memory"); }
        asm volatile("s_barrier" ::: "memory");
        if (n + 2 < NCHK) { const int s2 = slot == 0 ? 2 : slot - 1; DN_ISSUE(n + 2, s2); }
        if (consumer) {
            const ldsp img = c.lds3 + slot * RSLOT; const int sl = w;
#define DN_A(off, f) (*(const __attribute__((address_space(3))) bf16x8*)(img + (off) + (f) * 1024 + l * 16))
            const float gamma = gam_n; const u32x4 a = bv_n[0], bq = bv_n[1], a1 = bv_n[2], b1 = bv_n[3];
            if (n + 1 < NCHK) { const unsigned char* g2 = OPS + (size_t)(n + 1) * IMG;
                gam_n = *(const float*)(g2 + O_MISC);
                bv_n[0] = *(const u32x4*)(g2 + O_BV + ((sl * 2 + 0) * 64 + l) * 32); bv_n[1] = *(const u32x4*)(g2 + O_BV + ((sl * 2 + 0) * 64 + l) * 32 + 16);
                bv_n[2] = *(const u32x4*)(g2 + O_BV + ((sl * 2 + 1) * 64 + l) * 32); bv_n[3] = *(const u32x4*)(g2 + O_BV + ((sl * 2 + 1) * 64 + l) * 32 + 16); }
            const bf16x8 sb00 = DN_PACK8(S0, 0), sb01 = DN_PACK8(S0, 1), sb10 = DN_PACK8(S1, 0), sb11 = DN_PACK8(S1, 1);
            f32x16 v0, v1;
            {
#pragma unroll
              for (int q = 0; q < 4; ++q) { v0[2 * q] = bflo(a[q]); v0[2 * q + 1] = bfhi(a[q]); v0[8 + 2 * q] = bflo(bq[q]); v0[8 + 2 * q + 1] = bfhi(bq[q]);
                  v1[2 * q] = bflo(a1[q]); v1[2 * q + 1] = bfhi(a1[q]); v1[8 + 2 * q] = bflo(b1[q]); v1[8 + 2 * q + 1] = bfhi(b1[q]); } }
            v0 = DN_MFMA(DN_A(O_NEGK, 0), sb00, v0); v1 = DN_MFMA(DN_A(O_NEGK, 4), sb00, v1);
            v0 = DN_MFMA(DN_A(O_NEGK, 1), sb01, v0); v1 = DN_MFMA(DN_A(O_NEGK, 5), sb01, v1);
            v0 = DN_MFMA(DN_A(O_NEGK, 2), sb10, v0); v1 = DN_MFMA(DN_A(O_NEGK, 6), sb10, v1);
            v0 = DN_MFMA(DN_A(O_NEGK, 3), sb11, v0); v1 = DN_MFMA(DN_A(O_NEGK, 7), sb11, v1);
            __builtin_amdgcn_sched_barrier(0);
            const bf16x8 vb00 = DN_PACK8(v0, 0), vb01 = DN_PACK8(v0, 1);
            f32x16 n0 = {}, n1 = {};
            n0 = DN_MFMA(DN_A(O_T, 0), vb00, n0); n0 = DN_MFMA(DN_A(O_T, 1), vb01, n0);
            const bf16x8 nb00 = DN_PACK8(n0, 0), nb01 = DN_PACK8(n0, 1);
            v1 = DN_MFMA(DN_A(O_T, 2), nb00, v1); v1 = DN_MFMA(DN_A(O_T, 3), nb01, v1);
            const bf16x8 xb10 = DN_PACK8(v1, 0), xb11 = DN_PACK8(v1, 1);
            n1 = DN_MFMA(DN_A(O_T, 4), xb10, n1); n1 = DN_MFMA(DN_A(O_T, 5), xb11, n1);
            const bf16x8 nb10 = DN_PACK8(n1, 0), nb11 = DN_PACK8(n1, 1);
            __builtin_amdgcn_sched_barrier(0);
            f32x16 o0 = {}, o1 = {};
            o0 = DN_MFMA(DN_A(O_QG, 0), sb00, o0); o1 = DN_MFMA(DN_A(O_QG, 4), sb00, o1);
            o0 = DN_MFMA(DN_A(O_QG, 1), sb01, o0); o1 = DN_MFMA(DN_A(O_QG, 5), sb01, o1);
            o0 = DN_MFMA(DN_A(O_QG, 2), sb10, o0); o1 = DN_MFMA(DN_A(O_QG, 6), sb10, o1);
            o0 = DN_MFMA(DN_A(O_QG, 3), sb11, o0); o1 = DN_MFMA(DN_A(O_QG, 7), sb11, o1);
            o0 = DN_MFMA(DN_A(O_AT, 0), nb00, o0); o1 = DN_MFMA(DN_A(O_AT, 2), nb00, o1);
            o0 = DN_MFMA(DN_A(O_AT, 1), nb01, o0); o1 = DN_MFMA(DN_A(O_AT, 3), nb01, o1);
            o1 = DN_MFMA(DN_A(O_AT, 4), nb10, o1); o1 = DN_MFMA(DN_A(O_AT, 5), nb11, o1);
            __builtin_amdgcn_sched_barrier(0);
            {
                const int base = chunk_base(b, dir, n); float* od = OD + (size_t)dir * NT * 384 + h * 64 + 32 * sl + r;
#pragma unroll
                for (int t = 0; t < 16; ++t) { const int i0 = rowmap(t, hq), i1 = 32 + i0;
                    od[(size_t)(base + (dir ? 63 - i0 : i0)) * 384] = o0[t]; od[(size_t)(base + (dir ? 63 - i1 : i1)) * 384] = o1[t]; }
            }
            __builtin_amdgcn_sched_barrier(0);
#pragma unroll
            for (int t = 0; t < 16; ++t) { S0[t] *= gamma; S1[t] *= gamma; }
            S0 = DN_MFMA(DN_A(O_KDT, 0), nb00, S0); S1 = DN_MFMA(DN_A(O_KDT, 4), nb00, S1);
            S0 = DN_MFMA(DN_A(O_KDT, 1), nb01, S0); S1 = DN_MFMA(DN_A(O_KDT, 5), nb01, S1);
            S0 = DN_MFMA(DN_A(O_KDT, 2), nb10, S0); S1 = DN_MFMA(DN_A(O_KDT, 6), nb10, S1);
            S0 = DN_MFMA(DN_A(O_KDT, 3), nb11, S0); S1 = DN_MFMA(DN_A(O_KDT, 7), nb11, S1);
#undef DN_A
        }
        slot = slot == 2 ? 0 : slot + 1;
    }
    asm volatile("s_waitcnt vmcnt(0) lgkmcnt(0)\n\ts_barrier" ::: "memory");
#undef DN_ISSUE
}
}

DEVI void phase_sgu(const Ctx& c, int layer, bool need_ctx) {
    using dn::bf16x8; using dn::f32x16;
    const bf16_t* Z = (const bf16_t*)(c.ws + WS_Z); const bf16_t* SV = (const bf16_t*)(c.ws + WS_SV); bf16_t* MIX = (bf16_t*)(c.ws + WS_MIX);
    const float* sw = c.in[I_SGUW] + (size_t)layer * 4 * 128 * 128; const float* sb = c.in[I_SGUB] + layer * 512;
    const int nchunks = (need_ctx ? NT : NLAT) / 128; const int l = c.lane, r = l & 31, hq = l >> 5;
    const bf16x8 id0 = dn::ident_frag(0, r, hq), id1 = dn::ident_frag(1, r, hq);
    const int vgw = c.wave * (int)gridDim.x + (int)blockIdx.x, nitems = nchunks * 32;
    const int nA = dn::NSEQ * dn::NCHK - c.ngw < 0 ? 0 : (dn::NSEQ * dn::NCHK - c.ngw > c.ngw ? c.ngw : dn::NSEQ * dn::NCHK - c.ngw), nB = c.ngw - nA;
    const bool isB = vgw >= nA; const int bidx = vgw - nA;
    for (int k = isB ? 0 : 3; ; ++k) {
        const int sit = k < 3 ? bidx + k * nB : 3 * nB + vgw + (k - 3) * c.ngw;
        if (sit >= nitems) { if (k < 3) continue; break; }
        const int it = sit >> 2, itile = sit & 3, ch = it >> 3, g = (it >> 1) & 3, dvb = it & 1, r0 = ch * 128;
        bf16x8 yb[4][2];
#pragma unroll
        for (int jt = 0; jt < 4; ++jt) { const bf16_t* sp = SV + (size_t)(r0 + 32 * jt + r) * 256 + g * 64 + 32 * dvb + 8 * hq;
            f32x16 Y = {};
            Y = DN_MFMA(__builtin_bit_cast(bf16x8, *(const u32x4*)sp), id0, Y); Y = DN_MFMA(__builtin_bit_cast(bf16x8, *(const u32x4*)(sp + 16)), id1, Y);
            yb[jt][0] = DN_PACK8(Y, 0); yb[jt][1] = DN_PACK8(Y, 1); }
        const float* wg = sw + (size_t)g * 128 * 128;
        {
            f32x16 C = {}; const float* wr = wg + (size_t)(32 * itile + r) * 128 + 4 * hq;
#pragma unroll
            for (int jt = 0; jt < 4; ++jt)
#pragma unroll
                for (int sI = 0; sI < 2; ++sI) { const f32x4 w0 = *(const f32x4*)(wr + 32 * jt + 16 * sI), w1 = *(const f32x4*)(wr + 32 * jt + 16 * sI + 8);
                    u32x4 a; a.x = dn::cvtpk(w0.x, w0.y); a.y = dn::cvtpk(w0.z, w0.w); a.z = dn::cvtpk(w1.x, w1.y); a.w = dn::cvtpk(w1.z, w1.w);
                    C = DN_MFMA(__builtin_bit_cast(bf16x8, a), yb[jt][sI], C); }
#pragma unroll
            for (int t = 0; t < 16; ++t) { const int i = 32 * itile + dn::rowmap(t, hq); const size_t row = (size_t)(r0 + i);
                const float u = gelu_f(bf2f(Z[row * ZP + ZC_MU + g * 64 + 32 * dvb + r]));
                MIX[row * 1024 + 768 + g * 64 + 32 * dvb + r] = (bf16_t)f2bf(u * (C[t] + sb[g * 128 + i])); }
        }
    }
}

namespace attn_body {
using bf16=__hip_bfloat16;
using bf16x8=__attribute__((ext_vector_type(8)))short;
using s16x4=__attribute__((ext_vector_type(4)))short;
using f32x16=__attribute__((ext_vector_type(16)))float;
using u32x4=__attribute__((ext_vector_type(4)))unsigned;
constexpr int D=64,QP=384,KVP=128,OP=1024;
constexpr int NW=8,QBLK=32,QB=QBLK*NW,KVBLK=64;
constexpr int ATTN_UNIT_ROWS=QB;
__device__ __forceinline__ int crow(int r,int hi){return (r&3)+8*(r>>2)+4*hi;}
#define SBAR() __builtin_amdgcn_sched_barrier(0)
__device__ __forceinline__ void cmask(f32x16&p0,f32x16&p1,int jb,int qrel,int hi){
  const float NEG=-INFINITY; int kb=64*jb+4*hi;
  #pragma unroll
  for(int r=0;r<16;++r){int kv=kb+(r&3)+8*(r>>2); if(kv>qrel)p0[r]=NEG; if(kv+32>qrel)p1[r]=NEG;}
}

constexpr int NSLOT=3, SLOTB=8192;
constexpr int LDS_K=0, LDS_V=NSLOT*SLOTB, LDS_WS=2*NSLOT*SLOTB, LDS_OST=LDS_WS+NW*64*4, LDS_BYTES=LDS_OST+NW*4096;
constexpr float C2=0.125f*1.4426950408889634f;
__device__ __forceinline__ void glds16(const void*gsrc,unsigned lds_dst){unsigned keep;
  asm volatile("s_mov_b32 %0, m0\n\ts_mov_b32 m0, %2\n\ts_nop 0\n\tglobal_load_lds_dwordx4 %1, off\n\ts_mov_b32 m0, %0":"=&s"(keep):"v"(gsrc),"s"(lds_dst):"memory");}
__device__ __forceinline__ float max3f(float a,float b,float c){float r;asm("v_max3_f32 %0, %1, %2, %3":"=v"(r):"v"(a),"v"(b),"v"(c));return r;}
__device__ __forceinline__ float max2f(float a,float b){float r;asm("v_max_f32_e32 %0, %1, %2":"=v"(r):"v"(a),"v"(b));return r;}
__device__ __forceinline__ float fadd_s(float a,float b){float r;asm("v_add_f32_e32 %0, %1, %2":"=v"(r):"v"(a),"v"(b));return r;}
__device__ __forceinline__ float fsub_s(float a,float b){float r;asm("v_sub_f32_e32 %0, %1, %2":"=v"(r):"v"(a),"v"(b));return r;}
typedef float f32x2_t __attribute__((ext_vector_type(2))); typedef __bf16 bf16x2_t __attribute__((ext_vector_type(2)));
__device__ __forceinline__ unsigned cvtpk_s(float lo,float hi){f32x2_t v={lo,hi};bf16x2_t b=__builtin_convertvector(v,bf16x2_t);return __builtin_bit_cast(unsigned,b);}
#define WAIT_BAR(N) asm volatile("s_waitcnt vmcnt(" #N ") lgkmcnt(0)\n\ts_barrier":::"memory")

__device__ __forceinline__ void qkt(f32x16&p0,f32x16&p1,const char*Kslot,const bf16x8*qr,const f32x16&negm,int r32,int hi){
  const char*kb=Kslot+hi*1024+r32*16;
  #pragma unroll
  for(int d0=0;d0<4;++d0){
    const bf16x8 b0=*reinterpret_cast<const bf16x8*>(kb+d0*2048);
    const bf16x8 b1=*reinterpret_cast<const bf16x8*>(kb+d0*2048+512);
    if(d0==0){p0=__builtin_amdgcn_mfma_f32_32x32x16_bf16(b0,qr[0],negm,0,0,0);p1=__builtin_amdgcn_mfma_f32_32x32x16_bf16(b1,qr[0],negm,0,0,0);}
    else{p0=__builtin_amdgcn_mfma_f32_32x32x16_bf16(b0,qr[d0],p0,0,0,0);p1=__builtin_amdgcn_mfma_f32_32x32x16_bf16(b1,qr[d0],p1,0,0,0);}}
}
typedef __attribute__((address_space(3))) const char* lds_cptr;
typedef short v4i16_t __attribute__((ext_vector_type(4)));
__device__ __forceinline__ void kload8(bf16x8*kf,lds_cptr kp){
  kf[0]=*(const __attribute__((address_space(3))) bf16x8*)(kp);      kf[1]=*(const __attribute__((address_space(3))) bf16x8*)(kp+512);
  kf[2]=*(const __attribute__((address_space(3))) bf16x8*)(kp+2048); kf[3]=*(const __attribute__((address_space(3))) bf16x8*)(kp+2560);
  kf[4]=*(const __attribute__((address_space(3))) bf16x8*)(kp+4096); kf[5]=*(const __attribute__((address_space(3))) bf16x8*)(kp+4608);
  kf[6]=*(const __attribute__((address_space(3))) bf16x8*)(kp+6144); kf[7]=*(const __attribute__((address_space(3))) bf16x8*)(kp+6656);
}
__device__ __forceinline__ void kload2(bf16x8*kf,lds_cptr kp,int j){ kf[2*j]=*(const __attribute__((address_space(3))) bf16x8*)(kp+j*2048); kf[2*j+1]=*(const __attribute__((address_space(3))) bf16x8*)(kp+j*2048+512); }
__device__ __forceinline__ s16x4 vtr(lds_cptr p){ return __builtin_bit_cast(s16x4,__builtin_amdgcn_ds_read_tr16_b64_v4i16((__attribute__((address_space(3))) v4i16_t*)p)); }
__device__ __forceinline__ float rowmax(const f32x16&p0,const f32x16&p1){
  float a=max3f(p0[0],p0[1],p1[0]),b=max3f(p0[2],p0[3],p1[1]);a=max3f(a,p1[2],p1[3]);
  #pragma unroll
  for(int r=4;r<16;r+=4){a=max3f(a,p0[r],p0[r+1]);b=max3f(b,p0[r+2],p0[r+3]);a=max3f(a,p1[r],p1[r+1]);b=max3f(b,p1[r+2],p1[r+3]);}
  const float m=max2f(a,b);
  auto rr=__builtin_amdgcn_permlane32_swap(__float_as_uint(m),__float_as_uint(m),false,false);
  return max2f(__uint_as_float(rr[0]),__uint_as_float(rr[1]));
}
__device__ __forceinline__ void pv(f32x16*o,int vb,bf16x8 pa0,bf16x8 pa1,bf16x8 pa2,bf16x8 pa3){
  #pragma unroll
  for(int d0=0;d0<2;++d0){s16x4 lo[4],hi[4];
    #pragma unroll
    for(int ks=0;ks<4;++ks){
      asm volatile("ds_read_b64_tr_b16 %0,%1 offset:%c2":"=&v"(lo[ks]):"v"(vb),"i"(d0*4096+ks*1024):"memory");
      asm volatile("ds_read_b64_tr_b16 %0,%1 offset:%c2":"=&v"(hi[ks]):"v"(vb),"i"(d0*4096+ks*1024+512):"memory");}
    asm volatile("s_waitcnt lgkmcnt(0)":::"memory");SBAR();
    #define PK(k) (bf16x8){lo[k][0],lo[k][1],lo[k][2],lo[k][3],hi[k][0],hi[k][1],hi[k][2],hi[k][3]}
    o[d0]=__builtin_amdgcn_mfma_f32_32x32x16_bf16(pa0,PK(0),o[d0],0,0,0);
    o[d0]=__builtin_amdgcn_mfma_f32_32x32x16_bf16(pa1,PK(1),o[d0],0,0,0);
    o[d0]=__builtin_amdgcn_mfma_f32_32x32x16_bf16(pa2,PK(2),o[d0],0,0,0);
    o[d0]=__builtin_amdgcn_mfma_f32_32x32x16_bf16(pa3,PK(3),o[d0],0,0,0);
    #undef PK
  }
}

#ifndef ATTN_STORE16
#define ATTN_STORE16(p,v) (*(u32x4*)(p)=(v))
#endif
template<int THRL> __device__ __forceinline__ void attn_unit(const bf16*Qu,const bf16*__restrict__ Kh,const bf16*__restrict__ Vh,const int NT,bf16*Ou,char*shm){
  const int tid=threadIdx.x,lane=tid&63,r32=lane&31,hi=lane>>5; const int wid=__builtin_amdgcn_readfirstlane(tid>>6);
  const bf16*Qw=Qu+(long)(wid*QBLK)*QP;
  const unsigned lds0=(unsigned)(uintptr_t)shm;
  float*wsf=(float*)(shm+LDS_WS)+wid*64;
  const bf16*ksrc=Kh+(long)lane*KVP+wid*8;
  const bf16*vsrc=Vh+(long)(16*(wid&3)+(lane>>2))*KVP+(wid>>2)*32+(lane&3)*8;
  const unsigned kdst=lds0+LDS_K+wid*1024, vdst=lds0+LDS_V+wid*1024;
  #define DMA_K(t,slot) glds16(ksrc+(long)(t)*KVBLK*KVP,(unsigned)__builtin_amdgcn_readfirstlane(kdst+(slot)))
  #define DMA_V(t,slot) glds16(vsrc+(long)(t)*KVBLK*KVP,(unsigned)__builtin_amdgcn_readfirstlane(vdst+(slot)))
  const int vb0=(int)(lds0+LDS_V)+((lane>>4)&1)*32+(lane&3)*8+(4*hi+((lane&15)>>2))*64;
  const char*Kbase=shm+LDS_K; bf16x8 kf[8];
  const lds_cptr shm3=(lds_cptr)shm; const lds_cptr kp0=shm3+LDS_K+hi*1024+r32*16; const lds_cptr vp0=shm3+LDS_V+((lane>>4)&1)*32+(lane&3)*8+(4*hi+((lane&15)>>2))*64;
  DMA_K(0,0);DMA_V(0,0);DMA_K(1,SLOTB);
  bf16x8 qr[4];
  #pragma unroll
  for(int d0=0;d0<4;++d0)qr[d0]=*reinterpret_cast<const bf16x8*>(&Qw[(long)r32*QP+d0*16+hi*8]);
  float mhat=0.f,l_reg=0.f;f32x16 o[2];o[0]=f32x16{};o[1]=f32x16{};f32x16 negm=f32x16{};asm volatile("":"+v"(negm));
  #define CMASK(P0,P1,t) do{}while(0)
  bool resc=false;
  #define START(P0,P1) do{ const float rm=rowmax(P0,P1); resc=false; \
    { const float dl=rm; mhat=fadd_s(mhat,dl); \
      _Pragma("unroll") for(int r=0;r<16;++r){P0[r]=fsub_s(P0[r],dl);P1[r]=fsub_s(P1[r],dl);} \
      _Pragma("unroll") for(int r=0;r<16;++r)negm[r]=-mhat; asm volatile("":"+v"(negm)); } \
    _Pragma("unroll") for(int r=0;r<16;++r)P0[r]=__builtin_amdgcn_exp2f(P0[r]); }while(0)
  #define RESC() do{ if(resc){ asm volatile("s_waitcnt lgkmcnt(0)":::"memory"); \
      _Pragma("unroll") for(int d_=0;d_<2;++d_) _Pragma("unroll") for(int r=0;r<16;++r)o[d_][r]*=wsf[crow(r,hi)]; } }while(0)
  f32x16 pA0,pA1,pB0,pB1;
  int sl_prev=0,sl_cur=0,sl_next=SLOTB;
  #define ROT() do{sl_prev=sl_cur;sl_cur=sl_next;sl_next=(sl_next==(NSLOT-1)*SLOTB)?0:sl_next+SLOTB;}while(0)
  DMA_K(2,2*SLOTB);
  WAIT_BAR(3);
  qkt(pA0,pA1,Kbase,qr,negm,r32,hi);asm volatile("s_nop 15\n\ts_nop 7":"+v"(pA0),"+v"(pA1));CMASK(pA0,pA1,0);
  START(pA0,pA1);
  _Pragma("unroll") for(int r=0;r<16;++r)pA1[r]=__builtin_amdgcn_exp2f(pA1[r]);
  WAIT_BAR(0);
  DMA_K(3,0);DMA_V(1,SLOTB);
  ROT();
  kload8(kf,kp0+sl_cur);
  WAIT_BAR(2);
  s16x4 vlo[8],vhi[8]; u32x4 pw0,pw1,pw2,pw3;
  #define PKW(P,B) cvtpk_s(P[B],P[B+1])
  #define PAF(k) __builtin_bit_cast(bf16x8,pw##k)
  #define VFR(i) (bf16x8){vlo[i][0],vlo[i][1],vlo[i][2],vlo[i][3],vhi[i][0],vhi[i][1],vhi[i][2],vhi[i][3]}
  #define PIN(x) asm volatile("":"+v"(x))
  #define MX3(a,b,c) __builtin_fmaxf(__builtin_fmaxf((a),(b)),(c))
  #define GAPA(MF,A0,A1,A2,A3,W0,W1,PW) do{ MF; sacc+=A0; sacc+=A1; sacc+=A2; sacc+=A3; PIN(sacc); W0; W1; PIN(PW); SBAR(); }while(0)
  #define EX(v) __builtin_amdgcn_exp2f(v)
  #define GAPB(MF,X,B) do{ MF; X[B]=EX(X[B]); X[B+1]=EX(X[B+1]); X[B+2]=EX(X[B+2]); X[B+3]=EX(X[B+3]); PIN(X); SBAR(); }while(0)
  #define VRD(i) do{ vlo[i]=vtr(vp_+(((i)>>2)*4096+((i)&3)*1024)); vhi[i]=vtr(vp_+(((i)>>2)*4096+((i)&3)*1024+512)); }while(0)
  #define KRD(G,j) do{ if(G){ kload2(kf,kp0+sl_next,j); SBAR(); } }while(0)
  #define STEP(C0,C1,P0,P1,t,GK,GV,GL) do{ SBAR(); \
    const lds_cptr vp_=vp0+sl_prev; \
    VRD(0); SBAR(); float sacc=(P0[0]+P0[1]); \
    GAPA(C0=__builtin_amdgcn_mfma_f32_32x32x16_bf16(kf[0],qr[0],negm,0,0,0), P0[2],P0[3],P0[4],P0[5],     pw0[0]=PKW(P0,0), pw0[1]=PKW(P0,2), pw0); \
    VRD(4); SBAR(); GAPA(C1=__builtin_amdgcn_mfma_f32_32x32x16_bf16(kf[1],qr[0],negm,0,0,0), P0[6],P0[7],P0[8],P0[9],     pw0[2]=PKW(P0,4), pw0[3]=PKW(P0,6), pw0); \
    VRD(1); SBAR(); GAPA(C0=__builtin_amdgcn_mfma_f32_32x32x16_bf16(kf[2],qr[1],C0,0,0,0),   P0[10],P0[11],P0[12],P0[13], pw1[0]=PKW(P0,8), pw1[1]=PKW(P0,10), pw1); \
    VRD(5); SBAR(); GAPA(C1=__builtin_amdgcn_mfma_f32_32x32x16_bf16(kf[3],qr[1],C1,0,0,0),   P0[14],P0[15],P1[0],P1[1],   pw1[2]=PKW(P0,12),pw1[3]=PKW(P0,14), pw1); \
    VRD(2); SBAR(); GAPA(C0=__builtin_amdgcn_mfma_f32_32x32x16_bf16(kf[4],qr[2],C0,0,0,0),   P1[2],P1[3],P1[4],P1[5],     pw2[0]=PKW(P1,0), pw2[1]=PKW(P1,2), pw2); \
    VRD(6); SBAR(); GAPA(C1=__builtin_amdgcn_mfma_f32_32x32x16_bf16(kf[5],qr[2],C1,0,0,0),   P1[6],P1[7],P1[8],P1[9],     pw2[2]=PKW(P1,4), pw2[3]=PKW(P1,6), pw2); \
    VRD(3); SBAR(); GAPA(C0=__builtin_amdgcn_mfma_f32_32x32x16_bf16(kf[6],qr[3],C0,0,0,0),   P1[10],P1[11],P1[12],P1[13], pw3[0]=PKW(P1,8), pw3[1]=PKW(P1,10), pw3); \
    VRD(7); SBAR(); GAPA(C1=__builtin_amdgcn_mfma_f32_32x32x16_bf16(kf[7],qr[3],C1,0,0,0),   P1[14],P1[15],0.f,0.f,       pw3[2]=PKW(P1,12),pw3[3]=PKW(P1,14), pw3); \
    l_reg+=sacc; \
    if(GK){DMA_K((t)+3,sl_cur);} if(GV){DMA_V((t)+1,sl_next);} \
    CMASK(C0,C1,t); \
    { float a=MX3(C0[0],C0[1],C1[0]),b=MX3(C0[2],C0[3],C1[1]); a=MX3(a,C1[2],C1[3]); \
      _Pragma("unroll") for(int r=4;r<16;r+=4){a=MX3(a,C0[r],C0[r+1]);b=MX3(b,C0[r+2],C0[r+3]);a=MX3(a,C1[r],C1[r+1]);b=MX3(b,C1[r+2],C1[r+3]);} \
      float rm=__builtin_fmaxf(a,b); { auto rr=__builtin_amdgcn_permlane32_swap(__float_as_uint(rm),__float_as_uint(rm),false,false); rm=__builtin_fmaxf(__uint_as_float(rr[0]),__uint_as_float(rr[1])); } \
      resc=false; \
      if(__builtin_expect(__any(rm>(float)THRL),0)){ const float dl=__builtin_fmaxf(rm,0.f); mhat+=dl; \
        _Pragma("unroll") for(int r=0;r<16;++r){C0[r]-=dl;C1[r]-=dl;} \
        _Pragma("unroll") for(int r=0;r<16;++r)negm[r]=-mhat; asm volatile("":"+v"(negm)); \
        const float f=__builtin_amdgcn_exp2f(-dl); l_reg*=f; if(hi==0)wsf[r32]=f; resc=true; } } \
    SBAR(); \
    GAPB(o[0]=__builtin_amdgcn_mfma_f32_32x32x16_bf16(PAF(0),VFR(0),o[0],0,0,0), C0,0); \
    GAPB(o[1]=__builtin_amdgcn_mfma_f32_32x32x16_bf16(PAF(0),VFR(4),o[1],0,0,0), C0,4); \
    KRD(GL,0); GAPB(o[0]=__builtin_amdgcn_mfma_f32_32x32x16_bf16(PAF(1),VFR(1),o[0],0,0,0), C0,8); \
    KRD(GL,1); GAPB(o[1]=__builtin_amdgcn_mfma_f32_32x32x16_bf16(PAF(1),VFR(5),o[1],0,0,0), C0,12); \
    KRD(GL,2); GAPB(o[0]=__builtin_amdgcn_mfma_f32_32x32x16_bf16(PAF(2),VFR(2),o[0],0,0,0), C1,0); \
    KRD(GL,3); GAPB(o[1]=__builtin_amdgcn_mfma_f32_32x32x16_bf16(PAF(2),VFR(6),o[1],0,0,0), C1,4); \
    GAPB(o[0]=__builtin_amdgcn_mfma_f32_32x32x16_bf16(PAF(3),VFR(3),o[0],0,0,0), C1,8); \
    GAPB(o[1]=__builtin_amdgcn_mfma_f32_32x32x16_bf16(PAF(3),VFR(7),o[1],0,0,0), C1,12); \
    }while(0)
  int t=1;
  #undef CMASK
  #define CMASK(P0,P1,t) do{}while(0)
  for(;t+5<NT;t+=2){
    STEP(pB0,pB1,pA0,pA1,t,true,true,true);     WAIT_BAR(2); RESC(); ROT();
    STEP(pA0,pA1,pB0,pB1,t+1,true,true,true);   WAIT_BAR(2); RESC(); ROT();
  }
  #undef CMASK
  #define CMASK(P0,P1,t) do{}while(0)
  #define ENDW(tt) do{ if((tt)+3<NT){WAIT_BAR(2);} else if((tt)+2<NT){WAIT_BAR(1);} else {WAIT_BAR(0);} }while(0)
  for(;t+1<NT;t+=2){
    STEP(pB0,pB1,pA0,pA1,t,(t+3<NT),(t+1<NT),(t+1<NT));       ENDW(t);   RESC(); ROT();
    STEP(pA0,pA1,pB0,pB1,t+1,(t+4<NT),(t+2<NT),(t+2<NT));     ENDW(t+1); RESC(); ROT();
  }
  STEP(pB0,pB1,pA0,pA1,NT-1,false,false,false); RESC();
  { float sacc=pB0[0]+pB0[1]; _Pragma("unroll") for(int r=2;r<16;++r)sacc+=pB0[r]; _Pragma("unroll") for(int r=0;r<16;++r)sacc+=pB1[r]; l_reg+=sacc;
    pw0=(u32x4){PKW(pB0,0),PKW(pB0,2),PKW(pB0,4),PKW(pB0,6)};pw1=(u32x4){PKW(pB0,8),PKW(pB0,10),PKW(pB0,12),PKW(pB0,14)};pw2=(u32x4){PKW(pB1,0),PKW(pB1,2),PKW(pB1,4),PKW(pB1,6)};pw3=(u32x4){PKW(pB1,8),PKW(pB1,10),PKW(pB1,12),PKW(pB1,14)};
    SBAR(); pv(o,vb0+sl_cur,PAF(0),PAF(1),PAF(2),PAF(3)); }
  #undef PKW
  #undef PAF
  #undef VFR
  #undef PIN
  #undef MX3
  #undef GAPA
  #undef GAPB
  #undef EX
  #undef VRD
  #undef KRD
  #undef STEP
  #undef ENDW
  {auto rr=__builtin_amdgcn_permlane32_swap(__float_as_uint(l_reg),__float_as_uint(l_reg),false,false);l_reg=__uint_as_float(rr[0])+__uint_as_float(rr[1]);}
  if(hi==0)wsf[32+r32]=l_reg;asm volatile("s_waitcnt lgkmcnt(0)":::"memory");
  float rli[16];
  #pragma unroll
  for(int r=0;r<16;++r)rli[r]=__builtin_amdgcn_rcpf(wsf[32+crow(r,hi)]);
  bf16*Ow=Ou+(long)(wid*QBLK)*OP;
  { bf16*stg=(bf16*)(shm+LDS_OST)+wid*2048;
    #pragma unroll
    for(int r=0;r<16;++r){const int orow=crow(r,hi);
      #pragma unroll
      for(int d0=0;d0<2;++d0)stg[orow*64+d0*32+r32]=__float2bfloat16(o[d0][r]*rli[r]);}
    asm volatile("s_waitcnt lgkmcnt(0)":::"memory");
    #pragma unroll
    for(int i=0;i<4;++i){const int row=i*8+(lane>>3),ch=lane&7; const u32x4 v=*(const u32x4*)(stg+row*64+ch*8); ATTN_STORE16(Ow+(long)row*OP+ch*8,v);} }
  asm volatile("s_waitcnt lgkmcnt(0)\n\ts_barrier":::"memory");
  #undef DMA_K
  #undef DMA_V
  #undef CMASK
  #undef START
  #undef RESC
  #undef ROT
}
constexpr int ATTN_LDS_BYTES=LDS_BYTES;
#undef SBAR
#undef WAIT_BAR
}

DEVI void attn_unit_run(const Ctx& c, int u) {
    using attn_body::bf16;
    const bf16* Qa = (const bf16*)(c.ws + WS_QA); const bf16* Qc = (const bf16*)(c.ws + WS_QC); const bf16* Ka = (const bf16*)(c.ws + WS_KA); const bf16* Va = (const bf16*)(c.ws + WS_VA);
    bf16* MIX = (bf16*)(c.ws + WS_MIX);
    if (u < 384) { const int grp = u / 48, rem = u % 48, g = rem >> 4, qb = rem & 15, b = grp >> 1, kvh = grp & 1, hq = kvh * 3 + g;
        attn_body::attn_unit<8>(Qa + (size_t)(b * SEQ + qb * 256) * 384 + hq * 64, Ka + (size_t)b * SKV * 128 + kvh * 64, Va + (size_t)b * SKV * 128 + kvh * 64, SKV / 64,
                                MIX + (size_t)(b * SEQ + qb * 256) * 1024 + 384 + hq * 64, (char*)c.lds); }
    else { const int uc = u - 384, b = uc / 6, hq = uc % 6, kvh = hq / 3;
        attn_body::attn_unit<8>(Qc + (size_t)(b * CTXL) * 384 + hq * 64, Ka + (size_t)b * SKV * 128 + kvh * 64, Va + (size_t)b * SKV * 128 + kvh * 64, CTXL / 64,
                                MIX + (size_t)(NLAT + b * CTXL) * 1024 + 384 + hq * 64, (char*)c.lds); }
}
template <bool FAST_SCAN>
DEVI void phase_mixer_fast(const Ctx& c, bool with_ctx, int psub = 0) {
    const int G = gridDim.x, bx = blockIdx.x; const int nunits = 384 + (with_ctx ? 24 : 0);
    if (G == 256) {
        const int vcu = (bx & 7) * 32 + (bx >> 3), x = vcu >> 5, j = vcu & 31;
        if (FAST_SCAN && j < 6) { if (!(psub & 4)) dn::scan_sequence(c, x * 6 + j); return; }
        if (psub & 8) return;
        if (!FAST_SCAN) { for (int u = vcu; u < nunits; u += 256) attn_unit_run(c, u); return; }
        const int jp = j - 6;
        attn_unit_run(c, 48 * x + jp);
        if (jp < 22) attn_unit_run(c, 48 * x + 26 + jp);
        else if (with_ctx && jp < 25) attn_unit_run(c, 384 + (x >> 1) * 6 + (x & 1) * 3 + (jp - 22));
    } else {
        if (FAST_SCAN) for (int sq = bx; sq < 48; sq += G) dn::scan_sequence(c, sq);
        for (int u = bx; u < nunits; u += G) attn_unit_run(c, u);
    }
}

DEVI void phase_moe_assign(const Ctx& c) {
    int* cnt = (int*)c.lds;
    int* misc = (int*)c.lds + 2048;
    int* slots = (int*)c.lds + 2048 + 64;
    const int* gcnt = (const int*)(c.ws + CTL_CNT); const int* tope = (const int*)(c.ws + CTL_TOPE);
    const bf16_t* H = (const bf16_t*)(c.ws + WS_H); bf16_t* XBm = (bf16_t*)(c.ws + WS_MXB);
    for (int i = c.tid; i < 2048; i += NTHREADS) cnt[i] = gcnt[i];
    __syncthreads();
    if (c.tid < 8) { int tot = 0; for (int v = 0; v < 256; ++v) tot += cnt[v * 8 + c.tid]; misc[8 + c.tid] = tot; }
    __syncthreads();
    if (c.tid == 0) { int s = 0; for (int e = 0; e < 8; ++e) { misc[16 + e] = s; s += (misc[8 + e] + 255) & ~255; } misc[24] = s;
        if (blockIdx.x == 0) { int* seg = (int*)(c.ws + CTL_SEG); for (int e = 0; e <= 8; ++e) seg[e] = misc[16 + e]; for (int e = 0; e < 8; ++e) seg[16 + e] = misc[8 + e];
            for (int e = 0; e < 8; ++e) for (int pm = misc[16 + e] >> 8; pm < (misc[16 + e + 1] >> 8); ++pm) seg[32 + pm] = e; } }
    __syncthreads();
    if (blockIdx.x == 0) {
        int* ut = (int*)(c.ws + CTL_UTAB); const int nu = (misc[24] >> 8) * 4, ntab = nu <= 512 ? nu : 512 + 4 * (nu - 512);
        if (c.tid == 0) ut[0] = ntab;
        for (int L = c.tid; L < ntab; L += NTHREADS) { const int unit = L < 512 ? L : 512 + ((L - 512) >> 2), pm = unit >> 2; int e = 0;
            for (int q = 1; q < 8; ++q) e += (pm * 256 >= misc[16 + q]) ? 1 : 0;
            ut[4 + 4 * L] = pm; ut[4 + 4 * L + 1] = (unit & 3) + 4 * e; ut[4 + 4 * L + 2] = L < 512 ? 0 : ((L - 512) & 3) * (MFF / 4); ut[4 + 4 * L + 3] = L < 512 ? 0 : MFF / 256; } }
    for (int vb = blockIdx.x; vb < 256; vb += gridDim.x) {
        int* sel = slots + 128;
        if (c.tid < 128) sel[c.tid] = tope[vb * 128 + c.tid];
        __syncthreads();
        if (c.tid < 8) { int bs = 0; for (int v = 0; v < vb; ++v) bs += cnt[v * 8 + c.tid];
            int rank = misc[16 + c.tid] + bs;
            for (int i = 0; i < 128; ++i) if (sel[i] == c.tid) { slots[i] = rank; ++rank; } }
        __syncthreads();
        if (c.tid < 128) ((int*)(c.ws + CTL_TOKSLOT))[vb * 128 + c.tid] = slots[c.tid];
        for (int a = c.wave; a < 128; a += NWAVES) { const int row = vb * 64 + (a >> 1); const int slot = slots[a];
            const u32x4* src = (const u32x4*)(H + (size_t)row * 1024) + c.lane; u32x4* dst = (u32x4*)(XBm + (size_t)slot * 1024) + c.lane; dst[0] = src[0]; dst[64] = src[64]; }
        __syncthreads();
    }
    for (int e = 0; e < 8; ++e) { const int p0 = misc[16 + e] + misc[8 + e], p1 = misc[16 + e + 1];
        for (int s = p0 + c.gw; s < p1; s += c.ngw) { u32x4* dst = (u32x4*)(XBm + (size_t)s * 1024) + c.lane; dst[0] = (u32x4){0u, 0u, 0u, 0u}; dst[64] = (u32x4){0u, 0u, 0u, 0u}; } }
}

DEVI u32x2 zsum3(const u32x2* z) { const u32x2 a = z[0], b = z[2048 * 256], d = z[2 * 2048 * 256]; u32x2 o;
    o.x = pk2(bflo(a.x) + bflo(b.x) + bflo(d.x), bfhi(a.x) + bfhi(b.x) + bfhi(d.x)); o.y = pk2(bflo(a.y) + bflo(b.y) + bflo(d.y), bfhi(a.y) + bfhi(b.y) + bfhi(d.y)); return o; }
DEVI void phase_final(const Ctx& c) {
    const float* xb = (const float*)(c.ws + WS_XB); const bf16_t* YB = (const bf16_t*)(c.ws + WS_MXB); const bf16_t* YB2 = (const bf16_t*)(c.ws + WS_YB2);
    const int* ts = (const int*)(c.ws + CTL_TOKSLOT); const float* tg = (const float*)(c.ws + CTL_TOPG);
    struct Sc { int s1, s2; float g1, g2; };
    struct Dt { u32x2 a[4], b[4], za[4], zb[4]; f32x4 x[4]; };
#define FIN_SC(sc, r) do { sc.s1 = ts[(r) * 2]; sc.s2 = ts[(r) * 2 + 1]; sc.g1 = tg[(r) * 2]; sc.g2 = tg[(r) * 2 + 1]; } while (0)
#define FIN_DT(dt, sc, r) do { const u32x2* y1_ = (const u32x2*)(YB + (size_t)sc.s1 * 1024) + c.lane; const u32x2* y2_ = (const u32x2*)(YB + (size_t)sc.s2 * 1024) + c.lane; \
        const u32x2* z1_ = (const u32x2*)(YB2 + (size_t)(sc.s1 >= 32768 ? sc.s1 - 32768 : 0) * 1024) + c.lane; const u32x2* z2_ = (const u32x2*)(YB2 + (size_t)(sc.s2 >= 32768 ? sc.s2 - 32768 : 0) * 1024) + c.lane; \
        const f32x4* xr_ = (const f32x4*)(xb + (size_t)(r) * 1024) + c.lane; \
        _Pragma("unroll") for (int j_ = 0; j_ < 4; ++j_) { dt.a[j_] = y1_[64 * j_]; dt.b[j_] = y2_[64 * j_]; dt.x[j_] = xr_[64 * j_]; \
            dt.za[j_] = sc.s1 >= 32768 ? zsum3(z1_ + 64 * j_) : (u32x2){0u, 0u}; dt.zb[j_] = sc.s2 >= 32768 ? zsum3(z2_ + 64 * j_) : (u32x2){0u, 0u}; } } while (0)
    int r = c.gw; if (r >= NLAT) return;
    Sc sc0, sc1, sc2; Dt d0, d1;
    FIN_SC(sc0, r); sc1 = sc0; sc2 = sc0;
    if (r + c.ngw < NLAT) FIN_SC(sc1, r + c.ngw);
    FIN_DT(d0, sc0, r); d1 = d0;
    for (; r < NLAT; r += c.ngw) {
        if (r + 2 * c.ngw < NLAT) FIN_SC(sc2, r + 2 * c.ngw);
        if (r + c.ngw < NLAT) FIN_DT(d1, sc1, r + c.ngw);
        const float g1 = sc0.g1, g2 = sc0.g2; const f32x4* gt = (const f32x4*)modv(c, 1, r, 5) + c.lane;
        f32x4 v[4]; float ss = 0.f;
#pragma unroll
        for (int j = 0; j < 4; ++j) { const u32x2 a = d0.a[j], b = d0.b[j], p = d0.za[j], q = d0.zb[j]; const f32x4 g = gt[64 * j]; f32x4 y;
            y.x = g1 * (bflo(a.x) + bflo(p.x)) + g2 * (bflo(b.x) + bflo(q.x)); y.y = g1 * (bfhi(a.x) + bfhi(p.x)) + g2 * (bfhi(b.x) + bfhi(q.x));
            y.z = g1 * (bflo(a.y) + bflo(p.y)) + g2 * (bflo(b.y) + bflo(q.y)); y.w = g1 * (bfhi(a.y) + bfhi(p.y)) + g2 * (bfhi(b.y) + bfhi(q.y));
            v[j] = d0.x[j] + g * y; ss += (v[j].x * v[j].x + v[j].y * v[j].y) + (v[j].z * v[j].z + v[j].w * v[j].w); }
        const float rstd = rsqrtf(wave_sum(ss) * (1.f / 1024.f) + EPS);
        const f32x4* fg = (const f32x4*)c.in[I_FNG] + c.lane; f32x4* o = (f32x4*)(c.out + (size_t)r * 1024) + c.lane;
#pragma unroll
        for (int j = 0; j < 4; ++j) o[64 * j] = v[j] * rstd * fg[64 * j];
        sc0 = sc1; sc1 = sc2; d0 = d1;
    }
#undef FIN_SC
#undef FIN_DT
}

#define LAS __attribute__((address_space(3)))
#define XB_TMO      128
#define XB_XCNT(j)  (256  + 64 * (j))
#define XB_XSUB(j)  (1280 + 64 * (j))
#define XB_XGEN(j)  (2304 + 64 * (j))
#define XB_TOP      3328
#define XB_TOPGEN   3392
#define XCD_BAR_WORDS 3456
#define XB_SPIN_CAP (1u << 18)

__device__ __forceinline__ unsigned xb_ld(unsigned* p)              { return __hip_atomic_load(p, __ATOMIC_RELAXED, __HIP_MEMORY_SCOPE_AGENT); }
__device__ __forceinline__ unsigned xb_add(unsigned* p, unsigned v) { return __hip_atomic_fetch_add(p, v, __ATOMIC_RELAXED, __HIP_MEMORY_SCOPE_AGENT); }
__device__ __forceinline__ unsigned xb_xcc_id() { return (unsigned)__builtin_amdgcn_s_getreg((3 << 11) | 20) & 0xFu; }
#define XB_SPIN(cond, bar) do { unsigned _sp = 0; while (cond) { __builtin_amdgcn_s_sleep(1); \
    if ((++_sp & 255u) == 0u) { if (xb_ld(&(bar)[XB_TMO])) break; if (_sp > XB_SPIN_CAP) { atomicAdd(&(bar)[XB_TMO], 1u); break; } } } } while (0)

struct XcdBarrier {
    unsigned* bar; unsigned x;
    volatile LAS unsigned* st;
};

__device__ __forceinline__ XcdBarrier xcd_barrier_post(unsigned* bar, volatile LAS unsigned* st) {
    XcdBarrier b; b.bar = bar; b.x = xb_xcc_id(); b.st = st;
    if (threadIdx.x == 0) (void)xb_add(&bar[XB_XCNT(b.x)], 1u);
    return b;
}
__device__ __forceinline__ void xcd_barrier_complete(unsigned* bar, unsigned x, unsigned& nloc, unsigned& nx) {
    const unsigned G = gridDim.x * gridDim.y * gridDim.z;
    unsigned sum, cnt, mine, sp = 0u;
    for (;;) {
        sum = 0u; cnt = 0u; mine = 0u;
#pragma unroll
        for (unsigned j = 0; j < 16; ++j) { const unsigned c = xb_ld(&bar[XB_XCNT(j)]); sum += c; cnt += (c > 0u) ? 1u : 0u; mine = (j == x) ? c : mine; }
        if (sum == G) break;
        __builtin_amdgcn_s_sleep(1);
        if ((++sp & 255u) == 0u) { if (xb_ld(&bar[XB_TMO])) break; if (sp > XB_SPIN_CAP) { atomicAdd(&bar[XB_TMO], 1u); break; } }
    }
    nloc = mine > 0u ? mine : 1u; nx = cnt > 0u ? cnt : 1u;
}

__device__ __forceinline__ void xcd_barrier(const XcdBarrier& b) {
    asm volatile("s_waitcnt vmcnt(0)" ::: "memory");
    __syncthreads();
    if (threadIdx.x == 0) {
        unsigned* bar = b.bar;
        __builtin_amdgcn_s_waitcnt(0);
        unsigned nloc = b.st[0], nx = b.st[1];
        if (nloc == 0u) { xcd_barrier_complete(bar, b.x, nloc, nx); b.st[0] = nloc; b.st[1] = nx; }
        const unsigned old = xb_add(&bar[XB_XSUB(b.x)], 1u);
        const unsigned gen = old / nloc;
        if (old + 1u == (gen + 1u) * nloc) {
            __builtin_amdgcn_fence(__ATOMIC_RELEASE, "agent");
            asm volatile("s_waitcnt vmcnt(0)" ::: "memory");
            const unsigned og = xb_add(&bar[XB_TOP], 1u);
            const unsigned tg = og / nx;
            if (og + 1u == (tg + 1u) * nx) xb_add(&bar[XB_TOPGEN], 1u);
            else XB_SPIN(xb_ld(&bar[XB_TOPGEN]) == tg, bar);
            __builtin_amdgcn_fence(__ATOMIC_ACQUIRE, "agent");
            xb_add(&bar[XB_XGEN(b.x)], 1u);
            asm volatile("s_waitcnt vmcnt(0)" ::: "memory");
        } else {
            XB_SPIN(xb_ld(&bar[XB_XGEN(b.x)]) == gen, bar);
            __builtin_amdgcn_fence(__ATOMIC_ACQUIRE, "agent");
            asm volatile("s_waitcnt vmcnt(0)" ::: "memory");
        }
    }
    __syncthreads();
}

#ifndef FAST_DN
#define FAST_DN 1
#endif
constexpr int NPHASES = 24;
#define IN(k) (lo <= (k) && (k) < hi)
#define SYNC(k) do { if (IN(k) && IN((k) + 1)) xcd_barrier(grid); } while (0)
template <int LAYER>
DEVI void mixer_phases(const Ctx& c, int lo, int hi, int psub, const XcdBarrier& grid) {
    constexpr int P = 1 + LAYER * 10;
    bf16_t* wl = (bf16_t*)(c.ws + WS_WL);
    const float* mvl = (const float*)(c.ws + CTL_MODV) + (size_t)LAYER * 5 * 6144;
    const float* xl = LAYER == 0 ? c.in[I_X] : (const float*)(c.ws + WS_XB); const float* xc = LAYER == 0 ? c.in[I_CTX] : (const float*)(c.ws + WS_XB) + (size_t)NLAT * 1024;
    if (IN(P)) { phase_norm<false>(c, LAYER, 0, c.in[I_N1G] + LAYER * 1024, NT, xl, xc, LAYER == 1 ? (const float*)(c.ws + WS_PB) : nullptr); } SYNC(P);
    if (IN(P + 1)) { const bf16_t* bt = (const bf16_t*)((char*)wl + WL_WIN) + (size_t)LAYER * ZP * 1024;
        pg8::Gemm g{(const bf16_t*)(c.ws + WS_H), bt, NT, ZP, 1024}; pg8::StaticOrder S; S.init(NT, ZP, (int)gridDim.x, (int)blockIdx.x);
        pg8::gemm_phase<pg8::EpiStore, pg8::StaticOrder, true, true>(c.lds3, g, S, pg8::EpiStore{(bf16_t*)(c.ws + WS_Z), ZP, 0, 0l}); } SYNC(P + 1);
    if (IN(P + 2)) { phase_prep(c, LAYER, LAYER == 0); } SYNC(P + 2);
#if FAST_DN
    if (IN(P + 3)) { if (!(psub & 1)) dn::phase_chunkprep(c); if (!(psub & 2)) phase_sgu(c, LAYER, LAYER == 0); } SYNC(P + 3);
    if (IN(P + 4)) { phase_mixer_fast<true>(c, LAYER == 0, psub); } SYNC(P + 4);
#else
    if (IN(P + 3)) { phase_sgu(c, LAYER, LAYER == 0); } SYNC(P + 3);
    if (IN(P + 4)) { phase_dnscan_naive(c); phase_mixer_fast<false>(c, LAYER == 0); } SYNC(P + 4);
#endif
    if (IN(P + 5)) { phase_dnfinish(c, LAYER, LAYER == 0 ? NT : NLAT); } SYNC(P + 5);
    if (IN(P + 6)) { const bf16_t* bt = (const bf16_t*)((char*)wl + WL_WOUT) + (size_t)LAYER * 1024 * 1024;
        constexpr int MR = LAYER == 0 ? NT : NLAT;
        pg8::Gemm g{(const bf16_t*)(c.ws + WS_MIX), bt, MR, 1024, 1024}; pg8::StaticOrder S; S.init(MR, 1024, (int)gridDim.x, (int)blockIdx.x);
        pg8::gemm_phase<pg8::EpiRes, pg8::StaticOrder, true, true>(c.lds3, g, S, pg8::EpiRes{(float*)(c.ws + WS_XB), mvl, 2, xl, xc, nullptr});
        if (LAYER == 0 && gridDim.x == 256 && blockIdx.x >= 16) phase_conv_m2(c, ((int)blockIdx.x - 16) * NWAVES + c.wave, 240 * NWAVES, 0, 4); } SYNC(P + 6);
}

__global__ void __launch_bounds__(NTHREADS, 2) mega_fwd(Args args) {
    extern __shared__ __attribute__((aligned(16))) unsigned char lds_raw[];
    Ctx c;
#pragma unroll
    for (int i = 0; i < 28; ++i) c.in[i] = args.in[i];
    c.out = args.out; c.ws = args.ws; c.tid = threadIdx.x; c.lane = c.tid & 63; c.wave = __builtin_amdgcn_readfirstlane(c.tid >> 6);
    c.gw = blockIdx.x * NWAVES + c.wave; c.ngw = gridDim.x * NWAVES; c.lds = (float*)lds_raw; c.lds3 = (__attribute__((address_space(3))) unsigned char*)lds_raw;
    bf16_t* wl = (bf16_t*)(c.ws + WS_WL);
    const int lo = args.ph_lo, hi = args.ph_hi;
    volatile LAS unsigned* bst = (volatile LAS unsigned*)(c.lds3 + LDS_BYTES - 64);
    if (c.tid < 16) bst[c.tid] = 0u;
    __syncthreads();
    const XcdBarrier grid = xcd_barrier_post((unsigned*)(c.ws + WS_CTL), bst);
    if (IN(0)) { phase_prologue(c); } SYNC(0);
    mixer_phases<0>(c, lo, hi, args.probe_sub, grid);
    {
        const float* mvl = (const float*)(c.ws + CTL_MODV);
        const float* xbl = (const float*)(c.ws + WS_XB); const float* xbc = xbl + (size_t)NLAT * 1024;
        if (IN(8)) { phase_norm<false>(c, 0, 3, c.in[I_N2G], NT, xbl, xbc); } SYNC(8);
        if (IN(9)) { pg8::Gemm g{(const bf16_t*)(c.ws + WS_H), (const bf16_t*)((char*)wl + WL_F13), NT, 2 * FF, 1024}; pg8::StaticOrder S; S.init(NT, 2 * FF, (int)gridDim.x, (int)blockIdx.x);
            pg8::gemm_phase<pg8::EpiSwi, pg8::StaticOrder, true, true>(c.lds3, g, S, pg8::EpiSwi{(bf16_t*)(c.ws + WS_Z), FF, 0});
            if (gridDim.x == 256 && blockIdx.x >= 216) phase_conv_m2(c, ((int)blockIdx.x - 216) * NWAVES + c.wave, 40 * NWAVES, 7, 8); } SYNC(9);
        if (IN(10)) { pg8::Gemm g{(const bf16_t*)(c.ws + WS_Z), (const bf16_t*)((char*)wl + WL_F2), NT, 1024, FF}; pg8::FfnDownOrder S; S.init((int)gridDim.x, (int)blockIdx.x);
            pg8::gemm_phase<pg8::EpiRes, pg8::FfnDownOrder, true, true>(c.lds3, g, S, pg8::EpiRes{(float*)(c.ws + WS_XB), mvl, 5, xbl, xbc, (float*)(c.ws + WS_PB)});
            if (gridDim.x == 256 && blockIdx.x >= 64) phase_conv_m2(c, ((int)blockIdx.x - 64) * NWAVES + c.wave, 192 * NWAVES, 4, 7); } SYNC(10);
    }
    mixer_phases<1>(c, lo, hi, args.probe_sub, grid);
    {
        if (IN(18)) { const float* xbl = (const float*)(c.ws + WS_XB);
            if (gridDim.x == 256) {
                {
                    f32x4* rwl = (f32x4*)(c.lds + 256);
                    for (int idx = c.tid; idx < 2048; idx += NTHREADS) { const int ln = idx & 63, hf = (idx >> 6) & 1, jq = idx >> 7, col = 4 * ln + 256 * (jq >> 2) + (jq & 3);
                        rwl[idx] = *(const f32x4*)(c.in[I_RW] + col * 8 + 4 * hf); }
                    __syncthreads(); }
                if (c.wave < 4) norm_router_rows16(c, c.in[I_N2G] + 1024, xbl, (const f32x4*)(c.lds + 256), (int*)c.lds);
                else { phase_conv_m13(c, (int)blockIdx.x * 4 + (c.wave - 4), 1024); }
                __syncthreads();
                if (c.tid < 8) { const int* sel = (const int*)c.lds; int n = 0; for (int q = 0; q < 128; ++q) n += (sel[q] == c.tid) ? 1 : 0; ((int*)(c.ws + CTL_CNT))[blockIdx.x * 8 + c.tid] = n; }
            } else { phase_norm<true>(c, 1, 3, c.in[I_N2G] + 1024, NLAT, xbl, xbl + (size_t)NLAT * 1024); phase_conv_m13(c); phase_conv_m2(c); } } SYNC(18);
        if (IN(19)) { phase_moe_assign(c); } SYNC(19);
        if (IN(20)) { pg8::Gemm g{(const bf16_t*)(c.ws + WS_MXB), (const bf16_t*)(c.ws + WS_M13), 0, 0, 1024}; pg8::MoeOrder S; S.init((const int*)(c.ws + CTL_SEG), 28, (int)gridDim.x, (int)blockIdx.x);
            pg8::gemm_phase<pg8::EpiSwi, pg8::MoeOrder, true, true>(c.lds3, g, S, pg8::EpiSwi{(bf16_t*)(c.ws + WS_MHID), MFF, 28}); } SYNC(20);
        if (IN(22)) { pg8::Gemm g{(const bf16_t*)(c.ws + WS_MHID), (const bf16_t*)c.out, 0, 0, MFF}; pg8::TableOrder S; S.init((const int*)(c.ws + CTL_UTAB), (int)gridDim.x, (int)blockIdx.x);
            pg8::gemm_phase<pg8::EpiStore, pg8::TableOrder, true, true>(c.lds3, g, S, pg8::EpiStore{(bf16_t*)(c.ws + WS_MXB), 1024, 4, (long)((WS_YB2 - WS_MXB) / 2) - 32768l * 1024}); } SYNC(22);
        if (IN(23)) { phase_final(c); }
    }
}
#undef IN
#undef SYNC

extern "C" void kernel_launch(void* const* d_in, const int* in_sizes, int n_in, void* d_out, int out_size, void* d_ws, size_t ws_size, hipStream_t stream) {
    static int grid = 0;
    if (grid == 0) {
        if (n_in != 28 || out_size != NLAT * D || ws_size < WS_END) { fprintf(stderr, "kernel_launch: unexpected shapes (n_in %d out %d ws %zu)\n", n_in, out_size, ws_size); grid = -1; return; }
        int dev = 0, cus = 0, per_cu = 0;
        hipGetDevice(&dev); hipDeviceGetAttribute(&cus, hipDeviceAttributeMultiprocessorCount, dev);
        hipFuncSetAttribute((const void*)mega_fwd, hipFuncAttributeMaxDynamicSharedMemorySize, LDS_BYTES);
        hipOccupancyMaxActiveBlocksPerMultiprocessor(&per_cu, (const void*)mega_fwd, NTHREADS, LDS_BYTES);
        if (per_cu < 1) { fprintf(stderr, "kernel_launch: occupancy query says %d blocks per CU\n", per_cu); per_cu = 1; }
        (void)hipGetLastError();
        grid = cus;
    }
    if (grid < 0) return;
    if (hipMemsetAsync(d_ws, 0, 16384, stream) != hipSuccess) { fprintf(stderr, "kernel_launch: memset of the barrier words failed\n"); return; }
    Args a{};
    for (int i = 0; i < 28; ++i) a.in[i] = (const float*)d_in[i];
    a.out = (float*)d_out; a.ws = (unsigned char*)d_ws;
#ifndef MK_PER_PHASE
#define MK_PER_PHASE 0
#endif
#if MK_PER_PHASE
    for (int ph = 0; ph < NPHASES; ++ph) {
        a.ph_lo = ph; a.ph_hi = ph + 1; void* kargs[] = {&a};
        hipError_t e = hipLaunchCooperativeKernel((const void*)mega_fwd, dim3(grid), dim3(NTHREADS), kargs, LDS_BYTES, stream);
        if (e != hipSuccess) { fprintf(stderr, "launch failed: %s\n", hipGetErrorString(e)); break; }
    }
#else
    a.ph_lo = 0; a.ph_hi = NPHASES; void* kargs[] = {&a};
    hipError_t e = hipLaunchCooperativeKernel((const void*)mega_fwd, dim3(grid), dim3(NTHREADS), kargs, LDS_BYTES, stream);
    if (e != hipSuccess) fprintf(stderr, "launch failed: %s\n", hipGetErrorString(e));
#ifndef PROBE_LO
#define PROBE_LO -1
#define PROBE_HI -1
#endif
#if PROBE_LO >= 0
    (void)hipMemsetAsync(d_ws, 0, 16384, stream);
    a.ph_lo = PROBE_LO; a.ph_hi = PROBE_HI;
#ifdef PROBE_SUB
    a.probe_sub = PROBE_SUB;
#endif
    e = hipLaunchCooperativeKernel((const void*)mega_fwd, dim3(grid), dim3(NTHREADS), kargs, LDS_BYTES, stream);
    if (e != hipSuccess) fprintf(stderr, "probe launch failed: %s\n", hipGetErrorString(e));
#endif
#endif
}
```

```cpp
#include <hip/hip_runtime.h>
#include <hip/hip_cooperative_groups.h>
#include <hip/hip_bf16.h>
#include <cstdio>
#include <cstdint>
namespace cg = cooperative_groups;

#define DEVI __device__ __forceinline__
typedef unsigned short bf16_t;
typedef float f32x4 __attribute__((ext_vector_type(4)));
typedef float f32x2 __attribute__((ext_vector_type(2)));
typedef unsigned u32x4 __attribute__((ext_vector_type(4)));
typedef unsigned u32x2 __attribute__((ext_vector_type(2)));

constexpr int D = 1024, NB = 4, SEQ = 4096, CTXL = 256;
constexpr int NLAT = NB * SEQ, NCTX = NB * CTXL, NT = NLAT + NCTX;
constexpr int SKV = CTXL + SEQ;
constexpr int INC = 2712, ZP = 2816;
constexpr int ZC_QKV = 0, ZC_GATE = 1152, ZC_AQ = 1536, ZC_AK = 1920, ZC_AV = 2048, ZC_MU = 2176, ZC_MV = 2432, ZC_BETA = 2688, ZC_ALPHA = 2700;
constexpr int FF = 2816, MFF = 3584, NE = 8;
constexpr int MAXSLOT = 34816;
constexpr float EPS = 1e-6f;
constexpr float QSCALE = 0.125f * 1.4426950408889634f;

constexpr size_t MiB = 1u << 20, KiB = 1024;
constexpr size_t WS_CTL = 0;
constexpr size_t CTL_ROPE = 32 * KiB;
constexpr size_t CTL_MODV = 64 * KiB;
constexpr size_t CTL_TOPE = 320 * KiB;
constexpr size_t CTL_TOPG = 448 * KiB;
constexpr size_t CTL_CNT = 576 * KiB;
constexpr size_t CTL_SEG = 584 * KiB;
constexpr size_t CTL_TOKSLOT = 592 * KiB;
constexpr size_t CTL_ROWTAB = 768 * KiB;
constexpr size_t CTL_UTAB = 720 * KiB;
constexpr size_t WS_XB = 4 * MiB;
constexpr size_t WS_WL = 72 * MiB;
constexpr size_t WL_WIN = 0;
constexpr size_t WL_WOUT = 11 * MiB;
constexpr size_t WL_F13 = 15 * MiB;
constexpr size_t WL_F2 = 26 * MiB;
static_assert(WL_WIN + (size_t)2 * 2816 * 1024 * 2 <= WL_WOUT && WL_WOUT + (size_t)2 * 1024 * 1024 * 2 <= WL_F13 && WL_F13 + (size_t)5632 * 1024 * 2 <= WL_F2 && WS_WL + WL_F2 + (size_t)1024 * 2816 * 2 <= 104 * MiB, "WL map");
constexpr size_t WS_H = 104 * MiB;
constexpr size_t WS_Z = 138 * MiB;
constexpr size_t WS_MIX = 232 * MiB;
constexpr size_t WS_QA = 266 * MiB;
constexpr size_t WS_QC = 278 * MiB;
constexpr size_t WS_KA = 279 * MiB;
constexpr size_t WS_VA = 284 * MiB;
constexpr size_t WS_DN = 289 * MiB;
constexpr size_t WS_QN = WS_H, WS_KN = WS_H + 13 * MiB;
constexpr size_t DN_VB = 0;
constexpr size_t DN_BG = 13 * MiB;
constexpr size_t DN_O = 15 * MiB;
constexpr size_t WS_SV = 499 * MiB;
constexpr size_t DN_OPS = 66 * MiB;
static_assert(WS_DN + DN_OPS + (size_t)3264 * 46080 <= WS_SV && WS_SV + (size_t)NT * 256 * 2 <= 512 * MiB, "ws");
constexpr size_t WS_MHID = 72 * MiB;
constexpr size_t WS_MXB = 310 * MiB;
constexpr size_t WS_M13 = 378 * MiB;
constexpr size_t WS_M2 = 378 * MiB;
constexpr size_t WS_PB = 232 * MiB;
constexpr size_t WS_YB2 = 440 * MiB;
constexpr size_t WS_END = 512 * MiB;
static_assert(WS_M13 + (size_t)8 * 7168 * 1024 * 2 <= WS_END, "ws");
static_assert(WS_MHID + (size_t)MAXSLOT * 3584 * 2 <= WS_MXB && WS_MXB + (size_t)MAXSLOT * 1024 * 2 <= WS_M13, "ws");
static_assert(WS_H + (size_t)NT * 1024 * 2 <= WS_Z && WS_Z + (size_t)NT * ZP * 2 <= WS_MIX && WS_MIX + (size_t)NT * 1024 * 2 <= WS_QA, "ws");

constexpr int LDS_BYTES = 147456;
constexpr int NTHREADS = 512, NWAVES = 8;

DEVI unsigned f2bf(float f) { unsigned u = __float_as_uint(f); return (u + 0x7fffu + ((u >> 16) & 1u)) >> 16; }
DEVI float bf2f(unsigned h) { return __uint_as_float(h << 16); }
DEVI unsigned pk2(float lo, float hi) { return f2bf(lo) | (f2bf(hi) << 16); }
DEVI float bflo(unsigned w) { return __uint_as_float(w << 16); }
DEVI float bfhi(unsigned w) { return __uint_as_float(w & 0xffff0000u); }
DEVI void unpack8(const u32x4 w, float* v) { v[0] = bflo(w.x); v[1] = bfhi(w.x); v[2] = bflo(w.y); v[3] = bfhi(w.y); v[4] = bflo(w.z); v[5] = bfhi(w.z); v[6] = bflo(w.w); v[7] = bfhi(w.w); }
DEVI u32x4 pack8(const float* v) { u32x4 w; w.x = pk2(v[0], v[1]); w.y = pk2(v[2], v[3]); w.z = pk2(v[4], v[5]); w.w = pk2(v[6], v[7]); return w; }
DEVI float wave_sum(float v) {
#pragma unroll
    for (int o = 1; o < 64; o <<= 1) v += __shfl_xor(v, o);
    return v;
}
DEVI float wave_max(float v) {
#pragma unroll
    for (int o = 1; o < 64; o <<= 1) v = fmaxf(v, __shfl_xor(v, o));
    return v;
}
DEVI float silu_f(float x) { return x * __builtin_amdgcn_rcpf(1.f + __expf(-x)); }
DEVI float gelu_f(float x) { const float u = 0.7978845608028654f * (x + 0.044715f * x * x * x); const float e = __expf(2.f * u); return x * (1.f - __builtin_amdgcn_rcpf(1.f + e)); }
DEVI float softplus_f(float x) { const float e = __expf(-fabsf(x)); const float l = e < 0.01f ? e * (1.f - e * (0.5f - e * 0.33333334f)) : __logf(1.f + e); return fmaxf(x, 0.f) + l; }
DEVI int row_mod(int r) { return r < NLAT ? (r >> 12) : 4; }

struct Args { const float* in[28]; float* out; unsigned char* ws; int ph_lo, ph_hi, probe_sub, pad; };

struct Ctx {
    const float* in[28]; float* out; unsigned char* ws;
    int tid, lane, wave, gw, ngw;
    float* lds;
    __attribute__((address_space(3))) unsigned char* lds3;
};
enum { I_X = 0, I_C, I_CTX, I_CCTX, I_MODW, I_MODB, I_N1G, I_N2G, I_WIN, I_CONVW, I_ALOG, I_DTB, I_DNG, I_QG, I_KG, I_SGUG, I_SGUW, I_SGUB, I_WOUT,
       I_F1, I_F3, I_F2, I_RW, I_RB, I_M1, I_M3, I_M2, I_FNG };

DEVI const float* modv(const Ctx& c, int layer, int r, int which) { return (const float*)(c.ws + CTL_MODV) + ((size_t)(layer * 5 + row_mod(r)) * 6 + which) * 1024; }

template <int MAP>
DEVI int map_row(int n, int add) {
    if (MAP == 1) return n < 1536 ? n : (n < 1560 ? n + 1152 : n - 24);
    if (MAP == 2) return (n >> 7) * 256 + (n & 127) + add;
    return n;
}
template <int MAP>
DEVI void transpose_tiles(const Ctx& c, const float* W, int K, int N, bf16_t* WT, int add, int& base, int wv = -1, int nwv = 0) {
    float* Ls = c.lds + c.wave * (64 * 65);
    const int ntn = (N + 63) / 64, ntiles = (K / 64) * ntn, G = wv < 0 ? c.ngw : nwv, wid = wv < 0 ? c.gw : wv;
    const int nq = c.lane & 15, kr = c.lane >> 4, cch = c.lane & 7, rn = c.lane >> 3;
    int t = (wid - base % G + G) % G;
    base += ntiles;
    f32x4 v[16];
#define TT_LOAD(tile) do { const int kb_ = (tile) / ntn, nb_ = (tile) % ntn, n_ = nb_ * 64 + 4 * nq; \
        _Pragma("unroll") for (int p_ = 0; p_ < 16; ++p_) v[p_] = n_ < N ? __builtin_nontemporal_load((const f32x4*)(W + (size_t)(kb_ * 64 + kr + 4 * p_) * N + n_)) : (f32x4){0.f, 0.f, 0.f, 0.f}; } while (0)
    if (t < ntiles) TT_LOAD(t);
    for (; t < ntiles; t += G) {
#pragma unroll
        for (int p = 0; p < 16; ++p) { float* q = Ls + (kr + 4 * p) * 65 + 4 * nq; q[0] = v[p].x; q[1] = v[p].y; q[2] = v[p].z; q[3] = v[p].w; }
        if (t + G < ntiles) TT_LOAD(t + G);
        __builtin_amdgcn_wave_barrier(); asm volatile("" ::: "memory");
        const int kb = t / ntn, nb = t % ntn;
#pragma unroll
        for (int j = 0; j < 8; ++j) { const int nl = 8 * j + rn, n = nb * 64 + nl; float x[8];
#pragma unroll
            for (int i = 0; i < 8; ++i) x[i] = Ls[(8 * cch + i) * 65 + nl];
            if (n < N) *(u32x4*)(WT + (size_t)map_row<MAP>(n, add) * K + kb * 64 + 8 * cch) = pack8(x); }
        __builtin_amdgcn_wave_barrier(); asm volatile("" ::: "memory");
    }
#undef TT_LOAD
}

DEVI void phase_prologue(const Ctx& c) {
    bf16_t* wl = (bf16_t*)(c.ws + WS_WL);
    int tb = 0;
    for (int l = 0; l < 2; ++l) {
        transpose_tiles<1>(c, c.in[I_WIN] + (size_t)l * 1024 * INC, 1024, INC, (bf16_t*)((char*)wl + WL_WIN) + (size_t)l * ZP * 1024, 0, tb);
        transpose_tiles<0>(c, c.in[I_WOUT] + (size_t)l * 1024 * 1024, 1024, 1024, (bf16_t*)((char*)wl + WL_WOUT) + (size_t)l * 1024 * 1024, 0, tb);
        u32x4* pad = (u32x4*)((bf16_t*)((char*)wl + WL_WIN) + (size_t)l * ZP * 1024 + (size_t)INC * 1024);
        for (int i = c.gw * 64 + c.lane; i < (ZP - INC) * 1024 / 8; i += c.ngw * 64) pad[i] = (u32x4){0u, 0u, 0u, 0u};
    }
    transpose_tiles<2>(c, c.in[I_F1], 1024, FF, (bf16_t*)((char*)wl + WL_F13), 0, tb);
    transpose_tiles<2>(c, c.in[I_F3], 1024, FF, (bf16_t*)((char*)wl + WL_F13), 128, tb);
    transpose_tiles<0>(c, c.in[I_F2], FF, 1024, (bf16_t*)((char*)wl + WL_F2), 0, tb);
    if (blockIdx.x == 0) for (int i = c.tid; i < 2 * 64 * 16; i += NTHREADS) { const int p = i & 15, pos = (i >> 4) & 63, ax = i >> 10;
        const float ang = (float)pos * powf(10000.f, -2.f * (float)p / 32.f); float* tp = (float*)(c.ws + CTL_ROPE) + (ax * 64 + pos) * 32; tp[p] = cosf(ang); tp[16 + p] = sinf(ang); }
    if (blockIdx.x == 0 && c.tid < 32) ((float*)(c.ws + CTL_ROPE))[128 * 32 + c.tid] = c.tid < 16 ? 1.f : 0.f;
    __syncthreads();
    {
        float* sc = c.lds;
        float* part = c.lds + 5 * 1024;
        for (int i = c.tid; i < 5 * 1024; i += NTHREADS) { const int r = i >> 10, k = i & 1023; const float v = r < 4 ? c.in[I_C][r * 1024 + k] : c.in[I_CCTX][k]; sc[i] = silu_f(v); }
        __syncthreads();
        for (int item = blockIdx.x; item < 2 * 96; item += gridDim.x) {
            const int l = item / 96, j = (item % 96) * 64 + c.lane;
            const float* w = c.in[I_MODW] + (size_t)l * 1024 * 6144 + j;
            float a0 = 0.f, a1 = 0.f, a2 = 0.f, a3 = 0.f, a4 = 0.f;
            const int kb = c.wave * 128;
#pragma unroll 4
            for (int k = 0; k < 128; ++k) { const float wv = w[(size_t)(kb + k) * 6144]; a0 += sc[kb + k] * wv; a1 += sc[1024 + kb + k] * wv; a2 += sc[2048 + kb + k] * wv; a3 += sc[3072 + kb + k] * wv; a4 += sc[4096 + kb + k] * wv; }
            float* p = part + c.wave * 320 + c.lane; p[0] = a0; p[64] = a1; p[128] = a2; p[192] = a3; p[256] = a4;
            __syncthreads();
            if (c.tid < 320) { float s = 0.f;
#pragma unroll
                for (int w8 = 0; w8 < 8; ++w8) s += part[w8 * 320 + c.tid];
                const int r = c.tid >> 6, jj = (item % 96) * 64 + (c.tid & 63);
                ((float*)(c.ws + CTL_MODV))[(size_t)(l * 5 + r) * 6144 + jj] = s + c.in[I_MODB][l * 6144 + jj]; }
            __syncthreads();
        }
    }
}

DEVI void phase_conv_m13(const Ctx& c, int wv = -1, int nwv = 0) {
    int tb = 0;
    for (int e = 0; e < NE; ++e) {
        bf16_t* dst = (bf16_t*)(c.ws + WS_M13) + (size_t)e * 7168 * 1024;
        transpose_tiles<2>(c, c.in[I_M1] + (size_t)e * 1024 * MFF, 1024, MFF, dst, 0, tb, wv, nwv);
        transpose_tiles<2>(c, c.in[I_M3] + (size_t)e * 1024 * MFF, 1024, MFF, dst, 128, tb, wv, nwv);
    }
}
DEVI void phase_conv_m2(const Ctx& c, int wv = -1, int nwv = 0, int e0 = 0, int e1 = NE) {
    int tb = 0;
    for (int e = e0; e < e1; ++e)
        transpose_tiles<0>(c, c.in[I_M2] + (size_t)e * MFF * 1024, MFF, 1024, (bf16_t*)c.out + (size_t)e * 1024 * MFF, 0, tb, wv, nwv);
}

template <bool ROUTER>
DEVI void phase_norm(const Ctx& c, int layer, int which0, const float* gain, int nrows, const float* src_lat, const float* src_ctx, const float* addp = nullptr, int rpw = 8) {
    bf16_t* H = (bf16_t*)(c.ws + (ROUTER ? WS_MXB : WS_H));
#define NORM_ROW(rr) ((rr) < NLAT ? src_lat + (size_t)(rr) * 1024 : src_ctx + (size_t)((rr) - NLAT) * 1024)
    int* sel = (int*)c.lds;
    const int nvb = nrows / 64;
    int vb = blockIdx.x, i = 0;
    int r = ROUTER ? vb * 64 + c.wave * rpw : c.wave * (int)gridDim.x + (int)blockIdx.x;
    bool valid = ROUTER ? (vb < nvb && c.wave * rpw < 64) : (r < nrows);
    f32x4 v[4];
    if (valid) { const f32x4* xr = (const f32x4*)NORM_ROW(r) + c.lane;
#pragma unroll
        for (int j = 0; j < 4; ++j) v[j] = xr[64 * j]; }
    while (valid) {
        int rn, vbn = vb, in_ = i + 1; bool validn;
        if (ROUTER) { if (in_ == rpw) { in_ = 0; vbn = vb + gridDim.x; } rn = vbn * 64 + c.wave * rpw + in_; validn = vbn < nvb; }
        else { rn = r + c.ngw; validn = rn < nrows; }
        f32x4 vn[4];
        if (validn) { const f32x4* xr = (const f32x4*)NORM_ROW(rn) + c.lane;
#pragma unroll
            for (int j = 0; j < 4; ++j) vn[j] = xr[64 * j]; }
        if (addp && r >= NLAT) { const f32x4* pr = (const f32x4*)(addp + (size_t)(r - NLAT) * 1024) + c.lane;
#pragma unroll
            for (int j = 0; j < 4; ++j) v[j] = v[j] + (pr[64 * j] + pr[64 * j + 262144] + pr[64 * j + 524288]); }
        float ss = 0.f;
#pragma unroll
        for (int j = 0; j < 4; ++j) ss += (v[j].x * v[j].x + v[j].y * v[j].y) + (v[j].z * v[j].z + v[j].w * v[j].w);
        const float rstd = rsqrtf(wave_sum(ss) * (1.f / 1024.f) + EPS);
        const f32x4* g4 = (const f32x4*)gain + c.lane; const f32x4* sh4 = (const f32x4*)modv(c, layer, r, which0) + c.lane; const f32x4* sc4 = (const f32x4*)modv(c, layer, r, which0 + 1) + c.lane;
        u32x2* o8 = (u32x2*)(H + (size_t)r * 1024) + c.lane;
#pragma unroll
        for (int j = 0; j < 4; ++j) { const f32x4 g = g4[64 * j], sh = sh4[64 * j], sc = sc4[64 * j];
            v[j] = v[j] * rstd * g * (1.f + sc) + sh;
            u32x2 o; o.x = pk2(v[j].x, v[j].y); o.y = pk2(v[j].z, v[j].w); o8[64 * j] = o; }
        if (ROUTER) {
            float lg[8];
#pragma unroll
            for (int e = 0; e < 8; ++e) lg[e] = 0.f;
            const float* rw = c.in[I_RW];
#pragma unroll
            for (int j = 0; j < 4; ++j)
#pragma unroll
                for (int q = 0; q < 4; ++q) { const int col = 4 * c.lane + 256 * j + q; const f32x4 w0 = *(const f32x4*)(rw + col * 8), w1 = *(const f32x4*)(rw + col * 8 + 4); const float hv = v[j][q];
                    lg[0] += hv * w0.x; lg[1] += hv * w0.y; lg[2] += hv * w0.z; lg[3] += hv * w0.w; lg[4] += hv * w1.x; lg[5] += hv * w1.y; lg[6] += hv * w1.z; lg[7] += hv * w1.w; }
#pragma unroll
            for (int e = 0; e < 8; ++e) lg[e] = wave_sum(lg[e]) + c.in[I_RB][e];
            int e1 = 0; float l1 = lg[0];
#pragma unroll
            for (int e = 1; e < 8; ++e) if (lg[e] > l1) { l1 = lg[e]; e1 = e; }
            int e2 = -1; float l2 = -3.0e38f;
#pragma unroll
            for (int e = 0; e < 8; ++e) if (e != e1 && lg[e] > l2) { l2 = lg[e]; e2 = e; }
            const float g2 = 1.f / (1.f + expf(l1 - l2)), g1 = 1.f - g2;
            if (c.lane == 0) { int* te = (int*)(c.ws + CTL_TOPE) + r * 2; te[0] = e1; te[1] = e2; float* tg = (float*)(c.ws + CTL_TOPG) + r * 2; tg[0] = g1; tg[1] = g2;
                sel[(c.wave * rpw + i) * 2] = e1; sel[(c.wave * rpw + i) * 2 + 1] = e2; }
            if (rpw == 8 && i == 7) {
                __syncthreads();
                if (c.tid < 8) { int n = 0; for (int q = 0; q < 128; ++q) n += (sel[q] == c.tid) ? 1 : 0; ((int*)(c.ws + CTL_CNT))[vb * 8 + c.tid] = n; }
                __syncthreads();
            }
        }
#pragma unroll
        for (int j = 0; j < 4; ++j) v[j] = vn[j];
        r = rn; vb = vbn; i = in_; valid = validn;
    }
}

DEVI void norm_router_rows16(const Ctx& c, const float* gain, const float* src, const f32x4* rwl, int* sel) {
    bf16_t* H = (bf16_t*)(c.ws + WS_MXB);
    const int r0 = blockIdx.x * 64 + c.wave * 16;
    const f32x4* g4 = (const f32x4*)gain + c.lane; const f32x4* sh4 = (const f32x4*)modv(c, 1, r0, 3) + c.lane; const f32x4* sc4 = (const f32x4*)modv(c, 1, r0, 4) + c.lane;
    auto ld = [&](f32x4 (&v)[4], const int i) __attribute__((always_inline)) { const f32x4* xr = (const f32x4*)(src + (size_t)(r0 + i) * 1024) + c.lane;
#pragma unroll
        for (int j = 0; j < 4; ++j) v[j] = xr[64 * j]; };
    auto row = [&](f32x4 (&v)[4], const int i) __attribute__((always_inline)) {
        const int r = r0 + i; float ss = 0.f;
#pragma unroll
        for (int j = 0; j < 4; ++j) ss += (v[j].x * v[j].x + v[j].y * v[j].y) + (v[j].z * v[j].z + v[j].w * v[j].w);
        const float rstd = rsqrtf(wave_sum(ss) * (1.f / 1024.f) + EPS);
        u32x2* o8 = (u32x2*)(H + (size_t)r * 1024) + c.lane;
#pragma unroll
        for (int j = 0; j < 4; ++j) { const f32x4 g = g4[64 * j], sh = sh4[64 * j], sc = sc4[64 * j];
            v[j] = v[j] * rstd * g * (1.f + sc) + sh;
            u32x2 o; o.x = pk2(v[j].x, v[j].y); o.y = pk2(v[j].z, v[j].w); o8[64 * j] = o; }
        float lg[8];
#pragma unroll
        for (int e = 0; e < 8; ++e) lg[e] = 0.f;
#pragma unroll
        for (int j = 0; j < 4; ++j)
#pragma unroll
            for (int q = 0; q < 4; ++q) { const f32x4 w0 = rwl[((4 * j + q) * 2) * 64 + c.lane], w1 = rwl[((4 * j + q) * 2 + 1) * 64 + c.lane]; const float hv = v[j][q];
                lg[0] += hv * w0.x; lg[1] += hv * w0.y; lg[2] += hv * w0.z; lg[3] += hv * w0.w; lg[4] += hv * w1.x; lg[5] += hv * w1.y; lg[6] += hv * w1.z; lg[7] += hv * w1.w; }
#pragma unroll
        for (int e = 0; e < 8; ++e) lg[e] = wave_sum(lg[e]) + c.in[I_RB][e];
        int e1 = 0; float l1 = lg[0];
#pragma unroll
        for (int e = 1; e < 8; ++e) if (lg[e] > l1) { l1 = lg[e]; e1 = e; }
        int e2 = -1; float l2 = -3.0e38f;
#pragma unroll
        for (int e = 0; e < 8; ++e) if (e != e1 && lg[e] > l2) { l2 = lg[e]; e2 = e; }
        const float g2 = 1.f / (1.f + expf(l1 - l2)), g1 = 1.f - g2;
        if (c.lane == 0) { int* te = (int*)(c.ws + CTL_TOPE) + r * 2; te[0] = e1; te[1] = e2; float* tg = (float*)(c.ws + CTL_TOPG) + r * 2; tg[0] = g1; tg[1] = g2;
            sel[(c.wave * 16 + i) * 2] = e1; sel[(c.wave * 16 + i) * 2 + 1] = e2; }
    };
    f32x4 A[4], B[4], C[4];
    ld(A, 0); ld(B, 1); ld(C, 2);
    for (int i = 0; i < 15; i += 3) { row(A, i); ld(A, i + 3); row(B, i + 1); if (i + 4 < 16) ld(B, i + 4); row(C, i + 2); if (i + 5 < 16) ld(C, i + 5); }
    row(A, 15);
}

#undef NORM_ROW
template <bool DUAL, class BSel, class Epi>
DEVI void gemm_naive(const Ctx& c, const bf16_t* A, int lda, int K, int ntm, int ntn, const BSel& bsel, const Epi& epi) {
    float* As = c.lds; float* Bs = c.lds + 32 * 132; float* Bs2 = c.lds + 2 * 32 * 132;
    const int ty = c.tid >> 4, tx = c.tid & 15, lr = c.tid >> 2, lk = (c.tid & 3) * 8;
    for (int tile = blockIdx.x; tile < ntm * ntn; tile += gridDim.x) {
        const int tm = tile / ntn, tn = tile % ntn;
        const bf16_t* B0 = bsel(tm, tn, 0); if (!B0) continue;
        const bf16_t* B1 = DUAL ? bsel(tm, tn, 1) : B0;
        float acc[4][8], acc2[4][8];
#pragma unroll
        for (int i = 0; i < 4; ++i)
#pragma unroll
            for (int j = 0; j < 8; ++j) { acc[i][j] = 0.f; acc2[i][j] = 0.f; }
        const bf16_t* ap = A + (size_t)(tm * 128 + lr) * lda + lk; const bf16_t* bp = B0 + (size_t)lr * K + lk; const bf16_t* bp2 = B1 + (size_t)lr * K + lk;
        for (int k0 = 0; k0 < K; k0 += 32) {
            const u32x4 av = *(const u32x4*)(ap + k0), bv = *(const u32x4*)(bp + k0); u32x4 bv2 = bv; if (DUAL) bv2 = *(const u32x4*)(bp2 + k0);
            __syncthreads();
#pragma unroll
            for (int q = 0; q < 4; ++q) { As[(lk + 2 * q) * 132 + lr] = bflo(av[q]); As[(lk + 2 * q + 1) * 132 + lr] = bfhi(av[q]);
                Bs[(lk + 2 * q) * 132 + lr] = bflo(bv[q]); Bs[(lk + 2 * q + 1) * 132 + lr] = bfhi(bv[q]);
                if (DUAL) { Bs2[(lk + 2 * q) * 132 + lr] = bflo(bv2[q]); Bs2[(lk + 2 * q + 1) * 132 + lr] = bfhi(bv2[q]); } }
            __syncthreads();
#pragma unroll 4
            for (int kk = 0; kk < 32; ++kk) {
                const f32x4 a = *(const f32x4*)(As + kk * 132 + ty * 4); const f32x4 b0 = *(const f32x4*)(Bs + kk * 132 + tx * 8), b1 = *(const f32x4*)(Bs + kk * 132 + tx * 8 + 4);
#pragma unroll
                for (int i = 0; i < 4; ++i) { acc[i][0] += a[i] * b0.x; acc[i][1] += a[i] * b0.y; acc[i][2] += a[i] * b0.z; acc[i][3] += a[i] * b0.w; acc[i][4] += a[i] * b1.x; acc[i][5] += a[i] * b1.y; acc[i][6] += a[i] * b1.z; acc[i][7] += a[i] * b1.w; }
                if (DUAL) { const f32x4 c0 = *(const f32x4*)(Bs2 + kk * 132 + tx * 8), c1 = *(const f32x4*)(Bs2 + kk * 132 + tx * 8 + 4);
#pragma unroll
                    for (int i = 0; i < 4; ++i) { acc2[i][0] += a[i] * c0.x; acc2[i][1] += a[i] * c0.y; acc2[i][2] += a[i] * c0.z; acc2[i][3] += a[i] * c0.w; acc2[i][4] += a[i] * c1.x; acc2[i][5] += a[i] * c1.y; acc2[i][6] += a[i] * c1.z; acc2[i][7] += a[i] * c1.w; } }
            }
        }
#pragma unroll
        for (int i = 0; i < 4; ++i) epi(tm * 128 + ty * 4 + i, tn * 128 + tx * 8, acc[i], acc2[i]);
    }
}
struct BSelPlain { const bf16_t* Bt; int K; DEVI const bf16_t* operator()(int, int tn, int) const { return Bt + (size_t)tn * 128 * K; } };
struct BSelDual { const bf16_t* Bt; int K; DEVI const bf16_t* operator()(int, int tn, int which) const { return Bt + (size_t)(tn * 256 + which * 128) * K; } };
struct BSelMoe { const bf16_t* Bt; int K; int rows_per_expert; bool dual; const int* seg;
    DEVI const bf16_t* operator()(int tm, int tn, int which) const {
        const int s = tm * 128; if (s >= seg[8]) return nullptr; int e = 0;
#pragma unroll
        for (int q = 1; q < 8; ++q) e += (s >= seg[q]) ? 1 : 0;
        return Bt + (size_t)e * rows_per_expert * K + (size_t)(dual ? tn * 256 + which * 128 : tn * 128) * K; } };
struct EpiStoreBf16 { bf16_t* O; int ldc; DEVI void operator()(int r, int c0, const float* a, const float*) const {
    u32x4 o; o.x = pk2(a[0], a[1]); o.y = pk2(a[2], a[3]); o.z = pk2(a[4], a[5]); o.w = pk2(a[6], a[7]); *(u32x4*)(O + (size_t)r * ldc + c0) = o; } };
struct EpiSwiglu { bf16_t* O; int ldc; DEVI void operator()(int r, int c0, const float* a, const float* b) const {
    float h[8];
#pragma unroll
    for (int j = 0; j < 8; ++j) h[j] = silu_f(a[j]) * b[j];
    u32x4 o; o.x = pk2(h[0], h[1]); o.y = pk2(h[2], h[3]); o.z = pk2(h[4], h[5]); o.w = pk2(h[6], h[7]); *(u32x4*)(O + (size_t)r * ldc + c0) = o; } };
struct EpiResid { float* XB; const float* mv; int which;
    DEVI void operator()(int r, int c0, const float* a, const float*) const {
        const float* g = mv + (size_t)(row_mod(r) * 6 + which) * 1024 + c0; float* x = XB + (size_t)r * 1024 + c0;
        f32x4 x0 = *(f32x4*)x, x1 = *(f32x4*)(x + 4); const f32x4 g0 = *(const f32x4*)g, g1 = *(const f32x4*)(g + 4);
        x0.x += g0.x * a[0]; x0.y += g0.y * a[1]; x0.z += g0.z * a[2]; x0.w += g0.w * a[3]; x1.x += g1.x * a[4]; x1.y += g1.y * a[5]; x1.z += g1.z * a[6]; x1.w += g1.w * a[7];
        *(f32x4*)x = x0; *(f32x4*)(x + 4) = x1; } };

namespace pg8 {
#define PG8_LAS __attribute__((address_space(3)))

typedef short bf16x8 __attribute__((ext_vector_type(8)));


constexpr int MOE_FF = 3584;
constexpr int BM = 256, BK = 64, HALF = 128, HTB = HALF * BK * 2  , STAGE_BYTES = 8 * HTB, NXCD = 8, WGM = 8;

__host__ __device__ __forceinline__ int lds_byte(int r, int c) { const int st = (r >> 4) * 2 + (c >> 5), rr = r & 15, cc = c & 31, ob = rr * 64 + cc * 2; return st * 1024 + (ob ^ (((ob >> 9) & 1) << 5)); }
__host__ __device__ __forceinline__ void stage_rc(int b, int& R, int& C) { const int st = b / 1024, sb = b % 1024, swz = sb ^ (((sb >> 9) & 1) << 5); R = (st >> 1) * 16 + swz / 64; C = (st & 1) * 32 + (swz % 64) / 2; }
__host__ __device__ __forceinline__ int perm32(int rho) { const int n = rho >> 4, i = rho & 15; return 8 * (i >> 2) + 4 * n + (i & 3); }

struct Unit { int pm, pn, ko, nt; };
struct Gemm { const bf16_t* A; const bf16_t* Bt; int M, N, K; const unsigned* rt = nullptr; };

struct StaticOrder {
    int nM, nN, nwg, G, c;
    __host__ __device__ void init(int M, int N, int G_, int c_) { nM = M / BM; nN = N / BM; nwg = nM * nN; G = G_; c = c_; }
    __host__ __device__ bool next(int i, Unit& u) const {
        const long L = (long)i * G + c; if (L >= nwg) return false;
        int wgid = (int)L; { const int q = nwg / NXCD, r = nwg % NXCD, xcd = wgid % NXCD, off = wgid / NXCD; wgid = (xcd < r ? xcd * (q + 1) : r * (q + 1) + (xcd - r) * q) + off; }
        const int nig = WGM * nN, gid = wgid / nig, fm = gid * WGM, gsz = (nM - fm) < WGM ? (nM - fm) : WGM;
        u.pm = fm + ((wgid % nig) % gsz); u.pn = (wgid % nig) / gsz; u.ko = 0; u.nt = 0; return true;
    }
    __device__ __forceinline__ void a_ready(const Unit&) const {}
    __device__ __forceinline__ void done(const Unit&) const {}
};


__device__ __forceinline__ unsigned cvt_pk_bf16(float lo, float hi) { unsigned r; asm volatile("v_cvt_pk_bf16_f32 %0, %1, %2" : "=v"(r) : "v"(lo), "v"(hi)); return r; }
__device__ __forceinline__ float silu1(float x) { return x * __builtin_amdgcn_rcpf(1.f + __expf(-x)); }
struct EpiStore {
    static constexpr bool PERM = true, AFTER_DRAIN = false;
    bf16_t* O; int ldc; int nN; long d2;
    __device__ __forceinline__ void operator()(const f32x4 (&acc)[2][2][4][2], const Unit& u, int wr, int wc, int fr, int fq) const {
        const int row0 = u.pm * BM + wr * 64 + fr, pnl = nN ? u.pn % nN : u.pn, col0 = pnl * BM + wc * 32 + 8 * fq;
        bf16_t* Ob = O + (u.ko ? d2 + (long)(u.ko / 896 - 1) * (2048l * 1024) : 0l);
#pragma unroll
        for (int ai = 0; ai < 2; ++ai)
#pragma unroll
            for (int m = 0; m < 4; ++m) { bf16_t* rowp = Ob + (size_t)(row0 + ai * HALF + m * 16) * ldc + col0;
#pragma unroll
                for (int bj = 0; bj < 2; ++bj) { const f32x4 v0 = acc[ai][bj][m][0], v1 = acc[ai][bj][m][1];
                    u32x4 w; w.x = cvt_pk_bf16(v0[0], v0[1]); w.y = cvt_pk_bf16(v0[2], v0[3]); w.z = cvt_pk_bf16(v1[0], v1[1]); w.w = cvt_pk_bf16(v1[2], v1[3]);
                    *(u32x4*)(rowp + bj * HALF) = w; } }
    }
};
struct EpiSwi {
    static constexpr bool PERM = true, AFTER_DRAIN = false;
    bf16_t* O; int ldc; int nN;
    __device__ __forceinline__ void operator()(const f32x4 (&acc)[2][2][4][2], const Unit& u, int wr, int wc, int fr, int fq) const {
        const int row0 = u.pm * BM + wr * 64 + fr, pnl = nN ? u.pn % nN : u.pn, col0 = pnl * HALF + wc * 32 + 8 * fq;
#pragma unroll
        for (int ai = 0; ai < 2; ++ai)
#pragma unroll
            for (int m = 0; m < 4; ++m) { bf16_t* rowp = O + (size_t)(row0 + ai * HALF + m * 16) * ldc + col0;
                const f32x4 a0 = acc[ai][0][m][0], a1 = acc[ai][0][m][1], b0 = acc[ai][1][m][0], b1 = acc[ai][1][m][1];
                u32x4 w; w.x = cvt_pk_bf16(silu1(a0[0]) * b0[0], silu1(a0[1]) * b0[1]); w.y = cvt_pk_bf16(silu1(a0[2]) * b0[2], silu1(a0[3]) * b0[3]);
                w.z = cvt_pk_bf16(silu1(a1[0]) * b1[0], silu1(a1[1]) * b1[1]); w.w = cvt_pk_bf16(silu1(a1[2]) * b1[2], silu1(a1[3]) * b1[3]);
                *(u32x4*)rowp = w; }
    }
};
struct EpiRes {
    static constexpr bool PERM = false, AFTER_DRAIN = false;
    float* XB; const float* mv; int which; const float* base_lat; const float* base_ctx;
    float* PB;
    __device__ __forceinline__ void operator()(const f32x4 (&acc)[2][2][4][2], const Unit& u, int wr, int wc, int fr, int fq) const {
        const int row0 = u.pm * BM + wr * 64 + fr, col0 = u.pn * BM + wc * 32 + 4 * fq;
        float* PBp = PB + (size_t)((u.ko >= 1536 ? 1 : 0) + (u.ko >= 2176 ? 1 : 0)) * (1024 * 1024);
#pragma unroll
        for (int ai = 0; ai < 2; ++ai)
#pragma unroll
            for (int m = 0; m < 4; ++m) { const int r = row0 + ai * HALF + m * 16; const float* g = mv + (size_t)((r < 16384 ? (r >> 12) : 4) * 6 + which) * 1024 + col0; float* x = XB + (size_t)r * 1024 + col0;
                const float* bs = (r < 16384 ? base_lat + (size_t)r * 1024 : base_ctx + (size_t)(r - 16384) * 1024) + col0;
#pragma unroll
                for (int bj = 0; bj < 2; ++bj)
#pragma unroll
                    for (int n = 0; n < 2; ++n) { const int o = bj * HALF + n * 16; const f32x4 gv = *(const f32x4*)(g + o);
                        if (u.ko) *(f32x4*)(PBp + (size_t)(r - 16384) * 1024 + col0 + o) = gv * acc[ai][bj][m][n];
                        else { f32x4 xv = *(const f32x4*)(bs + o); xv = xv + gv * acc[ai][bj][m][n]; *(f32x4*)(x + o) = xv; } } }
    }
};
struct FfnDownOrder {
    StaticOrder so;
    __device__ __forceinline__ void init(int G_, int c_) { so.init(16384, 1024, G_, c_); }
    __device__ __forceinline__ bool next(int i, Unit& u) const {
        if (so.next(i, u)) return true;
        const long L = (long)i * so.G + so.c - so.nwg; if (L < 0 || L >= 64) return false;
        const int l = (int)L, q = (l & 7) + 8 * (l >> 5), p = q & 3;
        u.pm = 64 + (q >> 2); u.pn = (l >> 3) & 3; u.ko = (p * 12 - (p == 3 ? 2 : 0)) * 64; u.nt = p < 2 ? 12 : 10; return true; }
    __device__ __forceinline__ void a_ready(const Unit&) const {}
    __device__ __forceinline__ void done(const Unit&) const {}
};
struct MoeOrder {
    StaticOrder so; int nN; int sg[9];
    __device__ __forceinline__ void init(const int* seg, int nN_, int G_, int c_) {
#pragma unroll
        for (int i = 0; i < 9; ++i) sg[i] = seg[i];
        nN = nN_; so.nM = sg[8] >> 8; so.nN = nN_; so.nwg = so.nM * nN_; so.G = G_; so.c = c_; }
    __device__ __forceinline__ bool next(int i, Unit& u) const {
        if (!so.next(i, u)) return false;
        const int s = u.pm * 256; int e = 0;
#pragma unroll
        for (int q = 1; q < 8; ++q) e += (s >= sg[q]) ? 1 : 0;
        u.pn += e * nN; return true; }
    __device__ __forceinline__ void a_ready(const Unit&) const {}
    __device__ __forceinline__ void done(const Unit&) const {}
};
struct TableOrder {
    const int* tab; int n, G, vc;
    __device__ __forceinline__ void init(const int* tab_, int G_, int c_) { tab = tab_ + 4; n = tab_[0]; G = G_; vc = (G_ % 8 == 0) ? (c_ % 8) * (G_ / 8) + c_ / 8 : c_; }
    __device__ __forceinline__ bool next(int i, Unit& u) const { const int L = i * G + vc; if (L >= n) return false; const int* t = tab + 4 * L; u.pm = t[0]; u.pn = t[1]; u.ko = t[2]; u.nt = t[3]; return true; }
    __device__ __forceinline__ void a_ready(const Unit&) const {}
    __device__ __forceinline__ void done(const Unit&) const {}
};
template <class Epi, class Sched, bool ALIGN_EPI = false, bool SP2 = false, bool GATHER = false>
__device__ __forceinline__ void gemm_phase(PG8_LAS unsigned char* lds, const Gemm g, const Sched& S, const Epi& E) {
    static_assert(!GATHER || SP2, "GATHER is written for the SP2 loop");
    const int tid = threadIdx.x, wid = __builtin_amdgcn_readfirstlane(tid >> 6), lane = tid & 63, wr = wid >> 2, wc = wid & 3, fr = lane & 15, fq = lane >> 4;
    const int K = g.K; int nt = K / BK;
    unsigned voffA[2], voffB[2];
#pragma unroll
    for (int i = 0; i < 2; ++i) { int R, C; stage_rc(tid * 16 + i * 8192, R, C); const int Rb = Epi::PERM ? ((R & ~31) + perm32(R & 31)) : R;
        voffA[i] = GATHER ? (unsigned)C * 2u : (unsigned)(R * K + C) * 2u; voffB[i] = (unsigned)(Rb * K + C) * 2u; }
    const int R0 = (wid >> 1) * 16 + (lane >> 2);
    PG8_LAS unsigned* qt = (PG8_LAS unsigned*)(lds + STAGE_BYTES) + tid;
    const size_t kstep = (size_t)(BK * 2);
    const size_t hstep = (size_t)HALF * K * 2;
    const size_t tstep = 2 * hstep;
    const unsigned ldsw = (unsigned)wid * 1024u;
    const int aoff = lds_byte(wr * 64 + fr, fq * 8), boff = lds_byte(wc * 32 + fr, fq * 8);
#define PG8_SA(b, h) (((b) * 2 + (h)) * HTB)
#define PG8_SB(b, h) ((4 + (b) * 2 + (h)) * HTB)
#define PG8_STAGE(bufoff, gbase, voff) do { _Pragma("unroll") for (int _i = 0; _i < 2; ++_i) \
        __builtin_amdgcn_global_load_lds((const unsigned*)((const char*)(gbase) + (voff)[_i]), (PG8_LAS unsigned*)(lds + (bufoff) + ldsw + _i * 8192), 16, 0, 0); } while (0)
#define PG8_QLD(h, usen) (GATHER ? qt[((((usen) ? ui + 1 : ui) & 1) * 2 + (h)) * 512] : 0u)
#define PG8_STAGE_G(bufoff, kptr, q_) do { _Pragma("unroll") for (int _i = 0; _i < 2; ++_i) \
        __builtin_amdgcn_global_load_lds((const unsigned*)((const char*)(kptr) + (((((q_) >> (16 * _i)) & 0xffffu) << 11) | voffA[0])), (PG8_LAS unsigned*)(lds + (bufoff) + ldsw + _i * 8192), 16, 0, 0); } while (0)
#define PG8_LDA(dst, b, h) do { _Pragma("unroll") for (int m = 0; m < 4; ++m) _Pragma("unroll") for (int k = 0; k < 2; ++k) dst[m][k] = *(const PG8_LAS bf16x8*)(lds + PG8_SA(b, h) + aoff + m * 2048 + k * 1024); } while (0)
#define PG8_LDB(dst, b, h) do { _Pragma("unroll") for (int n = 0; n < 2; ++n) _Pragma("unroll") for (int k = 0; k < 2; ++k) dst[n][k] = *(const PG8_LAS bf16x8*)(lds + PG8_SB(b, h) + boff + n * 2048 + k * 1024); } while (0)
#define PG8_MMA(ai, bj, At, Bt) do { __builtin_amdgcn_s_setprio(1); _Pragma("unroll") for (int m = 0; m < 4; ++m) _Pragma("unroll") for (int n = 0; n < 2; ++n) _Pragma("unroll") for (int k = 0; k < 2; ++k) \
        acc[ai][bj][m][n] = __builtin_amdgcn_mfma_f32_16x16x32_bf16(Bt[n][k], At[m][k], acc[ai][bj][m][n], 0, 0, 0); __builtin_amdgcn_s_setprio(0); } while (0)
#define PG8_WAIT_V(n) asm volatile("s_waitcnt vmcnt(" #n ")" ::: "memory")
#define PG8_WAIT_L(n) asm volatile("s_waitcnt lgkmcnt(" #n ")" ::: "memory")
#define PG8_BAR __builtin_amdgcn_s_barrier()
#define PG8_SCHED __builtin_amdgcn_sched_barrier(0)
    Unit cur, nxt; int ui = 0;
    if (!S.next(0, cur)) return;
    if (cur.nt) nt = cur.nt;
    f32x4 acc[2][2][4][2];
#pragma unroll
    for (int a = 0; a < 2; ++a)
#pragma unroll
        for (int b = 0; b < 2; ++b)
#pragma unroll
            for (int m = 0; m < 4; ++m)
#pragma unroll
                for (int n = 0; n < 2; ++n) acc[a][b][m][n] = (f32x4){0.f, 0.f, 0.f, 0.f};
    bf16x8 At[4][2], B0[2][2], B1[2][2];
    const char* cA = (const char*)g.A + (GATHER ? (size_t)0 : (size_t)cur.pm * tstep) + (size_t)cur.ko * 2; const char* cB = (const char*)g.Bt + (size_t)cur.pn * tstep + (size_t)cur.ko * 2;
    S.a_ready(cur);
    if constexpr (GATHER) { qt[0] = g.rt[cur.pm * HALF + R0]; qt[512] = g.rt[cur.pm * HALF + 64 + R0]; }
    if constexpr (SP2) {
        PG8_STAGE(PG8_SB(0, 0), cB, voffB); PG8_STAGE(PG8_SB(0, 1), cB + hstep, voffB);
        if constexpr (GATHER) { const unsigned q0_ = PG8_QLD(0, false), q1_ = PG8_QLD(1, false); PG8_STAGE_G(PG8_SA(0, 0), cA, q0_); PG8_STAGE_G(PG8_SA(0, 1), cA, q1_); } else { PG8_STAGE(PG8_SA(0, 0), cA, voffA); PG8_STAGE(PG8_SA(0, 1), cA + hstep, voffA); }
        if (wr == 1) PG8_BAR;
        PG8_WAIT_V(2); PG8_BAR;
        PG8_STAGE(PG8_SB(1, 0), cB + kstep, voffB); if constexpr (GATHER) { const unsigned q0_ = PG8_QLD(0, false); PG8_STAGE_G(PG8_SA(1, 0), cA + kstep, q0_); } else PG8_STAGE(PG8_SA(1, 0), cA + kstep, voffA); PG8_STAGE(PG8_SB(1, 1), cB + hstep + kstep, voffB);
        PG8_WAIT_V(6); PG8_BAR;
    } else {
        PG8_STAGE(PG8_SB(0, 0), cB, voffB); PG8_STAGE(PG8_SA(0, 0), cA, voffA); PG8_STAGE(PG8_SB(0, 1), cB + hstep, voffB); PG8_STAGE(PG8_SA(0, 1), cA + hstep, voffA);
        if (wr == 1) PG8_BAR;
        PG8_WAIT_V(4); PG8_BAR;
        PG8_STAGE(PG8_SB(1, 0), cB + kstep, voffB); PG8_STAGE(PG8_SA(1, 0), cA + kstep, voffA); PG8_STAGE(PG8_SB(1, 1), cB + hstep + kstep, voffB);
        PG8_WAIT_V(6); PG8_BAR;
    }
    for (;;) {
        const bool has_next = S.next(ui + 1, nxt);
        const char* nA = has_next ? (const char*)g.A + (GATHER ? (size_t)0 : (size_t)nxt.pm * tstep) + (size_t)nxt.ko * 2 : cA; const char* nB = has_next ? (const char*)g.Bt + (size_t)nxt.pn * tstep + (size_t)nxt.ko * 2 : cB;
        for (int t = 0; t < nt; t += 2) {
            const bool last = (t == nt - 2);
            const char* a1 = cA + (size_t)(t + 1) * kstep;
            const char* a2 = last ? nA : cA + (size_t)(t + 2) * kstep; const char* b2 = last ? nB : cB + (size_t)(t + 2) * kstep;
            const char* a3 = a2 + kstep; const char* b3 = b2 + kstep;
            if (last && has_next) S.a_ready(nxt);
            const bool usen = GATHER && last && has_next;
            unsigned nq0 = 0u, nq1 = 0u;
            if constexpr (GATHER) { if (t == 0 && has_next) { nq0 = g.rt[nxt.pm * HALF + R0]; nq1 = g.rt[nxt.pm * HALF + 64 + R0]; } }
            if constexpr (SP2) {
            const unsigned qa_ = PG8_QLD(1, false);
            PG8_LDB(B0, 0, 0); PG8_LDB(B1, 0, 1); PG8_SCHED; PG8_LDA(At, 0, 0); if constexpr (GATHER) PG8_STAGE_G(PG8_SA(1, 1), a1, qa_); else PG8_STAGE(PG8_SA(1, 1), a1 + hstep, voffA);
            PG8_WAIT_V(8); PG8_WAIT_L(0); PG8_BAR; PG8_MMA(0, 0, At, B0); PG8_MMA(0, 1, At, B1); PG8_BAR; PG8_SCHED;
            const unsigned qb_ = PG8_QLD(0, usen);
            PG8_LDA(At, 0, 1); PG8_STAGE(PG8_SB(0, 0), b2, voffB); PG8_STAGE(PG8_SB(0, 1), b2 + hstep, voffB); if constexpr (GATHER) PG8_STAGE_G(PG8_SA(0, 0), a2, qb_); else PG8_STAGE(PG8_SA(0, 0), a2, voffA);
            PG8_WAIT_V(8); PG8_WAIT_L(0); PG8_BAR; PG8_MMA(1, 0, At, B0); PG8_MMA(1, 1, At, B1); PG8_BAR; PG8_SCHED;
            const unsigned qc_ = PG8_QLD(1, usen);
            PG8_LDB(B0, 1, 0); PG8_LDB(B1, 1, 1); PG8_SCHED; PG8_LDA(At, 1, 0); if constexpr (GATHER) PG8_STAGE_G(PG8_SA(0, 1), a2, qc_); else PG8_STAGE(PG8_SA(0, 1), a2 + hstep, voffA);
            PG8_WAIT_V(8); PG8_WAIT_L(0); PG8_BAR; PG8_MMA(0, 0, At, B0); PG8_MMA(0, 1, At, B1); PG8_BAR; PG8_SCHED;
            const unsigned qd_ = PG8_QLD(0, usen);
            PG8_LDA(At, 1, 1); PG8_STAGE(PG8_SB(1, 0), b3, voffB); PG8_STAGE(PG8_SB(1, 1), b3 + hstep, voffB); if constexpr (GATHER) PG8_STAGE_G(PG8_SA(1, 0), a3, qd_); else PG8_STAGE(PG8_SA(1, 0), a3, voffA);
            if constexpr (GATHER) { if (t == 0 && has_next) { qt[(((ui + 1) & 1) * 2) * 512] = nq0; qt[(((ui + 1) & 1) * 2 + 1) * 512] = nq1; } }
            PG8_WAIT_V(8); PG8_WAIT_L(0); PG8_BAR; PG8_MMA(1, 0, At, B0); PG8_MMA(1, 1, At, B1); PG8_BAR; PG8_SCHED;
            } else {
            PG8_LDB(B0, 0, 0); PG8_SCHED; PG8_LDA(At, 0, 0); PG8_STAGE(PG8_SA(1, 1), a1 + hstep, voffA);
            PG8_WAIT_L(8); PG8_BAR; PG8_WAIT_L(0); PG8_MMA(0, 0, At, B0); PG8_BAR; PG8_SCHED;
            PG8_LDB(B1, 0, 1); PG8_STAGE(PG8_SB(0, 0), b2, voffB);
            PG8_BAR; PG8_WAIT_L(0); PG8_MMA(0, 1, At, B1); PG8_BAR;
            PG8_LDA(At, 0, 1); PG8_STAGE(PG8_SA(0, 0), a2, voffA);
            PG8_BAR; PG8_WAIT_L(0); PG8_MMA(1, 0, At, B0); PG8_BAR; PG8_SCHED;
            PG8_STAGE(PG8_SB(0, 1), b2 + hstep, voffB);
            PG8_WAIT_V(6); PG8_BAR; PG8_MMA(1, 1, At, B1); PG8_BAR;
            PG8_LDB(B0, 1, 0); PG8_SCHED; PG8_LDA(At, 1, 0); PG8_STAGE(PG8_SA(0, 1), a2 + hstep, voffA);
            PG8_WAIT_L(8); PG8_BAR; PG8_WAIT_L(0); PG8_MMA(0, 0, At, B0); PG8_BAR; PG8_SCHED;
            PG8_LDB(B1, 1, 1); PG8_STAGE(PG8_SB(1, 0), b3, voffB);
            PG8_BAR; PG8_WAIT_L(0); PG8_MMA(0, 1, At, B1); PG8_BAR;
            PG8_LDA(At, 1, 1); PG8_STAGE(PG8_SA(1, 0), a3, voffA);
            PG8_BAR; PG8_WAIT_L(0); PG8_MMA(1, 0, At, B0); PG8_BAR; PG8_SCHED;
            PG8_STAGE(PG8_SB(1, 1), b3 + hstep, voffB);
            PG8_WAIT_V(6); PG8_BAR; PG8_MMA(1, 1, At, B1); PG8_BAR;
            }
        }
        if constexpr (ALIGN_EPI) { if (wr == 0) PG8_BAR; }
        if constexpr (!Epi::AFTER_DRAIN) { E(acc, cur, wr, wc, fr, fq); S.done(cur); }
        if (!has_next) break;
#pragma unroll
        for (int a = 0; a < 2; ++a)
#pragma unroll
            for (int b = 0; b < 2; ++b)
#pragma unroll
                for (int m = 0; m < 4; ++m)
#pragma unroll
                    for (int n = 0; n < 2; ++n) acc[a][b][m][n] = (f32x4){0.f, 0.f, 0.f, 0.f};
        cur = nxt; cA = nA; cB = nB; ++ui; nt = cur.nt ? cur.nt : K / BK;
        if constexpr (ALIGN_EPI) { if (wr == 1) PG8_BAR; }
    }
    PG8_WAIT_V(0);
    if constexpr (!ALIGN_EPI) { if (wr == 0) PG8_BAR; }
    PG8_BAR;
    if constexpr (Epi::AFTER_DRAIN) { E.fused(acc, cur, wr, wc, fr, fq, lds, wid, lane); S.done(cur); }
#undef PG8_SA
#undef PG8_SB
#undef PG8_STAGE
#undef PG8_STAGE_G
#undef PG8_QLD
#undef PG8_LDA
#undef PG8_LDB
#undef PG8_MMA
#undef PG8_WAIT_V
#undef PG8_WAIT_L
#undef PG8_BAR
#undef PG8_SCHED
}
}

DEVI void row_seq(int r, int& t, int& len) { if (r < NLAT) { t = r & 4095; len = SEQ; } else { t = (r - NLAT) & 255; len = CTXL; } }

#define DPP_F(v, ctrl) __int_as_float(__builtin_amdgcn_update_dpp(0, __float_as_int(v), (ctrl), 0xF, 0xF, true))
DEVI float sum8lanes(float x) { x += DPP_F(x, 0xB1); x += DPP_F(x, 0x4E); x += DPP_F(x, 0x141); return x; }

DEVI void phase_prep(const Ctx& c, int layer, bool need_ctx_q) {
    const bf16_t* Z = (const bf16_t*)(c.ws + WS_Z);
    const int vg = c.wave * (int)gridDim.x + (int)blockIdx.x, vgb = (vg + c.ngw / 2) % c.ngw, vgc = (vg + c.ngw - c.ngw / 4) % c.ngw;
    {
        bf16_t* QN = (bf16_t*)(c.ws + WS_QN); bf16_t* KN = (bf16_t*)(c.ws + WS_KN); bf16_t* VB = (bf16_t*)(c.ws + WS_DN + DN_VB); float* bg = (float*)(c.ws + WS_DN + DN_BG);
        const float* cw = c.in[I_CONVW] + (size_t)layer * 3 * 1152;
        const int lc = c.lane < 48 ? c.lane : 47;
        float w[3][3][8];
#pragma unroll
        for (int th = 0; th < 3; ++th)
#pragma unroll
            for (int tap = 0; tap < 3; ++tap) { const float* wp = cw + tap * 1152 + th * 384 + lc * 8; *(f32x4*)w[th][tap] = *(const f32x4*)wp; *(f32x4*)(w[th][tap] + 4) = *(const f32x4*)(wp + 4); }
        const int dh = c.lane - 48; float alog = 0.f, dtb = 0.f;
        if (c.lane >= 48 && c.lane < 60) { alog = -expf(c.in[I_ALOG][layer * 12 + dh]); dtb = c.in[I_DTB][layer * 12 + dh]; }
        for (int p = vg; p < NT / 2; p += c.ngw) {
            const int ra = 2 * p; int t, len; row_seq(ra, t, len);
            const bf16_t* zr = Z + (size_t)ra * ZP + lc * 8; const bool hm = t > 0, hp = t + 1 < len - 1;
            u32x4 z0[3], z1[3], z2[3], z3[3];
#pragma unroll
            for (int th = 0; th < 3; ++th) { z1[th] = *(const u32x4*)(zr + th * 384); z2[th] = *(const u32x4*)(zr + th * 384 + ZP);
                z0[th] = hm ? *(const u32x4*)(zr + th * 384 - ZP) : (u32x4){0u, 0u, 0u, 0u}; z3[th] = hp ? *(const u32x4*)(zr + th * 384 + 2 * ZP) : (u32x4){0u, 0u, 0u, 0u}; }
            float zb[2] = {0.f, 0.f}, za[2] = {0.f, 0.f};
            if (c.lane >= 48 && c.lane < 60) { zb[0] = bf2f(Z[(size_t)ra * ZP + ZC_BETA + dh]); za[0] = bf2f(Z[(size_t)ra * ZP + ZC_ALPHA + dh]); zb[1] = bf2f(Z[(size_t)(ra + 1) * ZP + ZC_BETA + dh]); za[1] = bf2f(Z[(size_t)(ra + 1) * ZP + ZC_ALPHA + dh]); }
#pragma unroll
            for (int q = 0; q < 2; ++q) { const int r = ra + q;
                u32x4 outw[3];
#pragma unroll
                for (int th = 0; th < 3; ++th) {
                    float a[8], b[8], d[8], v[8]; unpack8(q == 0 ? z0[th] : z1[th], a); unpack8(q == 0 ? z1[th] : z2[th], b); unpack8(q == 0 ? z2[th] : z3[th], d);
                    float ss = 0.f;
#pragma unroll
                    for (int e = 0; e < 8; ++e) { v[e] = silu_f(a[e] * w[th][0][e] + b[e] * w[th][1][e] + d[e] * w[th][2][e]); ss += v[e] * v[e]; }
                    if (th < 2) { ss = sum8lanes(ss); const float sc = rsqrtf(ss + EPS) * (th == 0 ? 0.125f : 1.f);
#pragma unroll
                        for (int e = 0; e < 8; ++e) v[e] *= sc; }
                    outw[th] = pack8(v);
                }
                if (c.lane < 48) { *(u32x4*)(QN + (size_t)r * 384 + c.lane * 8) = outw[0]; *(u32x4*)(KN + (size_t)r * 384 + c.lane * 8) = outw[1]; *(u32x4*)(VB + (size_t)r * 384 + c.lane * 8) = outw[2]; }
                else if (c.lane < 60) { bg[((size_t)r * 12 + dh) * 2] = __builtin_amdgcn_rcpf(1.f + __expf(-zb[q])); bg[((size_t)r * 12 + dh) * 2 + 1] = alog * softplus_f(za[q] + dtb); } }
        }
    }
    {
        bf16_t* Qa = (bf16_t*)(c.ws + WS_QA); bf16_t* Qc = (bf16_t*)(c.ws + WS_QC); bf16_t* Ka = (bf16_t*)(c.ws + WS_KA); bf16_t* Va = (bf16_t*)(c.ws + WS_VA);
        const float* rope = (const float*)(c.ws + CTL_ROPE);
        const bool isq = c.lane < 48; const int j = c.lane & 7, axis = j >> 2, half = (j >> 1) & 1, p0 = 8 * (j & 1);
        const int col = isq ? ZC_AQ + c.lane * 8 : ZC_AK + (c.lane - 48) * 8;
        float gn[8];
        { const float* gp = (isq ? c.in[I_QG] : c.in[I_KG]) + layer * 64 + 8 * j; *(f32x4*)gn = *(const f32x4*)gp; *(f32x4*)(gn + 4) = *(const f32x4*)(gp + 4); }
        const float qs = isq ? QSCALE : 1.f;
        for (int r0 = vgb; r0 < NT; r0 += 2 * c.ngw) {
            int rr[2]; bool ok[2]; rr[0] = r0; ok[0] = true; rr[1] = r0 + c.ngw; ok[1] = rr[1] < NT; if (!ok[1]) rr[1] = r0;
            u32x4 zq[2], zv[2]; const float* tp[2];
#pragma unroll
            for (int q = 0; q < 2; ++q) { const int r = rr[q]; zq[q] = *(const u32x4*)(Z + (size_t)r * ZP + col); zv[q] = *(const u32x4*)(Z + (size_t)r * ZP + ZC_AV + (c.lane & 15) * 8);
                const int t = r & 4095; tp[q] = rope + (r < NLAT ? (axis * 64 + (axis == 0 ? (t >> 6) : (t & 63))) * 32 : 128 * 32) + p0; }
#pragma unroll
            for (int q = 0; q < 2; ++q) { const int r = rr[q]; const bool lat = r < NLAT; const int b = lat ? (r >> 12) : ((r - NLAT) >> 8), pos = lat ? CTXL + (r & 4095) : ((r - NLAT) & 255);
                float v[8]; unpack8(zq[q], v);
                float ss = 0.f;
#pragma unroll
                for (int e = 0; e < 8; ++e) ss += v[e] * v[e];
                ss = sum8lanes(ss); const float sc = rsqrtf(ss * (1.f / 64.f) + EPS);
                float cs[8], sn[8]; *(f32x4*)cs = *(const f32x4*)tp[q]; *(f32x4*)(cs + 4) = *(const f32x4*)(tp[q] + 4); *(f32x4*)sn = *(const f32x4*)(tp[q] + 16); *(f32x4*)(sn + 4) = *(const f32x4*)(tp[q] + 20);
#pragma unroll
                for (int e = 0; e < 8; ++e) { v[e] *= sc * gn[e]; const float o = DPP_F(v[e], 0x4E); v[e] = (half == 0 ? v[e] * cs[e] - o * sn[e] : o * sn[e] + v[e] * cs[e]) * qs; }
                const u32x4 w = pack8(v);
                if (ok[q]) {
                    if (isq) { if (lat) *(u32x4*)(Qa + (size_t)r * 384 + c.lane * 8) = w; else if (need_ctx_q) *(u32x4*)(Qc + (size_t)(r - NLAT) * 384 + c.lane * 8) = w; }
                    else *(u32x4*)(Ka + ((size_t)b * SKV + pos) * 128 + (c.lane - 48) * 8) = w;
                    if (c.lane < 16) *(u32x4*)(Va + ((size_t)b * SKV + pos) * 128 + c.lane * 8) = zv[q];
                } }
        }
    }
    {
        bf16_t* SV = (bf16_t*)(c.ws + WS_SV); const int l32 = c.lane & 31;
        float gn[8]; { const float* gp = c.in[I_SGUG] + layer * 256 + l32 * 8; *(f32x4*)gn = *(const f32x4*)gp; *(f32x4*)(gn + 4) = *(const f32x4*)(gp + 4); }
        const int nr = need_ctx_q ? NT : NLAT;
        for (int it = vgc; it < nr / 2; it += c.ngw) {
            const int r = it * 2 + (c.lane >> 5);
            float v[8]; unpack8(*(const u32x4*)(Z + (size_t)r * ZP + ZC_MV + l32 * 8), v);
            float ss = 0.f;
#pragma unroll
            for (int e = 0; e < 8; ++e) { v[e] = gelu_f(v[e]); ss += v[e] * v[e]; }
            ss = sum8lanes(ss); const float sc = rsqrtf(ss * (1.f / 64.f) + EPS);
#pragma unroll
            for (int e = 0; e < 8; ++e) v[e] *= sc * gn[e];
            *(u32x4*)(SV + (size_t)r * 256 + l32 * 8) = pack8(v);
        }
    }
}
DEVI void phase_dnscan_naive(const Ctx& c) {
    const bf16_t* QN = (const bf16_t*)(c.ws + WS_QN); const bf16_t* KN = (const bf16_t*)(c.ws + WS_KN); const bf16_t* VB = (const bf16_t*)(c.ws + WS_DN + DN_VB);
    const float* BG = (const float*)(c.ws + WS_DN + DN_BG); float* OD = (float*)(c.ws + WS_DN + DN_O);
    float* kqv = c.lds; float* part = c.lds + 256; float* part2 = c.lds + 256 + 512;
    const int e = c.tid & 63, dg = c.tid >> 6;
    for (int seq = blockIdx.x; seq < 48; seq += gridDim.x) {
        const int b = seq / 12, h = (seq >> 1) % 6, dir = seq & 1;
        float S[8];
#pragma unroll
        for (int i = 0; i < 8; ++i) S[i] = 0.f;
        for (int step = 0; step < SKV; ++step) {
            int row;
            if (step < CTXL) { const int t = dir ? CTXL - 1 - step : step; row = NLAT + b * CTXL + t; }
            else { const int u = step - CTXL; const int t = dir ? SEQ - 1 - u : u; row = b * SEQ + t; }
            if (c.wave == 0) kqv[e] = bf2f(KN[(size_t)row * 384 + h * 64 + e]);
            else if (c.wave == 1) kqv[64 + e] = bf2f(QN[(size_t)row * 384 + h * 64 + e]);
            else if (c.wave == 2) kqv[128 + e] = bf2f(VB[(size_t)row * 384 + h * 64 + e]);
            else if (c.wave == 3 && e < 2) { const float v = BG[((size_t)row * 12 + dir * 6 + h) * 2 + e]; kqv[192 + e] = e == 0 ? v : __expf(v); }
            __syncthreads();
            const float a = kqv[193], beta = kqv[192];
            float kd[8], p = 0.f;
#pragma unroll
            for (int i = 0; i < 8; ++i) { kd[i] = kqv[dg * 8 + i]; S[i] *= a; p += S[i] * kd[i]; }
            part[dg * 64 + e] = p;
            __syncthreads();
            float rr = kqv[128 + e];
#pragma unroll
            for (int w = 0; w < 8; ++w) rr -= part[w * 64 + e];
            rr *= beta; float po = 0.f;
#pragma unroll
            for (int i = 0; i < 8; ++i) { S[i] += kd[i] * rr; po += S[i] * kqv[64 + dg * 8 + i]; }
            part2[dg * 64 + e] = po;
            __syncthreads();
            if (dg == 0) { float o = 0.f;
#pragma unroll
                for (int w = 0; w < 8; ++w) o += part2[w * 64 + e];
                OD[((size_t)dir * NT + row) * 384 + h * 64 + e] = o; }
        }
        __syncthreads();
    }
}

DEVI void phase_dnfinish(const Ctx& c, int layer, int nrows) {
    const float* OD = (const float*)(c.ws + WS_DN + DN_O); const bf16_t* Z = (const bf16_t*)(c.ws + WS_Z); bf16_t* MIX = (bf16_t*)(c.ws + WS_MIX);
    float gn[8]; { const float* gp = c.in[I_DNG] + layer * 64 + 8 * (c.lane & 7); *(f32x4*)gn = *(const f32x4*)gp; *(f32x4*)(gn + 4) = *(const f32x4*)(gp + 4); }
    if (c.lane < 48) for (int r = c.wave * (int)gridDim.x + (int)blockIdx.x; r < nrows; r += c.ngw) {
        const float* o0 = OD + (size_t)r * 384 + c.lane * 8; const float* o1 = o0 + (size_t)NT * 384;
        float v[8], g[8]; *(f32x4*)v = *(const f32x4*)o0 + *(const f32x4*)o1; *(f32x4*)(v + 4) = *(const f32x4*)(o0 + 4) + *(const f32x4*)(o1 + 4);
        unpack8(*(const u32x4*)(Z + (size_t)r * ZP + ZC_GATE + c.lane * 8), g);
        float ss = 0.f;
#pragma unroll
        for (int e = 0; e < 8; ++e) ss += v[e] * v[e];
        ss = sum8lanes(ss); const float sc = rsqrtf(ss * (1.f / 64.f) + EPS);
#pragma unroll
        for (int e = 0; e < 8; ++e) v[e] = v[e] * sc * gn[e] * silu_f(g[e]);
        *(u32x4*)(MIX + (size_t)r * 1024 + c.lane * 8) = pack8(v);
    }
}

DEVI void phase_attn_naive(const Ctx& c, bool with_ctx) {
    const bf16_t* Qa = (const bf16_t*)(c.ws + WS_QA); const bf16_t* Qc = (const bf16_t*)(c.ws + WS_QC); const bf16_t* Ka = (const bf16_t*)(c.ws + WS_KA); const bf16_t* Va = (const bf16_t*)(c.ws + WS_VA);
    bf16_t* MIX = (bf16_t*)(c.ws + WS_MIX);
    const int nitems = NLAT * 6 + (with_ctx ? NCTX * 6 : 0);
    for (int it = c.gw; it < nitems; it += c.ngw) {
        int b, hq, nkeys, orow; const bf16_t* qp;
        if (it < NLAT * 6) { const int r = it / 6; hq = it % 6; b = r >> 12; qp = Qa + (size_t)r * 384 + hq * 64; nkeys = SKV; orow = r; }
        else { const int q = it - NLAT * 6, rc = q / 6; hq = q % 6; b = rc >> 8; qp = Qc + (size_t)rc * 384 + hq * 64; nkeys = CTXL; orow = NLAT + rc; }
        const int kvh = hq / 3; const bf16_t* Kp = Ka + (size_t)b * SKV * 128 + kvh * 64; const bf16_t* Vp = Va + (size_t)b * SKV * 128 + kvh * 64;
        u32x4 qv[8];
#pragma unroll
        for (int i = 0; i < 8; ++i) qv[i] = *(const u32x4*)(qp + i * 8);
        float m = -1e30f, l = 0.f, acc = 0.f;
        for (int t0 = 0; t0 < nkeys; t0 += 64) {
            const bf16_t* kp = Kp + (size_t)(t0 + c.lane) * 128; float s = 0.f;
#pragma unroll
            for (int i = 0; i < 8; ++i) { const u32x4 kv = *(const u32x4*)(kp + i * 8);
#pragma unroll
                for (int q = 0; q < 4; ++q) s += bflo(kv[q]) * bflo(qv[i][q]) + bfhi(kv[q]) * bfhi(qv[i][q]); }
            const float mn = fmaxf(m, wave_max(s)); const float alpha = exp2f(m - mn); const float p = exp2f(s - mn);
            l = l * alpha + wave_sum(p); acc *= alpha; m = mn;
#pragma unroll 8
            for (int jj = 0; jj < 64; ++jj) { const float pj = __shfl(p, jj); acc += pj * bf2f(Vp[(size_t)(t0 + jj) * 128 + c.lane]); }
        }
        MIX[(size_t)orow * 1024 + 384 + hq * 64 + c.lane] = (bf16_t)f2bf(acc / l);
    }
}


namespace dn {
using bf16x8 = __attribute__((ext_vector_type(8))) short;
using f32x16 = __attribute__((ext_vector_type(16))) float;
typedef __attribute__((address_space(3))) unsigned char* ldsp;
constexpr int IMG = 46080, NCHK = 68, NSEQ = 48;
constexpr int O_NEGK = 0, O_T = 8192, O_QG = 14336, O_AT = 22528, O_KDT = 28672, O_BV = 36864, O_MISC = 45056;
DEVI int rowmap(int t, int hq) { return (t & 3) + 8 * (t >> 2) + 4 * hq; }
typedef float f32x2_t __attribute__((ext_vector_type(2))); typedef __bf16 bf16x2_t __attribute__((ext_vector_type(2)));
DEVI unsigned cvtpk(float lo, float hi) { f32x2_t v = {lo, hi}; bf16x2_t b = __builtin_convertvector(v, bf16x2_t); return __builtin_bit_cast(unsigned, b); }
#define DN_PACK8(x, s) __builtin_bit_cast(dn::bf16x8, (u32x4){dn::cvtpk((x)[8 * (s)], (x)[8 * (s) + 1]), dn::cvtpk((x)[8 * (s) + 2], (x)[8 * (s) + 3]), dn::cvtpk((x)[8 * (s) + 4], (x)[8 * (s) + 5]), dn::cvtpk((x)[8 * (s) + 6], (x)[8 * (s) + 7])})
#define DN_MFMA(a, b, c) __builtin_amdgcn_mfma_f32_32x32x16_bf16((a), (b), (c), 0, 0, 0)
DEVI u32x4 perm_frag(u32x4 f, int hq) {
    const unsigned s0 = hq ? f.x : f.z, s1 = hq ? f.y : f.w;
    const unsigned r0 = (unsigned)__shfl_xor((int)s0, 32), r1 = (unsigned)__shfl_xor((int)s1, 32);
    u32x4 o; o.x = hq ? r0 : f.x; o.y = hq ? r1 : f.y; o.z = hq ? f.z : r0; o.w = hq ? f.w : r1; return o;
}
DEVI u32x4 scale_frag(u32x4 f, float sc) {
    u32x4 o; o.x = cvtpk(bflo(f.x) * sc, bfhi(f.x) * sc); o.y = cvtpk(bflo(f.y) * sc, bfhi(f.y) * sc); o.z = cvtpk(bflo(f.z) * sc, bfhi(f.z) * sc); o.w = cvtpk(bflo(f.w) * sc, bfhi(f.w) * sc); return o;
}
DEVI bf16x8 ident_frag(int e, int r, int hq) {
    const int js = r - 16 * e - 8 * hq; u32x4 w;
    w.x = (js == 0 ? 0x3F80u : 0u) | (js == 1 ? 0x3F800000u : 0u); w.y = (js == 2 ? 0x3F80u : 0u) | (js == 3 ? 0x3F800000u : 0u);
    w.z = (js == 4 ? 0x3F80u : 0u) | (js == 5 ? 0x3F800000u : 0u); w.w = (js == 6 ? 0x3F80u : 0u) | (js == 7 ? 0x3F800000u : 0u);
    return __builtin_bit_cast(bf16x8, w);
}
DEVI int chunk_base(int b, int dir, int n) {
    if (n < 4) return NLAT + b * CTXL + (dir ? 3 - n : n) * 64;
    return b * SEQ + (dir ? 63 - (n - 4) : n - 4) * 64;
}

DEVI void phase_chunkprep(const Ctx& c) {
    const bf16_t* QN = (const bf16_t*)(c.ws + WS_QN); const bf16_t* KN = (const bf16_t*)(c.ws + WS_KN); const bf16_t* VB = (const bf16_t*)(c.ws + WS_DN + DN_VB);
    const float* BG = (const float*)(c.ws + WS_DN + DN_BG); unsigned char* OPS = c.ws + WS_DN + DN_OPS;
    float* Al = c.lds + c.wave * (17408 / 4);
    float* sgc = Al + 4096; float* sbe = sgc + 64; float* skd = sbe + 64;
    const int l = c.lane, r = l & 31, hq = l >> 5;
    for (int task = c.wave * (int)gridDim.x + (int)blockIdx.x; task < NSEQ * NCHK; task += c.ngw) {
        const int seq = task / NCHK, n = task % NCHK, b = seq / 12, h = (seq >> 1) % 6, dir = seq & 1;
        const int base = chunk_base(b, dir, n);
        unsigned char* img = OPS + (size_t)task * IMG;
        const int myrow = base + (dir ? 63 - l : l);
        const float beta = BG[((size_t)myrow * 12 + dir * 6 + h) * 2]; const float g = BG[((size_t)myrow * 12 + dir * 6 + h) * 2 + 1];
        float gc = g;
#pragma unroll
        for (int o = 1; o < 64; o <<= 1) { const float t = __shfl_up(gc, o); if (l >= o) gc += t; }
        const float glast = __shfl(gc, 63);
        sgc[l] = gc; sbe[l] = beta; skd[l] = __expf(glast - gc);
        if (l == 0) *(float*)(img + O_MISC) = __expf(glast);
        __builtin_amdgcn_wave_barrier(); asm volatile("" ::: "memory");
        u32x4 kf[2][4], qf[2][4];
#pragma unroll
        for (int t = 0; t < 2; ++t) { const int pos = 32 * t + r; const size_t ro = (size_t)(base + (dir ? 63 - pos : pos)) * 384 + h * 64 + 8 * hq;
#pragma unroll
            for (int kk = 0; kk < 4; ++kk) { kf[t][kk] = *(const u32x4*)(KN + ro + 16 * kk); qf[t][kk] = *(const u32x4*)(QN + ro + 16 * kk); } }
#define KF(t, kk) __builtin_bit_cast(bf16x8, kf[t][kk])
#define QF(t, kk) __builtin_bit_cast(bf16x8, qf[t][kk])
#pragma unroll
        for (int tile = 0; tile < 3; ++tile) { const int rb = tile == 2 ? 1 : 0, cb = tile == 0 ? 0 : 1;
            f32x16 G = {}, P = {};
#pragma unroll
            for (int kk = 0; kk < 4; ++kk) { G = DN_MFMA(KF(rb, kk), KF(cb, kk), G); P = DN_MFMA(KF(rb, kk), QF(cb, kk), P); }
            const int lp = 32 * cb + r; const float bl = __shfl(beta, lp), gl = __shfl(gc, lp);
#pragma unroll
            for (int t = 0; t < 16; ++t) { const int rp = 32 * rb + rowmap(t, hq); const float e = __expf(gl - sgc[rp]);
                if (tile == 1) G[t] = -bl * e * G[t]; else Al[rp * 64 + lp] = lp > rp ? bl * e * G[t] : 0.f;
                P[t] = rp <= lp ? P[t] * e : 0.f; }
            if (tile == 1) { *(bf16x8*)(img + O_T + 2 * 1024 + l * 16) = DN_PACK8(G, 0); *(bf16x8*)(img + O_T + 3 * 1024 + l * 16) = DN_PACK8(G, 1); }
            *(bf16x8*)(img + O_AT + (2 * tile + 0) * 1024 + l * 16) = DN_PACK8(P, 0);
            *(bf16x8*)(img + O_AT + (2 * tile + 1) * 1024 + l * 16) = DN_PACK8(P, 1); }
#pragma unroll
        for (int rt = 0; rt < 2; ++rt) { const float gr = __shfl(gc, 32 * rt + r), br = __shfl(beta, 32 * rt + r); const float eg = __expf(gr);
#pragma unroll
            for (int kk = 0; kk < 4; ++kk) {
                *(u32x4*)(img + O_NEGK + (rt * 4 + kk) * 1024 + l * 16) = scale_frag(perm_frag(kf[rt][kk], hq), -br * eg);
                *(u32x4*)(img + O_QG + (rt * 4 + kk) * 1024 + l * 16) = scale_frag(perm_frag(qf[rt][kk], hq), eg); } }
#pragma unroll
        for (int dt = 0; dt < 2; ++dt)
#pragma unroll
            for (int cb = 0; cb < 2; ++cb) { f32x16 X = {};
                X = DN_MFMA(KF(cb, 2 * dt), ident_frag(0, r, hq), X); X = DN_MFMA(KF(cb, 2 * dt + 1), ident_frag(1, r, hq), X);
#pragma unroll
                for (int t = 0; t < 16; ++t) X[t] *= skd[32 * cb + rowmap(t, hq)];
                *(bf16x8*)(img + O_KDT + ((dt * 2 + cb) * 2 + 0) * 1024 + l * 16) = DN_PACK8(X, 0);
                *(bf16x8*)(img + O_KDT + ((dt * 2 + cb) * 2 + 1) * 1024 + l * 16) = DN_PACK8(X, 1); }
        {
            u32x4 vf[2][4];
#pragma unroll
            for (int t = 0; t < 2; ++t) { const int pos = 32 * t + r; const size_t ro = (size_t)(base + (dir ? 63 - pos : pos)) * 384 + h * 64 + 8 * hq;
#pragma unroll
                for (int kk = 0; kk < 4; ++kk) vf[t][kk] = *(const u32x4*)(VB + ro + 16 * kk); }
#pragma unroll
            for (int sl = 0; sl < 2; ++sl)
#pragma unroll
                for (int ct = 0; ct < 2; ++ct) { f32x16 Y = {};
                    Y = DN_MFMA(__builtin_bit_cast(bf16x8, vf[ct][2 * sl]), ident_frag(0, r, hq), Y); Y = DN_MFMA(__builtin_bit_cast(bf16x8, vf[ct][2 * sl + 1]), ident_frag(1, r, hq), Y);
#pragma unroll
                    for (int t = 0; t < 16; ++t) Y[t] *= sbe[32 * ct + rowmap(t, hq)];
                    *(bf16x8*)(img + O_BV + ((sl * 2 + ct) * 64 + l) * 32) = DN_PACK8(Y, 0);
                    *(bf16x8*)(img + O_BV + ((sl * 2 + ct) * 64 + l) * 32 + 16) = DN_PACK8(Y, 1); }
        }
#undef KF
#undef QF
        __builtin_amdgcn_wave_barrier(); asm volatile("" ::: "memory");
        {
            const float* Ab = Al + hq * (32 * 64 + 32);
            float* Tb = Al + hq * (32 * 64) + (hq ? 0 : 32);
#pragma unroll 1
            for (int JB = 3; JB >= 0; --JB) {
                float acc[8];
#pragma unroll
                for (int jj = 0; jj < 8; ++jj) acc[jj] = (r == 8 * JB + jj) ? 1.f : 0.f;
                float tk[24];
#pragma unroll
                for (int k = 8; k < 32; ++k) { const float tv = Tb[k * 64 + r]; tk[k - 8] = (k >= 8 * (JB + 1)) ? tv : 0.f; }
                const float* Aj = Ab + (8 * JB) * 64;
#pragma unroll
                for (int jj = 0; jj < 8; ++jj) { float a0 = 0.f, a1 = 0.f;
#pragma unroll
                    for (int k4 = 2; k4 < 8; ++k4) { const f32x4 av = *(const f32x4*)(Aj + jj * 64 + 4 * k4);
                        a0 += tk[4 * k4 - 8] * av.x + tk[4 * k4 - 6] * av.z; a1 += tk[4 * k4 - 7] * av.y + tk[4 * k4 - 5] * av.w; }
                    acc[jj] -= a0 + a1; }
#pragma unroll
                for (int jj = 6; jj >= 0; --jj) {
                    const f32x4 a0v = *(const f32x4*)(Aj + jj * 64 + 8 * JB), a1v = *(const f32x4*)(Aj + jj * 64 + 8 * JB + 4);
                    const float av[8] = {a0v.x, a0v.y, a0v.z, a0v.w, a1v.x, a1v.y, a1v.z, a1v.w};
                    float a = acc[jj];
#pragma unroll
                    for (int kk = jj + 1; kk < 8; ++kk) a -= acc[kk] * av[kk];
                    acc[jj] = a; }
#pragma unroll
                for (int jj = 0; jj < 8; ++jj) Tb[(8 * JB + jj) * 64 + r] = acc[jj];
            }
            float T[32];
#pragma unroll
            for (int k = 0; k < 32; ++k) T[k] = Tb[k * 64 + r];
#pragma unroll
            for (int s = 0; s < 2; ++s)
#pragma unroll
                for (int h2 = 0; h2 < 2; ++h2) { const int k0 = 16 * s + 4 * h2;
                    u32x4 w; w.x = cvtpk(T[k0], T[k0 + 1]); w.y = cvtpk(T[k0 + 2], T[k0 + 3]); w.z = cvtpk(T[k0 + 8], T[k0 + 9]); w.w = cvtpk(T[k0 + 10], T[k0 + 11]);
                    *(u32x4*)(img + O_T + ((hq ? 4 : 0) + s) * 1024 + (32 * h2 + r) * 16) = w; }
        }
        __builtin_amdgcn_wave_barrier(); asm volatile("" ::: "memory");
    }
}

DEVI void glds16(const void* gsrc, unsigned lds_dst) { unsigned keep;
    asm volatile("s_mov_b32 %0, m0\n\ts_mov_b32 m0, %2\n\ts_nop 0\n\tglobal_load_lds_dwordx4 %1, off\n\ts_mov_b32 m0, %0" : "=&s"(keep) : "v"(gsrc), "s"(lds_dst) : "memory"); }
DEVI void scan_sequence(const Ctx& c, int seq) {
    const unsigned char* OPS = c.ws + WS_DN + DN_OPS + (size_t)seq * NCHK * IMG; float* OD = (float*)(c.ws + WS_DN + DN_O);
    const int b = seq / 12, h = (seq >> 1) % 6, dir = seq & 1;
    const int l = c.lane, r = l & 31, hq = l >> 5, w = c.wave;
    const unsigned lds0 = (unsigned)(uintptr_t)c.lds;
    const bool loader = (w >= 2), consumer = (w < 2);
    constexpr int RSLOT = 36864;
#define DN_ISSUE(step, slot) do { if (loader) { _Pragma("unroll") for (int q_ = 0; q_ < 6; ++q_) { const int p_ = (w - 2) * 6 + q_; \
        glds16(OPS + (size_t)(step) * IMG + p_ * 1024 + l * 16, (unsigned)__builtin_amdgcn_readfirstlane(lds0 + (slot) * RSLOT + p_ * 1024)); } } } while (0)
    f32x16 S0 = {}, S1 = {};
    float gam_n = 0.f; u32x4 bv_n[4] = {};
    if (consumer) { gam_n = *(const float*)(OPS + O_MISC);
        bv_n[0] = *(const u32x4*)(OPS + O_BV + ((w * 2 + 0) * 64 + l) * 32); bv_n[1] = *(const u32x4*)(OPS + O_BV + ((w * 2 + 0) * 64 + l) * 32 + 16);
        bv_n[2] = *(const u32x4*)(OPS + O_BV + ((w * 2 + 1) * 64 + l) * 32); bv_n[3] = *(const u32x4*)(OPS + O_BV + ((w * 2 + 1) * 64 + l) * 32 + 16); }
    DN_ISSUE(0, 0); DN_ISSUE(1, 1);
    int slot = 0;
    for (int n = 0; n < NCHK; ++n) {
        if (loader) { if (n + 1 < NCHK) asm volatile("s_waitcnt vmcnt(6)" ::: "memory"); else asm volatile("s_waitcnt vmcnt(0)" ::: "memory"); }
        asm volatile("s_barrier" ::: "memory");
        if (n + 2 < NCHK) { const int s2 = slot == 0 ? 2 : slot - 1; DN_ISSUE(n + 2, s2); }
        if (consumer) {
            const ldsp img = c.lds3 + slot * RSLOT; const int sl = w;
#define DN_A(off, f) (*(const __attribute__((address_space(3))) bf16x8*)(img + (off) + (f) * 1024 + l * 16))
            const float gamma = gam_n; const u32x4 a = bv_n[0], bq = bv_n[1], a1 = bv_n[2], b1 = bv_n[3];
            if (n + 1 < NCHK) { const unsigned char* g2 = OPS + (size_t)(n + 1) * IMG;
                gam_n = *(const float*)(g2 + O_MISC);
                bv_n[0] = *(const u32x4*)(g2 + O_BV + ((sl * 2 + 0) * 64 + l) * 32); bv_n[1] = *(const u32x4*)(g2 + O_BV + ((sl * 2 + 0) * 64 + l) * 32 + 16);
                bv_n[2] = *(const u32x4*)(g2 + O_BV + ((sl * 2 + 1) * 64 + l) * 32); bv_n[3] = *(const u32x4*)(g2 + O_BV + ((sl * 2 + 1) * 64 + l) * 32 + 16); }
            const bf16x8 sb00 = DN_PACK8(S0, 0), sb01 = DN_PACK8(S0, 1), sb10 = DN_PACK8(S1, 0), sb11 = DN_PACK8(S1, 1);
            f32x16 v0, v1;
            {
#pragma unroll
              for (int q = 0; q < 4; ++q) { v0[2 * q] = bflo(a[q]); v0[2 * q + 1] = bfhi(a[q]); v0[8 + 2 * q] = bflo(bq[q]); v0[8 + 2 * q + 1] = bfhi(bq[q]);
                  v1[2 * q] = bflo(a1[q]); v1[2 * q + 1] = bfhi(a1[q]); v1[8 + 2 * q] = bflo(b1[q]); v1[8 + 2 * q + 1] = bfhi(b1[q]); } }
            v0 = DN_MFMA(DN_A(O_NEGK, 0), sb00, v0); v1 = DN_MFMA(DN_A(O_NEGK, 4), sb00, v1);
            v0 = DN_MFMA(DN_A(O_NEGK, 1), sb01, v0); v1 = DN_MFMA(DN_A(O_NEGK, 5), sb01, v1);
            v0 = DN_MFMA(DN_A(O_NEGK, 2), sb10, v0); v1 = DN_MFMA(DN_A(O_NEGK, 6), sb10, v1);
            v0 = DN_MFMA(DN_A(O_NEGK, 3), sb11, v0); v1 = DN_MFMA(DN_A(O_NEGK, 7), sb11, v1);
            __builtin_amdgcn_sched_barrier(0);
            const bf16x8 vb00 = DN_PACK8(v0, 0), vb01 = DN_PACK8(v0, 1);
            f32x16 n0 = {}, n1 = {};
            n0 = DN_MFMA(DN_A(O_T, 0), vb00, n0); n0 = DN_MFMA(DN_A(O_T, 1), vb01, n0);
            const bf16x8 nb00 = DN_PACK8(n0, 0), nb01 = DN_PACK8(n0, 1);
            v1 = DN_MFMA(DN_A(O_T, 2), nb00, v1); v1 = DN_MFMA(DN_A(O_T, 3), nb01, v1);
            const bf16x8 xb10 = DN_PACK8(v1, 0), xb11 = DN_PACK8(v1, 1);
            n1 = DN_MFMA(DN_A(O_T, 4), xb10, n1); n1 = DN_MFMA(DN_A(O_T, 5), xb11, n1);
            const bf16x8 nb10 = DN_PACK8(n1, 0), nb11 = DN_PACK8(n1, 1);
            __builtin_amdgcn_sched_barrier(0);
            f32x16 o0 = {}, o1 = {};
            o0 = DN_MFMA(DN_A(O_QG, 0), sb00, o0); o1 = DN_MFMA(DN_A(O_QG, 4), sb00, o1);
            o0 = DN_MFMA(DN_A(O_QG, 1), sb01, o0); o1 = DN_MFMA(DN_A(O_QG, 5), sb01, o1);
            o0 = DN_MFMA(DN_A(O_QG, 2), sb10, o0); o1 = DN_MFMA(DN_A(O_QG, 6), sb10, o1);
            o0 = DN_MFMA(DN_A(O_QG, 3), sb11, o0); o1 = DN_MFMA(DN_A(O_QG, 7), sb11, o1);
            o0 = DN_MFMA(DN_A(O_AT, 0), nb00, o0); o1 = DN_MFMA(DN_A(O_AT, 2), nb00, o1);
            o0 = DN_MFMA(DN_A(O_AT, 1), nb01, o0); o1 = DN_MFMA(DN_A(O_AT, 3), nb01, o1);
            o1 = DN_MFMA(DN_A(O_AT, 4), nb10, o1); o1 = DN_MFMA(DN_A(O_AT, 5), nb11, o1);
            __builtin_amdgcn_sched_barrier(0);
            {
                const int base = chunk_base(b, dir, n); float* od = OD + (size_t)dir * NT * 384 + h * 64 + 32 * sl + r;
#pragma unroll
                for (int t = 0; t < 16; ++t) { const int i0 = rowmap(t, hq), i1 = 32 + i0;
                    od[(size_t)(base + (dir ? 63 - i0 : i0)) * 384] = o0[t]; od[(size_t)(base + (dir ? 63 - i1 : i1)) * 384] = o1[t]; }
            }
            __builtin_amdgcn_sched_barrier(0);
#pragma unroll
            for (int t = 0; t < 16; ++t) { S0[t] *= gamma; S1[t] *= gamma; }
            S0 = DN_MFMA(DN_A(O_KDT, 0), nb00, S0); S1 = DN_MFMA(DN_A(O_KDT, 4), nb00, S1);
            S0 = DN_MFMA(DN_A(O_KDT, 1), nb01, S0); S1 = DN_MFMA(DN_A(O_KDT, 5), nb01, S1);
            S0 = DN_MFMA(DN_A(O_KDT, 2), nb10, S0); S1 = DN_MFMA(DN_A(O_KDT, 6), nb10, S1);
            S0 = DN_MFMA(DN_A(O_KDT, 3), nb11, S0); S1 = DN_MFMA(DN_A(O_KDT, 7), nb11, S1);
#undef DN_A
        }
        slot = slot == 2 ? 0 : slot + 1;
    }
    asm volatile("s_waitcnt vmcnt(0) lgkmcnt(0)\n\ts_barrier" ::: "memory");
#undef DN_ISSUE
}
}

DEVI void phase_sgu(const Ctx& c, int layer, bool need_ctx) {
    using dn::bf16x8; using dn::f32x16;
    const bf16_t* Z = (const bf16_t*)(c.ws + WS_Z); const bf16_t* SV = (const bf16_t*)(c.ws + WS_SV); bf16_t* MIX = (bf16_t*)(c.ws + WS_MIX);
    const float* sw = c.in[I_SGUW] + (size_t)layer * 4 * 128 * 128; const float* sb = c.in[I_SGUB] + layer * 512;
    const int nchunks = (need_ctx ? NT : NLAT) / 128; const int l = c.lane, r = l & 31, hq = l >> 5;
    const bf16x8 id0 = dn::ident_frag(0, r, hq), id1 = dn::ident_frag(1, r, hq);
    const int vgw = c.wave * (int)gridDim.x + (int)blockIdx.x, nitems = nchunks * 32;
    const int nA = dn::NSEQ * dn::NCHK - c.ngw < 0 ? 0 : (dn::NSEQ * dn::NCHK - c.ngw > c.ngw ? c.ngw : dn::NSEQ * dn::NCHK - c.ngw), nB = c.ngw - nA;
    const bool isB = vgw >= nA; const int bidx = vgw - nA;
    for (int k = isB ? 0 : 3; ; ++k) {
        const int sit = k < 3 ? bidx + k * nB : 3 * nB + vgw + (k - 3) * c.ngw;
        if (sit >= nitems) { if (k < 3) continue; break; }
        const int it = sit >> 2, itile = sit & 3, ch = it >> 3, g = (it >> 1) & 3, dvb = it & 1, r0 = ch * 128;
        bf16x8 yb[4][2];
#pragma unroll
        for (int jt = 0; jt < 4; ++jt) { const bf16_t* sp = SV + (size_t)(r0 + 32 * jt + r) * 256 + g * 64 + 32 * dvb + 8 * hq;
            f32x16 Y = {};
            Y = DN_MFMA(__builtin_bit_cast(bf16x8, *(const u32x4*)sp), id0, Y); Y = DN_MFMA(__builtin_bit_cast(bf16x8, *(const u32x4*)(sp + 16)), id1, Y);
            yb[jt][0] = DN_PACK8(Y, 0); yb[jt][1] = DN_PACK8(Y, 1); }
        const float* wg = sw + (size_t)g * 128 * 128;
        {
            f32x16 C = {}; const float* wr = wg + (size_t)(32 * itile + r) * 128 + 4 * hq;
#pragma unroll
            for (int jt = 0; jt < 4; ++jt)
#pragma unroll
                for (int sI = 0; sI < 2; ++sI) { const f32x4 w0 = *(const f32x4*)(wr + 32 * jt + 16 * sI), w1 = *(const f32x4*)(wr + 32 * jt + 16 * sI + 8);
                    u32x4 a; a.x = dn::cvtpk(w0.x, w0.y); a.y = dn::cvtpk(w0.z, w0.w); a.z = dn::cvtpk(w1.x, w1.y); a.w = dn::cvtpk(w1.z, w1.w);
                    C = DN_MFMA(__builtin_bit_cast(bf16x8, a), yb[jt][sI], C); }
#pragma unroll
            for (int t = 0; t < 16; ++t) { const int i = 32 * itile + dn::rowmap(t, hq); const size_t row = (size_t)(r0 + i);
                const float u = gelu_f(bf2f(Z[row * ZP + ZC_MU + g * 64 + 32 * dvb + r]));
                MIX[row * 1024 + 768 + g * 64 + 32 * dvb + r] = (bf16_t)f2bf(u * (C[t] + sb[g * 128 + i])); }
        }
    }
}

namespace attn_body {
using bf16=__hip_bfloat16;
using bf16x8=__attribute__((ext_vector_type(8)))short;
using s16x4=__attribute__((ext_vector_type(4)))short;
using f32x16=__attribute__((ext_vector_type(16)))float;
using u32x4=__attribute__((ext_vector_type(4)))unsigned;
constexpr int D=64,QP=384,KVP=128,OP=1024;
constexpr int NW=8,QBLK=32,QB=QBLK*NW,KVBLK=64;
constexpr int ATTN_UNIT_ROWS=QB;
__device__ __forceinline__ int crow(int r,int hi){return (r&3)+8*(r>>2)+4*hi;}
#define SBAR() __builtin_amdgcn_sched_barrier(0)
__device__ __forceinline__ void cmask(f32x16&p0,f32x16&p1,int jb,int qrel,int hi){
  const float NEG=-INFINITY; int kb=64*jb+4*hi;
  #pragma unroll
  for(int r=0;r<16;++r){int kv=kb+(r&3)+8*(r>>2); if(kv>qrel)p0[r]=NEG; if(kv+32>qrel)p1[r]=NEG;}
}

constexpr int NSLOT=3, SLOTB=8192;
constexpr int LDS_K=0, LDS_V=NSLOT*SLOTB, LDS_WS=2*NSLOT*SLOTB, LDS_OST=LDS_WS+NW*64*4, LDS_BYTES=LDS_OST+NW*4096;
constexpr float C2=0.125f*1.4426950408889634f;
__device__ __forceinline__ void glds16(const void*gsrc,unsigned lds_dst){unsigned keep;
  asm volatile("s_mov_b32 %0, m0\n\ts_mov_b32 m0, %2\n\ts_nop 0\n\tglobal_load_lds_dwordx4 %1, off\n\ts_mov_b32 m0, %0":"=&s"(keep):"v"(gsrc),"s"(lds_dst):"memory");}
__device__ __forceinline__ float max3f(float a,float b,float c){float r;asm("v_max3_f32 %0, %1, %2, %3":"=v"(r):"v"(a),"v"(b),"v"(c));return r;}
__device__ __forceinline__ float max2f(float a,float b){float r;asm("v_max_f32_e32 %0, %1, %2":"=v"(r):"v"(a),"v"(b));return r;}
__device__ __forceinline__ float fadd_s(float a,float b){float r;asm("v_add_f32_e32 %0, %1, %2":"=v"(r):"v"(a),"v"(b));return r;}
__device__ __forceinline__ float fsub_s(float a,float b){float r;asm("v_sub_f32_e32 %0, %1, %2":"=v"(r):"v"(a),"v"(b));return r;}
typedef float f32x2_t __attribute__((ext_vector_type(2))); typedef __bf16 bf16x2_t __attribute__((ext_vector_type(2)));
__device__ __forceinline__ unsigned cvtpk_s(float lo,float hi){f32x2_t v={lo,hi};bf16x2_t b=__builtin_convertvector(v,bf16x2_t);return __builtin_bit_cast(unsigned,b);}
#define WAIT_BAR(N) asm volatile("s_waitcnt vmcnt(" #N ") lgkmcnt(0)\n\ts_barrier":::"memory")

__device__ __forceinline__ void qkt(f32x16&p0,f32x16&p1,const char*Kslot,const bf16x8*qr,const f32x16&negm,int r32,int hi){
  const char*kb=Kslot+hi*1024+r32*16;
  #pragma unroll
  for(int d0=0;d0<4;++d0){
    const bf16x8 b0=*reinterpret_cast<const bf16x8*>(kb+d0*2048);
    const bf16x8 b1=*reinterpret_cast<const bf16x8*>(kb+d0*2048+512);
    if(d0==0){p0=__builtin_amdgcn_mfma_f32_32x32x16_bf16(b0,qr[0],negm,0,0,0);p1=__builtin_amdgcn_mfma_f32_32x32x16_bf16(b1,qr[0],negm,0,0,0);}
    else{p0=__builtin_amdgcn_mfma_f32_32x32x16_bf16(b0,qr[d0],p0,0,0,0);p1=__builtin_amdgcn_mfma_f32_32x32x16_bf16(b1,qr[d0],p1,0,0,0);}}
}
typedef __attribute__((address_space(3))) const char* lds_cptr;
typedef short v4i16_t __attribute__((ext_vector_type(4)));
__device__ __forceinline__ void kload8(bf16x8*kf,lds_cptr kp){
  kf[0]=*(const __attribute__((address_space(3))) bf16x8*)(kp);      kf[1]=*(const __attribute__((address_space(3))) bf16x8*)(kp+512);
  kf[2]=*(const __attribute__((address_space(3))) bf16x8*)(kp+2048); kf[3]=*(const __attribute__((address_space(3))) bf16x8*)(kp+2560);
  kf[4]=*(const __attribute__((address_space(3))) bf16x8*)(kp+4096); kf[5]=*(const __attribute__((address_space(3))) bf16x8*)(kp+4608);
  kf[6]=*(const __attribute__((address_space(3))) bf16x8*)(kp+6144); kf[7]=*(const __attribute__((address_space(3))) bf16x8*)(kp+6656);
}
__device__ __forceinline__ void kload2(bf16x8*kf,lds_cptr kp,int j){ kf[2*j]=*(const __attribute__((address_space(3))) bf16x8*)(kp+j*2048); kf[2*j+1]=*(const __attribute__((address_space(3))) bf16x8*)(kp+j*2048+512); }
__device__ __forceinline__ s16x4 vtr(lds_cptr p){ return __builtin_bit_cast(s16x4,__builtin_amdgcn_ds_read_tr16_b64_v4i16((__attribute__((address_space(3))) v4i16_t*)p)); }
__device__ __forceinline__ float rowmax(const f32x16&p0,const f32x16&p1){
  float a=max3f(p0[0],p0[1],p1[0]),b=max3f(p0[2],p0[3],p1[1]);a=max3f(a,p1[2],p1[3]);
  #pragma unroll
  for(int r=4;r<16;r+=4){a=max3f(a,p0[r],p0[r+1]);b=max3f(b,p0[r+2],p0[r+3]);a=max3f(a,p1[r],p1[r+1]);b=max3f(b,p1[r+2],p1[r+3]);}
  const float m=max2f(a,b);
  auto rr=__builtin_amdgcn_permlane32_swap(__float_as_uint(m),__float_as_uint(m),false,false);
  return max2f(__uint_as_float(rr[0]),__uint_as_float(rr[1]));
}
__device__ __forceinline__ void pv(f32x16*o,int vb,bf16x8 pa0,bf16x8 pa1,bf16x8 pa2,bf16x8 pa3){
  #pragma unroll
  for(int d0=0;d0<2;++d0){s16x4 lo[4],hi[4];
    #pragma unroll
    for(int ks=0;ks<4;++ks){
      asm volatile("ds_read_b64_tr_b16 %0,%1 offset:%c2":"=&v"(lo[ks]):"v"(vb),"i"(d0*4096+ks*1024):"memory");
      asm volatile("ds_read_b64_tr_b16 %0,%1 offset:%c2":"=&v"(hi[ks]):"v"(vb),"i"(d0*4096+ks*1024+512):"memory");}
    asm volatile("s_waitcnt lgkmcnt(0)":::"memory");SBAR();
    #define PK(k) (bf16x8){lo[k][0],lo[k][1],lo[k][2],lo[k][3],hi[k][0],hi[k][1],hi[k][2],hi[k][3]}
    o[d0]=__builtin_amdgcn_mfma_f32_32x32x16_bf16(pa0,PK(0),o[d0],0,0,0);
    o[d0]=__builtin_amdgcn_mfma_f32_32x32x16_bf16(pa1,PK(1),o[d0],0,0,0);
    o[d0]=__builtin_amdgcn_mfma_f32_32x32x16_bf16(pa2,PK(2),o[d0],0,0,0);
    o[d0]=__builtin_amdgcn_mfma_f32_32x32x16_bf16(pa3,PK(3),o[d0],0,0,0);
    #undef PK
  }
}

#ifndef ATTN_STORE16
#define ATTN_STORE16(p,v) (*(u32x4*)(p)=(v))
#endif
template<int THRL> __device__ __forceinline__ void attn_unit(const bf16*Qu,const bf16*__restrict__ Kh,const bf16*__restrict__ Vh,const int NT,bf16*Ou,char*shm){
  const int tid=threadIdx.x,lane=tid&63,r32=lane&31,hi=lane>>5; const int wid=__builtin_amdgcn_readfirstlane(tid>>6);
  const bf16*Qw=Qu+(long)(wid*QBLK)*QP;
  const unsigned lds0=(unsigned)(uintptr_t)shm;
  float*wsf=(float*)(shm+LDS_WS)+wid*64;
  const bf16*ksrc=Kh+(long)lane*KVP+wid*8;
  const bf16*vsrc=Vh+(long)(16*(wid&3)+(lane>>2))*KVP+(wid>>2)*32+(lane&3)*8;
  const unsigned kdst=lds0+LDS_K+wid*1024, vdst=lds0+LDS_V+wid*1024;
  #define DMA_K(t,slot) glds16(ksrc+(long)(t)*KVBLK*KVP,(unsigned)__builtin_amdgcn_readfirstlane(kdst+(slot)))
  #define DMA_V(t,slot) glds16(vsrc+(long)(t)*KVBLK*KVP,(unsigned)__builtin_amdgcn_readfirstlane(vdst+(slot)))
  const int vb0=(int)(lds0+LDS_V)+((lane>>4)&1)*32+(lane&3)*8+(4*hi+((lane&15)>>2))*64;
  const char*Kbase=shm+LDS_K; bf16x8 kf[8];
  const lds_cptr shm3=(lds_cptr)shm; const lds_cptr kp0=shm3+LDS_K+hi*1024+r32*16; const lds_cptr vp0=shm3+LDS_V+((lane>>4)&1)*32+(lane&3)*8+(4*hi+((lane&15)>>2))*64;
  DMA_K(0,0);DMA_V(0,0);DMA_K(1,SLOTB);
  bf16x8 qr[4];
  #pragma unroll
  for(int d0=0;d0<4;++d0)qr[d0]=*reinterpret_cast<const bf16x8*>(&Qw[(long)r32*QP+d0*16+hi*8]);
  float mhat=0.f,l_reg=0.f;f32x16 o[2];o[0]=f32x16{};o[1]=f32x16{};f32x16 negm=f32x16{};asm volatile("":"+v"(negm));
  #define CMASK(P0,P1,t) do{}while(0)
  bool resc=false;
  #define START(P0,P1) do{ const float rm=rowmax(P0,P1); resc=false; \
    { const float dl=rm; mhat=fadd_s(mhat,dl); \
      _Pragma("unroll") for(int r=0;r<16;++r){P0[r]=fsub_s(P0[r],dl);P1[r]=fsub_s(P1[r],dl);} \
      _Pragma("unroll") for(int r=0;r<16;++r)negm[r]=-mhat; asm volatile("":"+v"(negm)); } \
    _Pragma("unroll") for(int r=0;r<16;++r)P0[r]=__builtin_amdgcn_exp2f(P0[r]); }while(0)
  #define RESC() do{ if(resc){ asm volatile("s_waitcnt lgkmcnt(0)":::"memory"); \
      _Pragma("unroll") for(int d_=0;d_<2;++d_) _Pragma("unroll") for(int r=0;r<16;++r)o[d_][r]*=wsf[crow(r,hi)]; } }while(0)
  f32x16 pA0,pA1,pB0,pB1;
  int sl_prev=0,sl_cur=0,sl_next=SLOTB;
  #define ROT() do{sl_prev=sl_cur;sl_cur=sl_next;sl_next=(sl_next==(NSLOT-1)*SLOTB)?0:sl_next+SLOTB;}while(0)
  DMA_K(2,2*SLOTB);
  WAIT_BAR(3);
  qkt(pA0,pA1,Kbase,qr,negm,r32,hi);asm volatile("s_nop 15\n\ts_nop 7":"+v"(pA0),"+v"(pA1));CMASK(pA0,pA1,0);
  START(pA0,pA1);
  _Pragma("unroll") for(int r=0;r<16;++r)pA1[r]=__builtin_amdgcn_exp2f(pA1[r]);
  WAIT_BAR(0);
  DMA_K(3,0);DMA_V(1,SLOTB);
  ROT();
  kload8(kf,kp0+sl_cur);
  WAIT_BAR(2);
  s16x4 vlo[8],vhi[8]; u32x4 pw0,pw1,pw2,pw3;
  #define PKW(P,B) cvtpk_s(P[B],P[B+1])
  #define PAF(k) __builtin_bit_cast(bf16x8,pw##k)
  #define VFR(i) (bf16x8){vlo[i][0],vlo[i][1],vlo[i][2],vlo[i][3],vhi[i][0],vhi[i][1],vhi[i][2],vhi[i][3]}
  #define PIN(x) asm volatile("":"+v"(x))
  #define MX3(a,b,c) __builtin_fmaxf(__builtin_fmaxf((a),(b)),(c))
  #define GAPA(MF,A0,A1,A2,A3,W0,W1,PW) do{ MF; sacc+=A0; sacc+=A1; sacc+=A2; sacc+=A3; PIN(sacc); W0; W1; PIN(PW); SBAR(); }while(0)
  #define EX(v) __builtin_amdgcn_exp2f(v)
  #define GAPB(MF,X,B) do{ MF; X[B]=EX(X[B]); X[B+1]=EX(X[B+1]); X[B+2]=EX(X[B+2]); X[B+3]=EX(X[B+3]); PIN(X); SBAR(); }while(0)
  #define VRD(i) do{ vlo[i]=vtr(vp_+(((i)>>2)*4096+((i)&3)*1024)); vhi[i]=vtr(vp_+(((i)>>2)*4096+((i)&3)*1024+512)); }while(0)
  #define KRD(G,j) do{ if(G){ kload2(kf,kp0+sl_next,j); SBAR(); } }while(0)
  #define STEP(C0,C1,P0,P1,t,GK,GV,GL) do{ SBAR(); \
    const lds_cptr vp_=vp0+sl_prev; \
    VRD(0); SBAR(); float sacc=(P0[0]+P0[1]); \
    GAPA(C0=__builtin_amdgcn_mfma_f32_32x32x16_bf16(kf[0],qr[0],negm,0,0,0), P0[2],P0[3],P0[4],P0[5],     pw0[0]=PKW(P0,0), pw0[1]=PKW(P0,2), pw0); \
    VRD(4); SBAR(); GAPA(C1=__builtin_amdgcn_mfma_f32_32x32x16_bf16(kf[1],qr[0],negm,0,0,0), P0[6],P0[7],P0[8],P0[9],     pw0[2]=PKW(P0,4), pw0[3]=PKW(P0,6), pw0); \
    VRD(1); SBAR(); GAPA(C0=__builtin_amdgcn_mfma_f32_32x32x16_bf16(kf[2],qr[1],C0,0,0,0),   P0[10],P0[11],P0[12],P0[13], pw1[0]=PKW(P0,8), pw1[1]=PKW(P0,10), pw1); \
    VRD(5); SBAR(); GAPA(C1=__builtin_amdgcn_mfma_f32_32x32x16_bf16(kf[3],qr[1],C1,0,0,0),   P0[14],P0[15],P1[0],P1[1],   pw1[2]=PKW(P0,12),pw1[3]=PKW(P0,14), pw1); \
    VRD(2); SBAR(); GAPA(C0=__builtin_amdgcn_mfma_f32_32x32x16_bf16(kf[4],qr[2],C0,0,0,0),   P1[2],P1[3],P1[4],P1[5],     pw2[0]=PKW(P1,0), pw2[1]=PKW(P1,2), pw2); \
    VRD(6); SBAR(); GAPA(C1=__builtin_amdgcn_mfma_f32_32x32x16_bf16(kf[5],qr[2],C1,0,0,0),   P1[6],P1[7],P1[8],P1[9],     pw2[2]=PKW(P1,4), pw2[3]=PKW(P1,6), pw2); \
    VRD(3); SBAR(); GAPA(C0=__builtin_amdgcn_mfma_f32_32x32x16_bf16(kf[6],qr[3],C0,0,0,0),   P1[10],P1[11],P1[12],P1[13], pw3[0]=PKW(P1,8), pw3[1]=PKW(P1,10), pw3); \
    VRD(7); SBAR(); GAPA(C1=__builtin_amdgcn_mfma_f32_32x32x16_bf16(kf[7],qr[3],C1,0,0,0),   P1[14],P1[15],0.f,0.f,       pw3[2]=PKW(P1,12),pw3[3]=PKW(P1,14), pw3); \
    l_reg+=sacc; \
    if(GK){DMA_K((t)+3,sl_cur);} if(GV){DMA_V((t)+1,sl_next);} \
    CMASK(C0,C1,t); \
    { float a=MX3(C0[0],C0[1],C1[0]),b=MX3(C0[2],C0[3],C1[1]); a=MX3(a,C1[2],C1[3]); \
      _Pragma("unroll") for(int r=4;r<16;r+=4){a=MX3(a,C0[r],C0[r+1]);b=MX3(b,C0[r+2],C0[r+3]);a=MX3(a,C1[r],C1[r+1]);b=MX3(b,C1[r+2],C1[r+3]);} \
      float rm=__builtin_fmaxf(a,b); { auto rr=__builtin_amdgcn_permlane32_swap(__float_as_uint(rm),__float_as_uint(rm),false,false); rm=__builtin_fmaxf(__uint_as_float(rr[0]),__uint_as_float(rr[1])); } \
      resc=false; \
      if(__builtin_expect(__any(rm>(float)THRL),0)){ const float dl=__builtin_fmaxf(rm,0.f); mhat+=dl; \
        _Pragma("unroll") for(int r=0;r<16;++r){C0[r]-=dl;C1[r]-=dl;} \
        _Pragma("unroll") for(int r=0;r<16;++r)negm[r]=-mhat; asm volatile("":"+v"(negm)); \
        const float f=__builtin_amdgcn_exp2f(-dl); l_reg*=f; if(hi==0)wsf[r32]=f; resc=true; } } \
    SBAR(); \
    GAPB(o[0]=__builtin_amdgcn_mfma_f32_32x32x16_bf16(PAF(0),VFR(0),o[0],0,0,0), C0,0); \
    GAPB(o[1]=__builtin_amdgcn_mfma_f32_32x32x16_bf16(PAF(0),VFR(4),o[1],0,0,0), C0,4); \
    KRD(GL,0); GAPB(o[0]=__builtin_amdgcn_mfma_f32_32x32x16_bf16(PAF(1),VFR(1),o[0],0,0,0), C0,8); \
    KRD(GL,1); GAPB(o[1]=__builtin_amdgcn_mfma_f32_32x32x16_bf16(PAF(1),VFR(5),o[1],0,0,0), C0,12); \
    KRD(GL,2); GAPB(o[0]=__builtin_amdgcn_mfma_f32_32x32x16_bf16(PAF(2),VFR(2),o[0],0,0,0), C1,0); \
    KRD(GL,3); GAPB(o[1]=__builtin_amdgcn_mfma_f32_32x32x16_bf16(PAF(2),VFR(6),o[1],0,0,0), C1,4); \
    GAPB(o[0]=__builtin_amdgcn_mfma_f32_32x32x16_bf16(PAF(3),VFR(3),o[0],0,0,0), C1,8); \
    GAPB(o[1]=__builtin_amdgcn_mfma_f32_32x32x16_bf16(PAF(3),VFR(7),o[1],0,0,0), C1,12); \
    }while(0)
  int t=1;
  #undef CMASK
  #define CMASK(P0,P1,t) do{}while(0)
  for(;t+5<NT;t+=2){
    STEP(pB0,pB1,pA0,pA1,t,true,true,true);     WAIT_BAR(2); RESC(); ROT();
    STEP(pA0,pA1,pB0,pB1,t+1,true,true,true);   WAIT_BAR(2); RESC(); ROT();
  }
  #undef CMASK
  #define CMASK(P0,P1,t) do{}while(0)
  #define ENDW(tt) do{ if((tt)+3<NT){WAIT_BAR(2);} else if((tt)+2<NT){WAIT_BAR(1);} else {WAIT_BAR(0);} }while(0)
  for(;t+1<NT;t+=2){
    STEP(pB0,pB1,pA0,pA1,t,(t+3<NT),(t+1<NT),(t+1<NT));       ENDW(t);   RESC(); ROT();
    STEP(pA0,pA1,pB0,pB1,t+1,(t+4<NT),(t+2<NT),(t+2<NT));     ENDW(t+1); RESC(); ROT();
  }
  STEP(pB0,pB1,pA0,pA1,NT-1,false,false,false); RESC();
  { float sacc=pB0[0]+pB0[1]; _Pragma("unroll") for(int r=2;r<16;++r)sacc+=pB0[r]; _Pragma("unroll") for(int r=0;r<16;++r)sacc+=pB1[r]; l_reg+=sacc;
    pw0=(u32x4){PKW(pB0,0),PKW(pB0,2),PKW(pB0,4),PKW(pB0,6)};pw1=(u32x4){PKW(pB0,8),PKW(pB0,10),PKW(pB0,12),PKW(pB0,14)};pw2=(u32x4){PKW(pB1,0),PKW(pB1,2),PKW(pB1,4),PKW(pB1,6)};pw3=(u32x4){PKW(pB1,8),PKW(pB1,10),PKW(pB1,12),PKW(pB1,14)};
    SBAR(); pv(o,vb0+sl_cur,PAF(0),PAF(1),PAF(2),PAF(3)); }
  #undef PKW
  #undef PAF
  #undef VFR
  #undef PIN
  #undef MX3
  #undef GAPA
  #undef GAPB
  #undef EX
  #undef VRD
  #undef KRD
  #undef STEP
  #undef ENDW
  {auto rr=__builtin_amdgcn_permlane32_swap(__float_as_uint(l_reg),__float_as_uint(l_reg),false,false);l_reg=__uint_as_float(rr[0])+__uint_as_float(rr[1]);}
  if(hi==0)wsf[32+r32]=l_reg;asm volatile("s_waitcnt lgkmcnt(0)":::"memory");
  float rli[16];
  #pragma unroll
  for(int r=0;r<16;++r)rli[r]=__builtin_amdgcn_rcpf(wsf[32+crow(r,hi)]);
  bf16*Ow=Ou+(long)(wid*QBLK)*OP;
  { bf16*stg=(bf16*)(shm+LDS_OST)+wid*2048;
    #pragma unroll
    for(int r=0;r<16;++r){const int orow=crow(r,hi);
      #pragma unroll
      for(int d0=0;d0<2;++d0)stg[orow*64+d0*32+r32]=__float2bfloat16(o[d0][r]*rli[r]);}
    asm volatile("s_waitcnt lgkmcnt(0)":::"memory");
    #pragma unroll
    for(int i=0;i<4;++i){const int row=i*8+(lane>>3),ch=lane&7; const u32x4 v=*(const u32x4*)(stg+row*64+ch*8); ATTN_STORE16(Ow+(long)row*OP+ch*8,v);} }
  asm volatile("s_waitcnt lgkmcnt(0)\n\ts_barrier":::"memory");
  #undef DMA_K
  #undef DMA_V
  #undef CMASK
  #undef START
  #undef RESC
  #undef ROT
}
constexpr int ATTN_LDS_BYTES=LDS_BYTES;
#undef SBAR
#undef WAIT_BAR
}

DEVI void attn_unit_run(const Ctx& c, int u) {
    using attn_body::bf16;
    const bf16* Qa = (const bf16*)(c.ws + WS_QA); const bf16* Qc = (const bf16*)(c.ws + WS_QC); const bf16* Ka = (const bf16*)(c.ws + WS_KA); const bf16* Va = (const bf16*)(c.ws + WS_VA);
    bf16* MIX = (bf16*)(c.ws + WS_MIX);
    if (u < 384) { const int grp = u / 48, rem = u % 48, g = rem >> 4, qb = rem & 15, b = grp >> 1, kvh = grp & 1, hq = kvh * 3 + g;
        attn_body::attn_unit<8>(Qa + (size_t)(b * SEQ + qb * 256) * 384 + hq * 64, Ka + (size_t)b * SKV * 128 + kvh * 64, Va + (size_t)b * SKV * 128 + kvh * 64, SKV / 64,
                                MIX + (size_t)(b * SEQ + qb * 256) * 1024 + 384 + hq * 64, (char*)c.lds); }
    else { const int uc = u - 384, b = uc / 6, hq = uc % 6, kvh = hq / 3;
        attn_body::attn_unit<8>(Qc + (size_t)(b * CTXL) * 384 + hq * 64, Ka + (size_t)b * SKV * 128 + kvh * 64, Va + (size_t)b * SKV * 128 + kvh * 64, CTXL / 64,
                                MIX + (size_t)(NLAT + b * CTXL) * 1024 + 384 + hq * 64, (char*)c.lds); }
}
template <bool FAST_SCAN>
DEVI void phase_mixer_fast(const Ctx& c, bool with_ctx, int psub = 0) {
    const int G = gridDim.x, bx = blockIdx.x; const int nunits = 384 + (with_ctx ? 24 : 0);
    if (G == 256) {
        const int vcu = (bx & 7) * 32 + (bx >> 3), x = vcu >> 5, j = vcu & 31;
        if (FAST_SCAN && j < 6) { if (!(psub & 4)) dn::scan_sequence(c, x * 6 + j); return; }
        if (psub & 8) return;
        if (!FAST_SCAN) { for (int u = vcu; u < nunits; u += 256) attn_unit_run(c, u); return; }
        const int jp = j - 6;
        attn_unit_run(c, 48 * x + jp);
        if (jp < 22) attn_unit_run(c, 48 * x + 26 + jp);
        else if (with_ctx && jp < 25) attn_unit_run(c, 384 + (x >> 1) * 6 + (x & 1) * 3 + (jp - 22));
    } else {
        if (FAST_SCAN) for (int sq = bx; sq < 48; sq += G) dn::scan_sequence(c, sq);
        for (int u = bx; u < nunits; u += G) attn_unit_run(c, u);
    }
}

DEVI void phase_moe_assign(const Ctx& c) {
    int* cnt = (int*)c.lds;
    int* misc = (int*)c.lds + 2048;
    int* slots = (int*)c.lds + 2048 + 64;
    const int* gcnt = (const int*)(c.ws + CTL_CNT); const int* tope = (const int*)(c.ws + CTL_TOPE);
    for (int i = c.tid; i < 2048; i += NTHREADS) cnt[i] = gcnt[i];
    __syncthreads();
    if (c.tid < 8) { int tot = 0; for (int v = 0; v < 256; ++v) tot += cnt[v * 8 + c.tid]; misc[8 + c.tid] = tot; }
    __syncthreads();
    if (c.tid == 0) { int s = 0; for (int e = 0; e < 8; ++e) { misc[16 + e] = s; s += (misc[8 + e] + 255) & ~255; } misc[24] = s;
        if (blockIdx.x == 0) { int* seg = (int*)(c.ws + CTL_SEG); for (int e = 0; e <= 8; ++e) seg[e] = misc[16 + e]; for (int e = 0; e < 8; ++e) seg[16 + e] = misc[8 + e];
            for (int e = 0; e < 8; ++e) for (int pm = misc[16 + e] >> 8; pm < (misc[16 + e + 1] >> 8); ++pm) seg[32 + pm] = e; } }
    __syncthreads();
    if (blockIdx.x == 0) {
        int* ut = (int*)(c.ws + CTL_UTAB); const int nu = (misc[24] >> 8) * 4, ntab = nu <= 512 ? nu : 512 + 4 * (nu - 512);
        if (c.tid == 0) ut[0] = ntab;
        for (int L = c.tid; L < ntab; L += NTHREADS) { const int unit = L < 512 ? L : 512 + ((L - 512) >> 2), pm = unit >> 2; int e = 0;
            for (int q = 1; q < 8; ++q) e += (pm * 256 >= misc[16 + q]) ? 1 : 0;
            ut[4 + 4 * L] = pm; ut[4 + 4 * L + 1] = (unit & 3) + 4 * e; ut[4 + 4 * L + 2] = L < 512 ? 0 : ((L - 512) & 3) * (MFF / 4); ut[4 + 4 * L + 3] = L < 512 ? 0 : MFF / 256; } }
    unsigned short* rowtab = (unsigned short*)(c.ws + CTL_ROWTAB);
    for (int vb = blockIdx.x; vb < 256; vb += gridDim.x) {
        int* sel = slots + 128;
        if (c.tid < 128) sel[c.tid] = tope[vb * 128 + c.tid];
        __syncthreads();
        if (c.tid < 8) { int bs = 0; for (int v = 0; v < vb; ++v) bs += cnt[v * 8 + c.tid];
            int rank = misc[16 + c.tid] + bs;
            for (int i = 0; i < 128; ++i) if (sel[i] == c.tid) { slots[i] = rank; ++rank; } }
        __syncthreads();
        if (c.tid < 128) { ((int*)(c.ws + CTL_TOKSLOT))[vb * 128 + c.tid] = slots[c.tid]; { const int s_ = slots[c.tid]; rowtab[(s_ >> 7) * 128 + (s_ & 63) * 2 + ((s_ >> 6) & 1)] = (unsigned short)(vb * 64 + (c.tid >> 1)); } }
        __syncthreads();
    }
    for (int e = 0; e < 8; ++e) { const int p0 = misc[16 + e] + misc[8 + e], p1 = misc[16 + e + 1];
        for (int s_ = p0 + c.gw * 64 + c.lane; s_ < p1; s_ += c.ngw * 64) rowtab[(s_ >> 7) * 128 + (s_ & 63) * 2 + ((s_ >> 6) & 1)] = (unsigned short)NLAT; }
    if (blockIdx.x == 1 % gridDim.x && c.tid < 128) ((u32x4*)((bf16_t*)(c.ws + WS_MXB) + (size_t)NLAT * 1024))[c.tid] = (u32x4){0u, 0u, 0u, 0u};
}

DEVI u32x2 zsum3(const u32x2* z) { const u32x2 a = z[0], b = z[2048 * 256], d = z[2 * 2048 * 256]; u32x2 o;
    o.x = pk2(bflo(a.x) + bflo(b.x) + bflo(d.x), bfhi(a.x) + bfhi(b.x) + bfhi(d.x)); o.y = pk2(bflo(a.y) + bflo(b.y) + bflo(d.y), bfhi(a.y) + bfhi(b.y) + bfhi(d.y)); return o; }
DEVI void phase_final(const Ctx& c) {
    const float* xb = (const float*)(c.ws + WS_XB); const bf16_t* YB = (const bf16_t*)(c.ws + WS_MXB); const bf16_t* YB2 = (const bf16_t*)(c.ws + WS_YB2);
    const int* ts = (const int*)(c.ws + CTL_TOKSLOT); const float* tg = (const float*)(c.ws + CTL_TOPG);
    struct Sc { int s1, s2; float g1, g2; };
    struct Dt { u32x2 a[4], b[4], za[4], zb[4]; f32x4 x[4]; };
#define FIN_SC(sc, r) do { sc.s1 = ts[(r) * 2]; sc.s2 = ts[(r) * 2 + 1]; sc.g1 = tg[(r) * 2]; sc.g2 = tg[(r) * 2 + 1]; } while (0)
#define FIN_DT(dt, sc, r) do { const u32x2* y1_ = (const u32x2*)(YB + (size_t)sc.s1 * 1024) + c.lane; const u32x2* y2_ = (const u32x2*)(YB + (size_t)sc.s2 * 1024) + c.lane; \
        const u32x2* z1_ = (const u32x2*)(YB2 + (size_t)(sc.s1 >= 32768 ? sc.s1 - 32768 : 0) * 1024) + c.lane; const u32x2* z2_ = (const u32x2*)(YB2 + (size_t)(sc.s2 >= 32768 ? sc.s2 - 32768 : 0) * 1024) + c.lane; \
        const f32x4* xr_ = (const f32x4*)(xb + (size_t)(r) * 1024) + c.lane; \
        _Pragma("unroll") for (int j_ = 0; j_ < 4; ++j_) { dt.a[j_] = y1_[64 * j_]; dt.b[j_] = y2_[64 * j_]; dt.x[j_] = xr_[64 * j_]; \
            dt.za[j_] = sc.s1 >= 32768 ? zsum3(z1_ + 64 * j_) : (u32x2){0u, 0u}; dt.zb[j_] = sc.s2 >= 32768 ? zsum3(z2_ + 64 * j_) : (u32x2){0u, 0u}; } } while (0)
    int r = c.gw; if (r >= NLAT) return;
    Sc sc0, sc1, sc2; Dt d0, d1;
    FIN_SC(sc0, r); sc1 = sc0; sc2 = sc0;
    if (r + c.ngw < NLAT) FIN_SC(sc1, r + c.ngw);
    FIN_DT(d0, sc0, r); d1 = d0;
    for (; r < NLAT; r += c.ngw) {
        if (r + 2 * c.ngw < NLAT) FIN_SC(sc2, r + 2 * c.ngw);
        if (r + c.ngw < NLAT) FIN_DT(d1, sc1, r + c.ngw);
        const float g1 = sc0.g1, g2 = sc0.g2; const f32x4* gt = (const f32x4*)modv(c, 1, r, 5) + c.lane;
        f32x4 v[4]; float ss = 0.f;
#pragma unroll
        for (int j = 0; j < 4; ++j) { const u32x2 a = d0.a[j], b = d0.b[j], p = d0.za[j], q = d0.zb[j]; const f32x4 g = gt[64 * j]; f32x4 y;
            y.x = g1 * (bflo(a.x) + bflo(p.x)) + g2 * (bflo(b.x) + bflo(q.x)); y.y = g1 * (bfhi(a.x) + bfhi(p.x)) + g2 * (bfhi(b.x) + bfhi(q.x));
            y.z = g1 * (bflo(a.y) + bflo(p.y)) + g2 * (bflo(b.y) + bflo(q.y)); y.w = g1 * (bfhi(a.y) + bfhi(p.y)) + g2 * (bfhi(b.y) + bfhi(q.y));
            v[j] = d0.x[j] + g * y; ss += (v[j].x * v[j].x + v[j].y * v[j].y) + (v[j].z * v[j].z + v[j].w * v[j].w); }
        const float rstd = rsqrtf(wave_sum(ss) * (1.f / 1024.f) + EPS);
        const f32x4* fg = (const f32x4*)c.in[I_FNG] + c.lane; f32x4* o = (f32x4*)(c.out + (size_t)r * 1024) + c.lane;
#pragma unroll
        for (int j = 0; j < 4; ++j) o[64 * j] = v[j] * rstd * fg[64 * j];
        sc0 = sc1; sc1 = sc2; d0 = d1;
    }
#undef FIN_SC
#undef FIN_DT
}

#define LAS __attribute__((address_space(3)))
#define XB_TMO      128
#define XB_XCNT(j)  (256  + 64 * (j))
#define XB_XSUB(j)  (1280 + 64 * (j))
#define XB_XGEN(j)  (2304 + 64 * (j))
#define XB_TOP      3328
#define XB_TOPGEN   3392
#define XCD_BAR_WORDS 3456
#define XB_SPIN_CAP (1u << 18)

__device__ __forceinline__ unsigned xb_ld(unsigned* p)              { return __hip_atomic_load(p, __ATOMIC_RELAXED, __HIP_MEMORY_SCOPE_AGENT); }
__device__ __forceinline__ unsigned xb_add(unsigned* p, unsigned v) { return __hip_atomic_fetch_add(p, v, __ATOMIC_RELAXED, __HIP_MEMORY_SCOPE_AGENT); }
__device__ __forceinline__ unsigned xb_xcc_id() { return (unsigned)__builtin_amdgcn_s_getreg((3 << 11) | 20) & 0xFu; }
#define XB_SPIN(cond, bar) do { unsigned _sp = 0; while (cond) { __builtin_amdgcn_s_sleep(1); \
    if ((++_sp & 255u) == 0u) { if (xb_ld(&(bar)[XB_TMO])) break; if (_sp > XB_SPIN_CAP) { atomicAdd(&(bar)[XB_TMO], 1u); break; } } } } while (0)

struct XcdBarrier {
    unsigned* bar; unsigned x;
    volatile LAS unsigned* st;
};

__device__ __forceinline__ XcdBarrier xcd_barrier_post(unsigned* bar, volatile LAS unsigned* st) {
    XcdBarrier b; b.bar = bar; b.x = xb_xcc_id(); b.st = st;
    if (threadIdx.x == 0) (void)xb_add(&bar[XB_XCNT(b.x)], 1u);
    return b;
}
__device__ __forceinline__ void xcd_barrier_complete(unsigned* bar, unsigned x, unsigned& nloc, unsigned& nx) {
    const unsigned G = gridDim.x * gridDim.y * gridDim.z;
    unsigned sum, cnt, mine, sp = 0u;
    for (;;) {
        sum = 0u; cnt = 0u; mine = 0u;
#pragma unroll
        for (unsigned j = 0; j < 16; ++j) { const unsigned c = xb_ld(&bar[XB_XCNT(j)]); sum += c; cnt += (c > 0u) ? 1u : 0u; mine = (j == x) ? c : mine; }
        if (sum == G) break;
        __builtin_amdgcn_s_sleep(1);
        if ((++sp & 255u) == 0u) { if (xb_ld(&bar[XB_TMO])) break; if (sp > XB_SPIN_CAP) { atomicAdd(&bar[XB_TMO], 1u); break; } }
    }
    nloc = mine > 0u ? mine : 1u; nx = cnt > 0u ? cnt : 1u;
}

__device__ __forceinline__ void xcd_barrier(const XcdBarrier& b) {
    asm volatile("s_waitcnt vmcnt(0)" ::: "memory");
    __syncthreads();
    if (threadIdx.x == 0) {
        unsigned* bar = b.bar;
        __builtin_amdgcn_s_waitcnt(0);
        unsigned nloc = b.st[0], nx = b.st[1];
        if (nloc == 0u) { xcd_barrier_complete(bar, b.x, nloc, nx); b.st[0] = nloc; b.st[1] = nx; }
        const unsigned old = xb_add(&bar[XB_XSUB(b.x)], 1u);
        const unsigned gen = old / nloc;
        if (old + 1u == (gen + 1u) * nloc) {
            __builtin_amdgcn_fence(__ATOMIC_RELEASE, "agent");
            asm volatile("s_waitcnt vmcnt(0)" ::: "memory");
            const unsigned og = xb_add(&bar[XB_TOP], 1u);
            const unsigned tg = og / nx;
            if (og + 1u == (tg + 1u) * nx) xb_add(&bar[XB_TOPGEN], 1u);
            else XB_SPIN(xb_ld(&bar[XB_TOPGEN]) == tg, bar);
            __builtin_amdgcn_fence(__ATOMIC_ACQUIRE, "agent");
            xb_add(&bar[XB_XGEN(b.x)], 1u);
            asm volatile("s_waitcnt vmcnt(0)" ::: "memory");
        } else {
            XB_SPIN(xb_ld(&bar[XB_XGEN(b.x)]) == gen, bar);
            __builtin_amdgcn_fence(__ATOMIC_ACQUIRE, "agent");
            asm volatile("s_waitcnt vmcnt(0)" ::: "memory");
        }
    }
    __syncthreads();
}

#ifndef FAST_DN
#define FAST_DN 1
#endif
constexpr int NPHASES = 24;
#define IN(k) (lo <= (k) && (k) < hi)
#define SYNC(k) do { if (IN(k) && IN((k) + 1)) xcd_barrier(grid); } while (0)
template <int LAYER>
DEVI void mixer_phases(const Ctx& c, int lo, int hi, int psub, const XcdBarrier& grid) {
    constexpr int P = 1 + LAYER * 10;
    bf16_t* wl = (bf16_t*)(c.ws + WS_WL);
    const float* mvl = (const float*)(c.ws + CTL_MODV) + (size_t)LAYER * 5 * 6144;
    const float* xl = LAYER == 0 ? c.in[I_X] : (const float*)(c.ws + WS_XB); const float* xc = LAYER == 0 ? c.in[I_CTX] : (const float*)(c.ws + WS_XB) + (size_t)NLAT * 1024;
    if (IN(P)) { phase_norm<false>(c, LAYER, 0, c.in[I_N1G] + LAYER * 1024, NT, xl, xc, LAYER == 1 ? (const float*)(c.ws + WS_PB) : nullptr); } SYNC(P);
    if (IN(P + 1)) { const bf16_t* bt = (const bf16_t*)((char*)wl + WL_WIN) + (size_t)LAYER * ZP * 1024;
        pg8::Gemm g{(const bf16_t*)(c.ws + WS_H), bt, NT, ZP, 1024}; pg8::StaticOrder S; S.init(NT, ZP, (int)gridDim.x, (int)blockIdx.x);
        pg8::gemm_phase<pg8::EpiStore, pg8::StaticOrder, true, true>(c.lds3, g, S, pg8::EpiStore{(bf16_t*)(c.ws + WS_Z), ZP, 0, 0l}); } SYNC(P + 1);
    if (IN(P + 2)) { phase_prep(c, LAYER, LAYER == 0); } SYNC(P + 2);
#if FAST_DN
    if (IN(P + 3)) { if (!(psub & 1)) dn::phase_chunkprep(c); if (!(psub & 2)) phase_sgu(c, LAYER, LAYER == 0); } SYNC(P + 3);
    if (IN(P + 4)) { phase_mixer_fast<true>(c, LAYER == 0, psub); } SYNC(P + 4);
#else
    if (IN(P + 3)) { phase_sgu(c, LAYER, LAYER == 0); } SYNC(P + 3);
    if (IN(P + 4)) { phase_dnscan_naive(c); phase_mixer_fast<false>(c, LAYER == 0); } SYNC(P + 4);
#endif
    if (IN(P + 5)) { phase_dnfinish(c, LAYER, LAYER == 0 ? NT : NLAT); } SYNC(P + 5);
    if (IN(P + 6)) { const bf16_t* bt = (const bf16_t*)((char*)wl + WL_WOUT) + (size_t)LAYER * 1024 * 1024;
        constexpr int MR = LAYER == 0 ? NT : NLAT;
        pg8::Gemm g{(const bf16_t*)(c.ws + WS_MIX), bt, MR, 1024, 1024}; pg8::StaticOrder S; S.init(MR, 1024, (int)gridDim.x, (int)blockIdx.x);
        pg8::gemm_phase<pg8::EpiRes, pg8::StaticOrder, true, true>(c.lds3, g, S, pg8::EpiRes{(float*)(c.ws + WS_XB), mvl, 2, xl, xc, nullptr});
        if (LAYER == 0 && gridDim.x == 256 && blockIdx.x >= 16) phase_conv_m2(c, ((int)blockIdx.x - 16) * NWAVES + c.wave, 240 * NWAVES, 0, 4); } SYNC(P + 6);
}

__global__ void __launch_bounds__(NTHREADS, 2) mega_fwd(Args args) {
    extern __shared__ __attribute__((aligned(16))) unsigned char lds_raw[];
    Ctx c;
#pragma unroll
    for (int i = 0; i < 28; ++i) c.in[i] = args.in[i];
    c.out = args.out; c.ws = args.ws; c.tid = threadIdx.x; c.lane = c.tid & 63; c.wave = __builtin_amdgcn_readfirstlane(c.tid >> 6);
    c.gw = blockIdx.x * NWAVES + c.wave; c.ngw = gridDim.x * NWAVES; c.lds = (float*)lds_raw; c.lds3 = (__attribute__((address_space(3))) unsigned char*)lds_raw;
    bf16_t* wl = (bf16_t*)(c.ws + WS_WL);
    const int lo = args.ph_lo, hi = args.ph_hi;
    volatile LAS unsigned* bst = (volatile LAS unsigned*)(c.lds3 + LDS_BYTES - 64);
    if (c.tid < 16) bst[c.tid] = 0u;
    __syncthreads();
    const XcdBarrier grid = xcd_barrier_post((unsigned*)(c.ws + WS_CTL), bst);
    if (IN(0)) { phase_prologue(c); } SYNC(0);
    mixer_phases<0>(c, lo, hi, args.probe_sub, grid);
    {
        const float* mvl = (const float*)(c.ws + CTL_MODV);
        const float* xbl = (const float*)(c.ws + WS_XB); const float* xbc = xbl + (size_t)NLAT * 1024;
        if (IN(8)) { phase_norm<false>(c, 0, 3, c.in[I_N2G], NT, xbl, xbc); } SYNC(8);
        if (IN(9)) { pg8::Gemm g{(const bf16_t*)(c.ws + WS_H), (const bf16_t*)((char*)wl + WL_F13), NT, 2 * FF, 1024}; pg8::StaticOrder S; S.init(NT, 2 * FF, (int)gridDim.x, (int)blockIdx.x);
            pg8::gemm_phase<pg8::EpiSwi, pg8::StaticOrder, true, true>(c.lds3, g, S, pg8::EpiSwi{(bf16_t*)(c.ws + WS_Z), FF, 0});
            if (gridDim.x == 256 && blockIdx.x >= 216) phase_conv_m2(c, ((int)blockIdx.x - 216) * NWAVES + c.wave, 40 * NWAVES, 7, 8); } SYNC(9);
        if (IN(10)) { pg8::Gemm g{(const bf16_t*)(c.ws + WS_Z), (const bf16_t*)((char*)wl + WL_F2), NT, 1024, FF}; pg8::FfnDownOrder S; S.init((int)gridDim.x, (int)blockIdx.x);
            pg8::gemm_phase<pg8::EpiRes, pg8::FfnDownOrder, true, true>(c.lds3, g, S, pg8::EpiRes{(float*)(c.ws + WS_XB), mvl, 5, xbl, xbc, (float*)(c.ws + WS_PB)});
            if (gridDim.x == 256 && blockIdx.x >= 64) phase_conv_m2(c, ((int)blockIdx.x - 64) * NWAVES + c.wave, 192 * NWAVES, 4, 7); } SYNC(10);
    }
    mixer_phases<1>(c, lo, hi, args.probe_sub, grid);
    {
        if (IN(18)) { const float* xbl = (const float*)(c.ws + WS_XB);
            if (gridDim.x == 256) {
                {
                    f32x4* rwl = (f32x4*)(c.lds + 256);
                    for (int idx = c.tid; idx < 2048; idx += NTHREADS) { const int ln = idx & 63, hf = (idx >> 6) & 1, jq = idx >> 7, col = 4 * ln + 256 * (jq >> 2) + (jq & 3);
                        rwl[idx] = *(const f32x4*)(c.in[I_RW] + col * 8 + 4 * hf); }
                    __syncthreads(); }
                if (c.wave < 4) norm_router_rows16(c, c.in[I_N2G] + 1024, xbl, (const f32x4*)(c.lds + 256), (int*)c.lds);
                else { phase_conv_m13(c, (int)blockIdx.x * 4 + (c.wave - 4), 1024); }
                __syncthreads();
                if (c.tid < 8) { const int* sel = (const int*)c.lds; int n = 0; for (int q = 0; q < 128; ++q) n += (sel[q] == c.tid) ? 1 : 0; ((int*)(c.ws + CTL_CNT))[blockIdx.x * 8 + c.tid] = n; }
            } else { phase_norm<true>(c, 1, 3, c.in[I_N2G] + 1024, NLAT, xbl, xbl + (size_t)NLAT * 1024); phase_conv_m13(c); phase_conv_m2(c); } } SYNC(18);
        if (IN(19)) { phase_moe_assign(c); } SYNC(19);
        if (IN(20)) { pg8::Gemm g{(const bf16_t*)(c.ws + WS_MXB), (const bf16_t*)(c.ws + WS_M13), 0, 0, 1024, (const unsigned*)(c.ws + CTL_ROWTAB)}; pg8::MoeOrder S; S.init((const int*)(c.ws + CTL_SEG), 28, (int)gridDim.x, (int)blockIdx.x);
            pg8::gemm_phase<pg8::EpiSwi, pg8::MoeOrder, true, true, true>(c.lds3, g, S, pg8::EpiSwi{(bf16_t*)(c.ws + WS_MHID), MFF, 28}); } SYNC(20);
        if (IN(22)) { pg8::Gemm g{(const bf16_t*)(c.ws + WS_MHID), (const bf16_t*)c.out, 0, 0, MFF}; pg8::TableOrder S; S.init((const int*)(c.ws + CTL_UTAB), (int)gridDim.x, (int)blockIdx.x);
            pg8::gemm_phase<pg8::EpiStore, pg8::TableOrder, true, true>(c.lds3, g, S, pg8::EpiStore{(bf16_t*)(c.ws + WS_MXB), 1024, 4, (long)((WS_YB2 - WS_MXB) / 2) - 32768l * 1024}); } SYNC(22);
        if (IN(23)) { phase_final(c); }
    }
}
#undef IN
#undef SYNC

extern "C" void kernel_launch(void* const* d_in, const int* in_sizes, int n_in, void* d_out, int out_size, void* d_ws, size_t ws_size, hipStream_t stream) {
    static int grid = 0;
    if (grid == 0) {
        if (n_in != 28 || out_size != NLAT * D || ws_size < WS_END) { fprintf(stderr, "kernel_launch: unexpected shapes (n_in %d out %d ws %zu)\n", n_in, out_size, ws_size); grid = -1; return; }
        int dev = 0, cus = 0, per_cu = 0;
        hipGetDevice(&dev); hipDeviceGetAttribute(&cus, hipDeviceAttributeMultiprocessorCount, dev);
        hipFuncSetAttribute((const void*)mega_fwd, hipFuncAttributeMaxDynamicSharedMemorySize, LDS_BYTES);
        hipOccupancyMaxActiveBlocksPerMultiprocessor(&per_cu, (const void*)mega_fwd, NTHREADS, LDS_BYTES);
        if (per_cu < 1) { fprintf(stderr, "kernel_launch: occupancy query says %d blocks per CU\n", per_cu); per_cu = 1; }
        (void)hipGetLastError();
        grid = cus;
    }
    if (grid < 0) return;
    if (hipMemsetAsync(d_ws, 0, 16384, stream) != hipSuccess) { fprintf(stderr, "kernel_launch: memset of the barrier words failed\n"); return; }
    Args a{};
    for (int i = 0; i < 28; ++i) a.in[i] = (const float*)d_in[i];
    a.out = (float*)d_out; a.ws = (unsigned char*)d_ws;
#ifndef MK_PER_PHASE
#define MK_PER_PHASE 0
#endif
#if MK_PER_PHASE
    for (int ph = 0; ph < NPHASES; ++ph) {
        a.ph_lo = ph; a.ph_hi = ph + 1; void* kargs[] = {&a};
        hipError_t e = hipLaunchCooperativeKernel((const void*)mega_fwd, dim3(grid), dim3(NTHREADS), kargs, LDS_BYTES, stream);
        if (e != hipSuccess) { fprintf(stderr, "launch failed: %s\n", hipGetErrorString(e)); break; }
    }
#else
    a.ph_lo = 0; a.ph_hi = NPHASES; void* kargs[] = {&a};
    hipError_t e = hipLaunchCooperativeKernel((const void*)mega_fwd, dim3(grid), dim3(NTHREADS), kargs, LDS_BYTES, stream);
    if (e != hipSuccess) fprintf(stderr, "launch failed: %s\n", hipGetErrorString(e));
#ifndef PROBE_LO
#define PROBE_LO -1
#define PROBE_HI -1
#endif
#if PROBE_LO >= 0
    (void)hipMemsetAsync(d_ws, 0, 16384, stream);
    a.ph_lo = PROBE_LO; a.ph_hi = PROBE_HI;
#ifdef PROBE_SUB
    a.probe_sub = PROBE_SUB;
#endif
    e = hipLaunchCooperativeKernel((const void*)mega_fwd, dim3(grid), dim3(NTHREADS), kargs, LDS_BYTES, stream);
    if (e != hipSuccess) fprintf(stderr, "probe launch failed: %s\n", hipGetErrorString(e));
#endif
#endif
}
```
